# Optimizing an MI355X kernel written in HIP

```python
import math
import jax, jax.numpy as jnp
from jax import lax
import numpy as np

D_MODEL = 1024
BATCH = 2
SEQ = 8192
DEPTH = 1

N_META = 16
GRID_W = 64
N_HEADS = 8
N_KV_HEADS = 2
HEAD_DIM = 64
Q_BLOCK = 128
ROPE_THETA = 10000.0
ATTN_WIDTH = N_HEADS * HEAD_DIM
KV_WIDTH = N_KV_HEADS * HEAD_DIM
SSM_WIDTH = D_MODEL // 2
SSM_GROUP = 16
SSM_GROUPS = SSM_WIDTH // SSM_GROUP
SSM_STATE = 64
DT_MIN = 1e-3
DT_MAX = 1e-1
N_EXPERTS = 16
EXPERT_FF = D_MODEL
CAPACITY_FACTOR = 2
IN_WIDTH = ATTN_WIDTH + 2 * KV_WIDTH + SSM_WIDTH + 2 * D_MODEL
SPLITS = (ATTN_WIDTH,
          ATTN_WIDTH + KV_WIDTH,
          ATTN_WIDTH + 2 * KV_WIDTH,
          ATTN_WIDTH + 2 * KV_WIDTH + SSM_WIDTH,
          ATTN_WIDTH + 2 * KV_WIDTH + SSM_WIDTH + D_MODEL)
DEEPNORM_ALPHA = (2.0 * DEPTH) ** 0.25
DEEPNORM_BETA = (8.0 * DEPTH) ** -0.25
LN_EPS = 1e-5
QK_EPS = 1e-6

kernel_name = "hybrid_gqa_s5_ecmoe_encoder"


def layer_norm(x, g, b):
    xf = x.astype(jnp.float32)
    mu = jnp.mean(xf, axis=-1, keepdims=True)
    var = jnp.mean(jnp.square(xf - mu), axis=-1, keepdims=True)
    y = (xf - mu) * lax.rsqrt(var + LN_EPS) * g.astype(jnp.float32) + b.astype(jnp.float32)
    return y.astype(x.dtype)


def rms_norm(x, g):
    xf = x.astype(jnp.float32)
    y = xf * lax.rsqrt(jnp.mean(jnp.square(xf), axis=-1, keepdims=True) + QK_EPS)
    return (y * g.astype(jnp.float32)).astype(x.dtype)


def axial_rope_angles(n_tokens):
    rows = n_tokens // GRID_W
    half = HEAD_DIM // 2
    inv_freq = ROPE_THETA ** (-jnp.arange(0, half, 2, dtype=jnp.float32) / half)
    row = jnp.repeat(jnp.arange(rows, dtype=jnp.float32), GRID_W)
    col = jnp.tile(jnp.arange(GRID_W, dtype=jnp.float32), rows)
    ang = jnp.concatenate([row[:, None] * inv_freq, col[:, None] * inv_freq], axis=-1)
    return jnp.concatenate([jnp.zeros((N_META, half), jnp.float32), ang], axis=0)


def apply_rope(x, cos, sin):
    xf = x.astype(jnp.float32).reshape(x.shape[:-1] + (HEAD_DIM // 2, 2))
    x0, x1 = xf[..., 0], xf[..., 1]
    c = cos[None, :, None, :]
    s = sin[None, :, None, :]
    out = jnp.stack([x0 * c - x1 * s, x0 * s + x1 * c], axis=-1)
    return out.reshape(x.shape).astype(x.dtype)


def block_attention(q, k, v):
    b_, l_ = q.shape[0], q.shape[1]
    n_blocks = -(-l_ // Q_BLOCK)
    lp = n_blocks * Q_BLOCK
    grp = N_HEADS // N_KV_HEADS
    qg = q.reshape(b_, l_, N_KV_HEADS, grp, HEAD_DIM)
    qg = jnp.pad(qg, ((0, 0), (0, lp - l_), (0, 0), (0, 0), (0, 0)))
    qb = qg.reshape(b_, n_blocks, Q_BLOCK, N_KV_HEADS, grp, HEAD_DIM).transpose(1, 0, 2, 3, 4, 5)
    scale = HEAD_DIM ** -0.5

    def one_block(qblk):
        s = jnp.einsum('bqkgd,bskd->bkgqs', qblk, k, preferred_element_type=jnp.float32) * scale
        p = jax.nn.softmax(s, axis=-1).astype(v.dtype)
        return jnp.einsum('bkgqs,bskd->bqkgd', p, v)

    ob = lax.map(one_block, qb)
    return ob.transpose(1, 0, 2, 3, 4, 5).reshape(b_, lp, ATTN_WIDTH)[:, :l_]


def zoh_discretise(a_re, a_im, log_dt, b_re, b_im):
    dt = jnp.exp(log_dt.astype(jnp.float32))[:, None]
    ar = a_re.astype(jnp.float32)
    ai = a_im.astype(jnp.float32)
    mag = jnp.exp(ar * dt)
    ang = ai * dt
    abar_re = mag * jnp.cos(ang)
    abar_im = mag * jnp.sin(ang)
    nr = abar_re - 1.0
    ni = abar_im
    den = ar * ar + ai * ai
    coef_re = (nr * ar + ni * ai) / den
    coef_im = (ni * ar - nr * ai) / den
    br = b_re.astype(jnp.float32)
    bi = b_im.astype(jnp.float32)
    bbar_re = coef_re[..., None] * br - coef_im[..., None] * bi
    bbar_im = coef_re[..., None] * bi + coef_im[..., None] * br
    return abar_re, abar_im, bbar_re, bbar_im


def complex_linear_scan(abar_re, abar_im, bu_re, bu_im):
    l_ = bu_re.shape[0]
    a_re = jnp.broadcast_to(abar_re, (l_,) + abar_re.shape)
    a_im = jnp.broadcast_to(abar_im, (l_,) + abar_im.shape)

    def combine(e1, e2):
        a1r, a1i, b1r, b1i = e1
        a2r, a2i, b2r, b2i = e2
        ar = a2r * a1r - a2i * a1i
        ai = a2r * a1i + a2i * a1r
        a2r_b = a2r[:, None]
        a2i_b = a2i[:, None]
        br = a2r_b * b1r - a2i_b * b1i + b2r
        bi = a2r_b * b1i + a2i_b * b1r + b2i
        return ar, ai, br, bi

    _, _, s_re, s_im = lax.associative_scan(combine, (a_re, a_im, bu_re, bu_im), axis=0)
    return s_re, s_im


def s5_branch(u, a_re, a_im, log_dt, b_re, b_im, c_re, c_im, d, w_glu, b_glu):
    b_, l_ = u.shape[0], u.shape[1]
    ug = u.reshape(b_, l_, SSM_GROUPS, SSM_GROUP).astype(jnp.float32)
    y = d.astype(jnp.float32) * ug
    for direction in range(2):
        abr, abi, bbr, bbi = zoh_discretise(a_re[direction], a_im[direction], log_dt[direction],
                                            b_re[direction], b_im[direction])
        src = ug if direction == 0 else jnp.flip(ug, axis=1)
        bu_re = jnp.einsum('blgh,gph->lbgp', src, bbr)
        bu_im = jnp.einsum('blgh,gph->lbgp', src, bbi)
        s_re, s_im = complex_linear_scan(abr, abi, bu_re, bu_im)
        yd = (jnp.einsum('lbgp,ghp->blgh', s_re, c_re[direction].astype(jnp.float32))
              - jnp.einsum('lbgp,ghp->blgh', s_im, c_im[direction].astype(jnp.float32)))
        if direction == 1:
            yd = jnp.flip(yd, axis=1)
        y = y + yd
    y = jax.nn.gelu(y.reshape(b_, l_, SSM_WIDTH))
    y = y * jax.nn.sigmoid(y @ w_glu.astype(jnp.float32) + b_glu.astype(jnp.float32))
    return y.astype(u.dtype)


def expert_choice_moe(t, w_router, w_gate, w_up, w_down):
    b_, s_, d_ = t.shape
    cap = CAPACITY_FACTOR * s_ // N_EXPERTS
    logits = jnp.einsum('bsd,de->bes', t, w_router, preferred_element_type=jnp.float32)
    affinity = jax.nn.softmax(logits, axis=1)
    gate, idx = lax.top_k(affinity, cap)
    xe = jax.vmap(lambda tb, ib: tb[ib])(t, idx)
    h = (jax.nn.silu(jnp.einsum('becd,edf->becf', xe, w_gate))
         * jnp.einsum('becd,edf->becf', xe, w_up))
    ye = jnp.einsum('becf,efd->becd', h, w_down) * gate[..., None].astype(t.dtype)
    out = jax.vmap(lambda ib, yb: jnp.zeros((s_, d_), t.dtype).at[ib.reshape(-1)].add(
        yb.reshape(-1, d_)))(idx, ye)
    return out


def setup_inputs(seed: int = 0) -> dict:
    key = jax.random.key(seed)
    ks = jax.random.split(key, 32)
    f32 = jnp.float32
    n = lambda k, shape: jax.random.normal(k, shape, f32)
    P = SSM_STATE
    G = SSM_GROUPS
    H = SSM_GROUP
    a_im_init = math.pi * jnp.arange(P, dtype=f32)
    return {
        "x": n(ks[0], (BATCH, SEQ, D_MODEL)),
        "meta_tokens": n(ks[1], (N_META, D_MODEL)),
        "ln_in_g": 1.0 + 0.02 * n(ks[2], (D_MODEL,)),
        "ln_in_b": 0.02 * n(ks[3], (D_MODEL,)),
        "w_in": n(ks[4], (DEPTH, D_MODEL, IN_WIDTH)) * D_MODEL ** -0.5,
        "q_norm_g": 1.0 + 0.02 * n(ks[5], (DEPTH, HEAD_DIM)),
        "k_norm_g": 1.0 + 0.02 * n(ks[6], (DEPTH, HEAD_DIM)),
        "ssm_a_re": -0.5 + 0.01 * n(ks[7], (DEPTH, 2, G, P)),
        "ssm_a_im": a_im_init + 0.01 * n(ks[8], (DEPTH, 2, G, P)),
        "ssm_log_dt": jax.random.uniform(ks[9], (DEPTH, 2, G), f32,
                                         math.log(DT_MIN), math.log(DT_MAX)),
        "ssm_b_re": n(ks[10], (DEPTH, 2, G, P, H)) * (2 * H) ** -0.5,
        "ssm_b_im": n(ks[11], (DEPTH, 2, G, P, H)) * (2 * H) ** -0.5,
        "ssm_c_re": n(ks[12], (DEPTH, 2, G, H, P)) * P ** -0.5,
        "ssm_c_im": n(ks[13], (DEPTH, 2, G, H, P)) * P ** -0.5,
        "ssm_d": n(ks[14], (DEPTH, G, H)),
        "w_glu": n(ks[15], (DEPTH, SSM_WIDTH, SSM_WIDTH)) * SSM_WIDTH ** -0.5,
        "b_glu": 0.02 * n(ks[16], (DEPTH, SSM_WIDTH)),
        "w_attn_br": n(ks[17], (DEPTH, ATTN_WIDTH, D_MODEL)) * ATTN_WIDTH ** -0.5,
        "w_ssm_br": n(ks[18], (DEPTH, SSM_WIDTH, D_MODEL)) * SSM_WIDTH ** -0.5,
        "w_o": n(ks[19], (DEPTH, D_MODEL, D_MODEL)) * D_MODEL ** -0.5 * DEEPNORM_BETA,
        "ln1_g": 1.0 + 0.02 * n(ks[20], (DEPTH, D_MODEL)),
        "ln1_b": 0.02 * n(ks[21], (DEPTH, D_MODEL)),
        "w_router": n(ks[22], (DEPTH, D_MODEL, N_EXPERTS)) * D_MODEL ** -0.5,
        "w_gate_e": n(ks[23], (DEPTH, N_EXPERTS, D_MODEL, EXPERT_FF)) * D_MODEL ** -0.5,
        "w_up_e": n(ks[24], (DEPTH, N_EXPERTS, D_MODEL, EXPERT_FF)) * D_MODEL ** -0.5,
        "w_down_e": n(ks[25], (DEPTH, N_EXPERTS, EXPERT_FF, D_MODEL)) * EXPERT_FF ** -0.5 * DEEPNORM_BETA,
        "ln2_g": 1.0 + 0.02 * n(ks[26], (DEPTH, D_MODEL)),
        "ln2_b": 0.02 * n(ks[27], (DEPTH, D_MODEL)),
    }


def reference(x, meta_tokens, ln_in_g, ln_in_b, w_in, q_norm_g, k_norm_g,
              ssm_a_re, ssm_a_im, ssm_log_dt, ssm_b_re, ssm_b_im, ssm_c_re, ssm_c_im,
              ssm_d, w_glu, b_glu, w_attn_br, w_ssm_br, w_o, ln1_g, ln1_b,
              w_router, w_gate_e, w_up_e, w_down_e, ln2_g, ln2_b):
    b_, s_, d_ = x.shape
    l_ = s_ + N_META
    meta = jnp.broadcast_to(meta_tokens.astype(x.dtype)[None], (b_, N_META, d_))
    h = layer_norm(jnp.concatenate([meta, x], axis=1), ln_in_g, ln_in_b)
    ang = axial_rope_angles(s_)
    cos, sin = jnp.cos(ang), jnp.sin(ang)
    for l in range(DEPTH):
        proj = h @ w_in[l]
        q, k, v, u, g_attn, g_ssm = jnp.split(proj, SPLITS, axis=-1)
        q = apply_rope(rms_norm(q.reshape(b_, l_, N_HEADS, HEAD_DIM), q_norm_g[l]), cos, sin)
        k = apply_rope(rms_norm(k.reshape(b_, l_, N_KV_HEADS, HEAD_DIM), k_norm_g[l]), cos, sin)
        v = v.reshape(b_, l_, N_KV_HEADS, HEAD_DIM)
        y_attn = block_attention(q, k, v)
        y_ssm = s5_branch(u, ssm_a_re[l], ssm_a_im[l], ssm_log_dt[l], ssm_b_re[l], ssm_b_im[l],
                          ssm_c_re[l], ssm_c_im[l], ssm_d[l], w_glu[l], b_glu[l])
        merged = (jax.nn.sigmoid(g_attn) * (y_attn @ w_attn_br[l])
                  + jax.nn.sigmoid(g_ssm) * (y_ssm @ w_ssm_br[l]))
        h = layer_norm(DEEPNORM_ALPHA * h + merged @ w_o[l], ln1_g[l], ln1_b[l])
        moe = expert_choice_moe(h[:, N_META:], w_router[l], w_gate_e[l], w_up_e[l], w_down_e[l])
        moe = jnp.concatenate([jnp.zeros((b_, N_META, d_), h.dtype), moe], axis=1)
        h = layer_norm(DEEPNORM_ALPHA * h + moe, ln2_g[l], ln2_b[l])
    return h[:, N_META:]
```

```cpp
#include <hip/hip_runtime.h>
#include <cstdio>
#include <cstdint>
#include <cstring>
namespace pg8 {
#define PG8_LAS __attribute__((address_space(3)))
typedef unsigned short bf16_t;
typedef short bf16x8 __attribute__((ext_vector_type(8)));
typedef float f32x4 __attribute__((ext_vector_type(4)));
typedef unsigned u32x4 __attribute__((ext_vector_type(4)));
constexpr int BM = 256, BK = 64, HALF = 128, HTB = HALF * BK * 2  , STAGE_BYTES = 8 * HTB, NXCD = 8, WGM = 8;

__host__ __device__ __forceinline__ int lds_byte(int r, int c) { const int st = (r >> 4) * 2 + (c >> 5), rr = r & 15, cc = c & 31, ob = rr * 64 + cc * 2; return st * 1024 + (ob ^ (((ob >> 9) & 1) << 5)); }
__host__ __device__ __forceinline__ void stage_rc(int b, int& R, int& C) { const int st = b / 1024, sb = b % 1024, swz = sb ^ (((sb >> 9) & 1) << 5); R = (st >> 1) * 16 + swz / 64; C = (st & 1) * 32 + (swz % 64) / 2; }
__host__ __device__ __forceinline__ int perm32(int rho) { const int n = rho >> 4, i = rho & 15; return 8 * (i >> 2) + 4 * n + (i & 3); }

struct Unit { int pm, pn; };
struct Gemm { const bf16_t* A; const bf16_t* Bt; int lda, ldb, K; };

struct StaticOrder {
    int nM, nN, nwg, G, c;
    __host__ __device__ void init(int M, int N, int G_, int c_) { nM = M / BM; nN = N / BM; nwg = nM * nN; G = G_; c = c_; }
    __host__ __device__ bool next(int i, Unit& u) const {
        const long L = (long)i * G + c; if (L >= nwg) return false;
        int wgid = (int)L; { const int q = nwg / NXCD, r = nwg % NXCD, xcd = wgid % NXCD, off = wgid / NXCD; wgid = (xcd < r ? xcd * (q + 1) : r * (q + 1) + (xcd - r) * q) + off; }
        const int nig = WGM * nN, gid = wgid / nig, fm = gid * WGM, gsz = (nM - fm) < WGM ? (nM - fm) : WGM;
        u.pm = fm + ((wgid % nig) % gsz); u.pn = (wgid % nig) / gsz; return true;
    }
    __device__ __forceinline__ void a_ready(const Unit&) const {}
    __device__ __forceinline__ void done(const Unit&) const {}
};

__device__ __forceinline__ unsigned cvt_pk_bf16(float lo, float hi) { unsigned r; asm volatile("v_cvt_pk_bf16_f32 %0, %1, %2" : "=v"(r) : "v"(lo), "v"(hi)); return r; }
typedef float f32x2 __attribute__((ext_vector_type(2)));
template <class Epi, class Sched, bool ALIGN_EPI = false, bool SP2 = false>
__device__ __forceinline__ void gemm_phase(PG8_LAS unsigned char* lds, const Gemm g, const Sched& S, const Epi& E) {
    const int tid = threadIdx.x, wid = __builtin_amdgcn_readfirstlane(tid >> 6), lane = tid & 63, wr = wid >> 2, wc = wid & 3, fr = lane & 15, fq = lane >> 4;
    const int K = g.K, nt = K / BK;
    unsigned voffA[2], voffB[2];
#pragma unroll
    for (int i = 0; i < 2; ++i) { int R, C; stage_rc(tid * 16 + i * 8192, R, C); const int Rb = Epi::PERM ? ((R & ~31) + perm32(R & 31)) : R;
        voffA[i] = (unsigned)(R * g.lda + C) * 2u; voffB[i] = (unsigned)(Rb * g.ldb + C) * 2u; }
    const size_t kstep = (size_t)(BK * 2);
    const size_t hstepA = (size_t)HALF * g.lda * 2, hstepB = (size_t)HALF * g.ldb * 2;
    const size_t tstepA = 2 * hstepA, tstepB = 2 * hstepB;
    const unsigned ldsw = (unsigned)wid * 1024u;
    const int aoff = lds_byte(wr * 64 + fr, fq * 8), boff = lds_byte(wc * 32 + fr, fq * 8);
#define PG8_SA(b, h) (((b) * 2 + (h)) * HTB)
#define PG8_SB(b, h) ((4 + (b) * 2 + (h)) * HTB)
#define PG8_STAGE(bufoff, gbase, voff) do { _Pragma("unroll") for (int _i = 0; _i < 2; ++_i) \
        __builtin_amdgcn_global_load_lds((const unsigned*)((const char*)(gbase) + (voff)[_i]), (PG8_LAS unsigned*)(lds + (bufoff) + ldsw + _i * 8192), 16, 0, 0); } while (0)
#define PG8_LDA(dst, b, h) do { _Pragma("unroll") for (int m = 0; m < 4; ++m) _Pragma("unroll") for (int k = 0; k < 2; ++k) dst[m][k] = *(const PG8_LAS bf16x8*)(lds + PG8_SA(b, h) + aoff + m * 2048 + k * 1024); } while (0)
#define PG8_LDB(dst, b, h) do { _Pragma("unroll") for (int n = 0; n < 2; ++n) _Pragma("unroll") for (int k = 0; k < 2; ++k) dst[n][k] = *(const PG8_LAS bf16x8*)(lds + PG8_SB(b, h) + boff + n * 2048 + k * 1024); } while (0)
#define PG8_MMA(ai, bj, At, Bt) do { __builtin_amdgcn_s_setprio(1); _Pragma("unroll") for (int m = 0; m < 4; ++m) _Pragma("unroll") for (int n = 0; n < 2; ++n) _Pragma("unroll") for (int k = 0; k < 2; ++k) \
        acc[ai][bj][m][n] = __builtin_amdgcn_mfma_f32_16x16x32_bf16(Bt[n][k], At[m][k], acc[ai][bj][m][n], 0, 0, 0); __builtin_amdgcn_s_setprio(0); } while (0)
#define PG8_WAIT_V(n) asm volatile("s_waitcnt vmcnt(" #n ")" ::: "memory")
#define PG8_WAIT_L(n) asm volatile("s_waitcnt lgkmcnt(" #n ")" ::: "memory")
#define PG8_BAR __builtin_amdgcn_s_barrier()
#define PG8_SCHED __builtin_amdgcn_sched_barrier(0)
    Unit cur, nxt; int ui = 0;
    if (!S.next(0, cur)) return;
    f32x4 acc[2][2][4][2];
#pragma unroll
    for (int a = 0; a < 2; ++a)
#pragma unroll
        for (int b = 0; b < 2; ++b)
#pragma unroll
            for (int m = 0; m < 4; ++m)
#pragma unroll
                for (int n = 0; n < 2; ++n) acc[a][b][m][n] = (f32x4){0.f, 0.f, 0.f, 0.f};
    bf16x8 At[4][2], B0[2][2], B1[2][2];
    const char* cA = (const char*)g.A + (size_t)cur.pm * tstepA; const char* cB = (const char*)g.Bt + (size_t)cur.pn * tstepB;
    S.a_ready(cur);
    if constexpr (SP2) {
        PG8_STAGE(PG8_SB(0, 0), cB, voffB); PG8_STAGE(PG8_SB(0, 1), cB + hstepB, voffB); PG8_STAGE(PG8_SA(0, 0), cA, voffA); PG8_STAGE(PG8_SA(0, 1), cA + hstepA, voffA);
        if (wr == 1) PG8_BAR;
        PG8_WAIT_V(2); PG8_BAR;
        PG8_STAGE(PG8_SB(1, 0), cB + kstep, voffB); PG8_STAGE(PG8_SA(1, 0), cA + kstep, voffA); PG8_STAGE(PG8_SB(1, 1), cB + hstepB + kstep, voffB);
        PG8_WAIT_V(6); PG8_BAR;
    } else {
        PG8_STAGE(PG8_SB(0, 0), cB, voffB); PG8_STAGE(PG8_SA(0, 0), cA, voffA); PG8_STAGE(PG8_SB(0, 1), cB + hstepB, voffB); PG8_STAGE(PG8_SA(0, 1), cA + hstepA, voffA);
        if (wr == 1) PG8_BAR;
        PG8_WAIT_V(4); PG8_BAR;
        PG8_STAGE(PG8_SB(1, 0), cB + kstep, voffB); PG8_STAGE(PG8_SA(1, 0), cA + kstep, voffA); PG8_STAGE(PG8_SB(1, 1), cB + hstepB + kstep, voffB);
        PG8_WAIT_V(6); PG8_BAR;
    }
    for (;;) {
        const bool has_next = S.next(ui + 1, nxt);
        const char* nA = has_next ? (const char*)g.A + (size_t)nxt.pm * tstepA : cA; const char* nB = has_next ? (const char*)g.Bt + (size_t)nxt.pn * tstepB : cB;
        for (int t = 0; t < nt; t += 2) {
            const bool last = (t == nt - 2);
            const char* a1 = cA + (size_t)(t + 1) * kstep;
            const char* a2 = last ? nA : cA + (size_t)(t + 2) * kstep; const char* b2 = last ? nB : cB + (size_t)(t + 2) * kstep;
            const char* a3 = a2 + kstep; const char* b3 = b2 + kstep;
            if (last && has_next) S.a_ready(nxt);
            if constexpr (SP2) {
            PG8_LDB(B0, 0, 0); PG8_LDB(B1, 0, 1); PG8_SCHED; PG8_LDA(At, 0, 0); PG8_STAGE(PG8_SA(1, 1), a1 + hstepA, voffA);
            PG8_WAIT_V(8); PG8_WAIT_L(0); PG8_BAR; PG8_MMA(0, 0, At, B0); PG8_MMA(0, 1, At, B1); PG8_BAR; PG8_SCHED;
            PG8_LDA(At, 0, 1); PG8_STAGE(PG8_SB(0, 0), b2, voffB); PG8_STAGE(PG8_SB(0, 1), b2 + hstepB, voffB); PG8_STAGE(PG8_SA(0, 0), a2, voffA);
            PG8_WAIT_V(8); PG8_WAIT_L(0); PG8_BAR; PG8_MMA(1, 0, At, B0); PG8_MMA(1, 1, At, B1); PG8_BAR; PG8_SCHED;
            PG8_LDB(B0, 1, 0); PG8_LDB(B1, 1, 1); PG8_SCHED; PG8_LDA(At, 1, 0); PG8_STAGE(PG8_SA(0, 1), a2 + hstepA, voffA);
            PG8_WAIT_V(8); PG8_WAIT_L(0); PG8_BAR; PG8_MMA(0, 0, At, B0); PG8_MMA(0, 1, At, B1); PG8_BAR; PG8_SCHED;
            PG8_LDA(At, 1, 1); PG8_STAGE(PG8_SB(1, 0), b3, voffB); PG8_STAGE(PG8_SB(1, 1), b3 + hstepB, voffB); PG8_STAGE(PG8_SA(1, 0), a3, voffA);
            PG8_WAIT_V(8); PG8_WAIT_L(0); PG8_BAR; PG8_MMA(1, 0, At, B0); PG8_MMA(1, 1, At, B1); PG8_BAR; PG8_SCHED;
            } else {
            PG8_LDB(B0, 0, 0); PG8_SCHED; PG8_LDA(At, 0, 0); PG8_STAGE(PG8_SA(1, 1), a1 + hstepA, voffA);
            PG8_WAIT_L(8); PG8_BAR; PG8_WAIT_L(0); PG8_MMA(0, 0, At, B0); PG8_BAR; PG8_SCHED;
            PG8_LDB(B1, 0, 1); PG8_STAGE(PG8_SB(0, 0), b2, voffB);
            PG8_BAR; PG8_WAIT_L(0); PG8_MMA(0, 1, At, B1); PG8_BAR;
            PG8_LDA(At, 0, 1); PG8_STAGE(PG8_SA(0, 0), a2, voffA);
            PG8_BAR; PG8_WAIT_L(0); PG8_MMA(1, 0, At, B0); PG8_BAR; PG8_SCHED;
            PG8_STAGE(PG8_SB(0, 1), b2 + hstepB, voffB);
            PG8_WAIT_V(6); PG8_BAR; PG8_MMA(1, 1, At, B1); PG8_BAR;
            PG8_LDB(B0, 1, 0); PG8_SCHED; PG8_LDA(At, 1, 0); PG8_STAGE(PG8_SA(0, 1), a2 + hstepA, voffA);
            PG8_WAIT_L(8); PG8_BAR; PG8_WAIT_L(0); PG8_MMA(0, 0, At, B0); PG8_BAR; PG8_SCHED;
            PG8_LDB(B1, 1, 1); PG8_STAGE(PG8_SB(1, 0), b3, voffB);
            PG8_BAR; PG8_WAIT_L(0); PG8_MMA(0, 1, At, B1); PG8_BAR;
            PG8_LDA(At, 1, 1); PG8_STAGE(PG8_SA(1, 0), a3, voffA);
            PG8_BAR; PG8_WAIT_L(0); PG8_MMA(1, 0, At, B0); PG8_BAR; PG8_SCHED;
            PG8_STAGE(PG8_SB(1, 1), b3 + hstepB, voffB);
            PG8_WAIT_V(6); PG8_BAR; PG8_MMA(1, 1, At, B1); PG8_BAR;
            }
        }
        if constexpr (ALIGN_EPI) { if (wr == 0) PG8_BAR; }
        if constexpr (!Epi::AFTER_DRAIN) { E(acc, cur, wr, wc, fr, fq); S.done(cur); }
        if (!has_next) break;
#pragma unroll
        for (int a = 0; a < 2; ++a)
#pragma unroll
            for (int b = 0; b < 2; ++b)
#pragma unroll
                for (int m = 0; m < 4; ++m)
#pragma unroll
                    for (int n = 0; n < 2; ++n) acc[a][b][m][n] = (f32x4){0.f, 0.f, 0.f, 0.f};
        cur = nxt; cA = nA; cB = nB; ++ui;
        if constexpr (ALIGN_EPI) { if (wr == 1) PG8_BAR; }
    }
    PG8_WAIT_V(0);
    if constexpr (!ALIGN_EPI) { if (wr == 0) PG8_BAR; }
    PG8_BAR;
    if constexpr (Epi::AFTER_DRAIN) { E.fused(acc, cur, wr, wc, fr, fq, lds, wid, lane); S.done(cur); }
#undef PG8_SA
#undef PG8_SB
#undef PG8_STAGE
#undef PG8_LDA
#undef PG8_LDB
#undef PG8_MMA
#undef PG8_WAIT_V
#undef PG8_WAIT_L
#undef PG8_BAR
#undef PG8_SCHED
}
}
#define PG8_SP2 true
#define PG8_ALIGN true
#include <hip/hip_bf16.h>
#include <cmath>
namespace attn_body {
using bf16=__hip_bfloat16;
using bf16x8=__attribute__((ext_vector_type(8)))short;
using s16x4=__attribute__((ext_vector_type(4)))short;
using f32x16=__attribute__((ext_vector_type(16)))float;
using u32x4=__attribute__((ext_vector_type(4)))unsigned;
constexpr int BATCH=2,NHEAD=8,SEQ=8192,D=64,DMQ=NHEAD*D,DMK=128,KVROWS=8320,KVALID=8208;
constexpr int NW=8,QBLK=32,QB=QBLK*NW,KVBLK=64,NQB=SEQ/QB;
constexpr int ATTN_PITCH=DMQ, ATTN_UNIT_ROWS=QB;
__device__ __forceinline__ int crow(int r,int hi){return (r&3)+8*(r>>2)+4*hi;}
#define SBAR() __builtin_amdgcn_sched_barrier(0)
__device__ __forceinline__ void cmask(f32x16&p0,f32x16&p1,int t,int hi){
  const float NEG=-INFINITY; int kb=64*t+4*hi;
  #pragma unroll
  for(int r=0;r<16;++r){int kv=kb+(r&3)+8*(r>>2); if(kv>=KVALID)p0[r]=NEG; if(kv+32>=KVALID)p1[r]=NEG;}
}

constexpr int NSLOT=3, SLOTB=8192;
constexpr int LDS_K=0, LDS_V=NSLOT*SLOTB, LDS_WS=2*NSLOT*SLOTB, LDS_OST=LDS_WS+NW*64*4, LDS_BYTES=LDS_OST+NW*4096;
constexpr float C2=0.125f*1.4426950408889634f;
__device__ __forceinline__ void glds16(const void*gsrc,unsigned lds_dst){unsigned keep;
  asm volatile("s_mov_b32 %0, m0\n\ts_mov_b32 m0, %2\n\ts_nop 0\n\tglobal_load_lds_dwordx4 %1, off\n\ts_mov_b32 m0, %0":"=&s"(keep):"v"(gsrc),"s"(lds_dst):"memory");}
__device__ __forceinline__ float max3f(float a,float b,float c){float r;asm("v_max3_f32 %0, %1, %2, %3":"=v"(r):"v"(a),"v"(b),"v"(c));return r;}
__device__ __forceinline__ float max2f(float a,float b){float r;asm("v_max_f32_e32 %0, %1, %2":"=v"(r):"v"(a),"v"(b));return r;}
__device__ __forceinline__ float fadd_s(float a,float b){float r;asm("v_add_f32_e32 %0, %1, %2":"=v"(r):"v"(a),"v"(b));return r;}
__device__ __forceinline__ float fsub_s(float a,float b){float r;asm("v_sub_f32_e32 %0, %1, %2":"=v"(r):"v"(a),"v"(b));return r;}
typedef float f32x2_t __attribute__((ext_vector_type(2))); typedef __bf16 bf16x2_t __attribute__((ext_vector_type(2)));
__device__ __forceinline__ unsigned cvtpk_s(float lo,float hi){f32x2_t v={lo,hi};bf16x2_t b=__builtin_convertvector(v,bf16x2_t);return __builtin_bit_cast(unsigned,b);}
#define WAIT_BAR(N) asm volatile("s_waitcnt vmcnt(" #N ") lgkmcnt(0)\n\ts_barrier":::"memory")

__device__ __forceinline__ void qkt(f32x16&p0,f32x16&p1,const char*Kslot,const bf16x8*qr,const f32x16&negm,int r32,int hi){
  const char*kb=Kslot+hi*1024+r32*16;
  #pragma unroll
  for(int d0=0;d0<4;++d0){
    const bf16x8 b0=*reinterpret_cast<const bf16x8*>(kb+d0*2048);
    const bf16x8 b1=*reinterpret_cast<const bf16x8*>(kb+d0*2048+512);
    if(d0==0){p0=__builtin_amdgcn_mfma_f32_32x32x16_bf16(b0,qr[0],negm,0,0,0);p1=__builtin_amdgcn_mfma_f32_32x32x16_bf16(b1,qr[0],negm,0,0,0);}
    else{p0=__builtin_amdgcn_mfma_f32_32x32x16_bf16(b0,qr[d0],p0,0,0,0);p1=__builtin_amdgcn_mfma_f32_32x32x16_bf16(b1,qr[d0],p1,0,0,0);}}
}
typedef __attribute__((address_space(3))) const char* lds_cptr;
typedef short v4i16_t __attribute__((ext_vector_type(4)));
__device__ __forceinline__ void kload8(bf16x8*kf,lds_cptr kp){
  kf[0]=*(const __attribute__((address_space(3))) bf16x8*)(kp);      kf[1]=*(const __attribute__((address_space(3))) bf16x8*)(kp+512);
  kf[2]=*(const __attribute__((address_space(3))) bf16x8*)(kp+2048); kf[3]=*(const __attribute__((address_space(3))) bf16x8*)(kp+2560);
  kf[4]=*(const __attribute__((address_space(3))) bf16x8*)(kp+4096); kf[5]=*(const __attribute__((address_space(3))) bf16x8*)(kp+4608);
  kf[6]=*(const __attribute__((address_space(3))) bf16x8*)(kp+6144); kf[7]=*(const __attribute__((address_space(3))) bf16x8*)(kp+6656);
}
__device__ __forceinline__ void kload2(bf16x8*kf,lds_cptr kp,int j){ kf[2*j]=*(const __attribute__((address_space(3))) bf16x8*)(kp+j*2048); kf[2*j+1]=*(const __attribute__((address_space(3))) bf16x8*)(kp+j*2048+512); }
__device__ __forceinline__ s16x4 vtr(lds_cptr p){ return __builtin_bit_cast(s16x4,__builtin_amdgcn_ds_read_tr16_b64_v4i16((__attribute__((address_space(3))) v4i16_t*)p)); }
__device__ __forceinline__ float rowmax(const f32x16&p0,const f32x16&p1){
  float a=max3f(p0[0],p0[1],p1[0]),b=max3f(p0[2],p0[3],p1[1]);a=max3f(a,p1[2],p1[3]);
  #pragma unroll
  for(int r=4;r<16;r+=4){a=max3f(a,p0[r],p0[r+1]);b=max3f(b,p0[r+2],p0[r+3]);a=max3f(a,p1[r],p1[r+1]);b=max3f(b,p1[r+2],p1[r+3]);}
  const float m=max2f(a,b);
  auto rr=__builtin_amdgcn_permlane32_swap(__float_as_uint(m),__float_as_uint(m),false,false);
  return max2f(__uint_as_float(rr[0]),__uint_as_float(rr[1]));
}
__device__ __forceinline__ void pv(f32x16*o,int vb,bf16x8 pa0,bf16x8 pa1,bf16x8 pa2,bf16x8 pa3){
  #pragma unroll
  for(int d0=0;d0<2;++d0){s16x4 lo[4],hi[4];
    #pragma unroll
    for(int ks=0;ks<4;++ks){
      asm volatile("ds_read_b64_tr_b16 %0,%1 offset:%c2":"=&v"(lo[ks]):"v"(vb),"i"(d0*4096+ks*1024):"memory");
      asm volatile("ds_read_b64_tr_b16 %0,%1 offset:%c2":"=&v"(hi[ks]):"v"(vb),"i"(d0*4096+ks*1024+512):"memory");}
    asm volatile("s_waitcnt lgkmcnt(0)":::"memory");SBAR();
    #define PK(k) (bf16x8){lo[k][0],lo[k][1],lo[k][2],lo[k][3],hi[k][0],hi[k][1],hi[k][2],hi[k][3]}
    o[d0]=__builtin_amdgcn_mfma_f32_32x32x16_bf16(pa0,PK(0),o[d0],0,0,0);
    o[d0]=__builtin_amdgcn_mfma_f32_32x32x16_bf16(pa1,PK(1),o[d0],0,0,0);
    o[d0]=__builtin_amdgcn_mfma_f32_32x32x16_bf16(pa2,PK(2),o[d0],0,0,0);
    o[d0]=__builtin_amdgcn_mfma_f32_32x32x16_bf16(pa3,PK(3),o[d0],0,0,0);
    #undef PK
  }
}

#ifndef ATTN_STORE16
#define ATTN_STORE16(p,v) (*(u32x4*)(p)=(v))
#endif
template<int THRL> __device__ __forceinline__ void attn_unit(int b,int h,int qb,const bf16*Q,const bf16*__restrict__ K,const bf16*__restrict__ V,bf16*O,char*shm){
  const int tid=threadIdx.x,lane=tid&63,r32=lane&31,hi=lane>>5; const int wid=__builtin_amdgcn_readfirstlane(tid>>6);
  const long rowbase=(long)b*SEQ, kvbase=(long)b*KVROWS; const int q0=qb*QB;
  const bf16*Qw=Q+(rowbase+q0+wid*QBLK)*DMQ+h*D;
  const bf16*Kh=K+kvbase*DMK+(h>>2)*D,*Vh=V+kvbase*DMK+(h>>2)*D;
  const unsigned lds0=(unsigned)(uintptr_t)shm;
  float*wsf=(float*)(shm+LDS_WS)+wid*64;
  const bf16*ksrc=Kh+(long)lane*DMK+wid*8;
  const bf16*vsrc=Vh+(long)(16*(wid&3)+(lane>>2))*DMK+(wid>>2)*32+(lane&3)*8;
  const unsigned kdst=lds0+LDS_K+wid*1024, vdst=lds0+LDS_V+wid*1024;
  #define DMA_K(t,slot) glds16(ksrc+(long)(t)*KVBLK*DMK,(unsigned)__builtin_amdgcn_readfirstlane(kdst+(slot)))
  #define DMA_V(t,slot) glds16(vsrc+(long)(t)*KVBLK*DMK,(unsigned)__builtin_amdgcn_readfirstlane(vdst+(slot)))
  const int vb0=(int)(lds0+LDS_V)+((lane>>4)&1)*32+(lane&3)*8+(4*hi+((lane&15)>>2))*64;
  const char*Kbase=shm+LDS_K; bf16x8 kf[8];
  const lds_cptr shm3=(lds_cptr)shm; const lds_cptr kp0=shm3+LDS_K+hi*1024+r32*16; const lds_cptr vp0=shm3+LDS_V+((lane>>4)&1)*32+(lane&3)*8+(4*hi+((lane&15)>>2))*64;
  constexpr int NT=KVROWS/KVBLK;
  DMA_K(0,0);DMA_V(0,0);DMA_K(1,SLOTB);
  bf16x8 qr[4];
  #pragma unroll
  for(int d0=0;d0<4;++d0)qr[d0]=*reinterpret_cast<const bf16x8*>(&Qw[(long)r32*DMQ+d0*16+hi*8]);
  float mhat=0.f,l_reg=0.f;f32x16 o[2];o[0]=f32x16{};o[1]=f32x16{};f32x16 negm=f32x16{};asm volatile("":"+v"(negm));
    #define CMASK(P0,P1,t) do{ if((t)>=NT-4)cmask(P0,P1,(t),hi); }while(0)
  bool resc=false;
  #define START(P0,P1) do{ const float rm=rowmax(P0,P1); resc=false; \
    { const float dl=rm; mhat=fadd_s(mhat,dl); \
      _Pragma("unroll") for(int r=0;r<16;++r){P0[r]=fsub_s(P0[r],dl);P1[r]=fsub_s(P1[r],dl);} \
      _Pragma("unroll") for(int r=0;r<16;++r)negm[r]=-mhat; asm volatile("":"+v"(negm)); } \
    _Pragma("unroll") for(int r=0;r<16;++r)P0[r]=__builtin_amdgcn_exp2f(P0[r]); }while(0)
  #define RESC() do{ if(resc){ asm volatile("s_waitcnt lgkmcnt(0)":::"memory"); \
      _Pragma("unroll") for(int d_=0;d_<2;++d_) _Pragma("unroll") for(int r=0;r<16;++r)o[d_][r]*=wsf[crow(r,hi)]; } }while(0)
  f32x16 pA0,pA1,pB0,pB1;
  int sl_prev=0,sl_cur=0,sl_next=SLOTB;
  #define ROT() do{sl_prev=sl_cur;sl_cur=sl_next;sl_next=(sl_next==(NSLOT-1)*SLOTB)?0:sl_next+SLOTB;}while(0)
  DMA_K(2,2*SLOTB);
  WAIT_BAR(3);
  qkt(pA0,pA1,Kbase,qr,negm,r32,hi);asm volatile("s_nop 15\n\ts_nop 7":"+v"(pA0),"+v"(pA1));CMASK(pA0,pA1,0);
  START(pA0,pA1);
  _Pragma("unroll") for(int r=0;r<16;++r)pA1[r]=__builtin_amdgcn_exp2f(pA1[r]);
  WAIT_BAR(0);
  DMA_K(3,0);DMA_V(1,SLOTB);
  ROT();
  kload8(kf,kp0+sl_cur);
  WAIT_BAR(2);
  s16x4 vlo[8],vhi[8]; u32x4 pw0,pw1,pw2,pw3;
  #define PKW(P,B) cvtpk_s(P[B],P[B+1])
  #define PAF(k) __builtin_bit_cast(bf16x8,pw##k)
  #define VFR(i) (bf16x8){vlo[i][0],vlo[i][1],vlo[i][2],vlo[i][3],vhi[i][0],vhi[i][1],vhi[i][2],vhi[i][3]}
  #define PIN(x) asm volatile("":"+v"(x))
  #define MX3(a,b,c) __builtin_fmaxf(__builtin_fmaxf((a),(b)),(c))
  #define GAPA(MF,A0,A1,A2,A3,W0,W1,PW) do{ MF; sacc+=A0; sacc+=A1; sacc+=A2; sacc+=A3; PIN(sacc); W0; W1; PIN(PW); SBAR(); }while(0)
  #define EX(v) __builtin_amdgcn_exp2f(v)
  #define GAPB(MF,X,B) do{ MF; X[B]=EX(X[B]); X[B+1]=EX(X[B+1]); X[B+2]=EX(X[B+2]); X[B+3]=EX(X[B+3]); PIN(X); SBAR(); }while(0)
  #define VRD(i) do{ vlo[i]=vtr(vp_+(((i)>>2)*4096+((i)&3)*1024)); vhi[i]=vtr(vp_+(((i)>>2)*4096+((i)&3)*1024+512)); }while(0)
  #define KRD(G,j) do{ if(G){ kload2(kf,kp0+sl_next,j); SBAR(); } }while(0)
  #define STEP(C0,C1,P0,P1,t,GK,GV,GL) do{ SBAR(); \
    const lds_cptr vp_=vp0+sl_prev; \
    VRD(0); SBAR(); float sacc=(P0[0]+P0[1]); \
    GAPA(C0=__builtin_amdgcn_mfma_f32_32x32x16_bf16(kf[0],qr[0],negm,0,0,0), P0[2],P0[3],P0[4],P0[5],     pw0[0]=PKW(P0,0), pw0[1]=PKW(P0,2), pw0); \
    VRD(4); SBAR(); GAPA(C1=__builtin_amdgcn_mfma_f32_32x32x16_bf16(kf[1],qr[0],negm,0,0,0), P0[6],P0[7],P0[8],P0[9],     pw0[2]=PKW(P0,4), pw0[3]=PKW(P0,6), pw0); \
    VRD(1); SBAR(); GAPA(C0=__builtin_amdgcn_mfma_f32_32x32x16_bf16(kf[2],qr[1],C0,0,0,0),   P0[10],P0[11],P0[12],P0[13], pw1[0]=PKW(P0,8), pw1[1]=PKW(P0,10), pw1); \
    VRD(5); SBAR(); GAPA(C1=__builtin_amdgcn_mfma_f32_32x32x16_bf16(kf[3],qr[1],C1,0,0,0),   P0[14],P0[15],P1[0],P1[1],   pw1[2]=PKW(P0,12),pw1[3]=PKW(P0,14), pw1); \
    VRD(2); SBAR(); GAPA(C0=__builtin_amdgcn_mfma_f32_32x32x16_bf16(kf[4],qr[2],C0,0,0,0),   P1[2],P1[3],P1[4],P1[5],     pw2[0]=PKW(P1,0), pw2[1]=PKW(P1,2), pw2); \
    VRD(6); SBAR(); GAPA(C1=__builtin_amdgcn_mfma_f32_32x32x16_bf16(kf[5],qr[2],C1,0,0,0),   P1[6],P1[7],P1[8],P1[9],     pw2[2]=PKW(P1,4), pw2[3]=PKW(P1,6), pw2); \
    VRD(3); SBAR(); GAPA(C0=__builtin_amdgcn_mfma_f32_32x32x16_bf16(kf[6],qr[3],C0,0,0,0),   P1[10],P1[11],P1[12],P1[13], pw3[0]=PKW(P1,8), pw3[1]=PKW(P1,10), pw3); \
    VRD(7); SBAR(); GAPA(C1=__builtin_amdgcn_mfma_f32_32x32x16_bf16(kf[7],qr[3],C1,0,0,0),   P1[14],P1[15],0.f,0.f,       pw3[2]=PKW(P1,12),pw3[3]=PKW(P1,14), pw3); \
    l_reg+=sacc; \
    if(GK){DMA_K((t)+3,sl_cur);} if(GV){DMA_V((t)+1,sl_next);} \
    CMASK(C0,C1,t); \
    { float a=MX3(C0[0],C0[1],C1[0]),b=MX3(C0[2],C0[3],C1[1]); a=MX3(a,C1[2],C1[3]); \
      _Pragma("unroll") for(int r=4;r<16;r+=4){a=MX3(a,C0[r],C0[r+1]);b=MX3(b,C0[r+2],C0[r+3]);a=MX3(a,C1[r],C1[r+1]);b=MX3(b,C1[r+2],C1[r+3]);} \
      float rm=__builtin_fmaxf(a,b); { auto rr=__builtin_amdgcn_permlane32_swap(__float_as_uint(rm),__float_as_uint(rm),false,false); rm=__builtin_fmaxf(__uint_as_float(rr[0]),__uint_as_float(rr[1])); } \
      resc=false; \
      if(__builtin_expect(__any(rm>(float)THRL),0)){ const float dl=__builtin_fmaxf(rm,0.f); mhat+=dl; \
        _Pragma("unroll") for(int r=0;r<16;++r){C0[r]-=dl;C1[r]-=dl;} \
        _Pragma("unroll") for(int r=0;r<16;++r)negm[r]=-mhat; asm volatile("":"+v"(negm)); \
        const float f=__builtin_amdgcn_exp2f(-dl); l_reg*=f; if(hi==0)wsf[r32]=f; resc=true; } } \
    SBAR(); \
    GAPB(o[0]=__builtin_amdgcn_mfma_f32_32x32x16_bf16(PAF(0),VFR(0),o[0],0,0,0), C0,0); \
    GAPB(o[1]=__builtin_amdgcn_mfma_f32_32x32x16_bf16(PAF(0),VFR(4),o[1],0,0,0), C0,4); \
    KRD(GL,0); GAPB(o[0]=__builtin_amdgcn_mfma_f32_32x32x16_bf16(PAF(1),VFR(1),o[0],0,0,0), C0,8); \
    KRD(GL,1); GAPB(o[1]=__builtin_amdgcn_mfma_f32_32x32x16_bf16(PAF(1),VFR(5),o[1],0,0,0), C0,12); \
    KRD(GL,2); GAPB(o[0]=__builtin_amdgcn_mfma_f32_32x32x16_bf16(PAF(2),VFR(2),o[0],0,0,0), C1,0); \
    KRD(GL,3); GAPB(o[1]=__builtin_amdgcn_mfma_f32_32x32x16_bf16(PAF(2),VFR(6),o[1],0,0,0), C1,4); \
    GAPB(o[0]=__builtin_amdgcn_mfma_f32_32x32x16_bf16(PAF(3),VFR(3),o[0],0,0,0), C1,8); \
    GAPB(o[1]=__builtin_amdgcn_mfma_f32_32x32x16_bf16(PAF(3),VFR(7),o[1],0,0,0), C1,12); \
    }while(0)
  int t=1;
  #undef CMASK
  #define CMASK(P0,P1,t) do{}while(0)
  for(;t+5<NT;t+=2){
    STEP(pB0,pB1,pA0,pA1,t,true,true,true);     WAIT_BAR(2); RESC(); ROT();
    STEP(pA0,pA1,pB0,pB1,t+1,true,true,true);   WAIT_BAR(2); RESC(); ROT();
  }
  #undef CMASK
  #define CMASK(P0,P1,t) do{ if((t)>=NT-4)cmask(P0,P1,(t),hi); }while(0)
  #define ENDW(tt) do{ if((tt)+3<NT){WAIT_BAR(2);} else if((tt)+2<NT){WAIT_BAR(1);} else {WAIT_BAR(0);} }while(0)
  for(;t+1<NT;t+=2){
    STEP(pB0,pB1,pA0,pA1,t,(t+3<NT),(t+1<NT),(t+1<NT));       ENDW(t);   RESC(); ROT();
    STEP(pA0,pA1,pB0,pB1,t+1,(t+4<NT),(t+2<NT),(t+2<NT));     ENDW(t+1); RESC(); ROT();
  }
  STEP(pB0,pB1,pA0,pA1,NT-1,false,false,false); RESC();
  { float sacc=pB0[0]+pB0[1]; _Pragma("unroll") for(int r=2;r<16;++r)sacc+=pB0[r]; _Pragma("unroll") for(int r=0;r<16;++r)sacc+=pB1[r]; l_reg+=sacc;
    pw0=(u32x4){PKW(pB0,0),PKW(pB0,2),PKW(pB0,4),PKW(pB0,6)};pw1=(u32x4){PKW(pB0,8),PKW(pB0,10),PKW(pB0,12),PKW(pB0,14)};pw2=(u32x4){PKW(pB1,0),PKW(pB1,2),PKW(pB1,4),PKW(pB1,6)};pw3=(u32x4){PKW(pB1,8),PKW(pB1,10),PKW(pB1,12),PKW(pB1,14)};
    SBAR(); pv(o,vb0+sl_cur,PAF(0),PAF(1),PAF(2),PAF(3)); }
  #undef PKW
  #undef PAF
  #undef VFR
  #undef PIN
  #undef MX3
  #undef GAPA
  #undef GAPB
  #undef EX
  #undef VRD
  #undef KRD
  #undef STEP
  #undef ENDW
  {auto rr=__builtin_amdgcn_permlane32_swap(__float_as_uint(l_reg),__float_as_uint(l_reg),false,false);l_reg=__uint_as_float(rr[0])+__uint_as_float(rr[1]);}
  if(hi==0)wsf[32+r32]=l_reg;asm volatile("s_waitcnt lgkmcnt(0)":::"memory");
  float rli[16];
  #pragma unroll
  for(int r=0;r<16;++r)rli[r]=__builtin_amdgcn_rcpf(wsf[32+crow(r,hi)]);
  bf16*Ow=O+(rowbase+q0+wid*QBLK)*DMQ+h*D;
  { bf16*stg=(bf16*)(shm+LDS_OST)+wid*2048;
    #pragma unroll
    for(int r=0;r<16;++r){const int orow=crow(r,hi);
      #pragma unroll
      for(int d0=0;d0<2;++d0)stg[orow*64+d0*32+r32]=__float2bfloat16(o[d0][r]*rli[r]);}
    asm volatile("s_waitcnt lgkmcnt(0)":::"memory");
    #pragma unroll
    for(int i=0;i<4;++i){const int row=i*8+(lane>>3),ch=lane&7; const u32x4 v=*(const u32x4*)(stg+row*64+ch*8); ATTN_STORE16(Ow+(long)row*DMQ+ch*8,v);} }
  asm volatile("s_waitcnt lgkmcnt(0)\n\ts_barrier":::"memory");
  #undef DMA_K
  #undef DMA_V
  #undef CMASK
  #undef START
  #undef RESC
  #undef ROT
}
constexpr int ATTN_LDS_BYTES=LDS_BYTES;
struct AttnTensors { const bf16* Q; const bf16* K; const bf16* V; bf16* O; };
struct AttnUnit { int bh; int qb; };
struct StaticOrder {
  int vcu;
  __device__ __forceinline__ explicit StaticOrder(int grid,int block):vcu((block%8)*(grid/8)+block/8){}
  __device__ __forceinline__ bool next(int i,AttnUnit&u)const{ if(i>=2)return false; const int pr=vcu>>6,uu=2*(vcu&63)+i; u.bh=(pr>>1)*NHEAD+(pr&1)*4+(uu>>5); u.qb=uu&31; return true; }
  __device__ __forceinline__ void a_ready(const AttnUnit&)const{}
  __device__ __forceinline__ void done(const AttnUnit&)const{}
};
template<class Sched,int THRL=8> __device__ __forceinline__ void attn_phase(char*lds,const AttnTensors&T,const Sched&S){
  AttnUnit u;
  for(int i=0;S.next(i,u);++i){ S.a_ready(u); attn_unit<THRL>(u.bh/NHEAD,u.bh%NHEAD,u.qb,T.Q,T.K,T.V,T.O,lds); S.done(u); }
}
#undef SBAR
#undef WAIT_BAR
}
#define GAS __attribute__((address_space(1)))
#define LAS __attribute__((address_space(3)))
typedef unsigned short bf16;
typedef unsigned v4u __attribute__((ext_vector_type(4)));
typedef float f32x4 __attribute__((ext_vector_type(4)));
typedef short bf16x8 __attribute__((ext_vector_type(8)));
typedef GAS unsigned gu32;
typedef GAS unsigned long long gu64;
#define RLX_AGENT __ATOMIC_RELAXED, __HIP_MEMORY_SCOPE_AGENT
#define LDS_WAIT() asm volatile("s_waitcnt lgkmcnt(0)" ::: "memory")
#define VM_WAIT() asm volatile("s_waitcnt vmcnt(0)" ::: "memory")
__device__ __forceinline__ unsigned long long rt() { return __builtin_amdgcn_s_memrealtime(); }
__device__ __forceinline__ unsigned f2bf(float f) { unsigned u = __builtin_bit_cast(unsigned, f); return (u + 0x7fffu + ((u >> 16) & 1u)) >> 16; }
__device__ __forceinline__ unsigned pk2(float lo, float hi) { return f2bf(lo) | (f2bf(hi) << 16); }

#define XB_TMO      128
#define XB_XCNT(j)  (256  + 64 * (j))
#define XB_XSUB(j)  (1280 + 64 * (j))
#define XB_XGEN(j)  (2304 + 64 * (j))
#define XB_TOP      3328
#define XB_TOPGEN   3392
#define XCD_BAR_WORDS 3456
#define XB_SPIN_CAP (1u << 18)

__device__ __forceinline__ unsigned xb_ld(unsigned* p)              { return __hip_atomic_load(p, __ATOMIC_RELAXED, __HIP_MEMORY_SCOPE_AGENT); }
__device__ __forceinline__ unsigned xb_add(unsigned* p, unsigned v) { return __hip_atomic_fetch_add(p, v, __ATOMIC_RELAXED, __HIP_MEMORY_SCOPE_AGENT); }
__device__ __forceinline__ unsigned xb_xcc_id() { return (unsigned)__builtin_amdgcn_s_getreg((3 << 11) | 20) & 0xFu; }
#define XB_SPIN(cond, bar) do { unsigned _sp = 0; while (cond) { __builtin_amdgcn_s_sleep(1); \
    if ((++_sp & 255u) == 0u) { if (xb_ld(&(bar)[XB_TMO])) break; if (_sp > XB_SPIN_CAP) { atomicAdd(&(bar)[XB_TMO], 1u); break; } } } } while (0)

struct XcdBarrier {
    unsigned* bar; unsigned x;
    volatile LAS unsigned* st;
};

__device__ __forceinline__ XcdBarrier xcd_barrier_post(unsigned* bar, volatile LAS unsigned* st) {
    XcdBarrier b; b.bar = bar; b.x = xb_xcc_id(); b.st = st;
    if (threadIdx.x == 0) (void)xb_add(&bar[XB_XCNT(b.x)], 1u);
    return b;
}
__device__ __forceinline__ void xcd_barrier_complete(unsigned* bar, unsigned x, unsigned& nloc, unsigned& nx) {
    const unsigned G = gridDim.x * gridDim.y * gridDim.z;
    unsigned sum, cnt, mine, sp = 0u;
    for (;;) {
        sum = 0u; cnt = 0u; mine = 0u;
#pragma unroll
        for (unsigned j = 0; j < 16; ++j) { const unsigned c = xb_ld(&bar[XB_XCNT(j)]); sum += c; cnt += (c > 0u) ? 1u : 0u; mine = (j == x) ? c : mine; }
        if (sum == G) break;
        __builtin_amdgcn_s_sleep(1);
        if ((++sp & 255u) == 0u) { if (xb_ld(&bar[XB_TMO])) break; if (sp > XB_SPIN_CAP) { atomicAdd(&bar[XB_TMO], 1u); break; } }
    }
    nloc = mine > 0u ? mine : 1u; nx = cnt > 0u ? cnt : 1u;
}

__device__ __forceinline__ void xcd_barrier(const XcdBarrier& b) {
    asm volatile("s_waitcnt vmcnt(0)" ::: "memory");
    __syncthreads();
    if (threadIdx.x == 0) {
        unsigned* bar = b.bar;
        __builtin_amdgcn_s_waitcnt(0);
        unsigned nloc = b.st[0], nx = b.st[1];
        if (nloc == 0u) { xcd_barrier_complete(bar, b.x, nloc, nx); b.st[0] = nloc; b.st[1] = nx; }
        const unsigned old = xb_add(&bar[XB_XSUB(b.x)], 1u);
        const unsigned gen = old / nloc;
        if (old + 1u == (gen + 1u) * nloc) {
            __builtin_amdgcn_fence(__ATOMIC_RELEASE, "agent");
            asm volatile("s_waitcnt vmcnt(0)" ::: "memory");
            const unsigned og = xb_add(&bar[XB_TOP], 1u);
            const unsigned tg = og / nx;
            if (og + 1u == (tg + 1u) * nx) xb_add(&bar[XB_TOPGEN], 1u);
            else XB_SPIN(xb_ld(&bar[XB_TOPGEN]) == tg, bar);
            __builtin_amdgcn_fence(__ATOMIC_ACQUIRE, "agent");
            xb_add(&bar[XB_XGEN(b.x)], 1u);
            asm volatile("s_waitcnt vmcnt(0)" ::: "memory");
        } else {
            XB_SPIN(xb_ld(&bar[XB_XGEN(b.x)]) == gen, bar);
            __builtin_amdgcn_fence(__ATOMIC_ACQUIRE, "agent");
            asm volatile("s_waitcnt vmcnt(0)" ::: "memory");
        }
    }
    __syncthreads();
}

constexpr int NWAVES = 8;
constexpr int BATCH = 2, SEQ = 8192, DM = 1024, NMETA = 16;
constexpr int M = BATCH * SEQ;
constexpr int INW = 3328;
constexpr int KVROWS = 8320, KVALID = 8208;
constexpr int NG = 32, NE = 16, CAP = 1024;
constexpr int UGP = 768;
constexpr float LN_EPS = 1e-5f, QK_EPS = 1e-6f, ALPHA = 1.189207115002721f;
constexpr float C2Q = 0.125f * 1.4426950408889634f;

constexpr size_t MiB = 1u << 20;
constexpr size_t WS_CTL = 0, CTL_ZERO_BYTES = 1 * MiB;
constexpr size_t WS_STATS0 = 1 * MiB, WS_STATS1 = WS_STATS0 + 131072, WS_ROPE = WS_STATS1 + 131072, WS_UMETA = WS_ROPE + 32768, WS_GATE2 = WS_UMETA + 32768, WS_IDX2 = WS_GATE2 + 131072;
constexpr size_t WS_SLOTOF = 2 * MiB, WS_AFF = 3 * MiB;
constexpr size_t WS_WGU = 8 * MiB, WS_WD = 72 * MiB;
constexpr size_t WS_WIN = 104 * MiB, WS_WGLU = 111 * MiB, WS_WAB = 112 * MiB, WS_WSB = 113 * MiB, WS_WO = 114 * MiB;
constexpr size_t WS_WST = 116 * MiB, WS_MEXT = 124 * MiB;
constexpr size_t WS_XN = 148 * MiB;
constexpr size_t WS_Q = 181 * MiB, WS_K = 197 * MiB, WS_V = 202 * MiB;
constexpr size_t WS_UG2 = 207 * MiB, WS_S = 231 * MiB;
constexpr size_t WS_END = 247 * MiB;
constexpr size_t WS_YG = WS_XN, WS_Z = WS_XN + 16 * MiB;
constexpr size_t WS_T1 = WS_WST;
constexpr size_t WS_MERGED = WS_UG2;
constexpr size_t WS_H1 = WS_XN;
constexpr size_t WS_XE = WS_Q;
constexpr size_t WS_HB = WS_WIN;
static_assert(WS_XE + 64 * MiB <= WS_END && WS_HB + 64 * MiB <= WS_XE && WS_MERGED + 32 * MiB <= WS_END && WS_T1 + 32 * MiB <= WS_XN, "d_ws overlays");
constexpr int CW_TMO = 0, CW_BAR = 4096;

constexpr int RING_OFF = 0, RING_BYTES = 131072;
constexpr int LDSCTL_OFF = RING_BYTES, MISC_OFF = LDSCTL_OFF + 320;
constexpr int LDS_BYTES = 147456;

typedef unsigned u32x4_t __attribute__((ext_vector_type(4)));
typedef unsigned u32x2_t __attribute__((ext_vector_type(2)));
typedef float f32x2_t2 __attribute__((ext_vector_type(2)));
using pg8::Unit;

struct Frame {
    LAS unsigned char* lds; volatile LAS unsigned* MISC; gu32* ctl;
    int tid, lane, wave, vcu, G;
    unsigned char* ws;
    const float* in[28]; float* out;
};
__device__ __forceinline__ float wave_sum(float v) {
#pragma unroll
    for (int o = 1; o < 64; o <<= 1) v += __shfl_xor(v, o);
    return v;
}
__device__ __forceinline__ float sigm(float x) { return 1.f / (1.f + __expf(-x)); }
__device__ __forceinline__ float bf2f(unsigned short h) { return __uint_as_float((unsigned)h << 16); }
__device__ __forceinline__ float bflo(unsigned w) { return __uint_as_float(w << 16); }
__device__ __forceinline__ float bfhi(unsigned w) { return __uint_as_float(w & 0xffff0000u); }
__device__ __forceinline__ u32x4_t pack8(const f32x4& a, const f32x4& b) { u32x4_t w; w.x = pg8::cvt_pk_bf16(a[0], a[1]); w.y = pg8::cvt_pk_bf16(a[2], a[3]); w.z = pg8::cvt_pk_bf16(b[0], b[1]); w.w = pg8::cvt_pk_bf16(b[2], b[3]); return w; }
__device__ __forceinline__ float gelu_tanh(float y) { const float in = 0.7978845608028654f * (y + 0.044715f * y * y * y); const float e = __expf(2.f * in); return y * (1.f - 1.f / (e + 1.f)); }

struct InProjOrder {
    pg8::StaticOrder so;
    __device__ bool next(int i, Unit& u) const { if (so.next(i, u)) return true; const long L = (long)i * so.G + so.c; if (L >= so.nwg && L < so.nwg + 3) { u.pm = 64; u.pn = 2 + (int)(L - so.nwg); return true; } return false; }
    __device__ __forceinline__ void a_ready(const Unit&) const {}
    __device__ __forceinline__ void done(const Unit&) const {}
};
struct SsmStateOrder {
    int G, c;
    __device__ bool next(int i, Unit& u) const { const int L = i * G + c; if (L >= 64) return false; u.pm = L; u.pn = L >> 1; return true; }
    __device__ __forceinline__ void a_ready(const Unit&) const {}
    __device__ __forceinline__ void done(const Unit&) const {}
};
struct SsmYOrder {
    int G, c;
    __device__ bool next(int i, Unit& u) const { const int L = i * G + c; if (L >= 128) return false; const int g = L >> 2; u.pm = g * 2 + ((L >> 1) & 1); u.pn = g * 2 + (L & 1); return true; }
    __device__ __forceinline__ void a_ready(const Unit&) const {}
    __device__ __forceinline__ void done(const Unit&) const {}
};
struct MoeOrder {
    int G, c, nmi, nnj;
    __device__ bool next(int i, Unit& u) const { const int per = nmi * nnj, nwg = NE * per; const int L = i * G + c; if (L >= nwg) return false;
        const int wgid = (L % 8) * (nwg / 8) + L / 8; const int e = wgid / per, w = wgid % per; u.pm = e * nmi + (w % nmi); u.pn = e * nnj + (w / nmi); return true; }
    __device__ __forceinline__ void a_ready(const Unit&) const {}
    __device__ __forceinline__ void done(const Unit&) const {}
};

typedef float f32x4 __attribute__((ext_vector_type(4)));
#define EPI_LOOP_AM _Pragma("unroll") for (int ai = 0; ai < 2; ++ai) _Pragma("unroll") for (int m = 0; m < 4; ++m)
struct EpiInProj {
    static constexpr bool PERM = true, AFTER_DRAIN = false;
    bf16* Q; bf16* Kb; bf16* Vb; bf16* UG2; bf16* GATES; bf16* UMETA;
    __device__ __forceinline__ void operator()(const f32x4 (&acc)[2][2][4][2], const Unit& u, int wr, int wc, int fr, int fq) const {
        const int pn = u.pn, cl0 = wc * 32 + 8 * fq;
        if (u.pm == 64) {
            if (wr != 0) return;
            if (pn == 2) {
#pragma unroll
                for (int b = 0; b < 2; ++b) { const size_t o = ((size_t)b * KVROWS + fr) * 128 + cl0;
                    *(u32x4_t*)(Kb + o) = pack8(acc[0][0][0][0], acc[0][0][0][1]); *(u32x4_t*)(Vb + o) = pack8(acc[0][1][0][0], acc[0][1][0][1]); }
            } else {
#pragma unroll
                for (int bj = 0; bj < 2; ++bj) { const int cu = (pn - 3) * 256 + bj * 128 + cl0; *(u32x4_t*)(UMETA + ((size_t)(cu >> 4) * 16 + fr) * 16 + (cu & 15)) = pack8(acc[0][bj][0][0], acc[0][bj][0][1]); }
            }
            return;
        }
        const int row0 = u.pm * 256 + wr * 64 + fr;
        if (pn < 2) {
            EPI_LOOP_AM { const size_t o = (size_t)(row0 + ai * 128 + m * 16) * 512 + pn * 256 + cl0;
#pragma unroll
                for (int bj = 0; bj < 2; ++bj) *(u32x4_t*)(Q + o + bj * 128) = pack8(acc[ai][bj][m][0], acc[ai][bj][m][1]); }
        } else if (pn == 2) {
            EPI_LOOP_AM { const int row = row0 + ai * 128 + m * 16; const size_t o = ((size_t)(row >> 13) * KVROWS + NMETA + (row & 8191)) * 128 + cl0;
                *(u32x4_t*)(Kb + o) = pack8(acc[ai][0][m][0], acc[ai][0][m][1]); *(u32x4_t*)(Vb + o) = pack8(acc[ai][1][m][0], acc[ai][1][m][1]); }
        } else if (pn < 5) {
            EPI_LOOP_AM { const int row = row0 + ai * 128 + m * 16, b = row >> 13, s = row & 8191;
#pragma unroll
                for (int bj = 0; bj < 2; ++bj) { const int cu = (pn - 3) * 256 + bj * 128 + cl0, g = cu >> 4;
                    *(u32x4_t*)(UG2 + ((size_t)(g * 2 + b) * 256 + (s >> 5)) * UGP + (s & 31) * 16 + (cu & 15)) = pack8(acc[ai][bj][m][0], acc[ai][bj][m][1]); } }
        } else {
            EPI_LOOP_AM { const size_t o = (size_t)(row0 + ai * 128 + m * 16) * 2048 + (pn - 5) * 256 + cl0;
#pragma unroll
                for (int bj = 0; bj < 2; ++bj) { f32x4 a = acc[ai][bj][m][0], c = acc[ai][bj][m][1];
#pragma unroll
                    for (int j = 0; j < 4; ++j) { a[j] = sigm(a[j]); c[j] = sigm(c[j]); }
                    *(u32x4_t*)(GATES + o + bj * 128) = pack8(a, c); } }
        }
    }
};
struct EpiSsmState {
    static constexpr bool PERM = false, AFTER_DRAIN = false;
    float* S;
    __device__ __forceinline__ void operator()(const f32x4 (&acc)[2][2][4][2], const Unit& u, int wr, int wc, int fr, int fq) const {
        EPI_LOOP_AM { float* rp = S + ((size_t)u.pm * 256 + ai * 128 + wr * 64 + m * 16 + fr) * 256 + wc * 32 + 4 * fq;
#pragma unroll
            for (int bj = 0; bj < 2; ++bj)
#pragma unroll
                for (int n = 0; n < 2; ++n) *(f32x4*)(rp + bj * 128 + n * 16) = acc[ai][bj][m][n]; }
    }
};
struct EpiSsmY {
    static constexpr bool PERM = true, AFTER_DRAIN = false;
    bf16* YG;
    __device__ __forceinline__ void operator()(const f32x4 (&acc)[2][2][4][2], const Unit& u, int wr, int wc, int fr, int fq) const {
        const int g = u.pm >> 1, b = u.pm & 1, nh = u.pn & 1;
        EPI_LOOP_AM { const int cp = ai * 128 + wr * 64 + m * 16 + fr;
#pragma unroll
            for (int bj = 0; bj < 2; ++bj) { const int nl = nh * 256 + bj * 128 + wc * 32 + 8 * fq, t = nl >> 4, h0 = nl & 15;
                f32x4 a = acc[ai][bj][m][0], c = acc[ai][bj][m][1];
#pragma unroll
                for (int j = 0; j < 4; ++j) { a[j] = gelu_tanh(a[j]); c[j] = gelu_tanh(c[j]); }
                *(u32x4_t*)(YG + ((size_t)b * SEQ + cp * 32 + t) * 512 + g * 16 + h0) = pack8(a, c); } }
    }
};
struct EpiGlu {
    static constexpr bool PERM = true, AFTER_DRAIN = false;
    const bf16* YG; const float* bias; bf16* Z;
    __device__ __forceinline__ void operator()(const f32x4 (&acc)[2][2][4][2], const Unit& u, int wr, int wc, int fr, int fq) const {
        const int row0 = u.pm * 256 + wr * 64 + fr, col0 = u.pn * 256 + wc * 32 + 8 * fq;
        EPI_LOOP_AM { const size_t o = (size_t)(row0 + ai * 128 + m * 16) * 512 + col0;
#pragma unroll
            for (int bj = 0; bj < 2; ++bj) { const u32x4_t y = *(const u32x4_t*)(YG + o + bj * 128);
                const f32x4 b0 = *(const f32x4*)(bias + col0 + bj * 128), b1 = *(const f32x4*)(bias + col0 + bj * 128 + 4);
                f32x4 a = acc[ai][bj][m][0] + b0, c = acc[ai][bj][m][1] + b1;
                a[0] = bflo(y.x) * sigm(a[0]); a[1] = bfhi(y.x) * sigm(a[1]); a[2] = bflo(y.y) * sigm(a[2]); a[3] = bfhi(y.y) * sigm(a[3]);
                c[0] = bflo(y.z) * sigm(c[0]); c[1] = bfhi(y.z) * sigm(c[1]); c[2] = bflo(y.w) * sigm(c[2]); c[3] = bfhi(y.w) * sigm(c[3]);
                *(u32x4_t*)(Z + o + bj * 128) = pack8(a, c); } }
    }
};
template <int SECOND> struct EpiBranch {
    static constexpr bool PERM = true, AFTER_DRAIN = false;
    const bf16* GATES; const bf16* T1; bf16* O;
    __device__ __forceinline__ void operator()(const f32x4 (&acc)[2][2][4][2], const Unit& u, int wr, int wc, int fr, int fq) const {
        const int row0 = u.pm * 256 + wr * 64 + fr, col0 = u.pn * 256 + wc * 32 + 8 * fq;
        EPI_LOOP_AM { const size_t r = (size_t)(row0 + ai * 128 + m * 16);
#pragma unroll
            for (int bj = 0; bj < 2; ++bj) { const u32x4_t gt = *(const u32x4_t*)(GATES + r * 2048 + SECOND * 1024 + col0 + bj * 128);
                f32x4 a = acc[ai][bj][m][0], c = acc[ai][bj][m][1];
                a[0] *= bflo(gt.x); a[1] *= bfhi(gt.x); a[2] *= bflo(gt.y); a[3] *= bfhi(gt.y); c[0] *= bflo(gt.z); c[1] *= bfhi(gt.z); c[2] *= bflo(gt.w); c[3] *= bfhi(gt.w);
                if (SECOND) { const u32x4_t t1 = *(const u32x4_t*)(T1 + r * 1024 + col0 + bj * 128);
                    a[0] += bflo(t1.x); a[1] += bfhi(t1.x); a[2] += bflo(t1.y); a[3] += bfhi(t1.y); c[0] += bflo(t1.z); c[1] += bfhi(t1.z); c[2] += bflo(t1.w); c[3] += bfhi(t1.w); }
                *(u32x4_t*)(O + r * 1024 + col0 + bj * 128) = pack8(a, c); } }
    }
};
struct EpiPre1 {
    static constexpr bool PERM = false, AFTER_DRAIN = false;
    const float* x; const float* g; const float* bb; const f32x2_t2* st; float* out;
    __device__ __forceinline__ void operator()(const f32x4 (&acc)[2][2][4][2], const Unit& u, int wr, int wc, int fr, int fq) const {
        const int row0 = u.pm * 256 + wr * 64 + fr, col0 = u.pn * 256 + wc * 32 + 4 * fq;
        EPI_LOOP_AM { const int row = row0 + ai * 128 + m * 16; const f32x2_t2 s = st[row]; const size_t o = (size_t)row * 1024 + col0;
#pragma unroll
            for (int bj = 0; bj < 2; ++bj)
#pragma unroll
                for (int n = 0; n < 2; ++n) { const int c = bj * 128 + n * 16; const f32x4 xv = *(const f32x4*)(x + o + c), gv = *(const f32x4*)(g + col0 + c), bv = *(const f32x4*)(bb + col0 + c);
                    *(f32x4*)(out + o + c) = ((xv - s.x) * s.y * gv + bv) * ALPHA + acc[ai][bj][m][n]; } }
    }
};
struct EpiMoe1 {
    static constexpr bool PERM = true, AFTER_DRAIN = false;
    bf16* HB;
    __device__ __forceinline__ void operator()(const f32x4 (&acc)[2][2][4][2], const Unit& u, int wr, int wc, int fr, int fq) const {
        const int row0 = u.pm * 256 + wr * 64 + fr, col0 = (u.pn & 7) * 128 + wc * 32 + 8 * fq;
        EPI_LOOP_AM { f32x4 a = acc[ai][0][m][0], c = acc[ai][0][m][1]; const f32x4 ua = acc[ai][1][m][0], uc = acc[ai][1][m][1];
#pragma unroll
            for (int j = 0; j < 4; ++j) { a[j] = a[j] * sigm(a[j]) * ua[j]; c[j] = c[j] * sigm(c[j]) * uc[j]; }
            *(u32x4_t*)(HB + (size_t)(row0 + ai * 128 + m * 16) * 1024 + col0) = pack8(a, c); }
    }
};
struct EpiMoe2 {
    static constexpr bool PERM = true, AFTER_DRAIN = false;
    const float* gate; bf16* YE;
    __device__ __forceinline__ void operator()(const f32x4 (&acc)[2][2][4][2], const Unit& u, int wr, int wc, int fr, int fq) const {
        const int row0 = u.pm * 256 + wr * 64 + fr, col0 = (u.pn & 3) * 256 + wc * 32 + 8 * fq;
        EPI_LOOP_AM { const int row = row0 + ai * 128 + m * 16; const float gt = gate[row];
#pragma unroll
            for (int bj = 0; bj < 2; ++bj) *(u32x4_t*)(YE + (size_t)row * 1024 + col0 + bj * 128) = pack8(acc[ai][bj][m][0] * gt, acc[ai][bj][m][1] * gt); }
    }
};

__device__ __forceinline__ void p0_transpose_item(const float* W, int K, int N, bf16* WT, int k0, int n0, int drow0, LAS float* scr, int lane) {
#pragma unroll 8
    for (int i = 0; i < 32; ++i) { const int kk = 2 * i + (lane >> 5); scr[kk * 33 + (lane & 31)] = W[(size_t)(k0 + kk) * N + n0 + (lane & 31)]; }
    LDS_WAIT(); asm volatile("" ::: "memory");
    const int c = lane & 7;
#pragma unroll
    for (int j = 0; j < 4; ++j) { const int n = (lane >> 3) + 8 * j; const LAS float* s = scr + (8 * c) * 33 + n;
        v4u o; o.x = pk2(s[0 * 33], s[1 * 33]); o.y = pk2(s[2 * 33], s[3 * 33]); o.z = pk2(s[4 * 33], s[5 * 33]); o.w = pk2(s[6 * 33], s[7 * 33]);
        *(GAS v4u*)(WT + (size_t)(drow0 + n) * K + k0 + 8 * c) = o; }
    LDS_WAIT(); asm volatile("" ::: "memory");
}
__device__ __forceinline__ void ssm_par(const Frame& F, int dg, int p, float& lr, float& li, float& cr, float& ci) {
    const float dt = expf(F.in[9][dg]); const float ar = F.in[7][dg * 64 + p], ai = F.in[8][dg * 64 + p];
    lr = ar * dt; li = ai * dt;
    float sn, cs; sincosf(li, &sn, &cs); const float mag = expf(lr);
    const float nr = mag * cs - 1.f, ni = mag * sn, den = ar * ar + ai * ai;
    cr = (nr * ar + ni * ai) / den; ci = (ni * ar - nr * ai) / den;
}
__device__ __forceinline__ void cpow(float lr, float li, float e, float& pr, float& pi) { float sn, cs; sincosf(li * e, &sn, &cs); const float mg = expf(lr * e); pr = mg * cs; pi = mg * sn; }

__device__ __forceinline__ void p0_prologue(Frame& F) {
    const int gw = F.vcu * NWAVES + F.wave, NGW = F.G * NWAVES, lane = F.lane, tid = F.tid;
    unsigned char* ws = F.ws;
    {
        LAS float* POW = (LAS float*)(F.lds + RING_OFF);
        LAS float* BB = POW + 2 * 33 * 64 * 2;
        LAS float* CC = BB + 2 * 64 * 16 * 2;
        LAS float* KT = CC + 2 * 4 * 64 * 2;
        bf16* MEXT = (bf16*)(ws + WS_MEXT);
        for (int it = F.vcu; it < 128; it += F.G) {
            const int g = it >> 2, hq = it & 3;
            __syncthreads();
            for (int i = tid; i < 2 * 33 * 64; i += NWAVES * 64) { const int dir = i / (33 * 64), j = (i / 64) % 33, p = i & 63; float lr, li, cr, ci; ssm_par(F, dir * 32 + g, p, lr, li, cr, ci);
                float pr, pi; cpow(lr, li, (float)j, pr, pi); POW[i * 2] = pr; POW[i * 2 + 1] = pi; }
            for (int i = tid; i < 2 * 64 * 16; i += NWAVES * 64) { const int dir = i / 1024, p = (i >> 4) & 63, h = i & 15; float lr, li, cr, ci; ssm_par(F, dir * 32 + g, p, lr, li, cr, ci);
                const size_t o = ((size_t)(dir * 32 + g) * 64 + p) * 16 + h; const float br = F.in[10][o], bi = F.in[11][o]; BB[i * 2] = cr * br - ci * bi; BB[i * 2 + 1] = cr * bi + ci * br; }
            for (int i = tid; i < 2 * 4 * 64; i += NWAVES * 64) { const int dir = i / 256, hl = (i >> 6) & 3, p = i & 63; const size_t o = ((size_t)(dir * 32 + g) * 16 + hq * 4 + hl) * 64 + p; CC[i * 2] = F.in[12][o]; CC[i * 2 + 1] = F.in[13][o]; }
            __syncthreads();
            for (int i = tid; i < 2 * 4 * 32 * 16; i += NWAVES * 64) { const int dir = i / 2048, hl = (i >> 9) & 3, j = (i >> 4) & 31, hi = i & 15; float s = 0.f;
                for (int p = 0; p < 64; ++p) { const float cr = CC[((dir * 4 + hl) * 64 + p) * 2], ci = CC[((dir * 4 + hl) * 64 + p) * 2 + 1], pr = POW[((dir * 33 + j) * 64 + p) * 2], pi = POW[((dir * 33 + j) * 64 + p) * 2 + 1];
                    const float er = cr * pr - ci * pi, ei = cr * pi + ci * pr; const float br = BB[((dir * 64 + p) * 16 + hi) * 2], bi = BB[((dir * 64 + p) * 16 + hi) * 2 + 1]; s += er * br - ei * bi; }
                KT[i] = s; }
            __syncthreads();
            for (int ch = tid; ch < 128 * 96; ch += NWAVES * 64) { const int rl = ch / 96, cc = ch % 96, t = rl >> 2, hl = rl & 3, ho = hq * 4 + hl; float v[8];
                if (cc < 64) { const int s = cc >> 1, hi0 = (cc & 1) * 8;
#pragma unroll
                    for (int j = 0; j < 8; ++j) { const int hi = hi0 + j; float x = 0.f; if (s <= t) x += KT[((0 * 4 + hl) * 32 + (t - s)) * 16 + hi]; if (s >= t) x += KT[((1 * 4 + hl) * 32 + (s - t)) * 16 + hi];
                        if (s == t && hi == ho) x += F.in[14][g * 16 + ho]; v[j] = x; }
                } else { const int kk = (cc - 64) * 8, dir = kk >> 7, reim = (kk >> 6) & 1, p0 = kk & 63, e = dir == 0 ? t + 1 : 32 - t;
#pragma unroll
                    for (int j = 0; j < 8; ++j) { const int p = p0 + j; const float cr = CC[((dir * 4 + hl) * 64 + p) * 2], ci = CC[((dir * 4 + hl) * 64 + p) * 2 + 1], pr = POW[((dir * 33 + e) * 64 + p) * 2], pi = POW[((dir * 33 + e) * 64 + p) * 2 + 1];
                        v[j] = reim == 0 ? (cr * pr - ci * pi) : -(cr * pi + ci * pr); } }
                v4u o; o.x = pk2(v[0], v[1]); o.y = pk2(v[2], v[3]); o.z = pk2(v[4], v[5]); o.w = pk2(v[6], v[7]);
                *(GAS v4u*)(MEXT + ((size_t)g * 512 + t * 16 + ho) * UGP + cc * 8) = o; }
        }
        __syncthreads();
    }
    LAS float* scr = (LAS float*)(F.lds + RING_OFF + F.wave * 16384);
    { bf16* WST = (bf16*)(ws + WS_WST);
      for (int it = gw; it < NG * 256; it += NGW) { const int g = it >> 8, n = it & 255, dir = n >> 7, reim = (n >> 6) & 1, p = n & 63; float lr, li, cr, ci; ssm_par(F, dir * 32 + g, p, lr, li, cr, ci);
          const int t = lane >> 1, h0 = (lane & 1) * 8; float pr, pi; cpow(lr, li, (float)(dir == 0 ? 31 - t : t), pr, pi);
          const float er = pr * cr - pi * ci, ei = pr * ci + pi * cr; const size_t o = ((size_t)(dir * 32 + g) * 64 + p) * 16 + h0; float v[8];
#pragma unroll
          for (int j = 0; j < 8; ++j) { const float br = F.in[10][o + j], bi = F.in[11][o + j]; v[j] = reim == 0 ? (er * br - ei * bi) : (er * bi + ei * br); }
          v4u w; w.x = pk2(v[0], v[1]); w.y = pk2(v[2], v[3]); w.z = pk2(v[4], v[5]); w.w = pk2(v[6], v[7]);
          *(GAS v4u*)(WST + ((size_t)g * 256 + n) * 512 + lane * 8) = w; } }
    { constexpr int I_IN = 16 * 104, I_GLU = 8 * 16, I_BR = 8 * 32, I_O = 16 * 32, I_E = 16 * 32;
      constexpr int NIT = I_IN + I_GLU + 2 * I_BR + I_O + NE * 3 * I_E;
      for (int it = gw; it < NIT; it += NGW) { int r = it;
          if (r < I_IN) { const int kb = r / 104, nb = r % 104; p0_transpose_item(F.in[4], 1024, INW, (bf16*)(ws + WS_WIN), 64 * kb, 32 * nb, 32 * nb, scr, lane); continue; } r -= I_IN;
          if (r < I_GLU) { const int kb = r / 16, nb = r % 16; p0_transpose_item(F.in[15], 512, 512, (bf16*)(ws + WS_WGLU), 64 * kb, 32 * nb, 32 * nb, scr, lane); continue; } r -= I_GLU;
          if (r < I_BR) { const int kb = r / 32, nb = r % 32; p0_transpose_item(F.in[17], 512, 1024, (bf16*)(ws + WS_WAB), 64 * kb, 32 * nb, 32 * nb, scr, lane); continue; } r -= I_BR;
          if (r < I_BR) { const int kb = r / 32, nb = r % 32; p0_transpose_item(F.in[18], 512, 1024, (bf16*)(ws + WS_WSB), 64 * kb, 32 * nb, 32 * nb, scr, lane); continue; } r -= I_BR;
          if (r < I_O) { const int kb = r / 32, nb = r % 32; p0_transpose_item(F.in[19], 1024, 1024, (bf16*)(ws + WS_WO), 64 * kb, 32 * nb, 32 * nb, scr, lane); continue; } r -= I_O;
          const int e = r / (3 * I_E), which = (r / I_E) % 3, q = r % I_E, kb = q / 32, nb = q % 32, n0 = 32 * nb;
          const float* W = (which == 0 ? F.in[23] : which == 1 ? F.in[24] : F.in[25]) + (size_t)e * 1024 * 1024;
          if (which < 2) p0_transpose_item(W, 1024, 1024, (bf16*)(ws + WS_WGU), 64 * kb, n0, e * 2048 + (n0 >> 7) * 256 + which * 128 + (n0 & 127), scr, lane);
          else p0_transpose_item(W, 1024, 1024, (bf16*)(ws + WS_WD), 64 * kb, n0, e * 1024 + n0, scr, lane); } }
    { bf16* XN = (bf16*)(ws + WS_XN); f32x2_t2* ST = (f32x2_t2*)(ws + WS_STATS0);
      for (int r = gw; r < M + NMETA; r += NGW) { const float* src = r < M ? F.in[0] + (size_t)r * DM : F.in[1] + (size_t)(r - M) * DM;
          const GAS f32x4* xr = (const GAS f32x4*)src + lane; f32x4 v[4]; float s = 0.f;
#pragma unroll
          for (int j = 0; j < 4; ++j) { v[j] = xr[64 * j]; s += (v[j].x + v[j].y) + (v[j].z + v[j].w); }
          const float mean = wave_sum(s) * (1.f / DM); float s2 = 0.f;
#pragma unroll
          for (int j = 0; j < 4; ++j) { v[j] = v[j] - mean; s2 += (v[j].x * v[j].x + v[j].y * v[j].y) + (v[j].z * v[j].z + v[j].w * v[j].w); }
          const float rstd = 1.f / sqrtf(wave_sum(s2) * (1.f / DM) + LN_EPS);
          if (r < M && lane == 0) ST[r] = (f32x2_t2){mean, rstd};
          GAS unsigned long long* o8 = (GAS unsigned long long*)(XN + (size_t)r * DM) + lane;
#pragma unroll
          for (int j = 0; j < 4; ++j) { const f32x4 gg = ((const GAS f32x4*)F.in[2])[lane + 64 * j], bb = ((const GAS f32x4*)F.in[3])[lane + 64 * j]; const f32x4 o = v[j] * rstd * gg + bb;
              o8[64 * j] = (unsigned long long)pk2(o.x, o.y) | ((unsigned long long)pk2(o.z, o.w) << 32); } } }
    { const int gt = F.vcu * (NWAVES * 64) + tid, NT_ = F.G * NWAVES * 64;
      for (int i = gt; i < 2 * 2 * 112 * 16; i += NT_) { const int arr = i / (2 * 112 * 16), b = (i / (112 * 16)) & 1, q = i % (112 * 16);
          *(GAS v4u*)((bf16*)(ws + (arr ? WS_V : WS_K)) + ((size_t)b * KVROWS + KVALID) * 128 + q * 8) = (v4u){0u, 0u, 0u, 0u}; }
      float* RP = (float*)(ws + WS_ROPE);
      for (int i = gt; i < 3072; i += NT_) { const bool isr = i < 2048; const int q = isr ? i : i - 2048, pos = q >> 4, j = q & 15; const float ang = (float)pos * powf(10000.f, -(float)j / 16.f);
          float sn, cs; sincosf(ang, &sn, &cs); if (isr) { RP[q] = cs; RP[2048 + q] = sn; } else { RP[4096 + q] = cs; RP[5120 + q] = sn; } } }
}

__device__ __forceinline__ void qk_prep(Frame& F) {
    const int gw = F.vcu * NWAVES + F.wave, NGW = F.G * NWAVES, lane = F.lane;
    bf16* Q = (bf16*)(F.ws + WS_Q); bf16* K = (bf16*)(F.ws + WS_K); const float* RP = (const float*)(F.ws + WS_ROPE);
    constexpr int NQ = M * 8, NK = 2 * KVALID * 2;
    for (int it = gw; it < NQ + NK; it += NGW) {
        bf16* p; int pos; float gsc, osc;
        if (it < NQ) { const int row = it >> 3, h = it & 7; p = Q + (size_t)row * 512 + h * 64; pos = row & 8191; gsc = F.in[5][lane]; osc = C2Q; }
        else { const int r = it - NQ, b = r / (KVALID * 2), q = r % (KVALID * 2), l = q >> 1, kvh = q & 1; p = K + ((size_t)b * KVROWS + l) * 128 + kvh * 64; pos = l - NMETA; gsc = F.in[6][lane]; osc = 1.f; }
        const float x = bf2f(p[lane]);
        const float ss = wave_sum(x * x) * (1.f / 64.f);
        const float y = x * rsqrtf(ss + QK_EPS) * gsc, yo = __shfl_xor(y, 1);
        float cs = 1.f, sn = 0.f;
        if (pos >= 0) { const int j = lane >> 1; if (j < 16) { cs = RP[(pos >> 6) * 16 + j]; sn = RP[2048 + (pos >> 6) * 16 + j]; } else { cs = RP[4096 + (pos & 63) * 16 + j - 16]; sn = RP[5120 + (pos & 63) * 16 + j - 16]; } }
        const float o = ((lane & 1) ? (yo * sn + y * cs) : (y * cs - yo * sn)) * osc;
        p[lane] = (bf16)f2bf(o);
    }
}

__device__ __forceinline__ void ssm_scan(Frame& F) {
    if (F.wave != 0 || F.vcu >= 128) return;
    const int it = F.vcu, b = it >> 6, g = (it >> 1) & 31, dir = it & 1, p = F.lane;
    float lr, li, cr, ci; ssm_par(F, dir * 32 + g, p, lr, li, cr, ci);
    float a32r, a32i; cpow(lr, li, 32.f, a32r, a32i);
    const float* S = (const float*)(F.ws + WS_S) + (size_t)(g * 2 + b) * 256 * 256 + dir * 128 + p;
    bf16* U = (bf16*)(F.ws + WS_UG2) + (size_t)(g * 2 + b) * 256 * UGP + 512 + dir * 128 + p;
    float sr = 0.f, si = 0.f;
    if (dir == 0) {
        float a1r, a1i; cpow(lr, li, 1.f, a1r, a1i);
        const bf16* um = (const bf16*)(F.ws + WS_UMETA) + (size_t)g * 256; const size_t o = ((size_t)g * 64 + p) * 16;
        float bbr[16], bbi[16];
#pragma unroll
        for (int h = 0; h < 16; ++h) { const float br = F.in[10][o + h], bi = F.in[11][o + h]; bbr[h] = cr * br - ci * bi; bbi[h] = cr * bi + ci * br; }
        for (int t = 0; t < 16; ++t) { float bur = 0.f, bui = 0.f;
#pragma unroll
            for (int h = 0; h < 16; ++h) { const float uv = bf2f(um[t * 16 + h]); bur = fmaf(bbr[h], uv, bur); bui = fmaf(bbi[h], uv, bui); }
            const float nr = a1r * sr - a1i * si + bur, ni = a1r * si + a1i * sr + bui; sr = nr; si = ni; }
    }
    for (int c0 = 0; c0 < 256; c0 += 32) {
        float vr[32], vi[32];
#pragma unroll
        for (int k = 0; k < 32; ++k) { const int c = dir == 0 ? c0 + k : 255 - (c0 + k); vr[k] = S[(size_t)c * 256]; vi[k] = S[(size_t)c * 256 + 64]; }
#pragma unroll
        for (int k = 0; k < 32; ++k) { const int c = dir == 0 ? c0 + k : 255 - (c0 + k);
            U[(size_t)c * UGP] = (bf16)f2bf(sr); U[(size_t)c * UGP + 64] = (bf16)f2bf(si);
            const float nr = a32r * sr - a32i * si + vr[k], ni = a32r * si + a32i * sr + vi[k]; sr = nr; si = ni; }
    }
}

__device__ __forceinline__ float treduce16(const float (&v)[16], int lane) {
    float r8[8], r4[4], r2[2], r1;
    { const bool up = lane & 32;
#pragma unroll
      for (int i = 0; i < 8; ++i) { const float keep = up ? v[i + 8] : v[i], send = up ? v[i] : v[i + 8]; r8[i] = keep + __shfl_xor(send, 32); } }
    { const bool up = lane & 16;
#pragma unroll
      for (int i = 0; i < 4; ++i) { const float keep = up ? r8[i + 4] : r8[i], send = up ? r8[i] : r8[i + 4]; r4[i] = keep + __shfl_xor(send, 16); } }
    { const bool up = lane & 8;
#pragma unroll
      for (int i = 0; i < 2; ++i) { const float keep = up ? r4[i + 2] : r4[i], send = up ? r4[i] : r4[i + 2]; r2[i] = keep + __shfl_xor(send, 8); } }
    { const bool up = lane & 4; const float keep = up ? r2[1] : r2[0], send = up ? r2[0] : r2[1]; r1 = keep + __shfl_xor(send, 4); }
    r1 += __shfl_xor(r1, 2); r1 += __shfl_xor(r1, 1);
    return r1;
}
__device__ __forceinline__ void ln1_router(Frame& F) {
    const int gw = F.vcu * NWAVES + F.wave, NGW = F.G * NWAVES, lane = F.lane;
    LAS float* WRT = (LAS float*)(F.lds + RING_OFF);
    for (int i = F.tid; i < 16 * 1024; i += NWAVES * 64) { const int d = i >> 4, e = i & 15; WRT[e * 1024 + d] = F.in[22][i]; }
    __syncthreads();
    const float* PRE = F.out; bf16* H1 = (bf16*)(F.ws + WS_H1); f32x2_t2* ST = (f32x2_t2*)(F.ws + WS_STATS1); float* AFF = (float*)(F.ws + WS_AFF);
    for (int r = gw; r < M; r += NGW) {
        const GAS f32x4* xr = (const GAS f32x4*)(PRE + (size_t)r * DM) + lane; f32x4 v[4]; float s = 0.f;
#pragma unroll
        for (int j = 0; j < 4; ++j) { v[j] = xr[64 * j]; s += (v[j].x + v[j].y) + (v[j].z + v[j].w); }
        const float mean = wave_sum(s) * (1.f / DM); float s2 = 0.f;
#pragma unroll
        for (int j = 0; j < 4; ++j) { v[j] = v[j] - mean; s2 += (v[j].x * v[j].x + v[j].y * v[j].y) + (v[j].z * v[j].z + v[j].w * v[j].w); }
        const float rstd = 1.f / sqrtf(wave_sum(s2) * (1.f / DM) + LN_EPS);
        if (lane == 0) ST[r] = (f32x2_t2){mean, rstd};
        GAS unsigned long long* o8 = (GAS unsigned long long*)(H1 + (size_t)r * DM) + lane;
#pragma unroll
        for (int j = 0; j < 4; ++j) { const f32x4 gg = ((const GAS f32x4*)F.in[20])[lane + 64 * j], bb = ((const GAS f32x4*)F.in[21])[lane + 64 * j]; v[j] = v[j] * rstd * gg + bb;
            o8[64 * j] = (unsigned long long)pk2(v[j].x, v[j].y) | ((unsigned long long)pk2(v[j].z, v[j].w) << 32); }
        float acc[16];
        asm volatile("" ::: "memory");
#pragma unroll
        for (int e = 0; e < 16; ++e) { float a = 0.f;
#pragma unroll
            for (int j = 0; j < 4; ++j) { const f32x4 w = *(const LAS f32x4*)(WRT + e * 1024 + (lane + 64 * j) * 4); a += (v[j].x * w.x + v[j].y * w.y) + (v[j].z * w.z + v[j].w * w.w); }
            acc[e] = a; }
        const float lg = treduce16(acc, lane);
        float mx = lg;
#pragma unroll
        for (int o = 4; o < 64; o <<= 1) mx = fmaxf(mx, __shfl_xor(mx, o));
        const float ex = expf(lg - mx); float sm = ex;
#pragma unroll
        for (int o = 4; o < 64; o <<= 1) sm += __shfl_xor(sm, o);
        if ((lane & 3) == 0) AFF[((size_t)(r >> 13) * NE + (lane >> 2)) * SEQ + (r & 8191)] = ex / sm;
    }
}

__device__ __forceinline__ void topk_phase(Frame& F) {
    if (F.vcu >= BATCH * NE) return;
    const int be = F.vcu, b = be >> 4, e = be & 15, t = F.tid, lane = F.lane, w = F.wave;
    LAS int* red = (LAS int*)(F.lds + RING_OFF); LAS int* sc_gt = red + 16; LAS int* sc_eq = sc_gt + 512; LAS int* tot = sc_eq + 512;
    const float* a = (const float*)(F.ws + WS_AFF) + (size_t)be * SEQ;
    unsigned v[16];
#pragma unroll
    for (int i = 0; i < 16; ++i) v[i] = __float_as_uint(a[t * 16 + i]);
    unsigned thr = 0u;
    for (int bit = 30; bit >= 0; --bit) {
        const unsigned cand = thr | (1u << bit); int c = 0;
#pragma unroll
        for (int i = 0; i < 16; ++i) c += (v[i] >= cand) ? 1 : 0;
#pragma unroll
        for (int o = 32; o > 0; o >>= 1) c += __shfl_xor(c, o);
        __syncthreads();
        if (lane == 0) red[w] = c;
        __syncthreads();
        int total = 0;
#pragma unroll
        for (int k = 0; k < 8; ++k) total += red[k];
        if (total >= CAP) thr = cand;
    }
    int ngt = 0, neq = 0;
#pragma unroll
    for (int i = 0; i < 16; ++i) { ngt += (v[i] > thr) ? 1 : 0; neq += (v[i] == thr) ? 1 : 0; }
    __syncthreads();
    sc_gt[t] = ngt; sc_eq[t] = neq;
    __syncthreads();
    if (t == 0) { int ag = 0, ae = 0; for (int i = 0; i < 512; ++i) { const int g0 = sc_gt[i], e0 = sc_eq[i]; sc_gt[i] = ag; sc_eq[i] = ae; ag += g0; ae += e0; } tot[0] = ag; }
    __syncthreads();
    const int quota = CAP - tot[0]; int gpre = sc_gt[t], epre = sc_eq[t];
    int* IDX2 = (int*)(F.ws + WS_IDX2); float* GATE2 = (float*)(F.ws + WS_GATE2); int* SLOTOF = (int*)(F.ws + WS_SLOTOF);
#pragma unroll
    for (int i = 0; i < 16; ++i) {
        const bool gt = v[i] > thr, eq = v[i] == thr, sel = gt || (eq && epre < quota);
        const int tok = t * 16 + i; int so = -1;
        if (sel) { const int slot = gpre + (epre < quota ? epre : quota); so = e * 2048 + b * 1024 + slot; IDX2[so] = b * SEQ + tok; GATE2[so] = __uint_as_float(v[i]); }
        SLOTOF[((size_t)b * SEQ + tok) * NE + e] = so;
        gpre += gt ? 1 : 0; epre += eq ? 1 : 0;
    }
    __syncthreads();
}

__device__ __forceinline__ void gather_phase(Frame& F) {
    const int gw = F.vcu * NWAVES + F.wave, NGW = F.G * NWAVES, lane = F.lane;
    const int* IDX2 = (const int*)(F.ws + WS_IDX2); const bf16* H1 = (const bf16*)(F.ws + WS_H1); bf16* XE = (bf16*)(F.ws + WS_XE);
    for (int r = gw; r < NE * 2048; r += NGW) { const int src = IDX2[r];
        const GAS v4u* s = (const GAS v4u*)(H1 + (size_t)src * DM) + lane; GAS v4u* d = (GAS v4u*)(XE + (size_t)r * DM) + lane;
        const v4u a = s[0], c = s[64]; d[0] = a; d[64] = c; }
}

__device__ __forceinline__ void final_phase(Frame& F) {
    const int gw = F.vcu * NWAVES + F.wave, NGW = F.G * NWAVES, lane = F.lane;
    float* OUT = F.out; const f32x2_t2* ST = (const f32x2_t2*)(F.ws + WS_STATS1); const int* SLOTOF = (const int*)(F.ws + WS_SLOTOF); const bf16* YE = (const bf16*)(F.ws + WS_XE);
    for (int r = gw; r < M; r += NGW) {
        GAS f32x4* xr = (GAS f32x4*)(OUT + (size_t)r * DM) + lane; f32x4 v[4]; const f32x2_t2 st = ST[r];
        const int myslot = SLOTOF[(size_t)r * NE + (lane & 15)];
#pragma unroll
        for (int j = 0; j < 4; ++j) { const f32x4 gg = ((const GAS f32x4*)F.in[20])[lane + 64 * j], bb = ((const GAS f32x4*)F.in[21])[lane + 64 * j]; v[j] = ((xr[64 * j] - st.x) * st.y * gg + bb) * ALPHA; }
        for (int e = 0; e < NE; ++e) { const int sl = __shfl(myslot, e);
            if (sl >= 0) { const GAS u32x2_t* yr = (const GAS u32x2_t*)(YE + (size_t)sl * DM) + lane;
#pragma unroll
                for (int j = 0; j < 4; ++j) { const u32x2_t y = yr[64 * j]; v[j].x += bflo(y.x); v[j].y += bfhi(y.x); v[j].z += bflo(y.y); v[j].w += bfhi(y.y); } } }
        float s = 0.f;
#pragma unroll
        for (int j = 0; j < 4; ++j) s += (v[j].x + v[j].y) + (v[j].z + v[j].w);
        const float mean = wave_sum(s) * (1.f / DM); float s2 = 0.f;
#pragma unroll
        for (int j = 0; j < 4; ++j) { v[j] = v[j] - mean; s2 += (v[j].x * v[j].x + v[j].y * v[j].y) + (v[j].z * v[j].z + v[j].w * v[j].w); }
        const float rstd = 1.f / sqrtf(wave_sum(s2) * (1.f / DM) + LN_EPS);
#pragma unroll
        for (int j = 0; j < 4; ++j) { const f32x4 gg = ((const GAS f32x4*)F.in[26])[lane + 64 * j], bb = ((const GAS f32x4*)F.in[27])[lane + 64 * j]; xr[64 * j] = v[j] * rstd * gg + bb; }
    }
}

#ifndef MK_PER_PHASE
#define MK_PER_PHASE 0
#endif
constexpr int N_PHASES = 16;
struct Args { const float* in[28]; float* out; unsigned char* ws; int ph_lo, ph_hi; };
__global__ void __launch_bounds__(NWAVES * 64, 2) mk_fwd(Args args) {
    extern __shared__ __attribute__((aligned(16))) unsigned char lds[];
    Frame F;
    F.lds = (LAS unsigned char*)lds; F.MISC = (volatile LAS unsigned*)(F.lds + MISC_OFF);
    F.tid = threadIdx.x; F.lane = F.tid & 63; F.wave = __builtin_amdgcn_readfirstlane(F.tid >> 6);
    F.G = gridDim.x; { const int bx = blockIdx.x; F.vcu = (F.G % 8 == 0) ? (bx % 8) * (F.G / 8) + bx / 8 : bx; }
    F.ws = args.ws; F.ctl = (gu32*)(args.ws + WS_CTL); F.out = args.out;
#pragma unroll
    for (int i = 0; i < 28; ++i) F.in[i] = args.in[i];
    for (int u = F.tid; u < (LDS_BYTES - LDSCTL_OFF) / 4; u += NWAVES * 64) ((LAS unsigned*)(F.lds + LDSCTL_OFF))[u] = 0u;
    __syncthreads();
    XcdBarrier bar; bar.bar = (unsigned*)(F.ctl + CW_BAR); bar.x = 0; bar.st = nullptr;
    if (!MK_PER_PHASE) bar = xcd_barrier_post((unsigned*)(F.ctl + CW_BAR), F.MISC + 8);
    const int lo = args.ph_lo, hi = args.ph_hi;
    unsigned char* ws = args.ws;
#define IN(k) (lo <= (k) && (k) < hi)
#define SEAM(k) do { if (IN(k) && IN((k) + 1)) xcd_barrier(bar); } while (0)
    using pg8::Gemm; using pg8::gemm_phase;
    if (IN(0)) { p0_prologue(F); } SEAM(0);
    if (IN(1)) { Gemm g{(const bf16*)(ws + WS_XN), (const bf16*)(ws + WS_WIN), 1024, 1024, 1024}; InProjOrder S; S.so.init(M, INW, F.G, (int)blockIdx.x);
        EpiInProj E{(bf16*)(ws + WS_Q), (bf16*)(ws + WS_K), (bf16*)(ws + WS_V), (bf16*)(ws + WS_UG2), (bf16*)args.out, (bf16*)(ws + WS_UMETA)};
        gemm_phase<EpiInProj, InProjOrder, true, true>(F.lds + RING_OFF, g, S, E); } SEAM(1);
    if (IN(2)) { qk_prep(F);
        Gemm g{(const bf16*)(ws + WS_UG2), (const bf16*)(ws + WS_WST), UGP, 512, 512}; SsmStateOrder S{F.G, F.vcu}; EpiSsmState E{(float*)(ws + WS_S)};
        __syncthreads();
        gemm_phase<EpiSsmState, SsmStateOrder, true, true>(F.lds + RING_OFF, g, S, E); } SEAM(2);
    if (IN(3)) { ssm_scan(F); __syncthreads();
        const attn_body::AttnTensors AT{(const attn_body::bf16*)(ws + WS_Q), (const attn_body::bf16*)(ws + WS_K), (const attn_body::bf16*)(ws + WS_V), (attn_body::bf16*)(ws + WS_Q)};
        const attn_body::StaticOrder S((int)F.G, (int)blockIdx.x);
        attn_body::attn_phase<attn_body::StaticOrder>((char*)lds + RING_OFF, AT, S); } SEAM(3);
    if (IN(4)) { Gemm g{(const bf16*)(ws + WS_UG2), (const bf16*)(ws + WS_MEXT), UGP, UGP, UGP}; SsmYOrder S{F.G, F.vcu}; EpiSsmY E{(bf16*)(ws + WS_YG)};
        gemm_phase<EpiSsmY, SsmYOrder, true, true>(F.lds + RING_OFF, g, S, E); } SEAM(4);
    if (IN(5)) { Gemm g{(const bf16*)(ws + WS_YG), (const bf16*)(ws + WS_WGLU), 512, 512, 512}; pg8::StaticOrder S; S.init(M, 512, F.G, (int)blockIdx.x); EpiGlu E{(const bf16*)(ws + WS_YG), F.in[16], (bf16*)(ws + WS_Z)};
        gemm_phase<EpiGlu, pg8::StaticOrder, true, true>(F.lds + RING_OFF, g, S, E); } SEAM(5);
    if (IN(6)) { Gemm g{(const bf16*)(ws + WS_Q), (const bf16*)(ws + WS_WAB), 512, 512, 512}; pg8::StaticOrder S; S.init(M, 1024, F.G, (int)blockIdx.x); EpiBranch<0> E{(const bf16*)args.out, nullptr, (bf16*)(ws + WS_T1)};
        gemm_phase<EpiBranch<0>, pg8::StaticOrder, true, true>(F.lds + RING_OFF, g, S, E); } SEAM(6);
    if (IN(7)) { Gemm g{(const bf16*)(ws + WS_Z), (const bf16*)(ws + WS_WSB), 512, 512, 512}; pg8::StaticOrder S; S.init(M, 1024, F.G, (int)blockIdx.x); EpiBranch<1> E{(const bf16*)args.out, (const bf16*)(ws + WS_T1), (bf16*)(ws + WS_MERGED)};
        gemm_phase<EpiBranch<1>, pg8::StaticOrder, true, true>(F.lds + RING_OFF, g, S, E); } SEAM(7);
    if (IN(8)) { Gemm g{(const bf16*)(ws + WS_MERGED), (const bf16*)(ws + WS_WO), 1024, 1024, 1024}; pg8::StaticOrder S; S.init(M, 1024, F.G, (int)blockIdx.x);
        EpiPre1 E{F.in[0], F.in[2], F.in[3], (const f32x2_t2*)(ws + WS_STATS0), args.out};
        gemm_phase<EpiPre1, pg8::StaticOrder, true, true>(F.lds + RING_OFF, g, S, E); } SEAM(8);
    if (IN(9)) { ln1_router(F); } SEAM(9);
    if (IN(10)) { topk_phase(F); } SEAM(10);
    if (IN(11)) { gather_phase(F); } SEAM(11);
    if (IN(12)) { Gemm g{(const bf16*)(ws + WS_XE), (const bf16*)(ws + WS_WGU), 1024, 1024, 1024}; MoeOrder S{F.G, (int)blockIdx.x, 8, 8}; EpiMoe1 E{(bf16*)(ws + WS_HB)};
        gemm_phase<EpiMoe1, MoeOrder, true, true>(F.lds + RING_OFF, g, S, E); } SEAM(12);
    if (IN(13)) { Gemm g{(const bf16*)(ws + WS_HB), (const bf16*)(ws + WS_WD), 1024, 1024, 1024}; MoeOrder S{F.G, (int)blockIdx.x, 8, 4}; EpiMoe2 E{(const float*)(ws + WS_GATE2), (bf16*)(ws + WS_XE)};
        gemm_phase<EpiMoe2, MoeOrder, true, true>(F.lds + RING_OFF, g, S, E); } SEAM(13);
    if (IN(14)) { final_phase(F); }
#undef IN
#undef SEAM
}

extern "C" void kernel_launch(void* const* d_in, const int* in_sizes, int n_in, void* d_out, int out_size, void* d_ws, size_t ws_size, hipStream_t stream) {
    static int grid = 0;
    if (grid == 0) {
        int dev = 0, cus = 0;
        if (hipGetDevice(&dev) != hipSuccess || hipDeviceGetAttribute(&cus, hipDeviceAttributeMultiprocessorCount, dev) != hipSuccess) { fprintf(stderr, "kernel_launch: device query failed\n"); grid = -1; return; }
        if (hipFuncSetAttribute((const void*)mk_fwd, hipFuncAttributeMaxDynamicSharedMemorySize, LDS_BYTES) != hipSuccess) { fprintf(stderr, "kernel_launch: hipFuncSetAttribute failed\n"); grid = -1; return; }
        (void)hipGetLastError();
        grid = cus;
        if (grid != 256 || n_in != 28 || ws_size < WS_END) fprintf(stderr, "kernel_launch: unexpected geometry: %d CUs, %d inputs, %zu bytes of workspace\n", cus, n_in, ws_size);
    }
    if (grid < 0) return;
    (void)hipMemsetAsync((char*)d_ws + WS_CTL, 0, CTL_ZERO_BYTES, stream);
    Args a; memset(&a, 0, sizeof(a));
    for (int i = 0; i < 28; ++i) a.in[i] = (const float*)d_in[i];
    a.out = (float*)d_out; a.ws = (unsigned char*)d_ws;
#if MK_PER_PHASE
    for (int p = 0; p < N_PHASES - 1; ++p) { a.ph_lo = p; a.ph_hi = p + 1; hipLaunchKernelGGL(mk_fwd, dim3(grid), dim3(NWAVES * 64), LDS_BYTES, stream, a); }
#else
    a.ph_lo = 0; a.ph_hi = N_PHASES; hipLaunchKernelGGL(mk_fwd, dim3(grid), dim3(NWAVES * 64), LDS_BYTES, stream, a);
#endif
}
```

```cpp
#include <hip/hip_runtime.h>
#include <cstdio>
#include <cstdint>
#include <cstring>
namespace pg8 {
#define PG8_LAS __attribute__((address_space(3)))
typedef unsigned short bf16_t;
typedef short bf16x8 __attribute__((ext_vector_type(8)));
typedef float f32x4 __attribute__((ext_vector_type(4)));
typedef unsigned u32x4 __attribute__((ext_vector_type(4)));
constexpr int BM = 256, BK = 64, HALF = 128, HTB = HALF * BK * 2  , STAGE_BYTES = 8 * HTB, NXCD = 8, WGM = 8;

__host__ __device__ __forceinline__ int lds_byte(int r, int c) { const int st = (r >> 4) * 2 + (c >> 5), rr = r & 15, cc = c & 31, ob = rr * 64 + cc * 2; return st * 1024 + (ob ^ (((ob >> 9) & 1) << 5)); }
__host__ __device__ __forceinline__ void stage_rc(int b, int& R, int& C) { const int st = b / 1024, sb = b % 1024, swz = sb ^ (((sb >> 9) & 1) << 5); R = (st >> 1) * 16 + swz / 64; C = (st & 1) * 32 + (swz % 64) / 2; }
__host__ __device__ __forceinline__ int perm32(int rho) { const int n = rho >> 4, i = rho & 15; return 8 * (i >> 2) + 4 * n + (i & 3); }

struct Unit { int pm, pn; };
struct Gemm { const bf16_t* A; const bf16_t* Bt; int lda, ldb, K; };

struct StaticOrder {
    int nM, nN, nwg, G, c;
    __host__ __device__ void init(int M, int N, int G_, int c_) { nM = M / BM; nN = N / BM; nwg = nM * nN; G = G_; c = c_; }
    __host__ __device__ bool next(int i, Unit& u) const {
        const long L = (long)i * G + c; if (L >= nwg) return false;
        int wgid = (int)L; { const int q = nwg / NXCD, r = nwg % NXCD, xcd = wgid % NXCD, off = wgid / NXCD; wgid = (xcd < r ? xcd * (q + 1) : r * (q + 1) + (xcd - r) * q) + off; }
        const int nig = WGM * nN, gid = wgid / nig, fm = gid * WGM, gsz = (nM - fm) < WGM ? (nM - fm) : WGM;
        u.pm = fm + ((wgid % nig) % gsz); u.pn = (wgid % nig) / gsz; return true;
    }
    __device__ __forceinline__ void a_ready(const Unit&) const {}
    __device__ __forceinline__ void done(const Unit&) const {}
};

__device__ __forceinline__ unsigned cvt_pk_bf16(float lo, float hi) { unsigned r; asm volatile("v_cvt_pk_bf16_f32 %0, %1, %2" : "=v"(r) : "v"(lo), "v"(hi)); return r; }
typedef float f32x2 __attribute__((ext_vector_type(2)));
template <class Epi, class Sched, bool ALIGN_EPI = false, bool SP2 = false>
__device__ __forceinline__ void gemm_phase(PG8_LAS unsigned char* lds, const Gemm g, const Sched& S, const Epi& E) {
    const int tid = threadIdx.x, wid = __builtin_amdgcn_readfirstlane(tid >> 6), lane = tid & 63, wr = wid >> 2, wc = wid & 3, fr = lane & 15, fq = lane >> 4;
    const int K = g.K, nt = K / BK;
    unsigned voffA[2], voffB[2];
#pragma unroll
    for (int i = 0; i < 2; ++i) { int R, C; stage_rc(tid * 16 + i * 8192, R, C); const int Rb = Epi::PERM ? ((R & ~31) + perm32(R & 31)) : R;
        voffA[i] = (unsigned)(R * g.lda + C) * 2u; voffB[i] = (unsigned)(Rb * g.ldb + C) * 2u; }
    const size_t kstep = (size_t)(BK * 2);
    const size_t hstepA = (size_t)HALF * g.lda * 2, hstepB = (size_t)HALF * g.ldb * 2;
    const size_t tstepA = 2 * hstepA, tstepB = 2 * hstepB;
    const unsigned ldsw = (unsigned)wid * 1024u;
    const int aoff = lds_byte(wr * 64 + fr, fq * 8), boff = lds_byte(wc * 32 + fr, fq * 8);
#define PG8_SA(b, h) (((b) * 2 + (h)) * HTB)
#define PG8_SB(b, h) ((4 + (b) * 2 + (h)) * HTB)
#define PG8_STAGE(bufoff, gbase, voff) do { _Pragma("unroll") for (int _i = 0; _i < 2; ++_i) \
        __builtin_amdgcn_global_load_lds((const unsigned*)((const char*)(gbase) + (voff)[_i]), (PG8_LAS unsigned*)(lds + (bufoff) + ldsw + _i * 8192), 16, 0, 0); } while (0)
#define PG8_LDA(dst, b, h) do { _Pragma("unroll") for (int m = 0; m < 4; ++m) _Pragma("unroll") for (int k = 0; k < 2; ++k) dst[m][k] = *(const PG8_LAS bf16x8*)(lds + PG8_SA(b, h) + aoff + m * 2048 + k * 1024); } while (0)
#define PG8_LDB(dst, b, h) do { _Pragma("unroll") for (int n = 0; n < 2; ++n) _Pragma("unroll") for (int k = 0; k < 2; ++k) dst[n][k] = *(const PG8_LAS bf16x8*)(lds + PG8_SB(b, h) + boff + n * 2048 + k * 1024); } while (0)
#define PG8_MMA(ai, bj, At, Bt) do { __builtin_amdgcn_s_setprio(1); _Pragma("unroll") for (int m = 0; m < 4; ++m) _Pragma("unroll") for (int n = 0; n < 2; ++n) _Pragma("unroll") for (int k = 0; k < 2; ++k) \
        acc[ai][bj][m][n] = __builtin_amdgcn_mfma_f32_16x16x32_bf16(Bt[n][k], At[m][k], acc[ai][bj][m][n], 0, 0, 0); __builtin_amdgcn_s_setprio(0); } while (0)
#define PG8_WAIT_V(n) asm volatile("s_waitcnt vmcnt(" #n ")" ::: "memory")
#define PG8_WAIT_L(n) asm volatile("s_waitcnt lgkmcnt(" #n ")" ::: "memory")
#define PG8_BAR __builtin_amdgcn_s_barrier()
#define PG8_SCHED __builtin_amdgcn_sched_barrier(0)
    Unit cur, nxt; int ui = 0;
    if (!S.next(0, cur)) return;
    f32x4 acc[2][2][4][2];
#pragma unroll
    for (int a = 0; a < 2; ++a)
#pragma unroll
        for (int b = 0; b < 2; ++b)
#pragma unroll
            for (int m = 0; m < 4; ++m)
#pragma unroll
                for (int n = 0; n < 2; ++n) acc[a][b][m][n] = (f32x4){0.f, 0.f, 0.f, 0.f};
    bf16x8 At[4][2], B0[2][2], B1[2][2];
    const char* cA = (const char*)g.A + (size_t)cur.pm * tstepA; const char* cB = (const char*)g.Bt + (size_t)cur.pn * tstepB;
    S.a_ready(cur);
    if constexpr (SP2) {
        PG8_STAGE(PG8_SB(0, 0), cB, voffB); PG8_STAGE(PG8_SB(0, 1), cB + hstepB, voffB); PG8_STAGE(PG8_SA(0, 0), cA, voffA); PG8_STAGE(PG8_SA(0, 1), cA + hstepA, voffA);
        if (wr == 1) PG8_BAR;
        PG8_WAIT_V(2); PG8_BAR;
        PG8_STAGE(PG8_SB(1, 0), cB + kstep, voffB); PG8_STAGE(PG8_SA(1, 0), cA + kstep, voffA); PG8_STAGE(PG8_SB(1, 1), cB + hstepB + kstep, voffB);
        PG8_WAIT_V(6); PG8_BAR;
    } else {
        PG8_STAGE(PG8_SB(0, 0), cB, voffB); PG8_STAGE(PG8_SA(0, 0), cA, voffA); PG8_STAGE(PG8_SB(0, 1), cB + hstepB, voffB); PG8_STAGE(PG8_SA(0, 1), cA + hstepA, voffA);
        if (wr == 1) PG8_BAR;
        PG8_WAIT_V(4); PG8_BAR;
        PG8_STAGE(PG8_SB(1, 0), cB + kstep, voffB); PG8_STAGE(PG8_SA(1, 0), cA + kstep, voffA); PG8_STAGE(PG8_SB(1, 1), cB + hstepB + kstep, voffB);
        PG8_WAIT_V(6); PG8_BAR;
    }
    for (;;) {
        const bool has_next = S.next(ui + 1, nxt);
        const char* nA = has_next ? (const char*)g.A + (size_t)nxt.pm * tstepA : cA; const char* nB = has_next ? (const char*)g.Bt + (size_t)nxt.pn * tstepB : cB;
        for (int t = 0; t < nt; t += 2) {
            const bool last = (t == nt - 2);
            const char* a1 = cA + (size_t)(t + 1) * kstep;
            const char* a2 = last ? nA : cA + (size_t)(t + 2) * kstep; const char* b2 = last ? nB : cB + (size_t)(t + 2) * kstep;
            const char* a3 = a2 + kstep; const char* b3 = b2 + kstep;
            if (last && has_next) S.a_ready(nxt);
            if constexpr (SP2) {
            PG8_LDB(B0, 0, 0); PG8_LDB(B1, 0, 1); PG8_SCHED; PG8_LDA(At, 0, 0); PG8_STAGE(PG8_SA(1, 1), a1 + hstepA, voffA);
            PG8_WAIT_V(8); PG8_WAIT_L(0); PG8_BAR; PG8_MMA(0, 0, At, B0); PG8_MMA(0, 1, At, B1); PG8_BAR; PG8_SCHED;
            PG8_LDA(At, 0, 1); PG8_STAGE(PG8_SB(0, 0), b2, voffB); PG8_STAGE(PG8_SB(0, 1), b2 + hstepB, voffB); PG8_STAGE(PG8_SA(0, 0), a2, voffA);
            PG8_WAIT_V(8); PG8_WAIT_L(0); PG8_BAR; PG8_MMA(1, 0, At, B0); PG8_MMA(1, 1, At, B1); PG8_BAR; PG8_SCHED;
            PG8_LDB(B0, 1, 0); PG8_LDB(B1, 1, 1); PG8_SCHED; PG8_LDA(At, 1, 0); PG8_STAGE(PG8_SA(0, 1), a2 + hstepA, voffA);
            PG8_WAIT_V(8); PG8_WAIT_L(0); PG8_BAR; PG8_MMA(0, 0, At, B0); PG8_MMA(0, 1, At, B1); PG8_BAR; PG8_SCHED;
            PG8_LDA(At, 1, 1); PG8_STAGE(PG8_SB(1, 0), b3, voffB); PG8_STAGE(PG8_SB(1, 1), b3 + hstepB, voffB); PG8_STAGE(PG8_SA(1, 0), a3, voffA);
            PG8_WAIT_V(8); PG8_WAIT_L(0); PG8_BAR; PG8_MMA(1, 0, At, B0); PG8_MMA(1, 1, At, B1); PG8_BAR; PG8_SCHED;
            } else {
            PG8_LDB(B0, 0, 0); PG8_SCHED; PG8_LDA(At, 0, 0); PG8_STAGE(PG8_SA(1, 1), a1 + hstepA, voffA);
            PG8_WAIT_L(8); PG8_BAR; PG8_WAIT_L(0); PG8_MMA(0, 0, At, B0); PG8_BAR; PG8_SCHED;
            PG8_LDB(B1, 0, 1); PG8_STAGE(PG8_SB(0, 0), b2, voffB);
            PG8_BAR; PG8_WAIT_L(0); PG8_MMA(0, 1, At, B1); PG8_BAR;
            PG8_LDA(At, 0, 1); PG8_STAGE(PG8_SA(0, 0), a2, voffA);
            PG8_BAR; PG8_WAIT_L(0); PG8_MMA(1, 0, At, B0); PG8_BAR; PG8_SCHED;
            PG8_STAGE(PG8_SB(0, 1), b2 + hstepB, voffB);
            PG8_WAIT_V(6); PG8_BAR; PG8_MMA(1, 1, At, B1); PG8_BAR;
            PG8_LDB(B0, 1, 0); PG8_SCHED; PG8_LDA(At, 1, 0); PG8_STAGE(PG8_SA(0, 1), a2 + hstepA, voffA);
            PG8_WAIT_L(8); PG8_BAR; PG8_WAIT_L(0); PG8_MMA(0, 0, At, B0); PG8_BAR; PG8_SCHED;
            PG8_LDB(B1, 1, 1); PG8_STAGE(PG8_SB(1, 0), b3, voffB);
            PG8_BAR; PG8_WAIT_L(0); PG8_MMA(0, 1, At, B1); PG8_BAR;
            PG8_LDA(At, 1, 1); PG8_STAGE(PG8_SA(1, 0), a3, voffA);
            PG8_BAR; PG8_WAIT_L(0); PG8_MMA(1, 0, At, B0); PG8_BAR; PG8_SCHED;
            PG8_STAGE(PG8_SB(1, 1), b3 + hstepB, voffB);
            PG8_WAIT_V(6); PG8_BAR; PG8_MMA(1, 1, At, B1); PG8_BAR;
            }
        }
        if constexpr (ALIGN_EPI) { if (wr == 0) PG8_BAR; }
        if constexpr (!Epi::AFTER_DRAIN) { E(acc, cur, wr, wc, fr, fq); S.done(cur); }
        if (!has_next) break;
#pragma unroll
        for (int a = 0; a < 2; ++a)
#pragma unroll
            for (int b = 0; b < 2; ++b)
#pragma unroll
                for (int m = 0; m < 4; ++m)
#pragma unroll
                    for (int n = 0; n < 2; ++n) acc[a][b][m][n] = (f32x4){0.f, 0.f, 0.f, 0.f};
        cur = nxt; cA = nA; cB = nB; ++ui;
        if constexpr (ALIGN_EPI) { if (wr == 1) PG8_BAR; }
    }
    PG8_WAIT_V(0);
    if constexpr (!ALIGN_EPI) { if (wr == 0) PG8_BAR; }
    PG8_BAR;
    if constexpr (Epi::AFTER_DRAIN) { E.fused(acc, cur, wr, wc, fr, fq, lds, wid, lane); S.done(cur); }
#undef PG8_SA
#undef PG8_SB
#undef PG8_STAGE
#undef PG8_LDA
#undef PG8_LDB
#undef PG8_MMA
#undef PG8_WAIT_V
#undef PG8_WAIT_L
#undef PG8_BAR
#undef PG8_SCHED
}
}
#define PG8_SP2 true
#define PG8_ALIGN true
#include <hip/hip_bf16.h>
#include <cmath>
namespace attn_body {
using bf16=__hip_bfloat16;
using bf16x8=__attribute__((ext_vector_type(8)))short;
using s16x4=__attribute__((ext_vector_type(4)))short;
using f32x16=__attribute__((ext_vector_type(16)))float;
using u32x4=__attribute__((ext_vector_type(4)))unsigned;
constexpr int BATCH=2,NHEAD=8,SEQ=8192,D=64,DMQ=NHEAD*D,DMK=128,KVROWS=8320,KVALID=8208;
constexpr int NW=8,QBLK=32,QB=QBLK*NW,KVBLK=64,NQB=SEQ/QB;
constexpr int ATTN_PITCH=DMQ, ATTN_UNIT_ROWS=QB;
__device__ __forceinline__ int crow(int r,int hi){return (r&3)+8*(r>>2)+4*hi;}
#define SBAR() __builtin_amdgcn_sched_barrier(0)
__device__ __forceinline__ void cmask(f32x16&p0,f32x16&p1,int t,int hi){
  const float NEG=-INFINITY; int kb=64*t+4*hi;
  #pragma unroll
  for(int r=0;r<16;++r){int kv=kb+(r&3)+8*(r>>2); if(kv>=KVALID)p0[r]=NEG; if(kv+32>=KVALID)p1[r]=NEG;}
}

constexpr int NSLOT=3, SLOTB=8192;
constexpr int LDS_K=0, LDS_V=NSLOT*SLOTB, LDS_WS=2*NSLOT*SLOTB, LDS_OST=LDS_WS+NW*64*4, LDS_BYTES=LDS_OST+NW*4096;
constexpr float C2=0.125f*1.4426950408889634f;
__device__ __forceinline__ void glds16(const void*gsrc,unsigned lds_dst){unsigned keep;
  asm volatile("s_mov_b32 %0, m0\n\ts_mov_b32 m0, %2\n\ts_nop 0\n\tglobal_load_lds_dwordx4 %1, off\n\ts_mov_b32 m0, %0":"=&s"(keep):"v"(gsrc),"s"(lds_dst):"memory");}
__device__ __forceinline__ float max3f(float a,float b,float c){float r;asm("v_max3_f32 %0, %1, %2, %3":"=v"(r):"v"(a),"v"(b),"v"(c));return r;}
__device__ __forceinline__ float max2f(float a,float b){float r;asm("v_max_f32_e32 %0, %1, %2":"=v"(r):"v"(a),"v"(b));return r;}
__device__ __forceinline__ float fadd_s(float a,float b){float r;asm("v_add_f32_e32 %0, %1, %2":"=v"(r):"v"(a),"v"(b));return r;}
__device__ __forceinline__ float fsub_s(float a,float b){float r;asm("v_sub_f32_e32 %0, %1, %2":"=v"(r):"v"(a),"v"(b));return r;}
typedef float f32x2_t __attribute__((ext_vector_type(2))); typedef __bf16 bf16x2_t __attribute__((ext_vector_type(2)));
__device__ __forceinline__ unsigned cvtpk_s(float lo,float hi){f32x2_t v={lo,hi};bf16x2_t b=__builtin_convertvector(v,bf16x2_t);return __builtin_bit_cast(unsigned,b);}
#define WAIT_BAR(N) asm volatile("s_waitcnt vmcnt(" #N ") lgkmcnt(0)\n\ts_barrier":::"memory")

__device__ __forceinline__ void qkt(f32x16&p0,f32x16&p1,const char*Kslot,const bf16x8*qr,const f32x16&negm,int r32,int hi){
  const char*kb=Kslot+hi*1024+r32*16;
  #pragma unroll
  for(int d0=0;d0<4;++d0){
    const bf16x8 b0=*reinterpret_cast<const bf16x8*>(kb+d0*2048);
    const bf16x8 b1=*reinterpret_cast<const bf16x8*>(kb+d0*2048+512);
    if(d0==0){p0=__builtin_amdgcn_mfma_f32_32x32x16_bf16(b0,qr[0],negm,0,0,0);p1=__builtin_amdgcn_mfma_f32_32x32x16_bf16(b1,qr[0],negm,0,0,0);}
    else{p0=__builtin_amdgcn_mfma_f32_32x32x16_bf16(b0,qr[d0],p0,0,0,0);p1=__builtin_amdgcn_mfma_f32_32x32x16_bf16(b1,qr[d0],p1,0,0,0);}}
}
typedef __attribute__((address_space(3))) const char* lds_cptr;
typedef short v4i16_t __attribute__((ext_vector_type(4)));
__device__ __forceinline__ void kload8(bf16x8*kf,lds_cptr kp){
  kf[0]=*(const __attribute__((address_space(3))) bf16x8*)(kp);      kf[1]=*(const __attribute__((address_space(3))) bf16x8*)(kp+512);
  kf[2]=*(const __attribute__((address_space(3))) bf16x8*)(kp+2048); kf[3]=*(const __attribute__((address_space(3))) bf16x8*)(kp+2560);
  kf[4]=*(const __attribute__((address_space(3))) bf16x8*)(kp+4096); kf[5]=*(const __attribute__((address_space(3))) bf16x8*)(kp+4608);
  kf[6]=*(const __attribute__((address_space(3))) bf16x8*)(kp+6144); kf[7]=*(const __attribute__((address_space(3))) bf16x8*)(kp+6656);
}
__device__ __forceinline__ void kload2(bf16x8*kf,lds_cptr kp,int j){ kf[2*j]=*(const __attribute__((address_space(3))) bf16x8*)(kp+j*2048); kf[2*j+1]=*(const __attribute__((address_space(3))) bf16x8*)(kp+j*2048+512); }
__device__ __forceinline__ s16x4 vtr(lds_cptr p){ return __builtin_bit_cast(s16x4,__builtin_amdgcn_ds_read_tr16_b64_v4i16((__attribute__((address_space(3))) v4i16_t*)p)); }
__device__ __forceinline__ float rowmax(const f32x16&p0,const f32x16&p1){
  float a=max3f(p0[0],p0[1],p1[0]),b=max3f(p0[2],p0[3],p1[1]);a=max3f(a,p1[2],p1[3]);
  #pragma unroll
  for(int r=4;r<16;r+=4){a=max3f(a,p0[r],p0[r+1]);b=max3f(b,p0[r+2],p0[r+3]);a=max3f(a,p1[r],p1[r+1]);b=max3f(b,p1[r+2],p1[r+3]);}
  const float m=max2f(a,b);
  auto rr=__builtin_amdgcn_permlane32_swap(__float_as_uint(m),__float_as_uint(m),false,false);
  return max2f(__uint_as_float(rr[0]),__uint_as_float(rr[1]));
}
__device__ __forceinline__ void pv(f32x16*o,int vb,bf16x8 pa0,bf16x8 pa1,bf16x8 pa2,bf16x8 pa3){
  #pragma unroll
  for(int d0=0;d0<2;++d0){s16x4 lo[4],hi[4];
    #pragma unroll
    for(int ks=0;ks<4;++ks){
      asm volatile("ds_read_b64_tr_b16 %0,%1 offset:%c2":"=&v"(lo[ks]):"v"(vb),"i"(d0*4096+ks*1024):"memory");
      asm volatile("ds_read_b64_tr_b16 %0,%1 offset:%c2":"=&v"(hi[ks]):"v"(vb),"i"(d0*4096+ks*1024+512):"memory");}
    asm volatile("s_waitcnt lgkmcnt(0)":::"memory");SBAR();
    #define PK(k) (bf16x8){lo[k][0],lo[k][1],lo[k][2],lo[k][3],hi[k][0],hi[k][1],hi[k][2],hi[k][3]}
    o[d0]=__builtin_amdgcn_mfma_f32_32x32x16_bf16(pa0,PK(0),o[d0],0,0,0);
    o[d0]=__builtin_amdgcn_mfma_f32_32x32x16_bf16(pa1,PK(1),o[d0],0,0,0);
    o[d0]=__builtin_amdgcn_mfma_f32_32x32x16_bf16(pa2,PK(2),o[d0],0,0,0);
    o[d0]=__builtin_amdgcn_mfma_f32_32x32x16_bf16(pa3,PK(3),o[d0],0,0,0);
    #undef PK
  }
}

#ifndef ATTN_STORE16
#define ATTN_STORE16(p,v) (*(u32x4*)(p)=(v))
#endif
template<int THRL> __device__ __forceinline__ void attn_unit(int b,int h,int qb,const bf16*Q,const bf16*__restrict__ K,const bf16*__restrict__ V,bf16*O,char*shm){
  const int tid=threadIdx.x,lane=tid&63,r32=lane&31,hi=lane>>5; const int wid=__builtin_amdgcn_readfirstlane(tid>>6);
  const long rowbase=(long)b*SEQ, kvbase=(long)b*KVROWS; const int q0=qb*QB;
  const bf16*Qw=Q+(rowbase+q0+wid*QBLK)*DMQ+h*D;
  const bf16*Kh=K+kvbase*DMK+(h>>2)*D,*Vh=V+kvbase*DMK+(h>>2)*D;
  const unsigned lds0=(unsigned)(uintptr_t)shm;
  float*wsf=(float*)(shm+LDS_WS)+wid*64;
  const bf16*ksrc=Kh+(long)lane*DMK+wid*8;
  const bf16*vsrc=Vh+(long)(16*(wid&3)+(lane>>2))*DMK+(wid>>2)*32+(lane&3)*8;
  const unsigned kdst=lds0+LDS_K+wid*1024, vdst=lds0+LDS_V+wid*1024;
  #define DMA_K(t,slot) glds16(ksrc+(long)(t)*KVBLK*DMK,(unsigned)__builtin_amdgcn_readfirstlane(kdst+(slot)))
  #define DMA_V(t,slot) glds16(vsrc+(long)(t)*KVBLK*DMK,(unsigned)__builtin_amdgcn_readfirstlane(vdst+(slot)))
  const int vb0=(int)(lds0+LDS_V)+((lane>>4)&1)*32+(lane&3)*8+(4*hi+((lane&15)>>2))*64;
  const char*Kbase=shm+LDS_K; bf16x8 kf[8];
  const lds_cptr shm3=(lds_cptr)shm; const lds_cptr kp0=shm3+LDS_K+hi*1024+r32*16; const lds_cptr vp0=shm3+LDS_V+((lane>>4)&1)*32+(lane&3)*8+(4*hi+((lane&15)>>2))*64;
  constexpr int NT=KVROWS/KVBLK;
  DMA_K(0,0);DMA_V(0,0);DMA_K(1,SLOTB);
  bf16x8 qr[4];
  #pragma unroll
  for(int d0=0;d0<4;++d0)qr[d0]=*reinterpret_cast<const bf16x8*>(&Qw[(long)r32*DMQ+d0*16+hi*8]);
  float mhat=0.f,l_reg=0.f;f32x16 o[2];o[0]=f32x16{};o[1]=f32x16{};f32x16 negm=f32x16{};asm volatile("":"+v"(negm));
    #define CMASK(P0,P1,t) do{ if((t)>=NT-4)cmask(P0,P1,(t),hi); }while(0)
  bool resc=false;
  #define START(P0,P1) do{ const float rm=rowmax(P0,P1); resc=false; \
    { const float dl=rm; mhat=fadd_s(mhat,dl); \
      _Pragma("unroll") for(int r=0;r<16;++r){P0[r]=fsub_s(P0[r],dl);P1[r]=fsub_s(P1[r],dl);} \
      _Pragma("unroll") for(int r=0;r<16;++r)negm[r]=-mhat; asm volatile("":"+v"(negm)); } \
    _Pragma("unroll") for(int r=0;r<16;++r)P0[r]=__builtin_amdgcn_exp2f(P0[r]); }while(0)
  #define RESC() do{ if(resc){ asm volatile("s_waitcnt lgkmcnt(0)":::"memory"); \
      _Pragma("unroll") for(int d_=0;d_<2;++d_) _Pragma("unroll") for(int r=0;r<16;++r)o[d_][r]*=wsf[crow(r,hi)]; } }while(0)
  f32x16 pA0,pA1,pB0,pB1;
  int sl_prev=0,sl_cur=0,sl_next=SLOTB;
  #define ROT() do{sl_prev=sl_cur;sl_cur=sl_next;sl_next=(sl_next==(NSLOT-1)*SLOTB)?0:sl_next+SLOTB;}while(0)
  DMA_K(2,2*SLOTB);
  WAIT_BAR(3);
  qkt(pA0,pA1,Kbase,qr,negm,r32,hi);asm volatile("s_nop 15\n\ts_nop 7":"+v"(pA0),"+v"(pA1));CMASK(pA0,pA1,0);
  START(pA0,pA1);
  _Pragma("unroll") for(int r=0;r<16;++r)pA1[r]=__builtin_amdgcn_exp2f(pA1[r]);
  WAIT_BAR(0);
  DMA_K(3,0);DMA_V(1,SLOTB);
  ROT();
  kload8(kf,kp0+sl_cur);
  WAIT_BAR(2);
  s16x4 vlo[8],vhi[8]; u32x4 pw0,pw1,pw2,pw3;
  #define PKW(P,B) cvtpk_s(P[B],P[B+1])
  #define PAF(k) __builtin_bit_cast(bf16x8,pw##k)
  #define VFR(i) (bf16x8){vlo[i][0],vlo[i][1],vlo[i][2],vlo[i][3],vhi[i][0],vhi[i][1],vhi[i][2],vhi[i][3]}
  #define PIN(x) asm volatile("":"+v"(x))
  #define MX3(a,b,c) __builtin_fmaxf(__builtin_fmaxf((a),(b)),(c))
  #define GAPA(MF,A0,A1,A2,A3,W0,W1,PW) do{ MF; sacc+=A0; sacc+=A1; sacc+=A2; sacc+=A3; PIN(sacc); W0; W1; PIN(PW); SBAR(); }while(0)
  #define EX(v) __builtin_amdgcn_exp2f(v)
  #define GAPB(MF,X,B) do{ MF; X[B]=EX(X[B]); X[B+1]=EX(X[B+1]); X[B+2]=EX(X[B+2]); X[B+3]=EX(X[B+3]); PIN(X); SBAR(); }while(0)
  #define VRD(i) do{ vlo[i]=vtr(vp_+(((i)>>2)*4096+((i)&3)*1024)); vhi[i]=vtr(vp_+(((i)>>2)*4096+((i)&3)*1024+512)); }while(0)
  #define KRD(G,j) do{ if(G){ kload2(kf,kp0+sl_next,j); SBAR(); } }while(0)
  #define STEP(C0,C1,P0,P1,t,GK,GV,GL) do{ SBAR(); \
    const lds_cptr vp_=vp0+sl_prev; \
    VRD(0); SBAR(); float sacc=(P0[0]+P0[1]); \
    GAPA(C0=__builtin_amdgcn_mfma_f32_32x32x16_bf16(kf[0],qr[0],negm,0,0,0), P0[2],P0[3],P0[4],P0[5],     pw0[0]=PKW(P0,0), pw0[1]=PKW(P0,2), pw0); \
    VRD(4); SBAR(); GAPA(C1=__builtin_amdgcn_mfma_f32_32x32x16_bf16(kf[1],qr[0],negm,0,0,0), P0[6],P0[7],P0[8],P0[9],     pw0[2]=PKW(P0,4), pw0[3]=PKW(P0,6), pw0); \
    VRD(1); SBAR(); GAPA(C0=__builtin_amdgcn_mfma_f32_32x32x16_bf16(kf[2],qr[1],C0,0,0,0),   P0[10],P0[11],P0[12],P0[13], pw1[0]=PKW(P0,8), pw1[1]=PKW(P0,10), pw1); \
    VRD(5); SBAR(); GAPA(C1=__builtin_amdgcn_mfma_f32_32x32x16_bf16(kf[3],qr[1],C1,0,0,0),   P0[14],P0[15],P1[0],P1[1],   pw1[2]=PKW(P0,12),pw1[3]=PKW(P0,14), pw1); \
    VRD(2); SBAR(); GAPA(C0=__builtin_amdgcn_mfma_f32_32x32x16_bf16(kf[4],qr[2],C0,0,0,0),   P1[2],P1[3],P1[4],P1[5],     pw2[0]=PKW(P1,0), pw2[1]=PKW(P1,2), pw2); \
    VRD(6); SBAR(); GAPA(C1=__builtin_amdgcn_mfma_f32_32x32x16_bf16(kf[5],qr[2],C1,0,0,0),   P1[6],P1[7],P1[8],P1[9],     pw2[2]=PKW(P1,4), pw2[3]=PKW(P1,6), pw2); \
    VRD(3); SBAR(); GAPA(C0=__builtin_amdgcn_mfma_f32_32x32x16_bf16(kf[6],qr[3],C0,0,0,0),   P1[10],P1[11],P1[12],P1[13], pw3[0]=PKW(P1,8), pw3[1]=PKW(P1,10), pw3); \
    VRD(7); SBAR(); GAPA(C1=__builtin_amdgcn_mfma_f32_32x32x16_bf16(kf[7],qr[3],C1,0,0,0),   P1[14],P1[15],0.f,0.f,       pw3[2]=PKW(P1,12),pw3[3]=PKW(P1,14), pw3); \
    l_reg+=sacc; \
    if(GK){DMA_K((t)+3,sl_cur);} if(GV){DMA_V((t)+1,sl_next);} \
    CMASK(C0,C1,t); \
    { float a=MX3(C0[0],C0[1],C1[0]),b=MX3(C0[2],C0[3],C1[1]); a=MX3(a,C1[2],C1[3]); \
      _Pragma("unroll") for(int r=4;r<16;r+=4){a=MX3(a,C0[r],C0[r+1]);b=MX3(b,C0[r+2],C0[r+3]);a=MX3(a,C1[r],C1[r+1]);b=MX3(b,C1[r+2],C1[r+3]);} \
      float rm=__builtin_fmaxf(a,b); { auto rr=__builtin_amdgcn_permlane32_swap(__float_as_uint(rm),__float_as_uint(rm),false,false); rm=__builtin_fmaxf(__uint_as_float(rr[0]),__uint_as_float(rr[1])); } \
      resc=false; \
      if(__builtin_expect(__any(rm>(float)THRL),0)){ const float dl=__builtin_fmaxf(rm,0.f); mhat+=dl; \
        _Pragma("unroll") for(int r=0;r<16;++r){C0[r]-=dl;C1[r]-=dl;} \
        _Pragma("unroll") for(int r=0;r<16;++r)negm[r]=-mhat; asm volatile("":"+v"(negm)); \
        const float f=__builtin_amdgcn_exp2f(-dl); l_reg*=f; if(hi==0)wsf[r32]=f; resc=true; } } \
    SBAR(); \
    GAPB(o[0]=__builtin_amdgcn_mfma_f32_32x32x16_bf16(PAF(0),VFR(0),o[0],0,0,0), C0,0); \
    GAPB(o[1]=__builtin_amdgcn_mfma_f32_32x32x16_bf16(PAF(0),VFR(4),o[1],0,0,0), C0,4); \
    KRD(GL,0); GAPB(o[0]=__builtin_amdgcn_mfma_f32_32x32x16_bf16(PAF(1),VFR(1),o[0],0,0,0), C0,8); \
    KRD(GL,1); GAPB(o[1]=__builtin_amdgcn_mfma_f32_32x32x16_bf16(PAF(1),VFR(5),o[1],0,0,0), C0,12); \
    KRD(GL,2); GAPB(o[0]=__builtin_amdgcn_mfma_f32_32x32x16_bf16(PAF(2),VFR(2),o[0],0,0,0), C1,0); \
    KRD(GL,3); GAPB(o[1]=__builtin_amdgcn_mfma_f32_32x32x16_bf16(PAF(2),VFR(6),o[1],0,0,0), C1,4); \
    GAPB(o[0]=__builtin_amdgcn_mfma_f32_32x32x16_bf16(PAF(3),VFR(3),o[0],0,0,0), C1,8); \
    GAPB(o[1]=__builtin_amdgcn_mfma_f32_32x32x16_bf16(PAF(3),VFR(7),o[1],0,0,0), C1,12); \
    }while(0)
  int t=1;
  #undef CMASK
  #define CMASK(P0,P1,t) do{}while(0)
  for(;t+5<NT;t+=2){
    STEP(pB0,pB1,pA0,pA1,t,true,true,true);     WAIT_BAR(2); RESC(); ROT();
    STEP(pA0,pA1,pB0,pB1,t+1,true,true,true);   WAIT_BAR(2); RESC(); ROT();
  }
  #undef CMASK
  #define CMASK(P0,P1,t) do{ if((t)>=NT-4)cmask(P0,P1,(t),hi); }while(0)
  #define ENDW(tt) do{ if((tt)+3<NT){WAIT_BAR(2);} else if((tt)+2<NT){WAIT_BAR(1);} else {WAIT_BAR(0);} }while(0)
  for(;t+1<NT;t+=2){
    STEP(pB0,pB1,pA0,pA1,t,(t+3<NT),(t+1<NT),(t+1<NT));       ENDW(t);   RESC(); ROT();
    STEP(pA0,pA1,pB0,pB1,t+1,(t+4<NT),(t+2<NT),(t+2<NT));     ENDW(t+1); RESC(); ROT();
  }
  STEP(pB0,pB1,pA0,pA1,NT-1,false,false,false); RESC();
  { float sacc=pB0[0]+pB0[1]; _Pragma("unroll") for(int r=2;r<16;++r)sacc+=pB0[r]; _Pragma("unroll") for(int r=0;r<16;++r)sacc+=pB1[r]; l_reg+=sacc;
    pw0=(u32x4){PKW(pB0,0),PKW(pB0,2),PKW(pB0,4),PKW(pB0,6)};pw1=(u32x4){PKW(pB0,8),PKW(pB0,10),PKW(pB0,12),PKW(pB0,14)};pw2=(u32x4){PKW(pB1,0),PKW(pB1,2),PKW(pB1,4),PKW(pB1,6)};pw3=(u32x4){PKW(pB1,8),PKW(pB1,10),PKW(pB1,12),PKW(pB1,14)};
    SBAR(); pv(o,vb0+sl_cur,PAF(0),PAF(1),PAF(2),PAF(3)); }
  #undef PKW
  #undef PAF
  #undef VFR
  #undef PIN
  #undef MX3
  #undef GAPA
  #undef GAPB
  #undef EX
  #undef VRD
  #undef KRD
  #undef STEP
  #undef ENDW
  {auto rr=__builtin_amdgcn_permlane32_swap(__float_as_uint(l_reg),__float_as_uint(l_reg),false,false);l_reg=__uint_as_float(rr[0])+__uint_as_float(rr[1]);}
  if(hi==0)wsf[32+r32]=l_reg;asm volatile("s_waitcnt lgkmcnt(0)":::"memory");
  float rli[16];
  #pragma unroll
  for(int r=0;r<16;++r)rli[r]=__builtin_amdgcn_rcpf(wsf[32+crow(r,hi)]);
  bf16*Ow=O+(rowbase+q0+wid*QBLK)*DMQ+h*D;
  { bf16*stg=(bf16*)(shm+LDS_OST)+wid*2048;
    #pragma unroll
    for(int r=0;r<16;++r){const int orow=crow(r,hi);
      #pragma unroll
      for(int d0=0;d0<2;++d0)stg[orow*64+d0*32+r32]=__float2bfloat16(o[d0][r]*rli[r]);}
    asm volatile("s_waitcnt lgkmcnt(0)":::"memory");
    #pragma unroll
    for(int i=0;i<4;++i){const int row=i*8+(lane>>3),ch=lane&7; const u32x4 v=*(const u32x4*)(stg+row*64+ch*8); ATTN_STORE16(Ow+(long)row*DMQ+ch*8,v);} }
  asm volatile("s_waitcnt lgkmcnt(0)\n\ts_barrier":::"memory");
  #undef DMA_K
  #undef DMA_V
  #undef CMASK
  #undef START
  #undef RESC
  #undef ROT
}
constexpr int ATTN_LDS_BYTES=LDS_BYTES;
struct AttnTensors { const bf16* Q; const bf16* K; const bf16* V; bf16* O; };
struct AttnUnit { int bh; int qb; };
struct StaticOrder {
  int vcu;
  __device__ __forceinline__ explicit StaticOrder(int grid,int block):vcu((block%8)*(grid/8)+block/8){}
  __device__ __forceinline__ bool next(int i,AttnUnit&u)const{ if(i>=2)return false; const int pr=vcu>>6,uu=2*(vcu&63)+i; u.bh=(pr>>1)*NHEAD+(pr&1)*4+(uu>>5); u.qb=uu&31; return true; }
  __device__ __forceinline__ void a_ready(const AttnUnit&)const{}
  __device__ __forceinline__ void done(const AttnUnit&)const{}
};
template<class Sched,int THRL=8> __device__ __forceinline__ void attn_phase(char*lds,const AttnTensors&T,const Sched&S){
  AttnUnit u;
  for(int i=0;S.next(i,u);++i){ S.a_ready(u); attn_unit<THRL>(u.bh/NHEAD,u.bh%NHEAD,u.qb,T.Q,T.K,T.V,T.O,lds); S.done(u); }
}
#undef SBAR
#undef WAIT_BAR
}
#define GAS __attribute__((address_space(1)))
#define LAS __attribute__((address_space(3)))
typedef unsigned short bf16;
typedef unsigned v4u __attribute__((ext_vector_type(4)));
typedef float f32x4 __attribute__((ext_vector_type(4)));
typedef short bf16x8 __attribute__((ext_vector_type(8)));
typedef GAS unsigned gu32;
typedef GAS unsigned long long gu64;
#define RLX_AGENT __ATOMIC_RELAXED, __HIP_MEMORY_SCOPE_AGENT
#define LDS_WAIT() asm volatile("s_waitcnt lgkmcnt(0)" ::: "memory")
#define VM_WAIT() asm volatile("s_waitcnt vmcnt(0)" ::: "memory")
__device__ __forceinline__ unsigned long long rt() { return __builtin_amdgcn_s_memrealtime(); }
__device__ __forceinline__ unsigned f2bf(float f) { unsigned u = __builtin_bit_cast(unsigned, f); return (u + 0x7fffu + ((u >> 16) & 1u)) >> 16; }
__device__ __forceinline__ unsigned pk2(float lo, float hi) { return f2bf(lo) | (f2bf(hi) << 16); }

#define XB_TMO      128
#define XB_XCNT(j)  (256  + 64 * (j))
#define XB_XSUB(j)  (1280 + 64 * (j))
#define XB_XGEN(j)  (2304 + 64 * (j))
#define XB_TOP      3328
#define XB_TOPGEN   3392
#define XCD_BAR_WORDS 3456
#define XB_SPIN_CAP (1u << 18)

__device__ __forceinline__ unsigned xb_ld(unsigned* p)              { return __hip_atomic_load(p, __ATOMIC_RELAXED, __HIP_MEMORY_SCOPE_AGENT); }
__device__ __forceinline__ unsigned xb_add(unsigned* p, unsigned v) { return __hip_atomic_fetch_add(p, v, __ATOMIC_RELAXED, __HIP_MEMORY_SCOPE_AGENT); }
__device__ __forceinline__ unsigned xb_xcc_id() { return (unsigned)__builtin_amdgcn_s_getreg((3 << 11) | 20) & 0xFu; }
#define XB_SPIN(cond, bar) do { unsigned _sp = 0; while (cond) { __builtin_amdgcn_s_sleep(1); \
    if ((++_sp & 255u) == 0u) { if (xb_ld(&(bar)[XB_TMO])) break; if (_sp > XB_SPIN_CAP) { atomicAdd(&(bar)[XB_TMO], 1u); break; } } } } while (0)

struct XcdBarrier {
    unsigned* bar; unsigned x;
    volatile LAS unsigned* st;
};

__device__ __forceinline__ XcdBarrier xcd_barrier_post(unsigned* bar, volatile LAS unsigned* st) {
    XcdBarrier b; b.bar = bar; b.x = xb_xcc_id(); b.st = st;
    if (threadIdx.x == 0) (void)xb_add(&bar[XB_XCNT(b.x)], 1u);
    return b;
}
__device__ __forceinline__ void xcd_barrier_complete(unsigned* bar, unsigned x, unsigned& nloc, unsigned& nx) {
    const unsigned G = gridDim.x * gridDim.y * gridDim.z;
    unsigned sum, cnt, mine, sp = 0u;
    for (;;) {
        sum = 0u; cnt = 0u; mine = 0u;
#pragma unroll
        for (unsigned j = 0; j < 16; ++j) { const unsigned c = xb_ld(&bar[XB_XCNT(j)]); sum += c; cnt += (c > 0u) ? 1u : 0u; mine = (j == x) ? c : mine; }
        if (sum == G) break;
        __builtin_amdgcn_s_sleep(1);
        if ((++sp & 255u) == 0u) { if (xb_ld(&bar[XB_TMO])) break; if (sp > XB_SPIN_CAP) { atomicAdd(&bar[XB_TMO], 1u); break; } }
    }
    nloc = mine > 0u ? mine : 1u; nx = cnt > 0u ? cnt : 1u;
}

__device__ __forceinline__ void xcd_barrier(const XcdBarrier& b) {
    asm volatile("s_waitcnt vmcnt(0)" ::: "memory");
    __syncthreads();
    if (threadIdx.x == 0) {
        unsigned* bar = b.bar;
        __builtin_amdgcn_s_waitcnt(0);
        unsigned nloc = b.st[0], nx = b.st[1];
        if (nloc == 0u) { xcd_barrier_complete(bar, b.x, nloc, nx); b.st[0] = nloc; b.st[1] = nx; }
        const unsigned old = xb_add(&bar[XB_XSUB(b.x)], 1u);
        const unsigned gen = old / nloc;
        if (old + 1u == (gen + 1u) * nloc) {
            __builtin_amdgcn_fence(__ATOMIC_RELEASE, "agent");
            asm volatile("s_waitcnt vmcnt(0)" ::: "memory");
            const unsigned og = xb_add(&bar[XB_TOP], 1u);
            const unsigned tg = og / nx;
            if (og + 1u == (tg + 1u) * nx) xb_add(&bar[XB_TOPGEN], 1u);
            else XB_SPIN(xb_ld(&bar[XB_TOPGEN]) == tg, bar);
            __builtin_amdgcn_fence(__ATOMIC_ACQUIRE, "agent");
            xb_add(&bar[XB_XGEN(b.x)], 1u);
            asm volatile("s_waitcnt vmcnt(0)" ::: "memory");
        } else {
            XB_SPIN(xb_ld(&bar[XB_XGEN(b.x)]) == gen, bar);
            __builtin_amdgcn_fence(__ATOMIC_ACQUIRE, "agent");
            asm volatile("s_waitcnt vmcnt(0)" ::: "memory");
        }
    }
    __syncthreads();
}

constexpr int NWAVES = 8;
constexpr int BATCH = 2, SEQ = 8192, DM = 1024, NMETA = 16;
constexpr int M = BATCH * SEQ;
constexpr int INW = 3328;
constexpr int KVROWS = 8320, KVALID = 8208;
constexpr int NG = 32, NE = 16, CAP = 1024;
constexpr int UGP = 768;
constexpr float LN_EPS = 1e-5f, QK_EPS = 1e-6f, ALPHA = 1.189207115002721f;
constexpr float C2Q = 0.125f * 1.4426950408889634f;

constexpr size_t MiB = 1u << 20;
constexpr size_t WS_CTL = 0, CTL_ZERO_BYTES = 1 * MiB;
constexpr size_t WS_STATS0 = 1 * MiB, WS_STATS1 = WS_STATS0 + 131072, WS_ROPE = WS_STATS1 + 131072, WS_UMETA = WS_ROPE + 32768, WS_GATE2 = WS_UMETA + 32768, WS_IDX2 = WS_GATE2 + 131072;
constexpr size_t WS_SLOTOF = 2 * MiB, WS_AFF = 3 * MiB;
constexpr size_t WS_WGU = 8 * MiB, WS_WD = 72 * MiB;
constexpr size_t WS_WIN = 104 * MiB, WS_WGLU = 111 * MiB, WS_WAB = 112 * MiB, WS_WSB = 113 * MiB, WS_WO = 114 * MiB;
constexpr size_t WS_WST = 116 * MiB, WS_MEXT = 124 * MiB;
constexpr size_t WS_XN = 148 * MiB;
constexpr size_t WS_Q = 181 * MiB, WS_K = 197 * MiB, WS_V = 202 * MiB;
constexpr size_t WS_UG2 = 207 * MiB, WS_S = 231 * MiB;
constexpr size_t WS_END = 247 * MiB;
constexpr size_t WS_YG = WS_XN, WS_Z = WS_XN + 16 * MiB;
constexpr size_t WS_T1 = WS_WST;
constexpr size_t WS_MERGED = WS_UG2;
constexpr size_t WS_H1 = WS_XN;
constexpr size_t WS_XE = WS_Q;
constexpr size_t WS_HB = WS_WIN;
static_assert(WS_XE + 64 * MiB <= WS_END && WS_HB + 64 * MiB <= WS_XE && WS_MERGED + 32 * MiB <= WS_END && WS_T1 + 32 * MiB <= WS_XN, "d_ws overlays");
constexpr int CW_TMO = 0, CW_BAR = 4096;

constexpr int RING_OFF = 0, RING_BYTES = 131072;
constexpr int LDSCTL_OFF = RING_BYTES, MISC_OFF = LDSCTL_OFF + 320;
constexpr int LDS_BYTES = 147456;

typedef unsigned u32x4_t __attribute__((ext_vector_type(4)));
typedef unsigned u32x2_t __attribute__((ext_vector_type(2)));
typedef float f32x2_t2 __attribute__((ext_vector_type(2)));
using pg8::Unit;

struct Frame {
    LAS unsigned char* lds; volatile LAS unsigned* MISC; gu32* ctl;
    int tid, lane, wave, vcu, G;
    unsigned char* ws;
    const float* in[28]; float* out;
};
__device__ __forceinline__ float wave_sum(float v) {
#pragma unroll
    for (int o = 1; o < 64; o <<= 1) v += __shfl_xor(v, o);
    return v;
}
__device__ __forceinline__ float sigm(float x) { return 1.f / (1.f + __expf(-x)); }
__device__ __forceinline__ float bf2f(unsigned short h) { return __uint_as_float((unsigned)h << 16); }
__device__ __forceinline__ float bflo(unsigned w) { return __uint_as_float(w << 16); }
__device__ __forceinline__ float bfhi(unsigned w) { return __uint_as_float(w & 0xffff0000u); }
__device__ __forceinline__ u32x4_t pack8(const f32x4& a, const f32x4& b) { u32x4_t w; w.x = pg8::cvt_pk_bf16(a[0], a[1]); w.y = pg8::cvt_pk_bf16(a[2], a[3]); w.z = pg8::cvt_pk_bf16(b[0], b[1]); w.w = pg8::cvt_pk_bf16(b[2], b[3]); return w; }
__device__ __forceinline__ float gelu_tanh(float y) { const float in = 0.7978845608028654f * (y + 0.044715f * y * y * y); const float e = __expf(2.f * in); return y * (1.f - 1.f / (e + 1.f)); }

struct InProjOrder {
    pg8::StaticOrder so;
    __device__ bool next(int i, Unit& u) const { if (so.next(i, u)) return true; const long L = (long)i * so.G + so.c; if (L >= so.nwg && L < so.nwg + 3) { u.pm = 64; u.pn = 2 + (int)(L - so.nwg); return true; } return false; }
    __device__ __forceinline__ void a_ready(const Unit&) const {}
    __device__ __forceinline__ void done(const Unit&) const {}
};
struct SsmStateOrder {
    int G, c;
    __device__ bool next(int i, Unit& u) const { const int L = i * G + c; if (L >= 64) return false; u.pm = L; u.pn = L >> 1; return true; }
    __device__ __forceinline__ void a_ready(const Unit&) const {}
    __device__ __forceinline__ void done(const Unit&) const {}
};
struct SsmYOrder {
    int G, c;
    __device__ bool next(int i, Unit& u) const { const int L = i * G + c; if (L >= 128) return false; const int g = L >> 2; u.pm = g * 2 + ((L >> 1) & 1); u.pn = g * 2 + (L & 1); return true; }
    __device__ __forceinline__ void a_ready(const Unit&) const {}
    __device__ __forceinline__ void done(const Unit&) const {}
};
struct MoeOrder {
    int G, c, nmi, nnj;
    __device__ bool next(int i, Unit& u) const { const int per = nmi * nnj, nwg = NE * per; const int L = i * G + c; if (L >= nwg) return false;
        const int wgid = (L % 8) * (nwg / 8) + L / 8; const int e = wgid / per, w = wgid % per; u.pm = e * nmi + (w % nmi); u.pn = e * nnj + (w / nmi); return true; }
    __device__ __forceinline__ void a_ready(const Unit&) const {}
    __device__ __forceinline__ void done(const Unit&) const {}
};

typedef float f32x4 __attribute__((ext_vector_type(4)));
#define EPI_LOOP_AM _Pragma("unroll") for (int ai = 0; ai < 2; ++ai) _Pragma("unroll") for (int m = 0; m < 4; ++m)
constexpr int XCH_OFF = 132096;
struct EpiInProj {
    static constexpr bool PERM = true, AFTER_DRAIN = false;
    bf16* Q; bf16* Kb; bf16* Vb; bf16* UG2; bf16* GATES; bf16* UMETA; LAS float* XCH; const float* ngt; const float* RP;
    __device__ __forceinline__ u32x4_t normrope(const f32x4& a0, const f32x4& a1, float rinv, const f32x4& g0, const f32x4& g1, const f32x4& cs, const f32x4& sn, float osc) const {
        const float y0 = a0[0] * rinv * g0[0], y1 = a0[1] * rinv * g0[1], y2 = a0[2] * rinv * g0[2], y3 = a0[3] * rinv * g0[3];
        const float y4 = a1[0] * rinv * g1[0], y5 = a1[1] * rinv * g1[1], y6 = a1[2] * rinv * g1[2], y7 = a1[3] * rinv * g1[3];
        u32x4_t w;
        w.x = pg8::cvt_pk_bf16((y0 * cs[0] - y1 * sn[0]) * osc, (y0 * sn[0] + y1 * cs[0]) * osc);
        w.y = pg8::cvt_pk_bf16((y2 * cs[1] - y3 * sn[1]) * osc, (y2 * sn[1] + y3 * cs[1]) * osc);
        w.z = pg8::cvt_pk_bf16((y4 * cs[2] - y5 * sn[2]) * osc, (y4 * sn[2] + y5 * cs[2]) * osc);
        w.w = pg8::cvt_pk_bf16((y6 * cs[3] - y7 * sn[3]) * osc, (y6 * sn[3] + y7 * cs[3]) * osc);
        return w;
    }
    __device__ __forceinline__ void operator()(const f32x4 (&acc)[2][2][4][2], const Unit& u, int wr, int wc, int fr_, int fq_) const {
        int fr = fr_, fq = fq_; asm volatile("" : "+v"(fr), "+v"(fq));
        const int pn = u.pn, cl0 = wc * 32 + 8 * fq;
        if (pn <= 2) {
            const int nb = pn == 2 ? 1 : 2;
            EPI_LOOP_AM {
#pragma unroll
                for (int bj = 0; bj < 2; ++bj) {
                    if (bj < nb) { const f32x4 a = acc[ai][bj][m][0], c = acc[ai][bj][m][1]; float s = (a[0] * a[0] + a[1] * a[1]) + (a[2] * a[2] + a[3] * a[3]) + (c[0] * c[0] + c[1] * c[1]) + (c[2] * c[2] + c[3] * c[3]);
                        s += __shfl_xor(s, 16); s += __shfl_xor(s, 32);
                        if (fq == 0) XCH[(ai * 128 + wr * 64 + m * 16 + fr) * 8 + bj * 4 + wc] = s; } } }
            asm volatile("s_waitcnt lgkmcnt(0)" ::: "memory"); __builtin_amdgcn_s_barrier(); asm volatile("" ::: "memory");
            const float* gsrc = ngt + (pn == 2 ? 64 : 0) + (wc & 1) * 32 + 8 * fq;
            const f32x4 g0 = *(const f32x4*)gsrc, g1 = *(const f32x4*)(gsrc + 4);
            const float osc = pn == 2 ? 1.f : C2Q;
            const int codd = wc & 1;
            EPI_LOOP_AM {
                if (u.pm == 64 && (wr != 0 || ai != 0 || m != 0)) continue;
                const int rl = ai * 128 + wr * 64 + m * 16 + fr; const int row = u.pm * 256 + rl;
                f32x4 cs = (f32x4){1.f, 1.f, 1.f, 1.f}, sn = (f32x4){0.f, 0.f, 0.f, 0.f};
                if (u.pm != 64) { const int s = row & 8191; const float* tp = codd ? RP + 4096 + (s & 63) * 16 + 4 * fq : RP + (s >> 6) * 16 + 4 * fq; cs = *(const f32x4*)tp; sn = *(const f32x4*)(tp + (codd ? 1024 : 2048)); }
#pragma unroll
                for (int bj = 0; bj < 2; ++bj) {
                    if (bj < nb) {
                        const f32x2_t2 pr = *(const LAS f32x2_t2*)(XCH + rl * 8 + bj * 4 + (wc & 2)); const float tot = pr.x + pr.y;
                        const float rinv = rsqrtf(tot * (1.f / 64.f) + QK_EPS);
                        const u32x4_t w = normrope(acc[ai][bj][m][0], acc[ai][bj][m][1], rinv, g0, g1, cs, sn, osc);
                        if (pn < 2) *(u32x4_t*)(Q + (size_t)row * 512 + pn * 256 + bj * 128 + cl0) = w;
                        else if (u.pm != 64) *(u32x4_t*)(Kb + ((size_t)(row >> 13) * KVROWS + NMETA + (row & 8191)) * 128 + cl0) = w;
                        else { *(u32x4_t*)(Kb + (size_t)fr * 128 + cl0) = w; *(u32x4_t*)(Kb + ((size_t)KVROWS + fr) * 128 + cl0) = w; }
                    } else {
                        const u32x4_t w = pack8(acc[ai][1][m][0], acc[ai][1][m][1]);
                        if (u.pm != 64) *(u32x4_t*)(Vb + ((size_t)(row >> 13) * KVROWS + NMETA + (row & 8191)) * 128 + cl0) = w;
                        else { *(u32x4_t*)(Vb + (size_t)fr * 128 + cl0) = w; *(u32x4_t*)(Vb + ((size_t)KVROWS + fr) * 128 + cl0) = w; }
                    }
                }
            }
            return;
        }
        if (u.pm == 64) {
            if (wr != 0) return;
#pragma unroll
            for (int bj = 0; bj < 2; ++bj) { const int cu = (pn - 3) * 256 + bj * 128 + cl0; *(u32x4_t*)(UMETA + ((size_t)(cu >> 4) * 16 + fr) * 16 + (cu & 15)) = pack8(acc[0][bj][0][0], acc[0][bj][0][1]); }
            return;
        }
        const int row0 = u.pm * 256 + wr * 64 + fr;
        if (pn < 5) {
            EPI_LOOP_AM { const int row = row0 + ai * 128 + m * 16, b = row >> 13, s = row & 8191;
#pragma unroll
                for (int bj = 0; bj < 2; ++bj) { const int cu = (pn - 3) * 256 + bj * 128 + cl0, g = cu >> 4;
                    *(u32x4_t*)(UG2 + ((size_t)(g * 2 + b) * 256 + (s >> 5)) * UGP + (s & 31) * 16 + (cu & 15)) = pack8(acc[ai][bj][m][0], acc[ai][bj][m][1]); } }
        } else {
            EPI_LOOP_AM { const size_t o = (size_t)(row0 + ai * 128 + m * 16) * 2048 + (pn - 5) * 256 + cl0;
#pragma unroll
                for (int bj = 0; bj < 2; ++bj) { f32x4 a = acc[ai][bj][m][0], c = acc[ai][bj][m][1];
#pragma unroll
                    for (int j = 0; j < 4; ++j) { a[j] = sigm(a[j]); c[j] = sigm(c[j]); }
                    *(u32x4_t*)(GATES + o + bj * 128) = pack8(a, c); } }
        }
    }
};
struct EpiSsmState {
    static constexpr bool PERM = false, AFTER_DRAIN = false;
    float* S;
    __device__ __forceinline__ void operator()(const f32x4 (&acc)[2][2][4][2], const Unit& u, int wr, int wc, int fr, int fq) const {
        EPI_LOOP_AM { float* rp = S + ((size_t)u.pm * 256 + ai * 128 + wr * 64 + m * 16 + fr) * 256 + wc * 32 + 4 * fq;
#pragma unroll
            for (int bj = 0; bj < 2; ++bj)
#pragma unroll
                for (int n = 0; n < 2; ++n) *(f32x4*)(rp + bj * 128 + n * 16) = acc[ai][bj][m][n]; }
    }
};
struct EpiSsmY {
    static constexpr bool PERM = true, AFTER_DRAIN = false;
    bf16* YG;
    __device__ __forceinline__ void operator()(const f32x4 (&acc)[2][2][4][2], const Unit& u, int wr, int wc, int fr, int fq) const {
        const int g = u.pm >> 1, b = u.pm & 1, nh = u.pn & 1;
        EPI_LOOP_AM { const int cp = ai * 128 + wr * 64 + m * 16 + fr;
#pragma unroll
            for (int bj = 0; bj < 2; ++bj) { const int nl = nh * 256 + bj * 128 + wc * 32 + 8 * fq, t = nl >> 4, h0 = nl & 15;
                f32x4 a = acc[ai][bj][m][0], c = acc[ai][bj][m][1];
#pragma unroll
                for (int j = 0; j < 4; ++j) { a[j] = gelu_tanh(a[j]); c[j] = gelu_tanh(c[j]); }
                *(u32x4_t*)(YG + ((size_t)b * SEQ + cp * 32 + t) * 512 + g * 16 + h0) = pack8(a, c); } }
    }
};
struct EpiGlu {
    static constexpr bool PERM = true, AFTER_DRAIN = false;
    const bf16* YG; const float* bias; bf16* Z;
    __device__ __forceinline__ void operator()(const f32x4 (&acc)[2][2][4][2], const Unit& u, int wr, int wc, int fr, int fq) const {
        const int row0 = u.pm * 256 + wr * 64 + fr, col0 = u.pn * 256 + wc * 32 + 8 * fq;
        EPI_LOOP_AM { const size_t o = (size_t)(row0 + ai * 128 + m * 16) * 512 + col0;
#pragma unroll
            for (int bj = 0; bj < 2; ++bj) { const u32x4_t y = *(const u32x4_t*)(YG + o + bj * 128);
                const f32x4 b0 = *(const f32x4*)(bias + col0 + bj * 128), b1 = *(const f32x4*)(bias + col0 + bj * 128 + 4);
                f32x4 a = acc[ai][bj][m][0] + b0, c = acc[ai][bj][m][1] + b1;
                a[0] = bflo(y.x) * sigm(a[0]); a[1] = bfhi(y.x) * sigm(a[1]); a[2] = bflo(y.y) * sigm(a[2]); a[3] = bfhi(y.y) * sigm(a[3]);
                c[0] = bflo(y.z) * sigm(c[0]); c[1] = bfhi(y.z) * sigm(c[1]); c[2] = bflo(y.w) * sigm(c[2]); c[3] = bfhi(y.w) * sigm(c[3]);
                *(u32x4_t*)(Z + o + bj * 128) = pack8(a, c); } }
    }
};
template <int SECOND> struct EpiBranch {
    static constexpr bool PERM = true, AFTER_DRAIN = false;
    const bf16* GATES; const bf16* T1; bf16* O;
    __device__ __forceinline__ void operator()(const f32x4 (&acc)[2][2][4][2], const Unit& u, int wr, int wc, int fr, int fq) const {
        const int row0 = u.pm * 256 + wr * 64 + fr, col0 = u.pn * 256 + wc * 32 + 8 * fq;
        EPI_LOOP_AM { const size_t r = (size_t)(row0 + ai * 128 + m * 16);
#pragma unroll
            for (int bj = 0; bj < 2; ++bj) { const u32x4_t gt = *(const u32x4_t*)(GATES + r * 2048 + SECOND * 1024 + col0 + bj * 128);
                f32x4 a = acc[ai][bj][m][0], c = acc[ai][bj][m][1];
                a[0] *= bflo(gt.x); a[1] *= bfhi(gt.x); a[2] *= bflo(gt.y); a[3] *= bfhi(gt.y); c[0] *= bflo(gt.z); c[1] *= bfhi(gt.z); c[2] *= bflo(gt.w); c[3] *= bfhi(gt.w);
                if (SECOND) { const u32x4_t t1 = *(const u32x4_t*)(T1 + r * 1024 + col0 + bj * 128);
                    a[0] += bflo(t1.x); a[1] += bfhi(t1.x); a[2] += bflo(t1.y); a[3] += bfhi(t1.y); c[0] += bflo(t1.z); c[1] += bfhi(t1.z); c[2] += bflo(t1.w); c[3] += bfhi(t1.w); }
                *(u32x4_t*)(O + r * 1024 + col0 + bj * 128) = pack8(a, c); } }
    }
};
struct EpiPre1 {
    static constexpr bool PERM = false, AFTER_DRAIN = false;
    const float* x; const float* g; const float* bb; const f32x2_t2* st; float* out;
    __device__ __forceinline__ void operator()(const f32x4 (&acc)[2][2][4][2], const Unit& u, int wr, int wc, int fr, int fq) const {
        const int row0 = u.pm * 256 + wr * 64 + fr, col0 = u.pn * 256 + wc * 32 + 4 * fq;
        EPI_LOOP_AM { const int row = row0 + ai * 128 + m * 16; const f32x2_t2 s = st[row]; const size_t o = (size_t)row * 1024 + col0;
#pragma unroll
            for (int bj = 0; bj < 2; ++bj)
#pragma unroll
                for (int n = 0; n < 2; ++n) { const int c = bj * 128 + n * 16; const f32x4 xv = *(const f32x4*)(x + o + c), gv = *(const f32x4*)(g + col0 + c), bv = *(const f32x4*)(bb + col0 + c);
                    *(f32x4*)(out + o + c) = ((xv - s.x) * s.y * gv + bv) * ALPHA + acc[ai][bj][m][n]; } }
    }
};
struct EpiMoe1 {
    static constexpr bool PERM = true, AFTER_DRAIN = false;
    bf16* HB;
    __device__ __forceinline__ void operator()(const f32x4 (&acc)[2][2][4][2], const Unit& u, int wr, int wc, int fr, int fq) const {
        const int row0 = u.pm * 256 + wr * 64 + fr, col0 = (u.pn & 7) * 128 + wc * 32 + 8 * fq;
        EPI_LOOP_AM { f32x4 a = acc[ai][0][m][0], c = acc[ai][0][m][1]; const f32x4 ua = acc[ai][1][m][0], uc = acc[ai][1][m][1];
#pragma unroll
            for (int j = 0; j < 4; ++j) { a[j] = a[j] * sigm(a[j]) * ua[j]; c[j] = c[j] * sigm(c[j]) * uc[j]; }
            *(u32x4_t*)(HB + (size_t)(row0 + ai * 128 + m * 16) * 1024 + col0) = pack8(a, c); }
    }
};
struct EpiMoe2 {
    static constexpr bool PERM = true, AFTER_DRAIN = false;
    const float* gate; bf16* YE;
    __device__ __forceinline__ void operator()(const f32x4 (&acc)[2][2][4][2], const Unit& u, int wr, int wc, int fr, int fq) const {
        const int row0 = u.pm * 256 + wr * 64 + fr, col0 = (u.pn & 3) * 256 + wc * 32 + 8 * fq;
        EPI_LOOP_AM { const int row = row0 + ai * 128 + m * 16; const float gt = gate[row];
#pragma unroll
            for (int bj = 0; bj < 2; ++bj) *(u32x4_t*)(YE + (size_t)row * 1024 + col0 + bj * 128) = pack8(acc[ai][bj][m][0] * gt, acc[ai][bj][m][1] * gt); }
    }
};

__device__ __forceinline__ void p0_transpose_item(const float* W, int K, int N, bf16* WT, int k0, int n0, int drow0, LAS float* scr, int lane) {
#pragma unroll 8
    for (int i = 0; i < 32; ++i) { const int kk = 2 * i + (lane >> 5); scr[kk * 33 + (lane & 31)] = W[(size_t)(k0 + kk) * N + n0 + (lane & 31)]; }
    LDS_WAIT(); asm volatile("" ::: "memory");
    const int c = lane & 7;
#pragma unroll
    for (int j = 0; j < 4; ++j) { const int n = (lane >> 3) + 8 * j; const LAS float* s = scr + (8 * c) * 33 + n;
        v4u o; o.x = pk2(s[0 * 33], s[1 * 33]); o.y = pk2(s[2 * 33], s[3 * 33]); o.z = pk2(s[4 * 33], s[5 * 33]); o.w = pk2(s[6 * 33], s[7 * 33]);
        *(GAS v4u*)(WT + (size_t)(drow0 + n) * K + k0 + 8 * c) = o; }
    LDS_WAIT(); asm volatile("" ::: "memory");
}
__device__ __forceinline__ void ssm_par(const Frame& F, int dg, int p, float& lr, float& li, float& cr, float& ci) {
    const float dt = expf(F.in[9][dg]); const float ar = F.in[7][dg * 64 + p], ai = F.in[8][dg * 64 + p];
    lr = ar * dt; li = ai * dt;
    float sn, cs; sincosf(li, &sn, &cs); const float mag = expf(lr);
    const float nr = mag * cs - 1.f, ni = mag * sn, den = ar * ar + ai * ai;
    cr = (nr * ar + ni * ai) / den; ci = (ni * ar - nr * ai) / den;
}
__device__ __forceinline__ void cpow(float lr, float li, float e, float& pr, float& pi) { float sn, cs; sincosf(li * e, &sn, &cs); const float mg = expf(lr * e); pr = mg * cs; pi = mg * sn; }

__device__ __forceinline__ void p0_prologue(Frame& F) {
    const int gw = F.vcu * NWAVES + F.wave, NGW = F.G * NWAVES, lane = F.lane, tid = F.tid;
    unsigned char* ws = F.ws;
    {
        LAS float* POW = (LAS float*)(F.lds + RING_OFF);
        LAS float* BB = POW + 2 * 33 * 64 * 2;
        LAS float* CC = BB + 2 * 64 * 16 * 2;
        LAS float* KT = CC + 2 * 4 * 64 * 2;
        bf16* MEXT = (bf16*)(ws + WS_MEXT);
        for (int it = F.vcu; it < 128; it += F.G) {
            const int g = it >> 2, hq = it & 3;
            __syncthreads();
            for (int i = tid; i < 2 * 33 * 64; i += NWAVES * 64) { const int dir = i / (33 * 64), j = (i / 64) % 33, p = i & 63; float lr, li, cr, ci; ssm_par(F, dir * 32 + g, p, lr, li, cr, ci);
                float pr, pi; cpow(lr, li, (float)j, pr, pi); POW[i * 2] = pr; POW[i * 2 + 1] = pi; }
            for (int i = tid; i < 2 * 64 * 16; i += NWAVES * 64) { const int dir = i / 1024, p = (i >> 4) & 63, h = i & 15; float lr, li, cr, ci; ssm_par(F, dir * 32 + g, p, lr, li, cr, ci);
                const size_t o = ((size_t)(dir * 32 + g) * 64 + p) * 16 + h; const float br = F.in[10][o], bi = F.in[11][o]; BB[i * 2] = cr * br - ci * bi; BB[i * 2 + 1] = cr * bi + ci * br; }
            for (int i = tid; i < 2 * 4 * 64; i += NWAVES * 64) { const int dir = i / 256, hl = (i >> 6) & 3, p = i & 63; const size_t o = ((size_t)(dir * 32 + g) * 16 + hq * 4 + hl) * 64 + p; CC[i * 2] = F.in[12][o]; CC[i * 2 + 1] = F.in[13][o]; }
            __syncthreads();
            for (int i = tid; i < 2 * 4 * 32 * 16; i += NWAVES * 64) { const int dir = i / 2048, hl = (i >> 9) & 3, j = (i >> 4) & 31, hi = i & 15; float s = 0.f;
                for (int p = 0; p < 64; ++p) { const float cr = CC[((dir * 4 + hl) * 64 + p) * 2], ci = CC[((dir * 4 + hl) * 64 + p) * 2 + 1], pr = POW[((dir * 33 + j) * 64 + p) * 2], pi = POW[((dir * 33 + j) * 64 + p) * 2 + 1];
                    const float er = cr * pr - ci * pi, ei = cr * pi + ci * pr; const float br = BB[((dir * 64 + p) * 16 + hi) * 2], bi = BB[((dir * 64 + p) * 16 + hi) * 2 + 1]; s += er * br - ei * bi; }
                KT[i] = s; }
            __syncthreads();
            for (int ch = tid; ch < 128 * 96; ch += NWAVES * 64) { const int rl = ch / 96, cc = ch % 96, t = rl >> 2, hl = rl & 3, ho = hq * 4 + hl; float v[8];
                if (cc < 64) { const int s = cc >> 1, hi0 = (cc & 1) * 8;
#pragma unroll
                    for (int j = 0; j < 8; ++j) { const int hi = hi0 + j; float x = 0.f; if (s <= t) x += KT[((0 * 4 + hl) * 32 + (t - s)) * 16 + hi]; if (s >= t) x += KT[((1 * 4 + hl) * 32 + (s - t)) * 16 + hi];
                        if (s == t && hi == ho) x += F.in[14][g * 16 + ho]; v[j] = x; }
                } else { const int kk = (cc - 64) * 8, dir = kk >> 7, reim = (kk >> 6) & 1, p0 = kk & 63, e = dir == 0 ? t + 1 : 32 - t;
#pragma unroll
                    for (int j = 0; j < 8; ++j) { const int p = p0 + j; const float cr = CC[((dir * 4 + hl) * 64 + p) * 2], ci = CC[((dir * 4 + hl) * 64 + p) * 2 + 1], pr = POW[((dir * 33 + e) * 64 + p) * 2], pi = POW[((dir * 33 + e) * 64 + p) * 2 + 1];
                        v[j] = reim == 0 ? (cr * pr - ci * pi) : -(cr * pi + ci * pr); } }
                v4u o; o.x = pk2(v[0], v[1]); o.y = pk2(v[2], v[3]); o.z = pk2(v[4], v[5]); o.w = pk2(v[6], v[7]);
                *(GAS v4u*)(MEXT + ((size_t)g * 512 + t * 16 + ho) * UGP + cc * 8) = o; }
        }
        __syncthreads();
    }
    LAS float* scr = (LAS float*)(F.lds + RING_OFF + F.wave * 16384);
    { bf16* WST = (bf16*)(ws + WS_WST);
      for (int it = gw; it < NG * 256; it += NGW) { const int g = it >> 8, n = it & 255, dir = n >> 7, reim = (n >> 6) & 1, p = n & 63; float lr, li, cr, ci; ssm_par(F, dir * 32 + g, p, lr, li, cr, ci);
          const int t = lane >> 1, h0 = (lane & 1) * 8; float pr, pi; cpow(lr, li, (float)(dir == 0 ? 31 - t : t), pr, pi);
          const float er = pr * cr - pi * ci, ei = pr * ci + pi * cr; const size_t o = ((size_t)(dir * 32 + g) * 64 + p) * 16 + h0; float v[8];
#pragma unroll
          for (int j = 0; j < 8; ++j) { const float br = F.in[10][o + j], bi = F.in[11][o + j]; v[j] = reim == 0 ? (er * br - ei * bi) : (er * bi + ei * br); }
          v4u w; w.x = pk2(v[0], v[1]); w.y = pk2(v[2], v[3]); w.z = pk2(v[4], v[5]); w.w = pk2(v[6], v[7]);
          *(GAS v4u*)(WST + ((size_t)g * 256 + n) * 512 + lane * 8) = w; } }
    { constexpr int I_IN = 16 * 104, I_GLU = 8 * 16, I_BR = 8 * 32, I_O = 16 * 32, I_E = 16 * 32;
      constexpr int NIT = I_IN + I_GLU + 2 * I_BR + I_O + NE * 3 * I_E;
      for (int it = gw; it < NIT; it += NGW) { int r = it;
          if (r < I_IN) { const int kb = r / 104, nb = r % 104; p0_transpose_item(F.in[4], 1024, INW, (bf16*)(ws + WS_WIN), 64 * kb, 32 * nb, 32 * nb, scr, lane); continue; } r -= I_IN;
          if (r < I_GLU) { const int kb = r / 16, nb = r % 16; p0_transpose_item(F.in[15], 512, 512, (bf16*)(ws + WS_WGLU), 64 * kb, 32 * nb, 32 * nb, scr, lane); continue; } r -= I_GLU;
          if (r < I_BR) { const int kb = r / 32, nb = r % 32; p0_transpose_item(F.in[17], 512, 1024, (bf16*)(ws + WS_WAB), 64 * kb, 32 * nb, 32 * nb, scr, lane); continue; } r -= I_BR;
          if (r < I_BR) { const int kb = r / 32, nb = r % 32; p0_transpose_item(F.in[18], 512, 1024, (bf16*)(ws + WS_WSB), 64 * kb, 32 * nb, 32 * nb, scr, lane); continue; } r -= I_BR;
          if (r < I_O) { const int kb = r / 32, nb = r % 32; p0_transpose_item(F.in[19], 1024, 1024, (bf16*)(ws + WS_WO), 64 * kb, 32 * nb, 32 * nb, scr, lane); continue; } r -= I_O;
          const int e = r / (3 * I_E), which = (r / I_E) % 3, q = r % I_E, kb = q / 32, nb = q % 32, n0 = 32 * nb;
          const float* W = (which == 0 ? F.in[23] : which == 1 ? F.in[24] : F.in[25]) + (size_t)e * 1024 * 1024;
          if (which < 2) p0_transpose_item(W, 1024, 1024, (bf16*)(ws + WS_WGU), 64 * kb, n0, e * 2048 + (n0 >> 7) * 256 + which * 128 + (n0 & 127), scr, lane);
          else p0_transpose_item(W, 1024, 1024, (bf16*)(ws + WS_WD), 64 * kb, n0, e * 1024 + n0, scr, lane); } }
    { bf16* XN = (bf16*)(ws + WS_XN); f32x2_t2* ST = (f32x2_t2*)(ws + WS_STATS0);
      for (int r = gw; r < M + NMETA; r += NGW) { const float* src = r < M ? F.in[0] + (size_t)r * DM : F.in[1] + (size_t)(r - M) * DM;
          const GAS f32x4* xr = (const GAS f32x4*)src + lane; f32x4 v[4]; float s = 0.f;
#pragma unroll
          for (int j = 0; j < 4; ++j) { v[j] = xr[64 * j]; s += (v[j].x + v[j].y) + (v[j].z + v[j].w); }
          const float mean = wave_sum(s) * (1.f / DM); float s2 = 0.f;
#pragma unroll
          for (int j = 0; j < 4; ++j) { v[j] = v[j] - mean; s2 += (v[j].x * v[j].x + v[j].y * v[j].y) + (v[j].z * v[j].z + v[j].w * v[j].w); }
          const float rstd = 1.f / sqrtf(wave_sum(s2) * (1.f / DM) + LN_EPS);
          if (r < M && lane == 0) ST[r] = (f32x2_t2){mean, rstd};
          GAS unsigned long long* o8 = (GAS unsigned long long*)(XN + (size_t)r * DM) + lane;
#pragma unroll
          for (int j = 0; j < 4; ++j) { const f32x4 gg = ((const GAS f32x4*)F.in[2])[lane + 64 * j], bb = ((const GAS f32x4*)F.in[3])[lane + 64 * j]; const f32x4 o = v[j] * rstd * gg + bb;
              o8[64 * j] = (unsigned long long)pk2(o.x, o.y) | ((unsigned long long)pk2(o.z, o.w) << 32); } } }
    { const int gt = F.vcu * (NWAVES * 64) + tid, NT_ = F.G * NWAVES * 64;
      for (int i = gt; i < 2 * 2 * 112 * 16; i += NT_) { const int arr = i / (2 * 112 * 16), b = (i / (112 * 16)) & 1, q = i % (112 * 16);
          *(GAS v4u*)((bf16*)(ws + (arr ? WS_V : WS_K)) + ((size_t)b * KVROWS + KVALID) * 128 + q * 8) = (v4u){0u, 0u, 0u, 0u}; }
      float* RP = (float*)(ws + WS_ROPE);
      for (int i = gt; i < 3072; i += NT_) { const bool isr = i < 2048; const int q = isr ? i : i - 2048, pos = q >> 4, j = q & 15; const float ang = (float)pos * powf(10000.f, -(float)j / 16.f);
          float sn, cs; sincosf(ang, &sn, &cs); if (isr) { RP[q] = cs; RP[2048 + q] = sn; } else { RP[4096 + q] = cs; RP[5120 + q] = sn; } }
      for (int i = gt; i < 128; i += NT_) RP[6144 + i] = i < 64 ? F.in[5][i] : F.in[6][i - 64]; }
}

__device__ __forceinline__ void qk_prep(Frame& F) {
    const int gw = F.vcu * NWAVES + F.wave, NGW = F.G * NWAVES, lane = F.lane;
    bf16* Q = (bf16*)(F.ws + WS_Q); bf16* K = (bf16*)(F.ws + WS_K); const float* RP = (const float*)(F.ws + WS_ROPE);
    constexpr int NQ = M * 8, NK = 2 * KVALID * 2;
    for (int it = gw; it < NQ + NK; it += NGW) {
        bf16* p; int pos; float gsc, osc;
        if (it < NQ) { const int row = it >> 3, h = it & 7; p = Q + (size_t)row * 512 + h * 64; pos = row & 8191; gsc = F.in[5][lane]; osc = C2Q; }
        else { const int r = it - NQ, b = r / (KVALID * 2), q = r % (KVALID * 2), l = q >> 1, kvh = q & 1; p = K + ((size_t)b * KVROWS + l) * 128 + kvh * 64; pos = l - NMETA; gsc = F.in[6][lane]; osc = 1.f; }
        const float x = bf2f(p[lane]);
        const float ss = wave_sum(x * x) * (1.f / 64.f);
        const float y = x * rsqrtf(ss + QK_EPS) * gsc, yo = __shfl_xor(y, 1);
        float cs = 1.f, sn = 0.f;
        if (pos >= 0) { const int j = lane >> 1; if (j < 16) { cs = RP[(pos >> 6) * 16 + j]; sn = RP[2048 + (pos >> 6) * 16 + j]; } else { cs = RP[4096 + (pos & 63) * 16 + j - 16]; sn = RP[5120 + (pos & 63) * 16 + j - 16]; } }
        const float o = ((lane & 1) ? (yo * sn + y * cs) : (y * cs - yo * sn)) * osc;
        p[lane] = (bf16)f2bf(o);
    }
}

__device__ __forceinline__ void ssm_scan(Frame& F) {
    if (F.wave != 0 || F.vcu >= 128) return;
    const int it = F.vcu, b = it >> 6, g = (it >> 1) & 31, dir = it & 1, p = F.lane;
    float lr, li, cr, ci; ssm_par(F, dir * 32 + g, p, lr, li, cr, ci);
    float a32r, a32i; cpow(lr, li, 32.f, a32r, a32i);
    const float* S = (const float*)(F.ws + WS_S) + (size_t)(g * 2 + b) * 256 * 256 + dir * 128 + p;
    bf16* U = (bf16*)(F.ws + WS_UG2) + (size_t)(g * 2 + b) * 256 * UGP + 512 + dir * 128 + p;
    float sr = 0.f, si = 0.f;
    if (dir == 0) {
        float a1r, a1i; cpow(lr, li, 1.f, a1r, a1i);
        const bf16* um = (const bf16*)(F.ws + WS_UMETA) + (size_t)g * 256; const size_t o = ((size_t)g * 64 + p) * 16;
        float bbr[16], bbi[16];
#pragma unroll
        for (int h = 0; h < 16; ++h) { const float br = F.in[10][o + h], bi = F.in[11][o + h]; bbr[h] = cr * br - ci * bi; bbi[h] = cr * bi + ci * br; }
        for (int t = 0; t < 16; ++t) { float bur = 0.f, bui = 0.f;
#pragma unroll
            for (int h = 0; h < 16; ++h) { const float uv = bf2f(um[t * 16 + h]); bur = fmaf(bbr[h], uv, bur); bui = fmaf(bbi[h], uv, bui); }
            const float nr = a1r * sr - a1i * si + bur, ni = a1r * si + a1i * sr + bui; sr = nr; si = ni; }
    }
    for (int c0 = 0; c0 < 256; c0 += 32) {
        float vr[32], vi[32];
#pragma unroll
        for (int k = 0; k < 32; ++k) { const int c = dir == 0 ? c0 + k : 255 - (c0 + k); vr[k] = S[(size_t)c * 256]; vi[k] = S[(size_t)c * 256 + 64]; }
#pragma unroll
        for (int k = 0; k < 32; ++k) { const int c = dir == 0 ? c0 + k : 255 - (c0 + k);
            U[(size_t)c * UGP] = (bf16)f2bf(sr); U[(size_t)c * UGP + 64] = (bf16)f2bf(si);
            const float nr = a32r * sr - a32i * si + vr[k], ni = a32r * si + a32i * sr + vi[k]; sr = nr; si = ni; }
    }
}

__device__ __forceinline__ float treduce16(const float (&v)[16], int lane) {
    float r8[8], r4[4], r2[2], r1;
    { const bool up = lane & 32;
#pragma unroll
      for (int i = 0; i < 8; ++i) { const float keep = up ? v[i + 8] : v[i], send = up ? v[i] : v[i + 8]; r8[i] = keep + __shfl_xor(send, 32); } }
    { const bool up = lane & 16;
#pragma unroll
      for (int i = 0; i < 4; ++i) { const float keep = up ? r8[i + 4] : r8[i], send = up ? r8[i] : r8[i + 4]; r4[i] = keep + __shfl_xor(send, 16); } }
    { const bool up = lane & 8;
#pragma unroll
      for (int i = 0; i < 2; ++i) { const float keep = up ? r4[i + 2] : r4[i], send = up ? r4[i] : r4[i + 2]; r2[i] = keep + __shfl_xor(send, 8); } }
    { const bool up = lane & 4; const float keep = up ? r2[1] : r2[0], send = up ? r2[0] : r2[1]; r1 = keep + __shfl_xor(send, 4); }
    r1 += __shfl_xor(r1, 2); r1 += __shfl_xor(r1, 1);
    return r1;
}
__device__ __forceinline__ void ln1_router(Frame& F) {
    const int gw = F.vcu * NWAVES + F.wave, NGW = F.G * NWAVES, lane = F.lane;
    LAS float* WRT = (LAS float*)(F.lds + RING_OFF);
    for (int i = F.tid; i < 16 * 1024; i += NWAVES * 64) { const int d = i >> 4, e = i & 15; WRT[e * 1024 + d] = F.in[22][i]; }
    __syncthreads();
    const float* PRE = F.out; bf16* H1 = (bf16*)(F.ws + WS_H1); f32x2_t2* ST = (f32x2_t2*)(F.ws + WS_STATS1); float* AFF = (float*)(F.ws + WS_AFF);
    for (int r = gw; r < M; r += NGW) {
        const GAS f32x4* xr = (const GAS f32x4*)(PRE + (size_t)r * DM) + lane; f32x4 v[4]; float s = 0.f;
#pragma unroll
        for (int j = 0; j < 4; ++j) { v[j] = xr[64 * j]; s += (v[j].x + v[j].y) + (v[j].z + v[j].w); }
        const float mean = wave_sum(s) * (1.f / DM); float s2 = 0.f;
#pragma unroll
        for (int j = 0; j < 4; ++j) { v[j] = v[j] - mean; s2 += (v[j].x * v[j].x + v[j].y * v[j].y) + (v[j].z * v[j].z + v[j].w * v[j].w); }
        const float rstd = 1.f / sqrtf(wave_sum(s2) * (1.f / DM) + LN_EPS);
        if (lane == 0) ST[r] = (f32x2_t2){mean, rstd};
        GAS unsigned long long* o8 = (GAS unsigned long long*)(H1 + (size_t)r * DM) + lane;
#pragma unroll
        for (int j = 0; j < 4; ++j) { const f32x4 gg = ((const GAS f32x4*)F.in[20])[lane + 64 * j], bb = ((const GAS f32x4*)F.in[21])[lane + 64 * j]; v[j] = v[j] * rstd * gg + bb;
            o8[64 * j] = (unsigned long long)pk2(v[j].x, v[j].y) | ((unsigned long long)pk2(v[j].z, v[j].w) << 32); }
        float acc[16];
        asm volatile("" ::: "memory");
#pragma unroll
        for (int e = 0; e < 16; ++e) { float a = 0.f;
#pragma unroll
            for (int j = 0; j < 4; ++j) { const f32x4 w = *(const LAS f32x4*)(WRT + e * 1024 + (lane + 64 * j) * 4); a += (v[j].x * w.x + v[j].y * w.y) + (v[j].z * w.z + v[j].w * w.w); }
            acc[e] = a; }
        const float lg = treduce16(acc, lane);
        float mx = lg;
#pragma unroll
        for (int o = 4; o < 64; o <<= 1) mx = fmaxf(mx, __shfl_xor(mx, o));
        const float ex = expf(lg - mx); float sm = ex;
#pragma unroll
        for (int o = 4; o < 64; o <<= 1) sm += __shfl_xor(sm, o);
        if ((lane & 3) == 0) AFF[((size_t)(r >> 13) * NE + (lane >> 2)) * SEQ + (r & 8191)] = ex / sm;
    }
}

__device__ __forceinline__ void topk_phase(Frame& F) {
    if (F.vcu >= BATCH * NE) return;
    const int be = F.vcu, b = be >> 4, e = be & 15, t = F.tid, lane = F.lane, w = F.wave;
    LAS int* red = (LAS int*)(F.lds + RING_OFF); LAS int* sc_gt = red + 16; LAS int* sc_eq = sc_gt + 512; LAS int* tot = sc_eq + 512;
    const float* a = (const float*)(F.ws + WS_AFF) + (size_t)be * SEQ;
    unsigned v[16];
#pragma unroll
    for (int i = 0; i < 16; ++i) v[i] = __float_as_uint(a[t * 16 + i]);
    unsigned thr = 0u;
    for (int bit = 30; bit >= 0; --bit) {
        const unsigned cand = thr | (1u << bit); int c = 0;
#pragma unroll
        for (int i = 0; i < 16; ++i) c += (v[i] >= cand) ? 1 : 0;
#pragma unroll
        for (int o = 32; o > 0; o >>= 1) c += __shfl_xor(c, o);
        __syncthreads();
        if (lane == 0) red[w] = c;
        __syncthreads();
        int total = 0;
#pragma unroll
        for (int k = 0; k < 8; ++k) total += red[k];
        if (total >= CAP) thr = cand;
    }
    int ngt = 0, neq = 0;
#pragma unroll
    for (int i = 0; i < 16; ++i) { ngt += (v[i] > thr) ? 1 : 0; neq += (v[i] == thr) ? 1 : 0; }
    __syncthreads();
    sc_gt[t] = ngt; sc_eq[t] = neq;
    __syncthreads();
    if (t == 0) { int ag = 0, ae = 0; for (int i = 0; i < 512; ++i) { const int g0 = sc_gt[i], e0 = sc_eq[i]; sc_gt[i] = ag; sc_eq[i] = ae; ag += g0; ae += e0; } tot[0] = ag; }
    __syncthreads();
    const int quota = CAP - tot[0]; int gpre = sc_gt[t], epre = sc_eq[t];
    int* IDX2 = (int*)(F.ws + WS_IDX2); float* GATE2 = (float*)(F.ws + WS_GATE2); int* SLOTOF = (int*)(F.ws + WS_SLOTOF);
#pragma unroll
    for (int i = 0; i < 16; ++i) {
        const bool gt = v[i] > thr, eq = v[i] == thr, sel = gt || (eq && epre < quota);
        const int tok = t * 16 + i; int so = -1;
        if (sel) { const int slot = gpre + (epre < quota ? epre : quota); so = e * 2048 + b * 1024 + slot; IDX2[so] = b * SEQ + tok; GATE2[so] = __uint_as_float(v[i]); }
        SLOTOF[((size_t)b * SEQ + tok) * NE + e] = so;
        gpre += gt ? 1 : 0; epre += eq ? 1 : 0;
    }
    __syncthreads();
}

__device__ __forceinline__ void gather_phase(Frame& F) {
    const int gw = F.vcu * NWAVES + F.wave, NGW = F.G * NWAVES, lane = F.lane;
    const int* IDX2 = (const int*)(F.ws + WS_IDX2); const bf16* H1 = (const bf16*)(F.ws + WS_H1); bf16* XE = (bf16*)(F.ws + WS_XE);
    for (int r = gw; r < NE * 2048; r += NGW) { const int src = IDX2[r];
        const GAS v4u* s = (const GAS v4u*)(H1 + (size_t)src * DM) + lane; GAS v4u* d = (GAS v4u*)(XE + (size_t)r * DM) + lane;
        const v4u a = s[0], c = s[64]; d[0] = a; d[64] = c; }
}

__device__ __forceinline__ void final_phase(Frame& F) {
    const int gw = F.vcu * NWAVES + F.wave, NGW = F.G * NWAVES, lane = F.lane;
    float* OUT = F.out; const f32x2_t2* ST = (const f32x2_t2*)(F.ws + WS_STATS1); const int* SLOTOF = (const int*)(F.ws + WS_SLOTOF); const bf16* YE = (const bf16*)(F.ws + WS_XE);
    for (int r = gw; r < M; r += NGW) {
        GAS f32x4* xr = (GAS f32x4*)(OUT + (size_t)r * DM) + lane; f32x4 v[4]; const f32x2_t2 st = ST[r];
        const int myslot = SLOTOF[(size_t)r * NE + (lane & 15)];
#pragma unroll
        for (int j = 0; j < 4; ++j) { const f32x4 gg = ((const GAS f32x4*)F.in[20])[lane + 64 * j], bb = ((const GAS f32x4*)F.in[21])[lane + 64 * j]; v[j] = ((xr[64 * j] - st.x) * st.y * gg + bb) * ALPHA; }
        for (int e = 0; e < NE; ++e) { const int sl = __shfl(myslot, e);
            if (sl >= 0) { const GAS u32x2_t* yr = (const GAS u32x2_t*)(YE + (size_t)sl * DM) + lane;
#pragma unroll
                for (int j = 0; j < 4; ++j) { const u32x2_t y = yr[64 * j]; v[j].x += bflo(y.x); v[j].y += bfhi(y.x); v[j].z += bflo(y.y); v[j].w += bfhi(y.y); } } }
        float s = 0.f;
#pragma unroll
        for (int j = 0; j < 4; ++j) s += (v[j].x + v[j].y) + (v[j].z + v[j].w);
        const float mean = wave_sum(s) * (1.f / DM); float s2 = 0.f;
#pragma unroll
        for (int j = 0; j < 4; ++j) { v[j] = v[j] - mean; s2 += (v[j].x * v[j].x + v[j].y * v[j].y) + (v[j].z * v[j].z + v[j].w * v[j].w); }
        const float rstd = 1.f / sqrtf(wave_sum(s2) * (1.f / DM) + LN_EPS);
#pragma unroll
        for (int j = 0; j < 4; ++j) { const f32x4 gg = ((const GAS f32x4*)F.in[26])[lane + 64 * j], bb = ((const GAS f32x4*)F.in[27])[lane + 64 * j]; xr[64 * j] = v[j] * rstd * gg + bb; }
    }
}

#ifndef MK_PER_PHASE
#define MK_PER_PHASE 0
#endif
constexpr int N_PHASES = 16;
struct Args { const float* in[28]; float* out; unsigned char* ws; int ph_lo, ph_hi; };
__global__ void __launch_bounds__(NWAVES * 64, 2) mk_fwd(Args args) {
    extern __shared__ __attribute__((aligned(16))) unsigned char lds[];
    Frame F;
    F.lds = (LAS unsigned char*)lds; F.MISC = (volatile LAS unsigned*)(F.lds + MISC_OFF);
    F.tid = threadIdx.x; F.lane = F.tid & 63; F.wave = __builtin_amdgcn_readfirstlane(F.tid >> 6);
    F.G = gridDim.x; { const int bx = blockIdx.x; F.vcu = (F.G % 8 == 0) ? (bx % 8) * (F.G / 8) + bx / 8 : bx; }
    F.ws = args.ws; F.ctl = (gu32*)(args.ws + WS_CTL); F.out = args.out;
#pragma unroll
    for (int i = 0; i < 28; ++i) F.in[i] = args.in[i];
    for (int u = F.tid; u < (LDS_BYTES - LDSCTL_OFF) / 4; u += NWAVES * 64) ((LAS unsigned*)(F.lds + LDSCTL_OFF))[u] = 0u;
    __syncthreads();
    XcdBarrier bar; bar.bar = (unsigned*)(F.ctl + CW_BAR); bar.x = 0; bar.st = nullptr;
    if (!MK_PER_PHASE) bar = xcd_barrier_post((unsigned*)(F.ctl + CW_BAR), F.MISC + 8);
    const int lo = args.ph_lo, hi = args.ph_hi;
    unsigned char* ws = args.ws;
#define IN(k) (lo <= (k) && (k) < hi)
#define SEAM(k) do { if (IN(k) && IN((k) + 1)) xcd_barrier(bar); } while (0)
    using pg8::Gemm; using pg8::gemm_phase;
    if (IN(0)) { p0_prologue(F); } SEAM(0);
    if (IN(1)) { Gemm g{(const bf16*)(ws + WS_XN), (const bf16*)(ws + WS_WIN), 1024, 1024, 1024}; InProjOrder S; S.so.init(M, INW, F.G, (int)blockIdx.x);
        EpiInProj E{(bf16*)(ws + WS_Q), (bf16*)(ws + WS_K), (bf16*)(ws + WS_V), (bf16*)(ws + WS_UG2), (bf16*)args.out, (bf16*)(ws + WS_UMETA), (LAS float*)(F.lds + XCH_OFF), (const float*)(ws + WS_ROPE) + 6144, (const float*)(ws + WS_ROPE)};
        gemm_phase<EpiInProj, InProjOrder, true, true>(F.lds + RING_OFF, g, S, E); } SEAM(1);
    if (IN(2)) {
        Gemm g{(const bf16*)(ws + WS_UG2), (const bf16*)(ws + WS_WST), UGP, 512, 512}; SsmStateOrder S{F.G, F.vcu}; EpiSsmState E{(float*)(ws + WS_S)};
        gemm_phase<EpiSsmState, SsmStateOrder, true, true>(F.lds + RING_OFF, g, S, E); } SEAM(2);
    if (IN(3)) { ssm_scan(F); __syncthreads();
        const attn_body::AttnTensors AT{(const attn_body::bf16*)(ws + WS_Q), (const attn_body::bf16*)(ws + WS_K), (const attn_body::bf16*)(ws + WS_V), (attn_body::bf16*)(ws + WS_Q)};
        const attn_body::StaticOrder S((int)F.G, (int)blockIdx.x);
        attn_body::attn_phase<attn_body::StaticOrder>((char*)lds + RING_OFF, AT, S); } SEAM(3);
    if (IN(4)) { Gemm g{(const bf16*)(ws + WS_UG2), (const bf16*)(ws + WS_MEXT), UGP, UGP, UGP}; SsmYOrder S{F.G, F.vcu}; EpiSsmY E{(bf16*)(ws + WS_YG)};
        gemm_phase<EpiSsmY, SsmYOrder, true, true>(F.lds + RING_OFF, g, S, E); } SEAM(4);
    if (IN(5)) { Gemm g{(const bf16*)(ws + WS_YG), (const bf16*)(ws + WS_WGLU), 512, 512, 512}; pg8::StaticOrder S; S.init(M, 512, F.G, (int)blockIdx.x); EpiGlu E{(const bf16*)(ws + WS_YG), F.in[16], (bf16*)(ws + WS_Z)};
        gemm_phase<EpiGlu, pg8::StaticOrder, true, true>(F.lds + RING_OFF, g, S, E); } SEAM(5);
    if (IN(6)) { Gemm g{(const bf16*)(ws + WS_Q), (const bf16*)(ws + WS_WAB), 512, 512, 512}; pg8::StaticOrder S; S.init(M, 1024, F.G, (int)blockIdx.x); EpiBranch<0> E{(const bf16*)args.out, nullptr, (bf16*)(ws + WS_T1)};
        gemm_phase<EpiBranch<0>, pg8::StaticOrder, true, true>(F.lds + RING_OFF, g, S, E); } SEAM(6);
    if (IN(7)) { Gemm g{(const bf16*)(ws + WS_Z), (const bf16*)(ws + WS_WSB), 512, 512, 512}; pg8::StaticOrder S; S.init(M, 1024, F.G, (int)blockIdx.x); EpiBranch<1> E{(const bf16*)args.out, (const bf16*)(ws + WS_T1), (bf16*)(ws + WS_MERGED)};
        gemm_phase<EpiBranch<1>, pg8::StaticOrder, true, true>(F.lds + RING_OFF, g, S, E); } SEAM(7);
    if (IN(8)) { Gemm g{(const bf16*)(ws + WS_MERGED), (const bf16*)(ws + WS_WO), 1024, 1024, 1024}; pg8::StaticOrder S; S.init(M, 1024, F.G, (int)blockIdx.x);
        EpiPre1 E{F.in[0], F.in[2], F.in[3], (const f32x2_t2*)(ws + WS_STATS0), args.out};
        gemm_phase<EpiPre1, pg8::StaticOrder, true, true>(F.lds + RING_OFF, g, S, E); } SEAM(8);
    if (IN(9)) { ln1_router(F); } SEAM(9);
    if (IN(10)) { topk_phase(F); } SEAM(10);
    if (IN(11)) { gather_phase(F); } SEAM(11);
    if (IN(12)) { Gemm g{(const bf16*)(ws + WS_XE), (const bf16*)(ws + WS_WGU), 1024, 1024, 1024}; MoeOrder S{F.G, (int)blockIdx.x, 8, 8}; EpiMoe1 E{(bf16*)(ws + WS_HB)};
        gemm_phase<EpiMoe1, MoeOrder, true, true>(F.lds + RING_OFF, g, S, E); } SEAM(12);
    if (IN(13)) { Gemm g{(const bf16*)(ws + WS_HB), (const bf16*)(ws + WS_WD), 1024, 1024, 1024}; MoeOrder S{F.G, (int)blockIdx.x, 8, 4}; EpiMoe2 E{(const float*)(ws + WS_GATE2), (bf16*)(ws + WS_XE)};
        gemm_phase<EpiMoe2, MoeOrder, true, true>(F.lds + RING_OFF, g, S, E); } SEAM(13);
    if (IN(14)) { final_phase(F); }
#undef IN
#undef SEAM
}

extern "C" void kernel_launch(void* const* d_in, const int* in_sizes, int n_in, void* d_out, int out_size, void* d_ws, size_t ws_size, hipStream_t stream) {
    static int grid = 0;
    if (grid == 0) {
        int dev = 0, cus = 0;
        if (hipGetDevice(&dev) != hipSuccess || hipDeviceGetAttribute(&cus, hipDeviceAttributeMultiprocessorCount, dev) != hipSuccess) { fprintf(stderr, "kernel_launch: device query failed\n"); grid = -1; return; }
        if (hipFuncSetAttribute((const void*)mk_fwd, hipFuncAttributeMaxDynamicSharedMemorySize, LDS_BYTES) != hipSuccess) { fprintf(stderr, "kernel_launch: hipFuncSetAttribute failed\n"); grid = -1; return; }
        (void)hipGetLastError();
        grid = cus;
        if (grid != 256 || n_in != 28 || ws_size < WS_END) fprintf(stderr, "kernel_launch: unexpected geometry: %d CUs, %d inputs, %zu bytes of workspace\n", cus, n_in, ws_size);
    }
    if (grid < 0) return;
    (void)hipMemsetAsync((char*)d_ws + WS_CTL, 0, CTL_ZERO_BYTES, stream);
    Args a; memset(&a, 0, sizeof(a));
    for (int i = 0; i < 28; ++i) a.in[i] = (const float*)d_in[i];
    a.out = (float*)d_out; a.ws = (unsigned char*)d_ws;
#if MK_PER_PHASE
    for (int p = 0; p < N_PHASES - 1; ++p) { a.ph_lo = p; a.ph_hi = p + 1; hipLaunchKernelGGL(mk_fwd, dim3(grid), dim3(NWAVES * 64), LDS_BYTES, stream, a); }
#else
    a.ph_lo = 0; a.ph_hi = N_PHASES; hipLaunchKernelGGL(mk_fwd, dim3(grid), dim3(NWAVES * 64), LDS_BYTES, stream, a);
#endif
}
```

```cpp
#include <hip/hip_runtime.h>
#include <cstdio>
#include <cstdint>
#include <cstring>
namespace pg8 {
#define PG8_LAS __attribute__((address_space(3)))
typedef unsigned short bf16_t;
typedef short bf16x8 __attribute__((ext_vector_type(8)));
typedef float f32x4 __attribute__((ext_vector_type(4)));
typedef unsigned u32x4 __attribute__((ext_vector_type(4)));
constexpr int BM = 256, BK = 64, HALF = 128, HTB = HALF * BK * 2  , STAGE_BYTES = 8 * HTB, NXCD = 8, WGM = 8;

__host__ __device__ __forceinline__ int lds_byte(int r, int c) { const int st = (r >> 4) * 2 + (c >> 5), rr = r & 15, cc = c & 31, ob = rr * 64 + cc * 2; return st * 1024 + (ob ^ (((ob >> 9) & 1) << 5)); }
__host__ __device__ __forceinline__ void stage_rc(int b, int& R, int& C) { const int st = b / 1024, sb = b % 1024, swz = sb ^ (((sb >> 9) & 1) << 5); R = (st >> 1) * 16 + swz / 64; C = (st & 1) * 32 + (swz % 64) / 2; }
__host__ __device__ __forceinline__ int perm32(int rho) { const int n = rho >> 4, i = rho & 15; return 8 * (i >> 2) + 4 * n + (i & 3); }

struct Unit { int pm, pn; };
struct Gemm { const bf16_t* A; const bf16_t* Bt; int lda, ldb, K; };

struct StaticOrder {
    int nM, nN, nwg, G, c;
    __host__ __device__ void init(int M, int N, int G_, int c_) { nM = M / BM; nN = N / BM; nwg = nM * nN; G = G_; c = c_; }
    __host__ __device__ bool next(int i, Unit& u) const {
        const long L = (long)i * G + c; if (L >= nwg) return false;
        int wgid = (int)L; { const int q = nwg / NXCD, r = nwg % NXCD, xcd = wgid % NXCD, off = wgid / NXCD; wgid = (xcd < r ? xcd * (q + 1) : r * (q + 1) + (xcd - r) * q) + off; }
        const int nig = WGM * nN, gid = wgid / nig, fm = gid * WGM, gsz = (nM - fm) < WGM ? (nM - fm) : WGM;
        u.pm = fm + ((wgid % nig) % gsz); u.pn = (wgid % nig) / gsz; return true;
    }
    __device__ __forceinline__ void a_ready(const Unit&) const {}
    __device__ __forceinline__ void done(const Unit&) const {}
};

__device__ __forceinline__ unsigned cvt_pk_bf16(float lo, float hi) { unsigned r; asm volatile("v_cvt_pk_bf16_f32 %0, %1, %2" : "=v"(r) : "v"(lo), "v"(hi)); return r; }
typedef float f32x2 __attribute__((ext_vector_type(2)));
template <class Epi, class Sched, bool ALIGN_EPI = false, bool SP2 = false>
__device__ __forceinline__ void gemm_phase(PG8_LAS unsigned char* lds, const Gemm g, const Sched& S, const Epi& E) {
    const int tid = threadIdx.x, wid = __builtin_amdgcn_readfirstlane(tid >> 6), lane = tid & 63, wr = wid >> 2, wc = wid & 3, fr = lane & 15, fq = lane >> 4;
    const int K = g.K, nt = K / BK;
    unsigned voffA[2], voffB[2];
#pragma unroll
    for (int i = 0; i < 2; ++i) { int R, C; stage_rc(tid * 16 + i * 8192, R, C); const int Rb = Epi::PERM ? ((R & ~31) + perm32(R & 31)) : R;
        voffA[i] = (unsigned)(R * g.lda + C) * 2u; voffB[i] = (unsigned)(Rb * g.ldb + C) * 2u; }
    const size_t kstep = (size_t)(BK * 2);
    const size_t hstepA = (size_t)HALF * g.lda * 2, hstepB = (size_t)HALF * g.ldb * 2;
    const size_t tstepA = 2 * hstepA, tstepB = 2 * hstepB;
    const unsigned ldsw = (unsigned)wid * 1024u;
    const int aoff = lds_byte(wr * 64 + fr, fq * 8), boff = lds_byte(wc * 32 + fr, fq * 8);
#define PG8_SA(b, h) (((b) * 2 + (h)) * HTB)
#define PG8_SB(b, h) ((4 + (b) * 2 + (h)) * HTB)
#define PG8_STAGE(bufoff, gbase, voff) do { _Pragma("unroll") for (int _i = 0; _i < 2; ++_i) \
        __builtin_amdgcn_global_load_lds((const unsigned*)((const char*)(gbase) + (voff)[_i]), (PG8_LAS unsigned*)(lds + (bufoff) + ldsw + _i * 8192), 16, 0, 0); } while (0)
#define PG8_LDA(dst, b, h) do { _Pragma("unroll") for (int m = 0; m < 4; ++m) _Pragma("unroll") for (int k = 0; k < 2; ++k) dst[m][k] = *(const PG8_LAS bf16x8*)(lds + PG8_SA(b, h) + aoff + m * 2048 + k * 1024); } while (0)
#define PG8_LDB(dst, b, h) do { _Pragma("unroll") for (int n = 0; n < 2; ++n) _Pragma("unroll") for (int k = 0; k < 2; ++k) dst[n][k] = *(const PG8_LAS bf16x8*)(lds + PG8_SB(b, h) + boff + n * 2048 + k * 1024); } while (0)
#define PG8_MMA(ai, bj, At, Bt) do { __builtin_amdgcn_s_setprio(1); _Pragma("unroll") for (int m = 0; m < 4; ++m) _Pragma("unroll") for (int n = 0; n < 2; ++n) _Pragma("unroll") for (int k = 0; k < 2; ++k) \
        acc[ai][bj][m][n] = __builtin_amdgcn_mfma_f32_16x16x32_bf16(Bt[n][k], At[m][k], acc[ai][bj][m][n], 0, 0, 0); __builtin_amdgcn_s_setprio(0); } while (0)
#define PG8_WAIT_V(n) asm volatile("s_waitcnt vmcnt(" #n ")" ::: "memory")
#define PG8_WAIT_L(n) asm volatile("s_waitcnt lgkmcnt(" #n ")" ::: "memory")
#define PG8_BAR __builtin_amdgcn_s_barrier()
#define PG8_SCHED __builtin_amdgcn_sched_barrier(0)
    Unit cur, nxt; int ui = 0;
    if (!S.next(0, cur)) return;
    f32x4 acc[2][2][4][2];
#pragma unroll
    for (int a = 0; a < 2; ++a)
#pragma unroll
        for (int b = 0; b < 2; ++b)
#pragma unroll
            for (int m = 0; m < 4; ++m)
#pragma unroll
                for (int n = 0; n < 2; ++n) acc[a][b][m][n] = (f32x4){0.f, 0.f, 0.f, 0.f};
    bf16x8 At[4][2], B0[2][2], B1[2][2];
    const char* cA = (const char*)g.A + (size_t)cur.pm * tstepA; const char* cB = (const char*)g.Bt + (size_t)cur.pn * tstepB;
    S.a_ready(cur);
    if constexpr (SP2) {
        PG8_STAGE(PG8_SB(0, 0), cB, voffB); PG8_STAGE(PG8_SB(0, 1), cB + hstepB, voffB); PG8_STAGE(PG8_SA(0, 0), cA, voffA); PG8_STAGE(PG8_SA(0, 1), cA + hstepA, voffA);
        if (wr == 1) PG8_BAR;
        PG8_WAIT_V(2); PG8_BAR;
        PG8_STAGE(PG8_SB(1, 0), cB + kstep, voffB); PG8_STAGE(PG8_SA(1, 0), cA + kstep, voffA); PG8_STAGE(PG8_SB(1, 1), cB + hstepB + kstep, voffB);
        PG8_WAIT_V(6); PG8_BAR;
    } else {
        PG8_STAGE(PG8_SB(0, 0), cB, voffB); PG8_STAGE(PG8_SA(0, 0), cA, voffA); PG8_STAGE(PG8_SB(0, 1), cB + hstepB, voffB); PG8_STAGE(PG8_SA(0, 1), cA + hstepA, voffA);
        if (wr == 1) PG8_BAR;
        PG8_WAIT_V(4); PG8_BAR;
        PG8_STAGE(PG8_SB(1, 0), cB + kstep, voffB); PG8_STAGE(PG8_SA(1, 0), cA + kstep, voffA); PG8_STAGE(PG8_SB(1, 1), cB + hstepB + kstep, voffB);
        PG8_WAIT_V(6); PG8_BAR;
    }
    for (;;) {
        const bool has_next = S.next(ui + 1, nxt);
        const char* nA = has_next ? (const char*)g.A + (size_t)nxt.pm * tstepA : cA; const char* nB = has_next ? (const char*)g.Bt + (size_t)nxt.pn * tstepB : cB;
        for (int t = 0; t < nt; t += 2) {
            const bool last = (t == nt - 2);
            const char* a1 = cA + (size_t)(t + 1) * kstep;
            const char* a2 = last ? nA : cA + (size_t)(t + 2) * kstep; const char* b2 = last ? nB : cB + (size_t)(t + 2) * kstep;
            const char* a3 = a2 + kstep; const char* b3 = b2 + kstep;
            if (last && has_next) S.a_ready(nxt);
            if constexpr (SP2) {
            PG8_LDB(B0, 0, 0); PG8_LDB(B1, 0, 1); PG8_SCHED; PG8_LDA(At, 0, 0); PG8_STAGE(PG8_SA(1, 1), a1 + hstepA, voffA);
            PG8_WAIT_V(8); PG8_WAIT_L(0); PG8_BAR; PG8_MMA(0, 0, At, B0); PG8_MMA(0, 1, At, B1); PG8_BAR; PG8_SCHED;
            PG8_LDA(At, 0, 1); PG8_STAGE(PG8_SB(0, 0), b2, voffB); PG8_STAGE(PG8_SB(0, 1), b2 + hstepB, voffB); PG8_STAGE(PG8_SA(0, 0), a2, voffA);
            PG8_WAIT_V(8); PG8_WAIT_L(0); PG8_BAR; PG8_MMA(1, 0, At, B0); PG8_MMA(1, 1, At, B1); PG8_BAR; PG8_SCHED;
            PG8_LDB(B0, 1, 0); PG8_LDB(B1, 1, 1); PG8_SCHED; PG8_LDA(At, 1, 0); PG8_STAGE(PG8_SA(0, 1), a2 + hstepA, voffA);
            PG8_WAIT_V(8); PG8_WAIT_L(0); PG8_BAR; PG8_MMA(0, 0, At, B0); PG8_MMA(0, 1, At, B1); PG8_BAR; PG8_SCHED;
            PG8_LDA(At, 1, 1); PG8_STAGE(PG8_SB(1, 0), b3, voffB); PG8_STAGE(PG8_SB(1, 1), b3 + hstepB, voffB); PG8_STAGE(PG8_SA(1, 0), a3, voffA);
            PG8_WAIT_V(8); PG8_WAIT_L(0); PG8_BAR; PG8_MMA(1, 0, At, B0); PG8_MMA(1, 1, At, B1); PG8_BAR; PG8_SCHED;
            } else {
            PG8_LDB(B0, 0, 0); PG8_SCHED; PG8_LDA(At, 0, 0); PG8_STAGE(PG8_SA(1, 1), a1 + hstepA, voffA);
            PG8_WAIT_L(8); PG8_BAR; PG8_WAIT_L(0); PG8_MMA(0, 0, At, B0); PG8_BAR; PG8_SCHED;
            PG8_LDB(B1, 0, 1); PG8_STAGE(PG8_SB(0, 0), b2, voffB);
            PG8_BAR; PG8_WAIT_L(0); PG8_MMA(0, 1, At, B1); PG8_BAR;
            PG8_LDA(At, 0, 1); PG8_STAGE(PG8_SA(0, 0), a2, voffA);
            PG8_BAR; PG8_WAIT_L(0); PG8_MMA(1, 0, At, B0); PG8_BAR; PG8_SCHED;
            PG8_STAGE(PG8_SB(0, 1), b2 + hstepB, voffB);
            PG8_WAIT_V(6); PG8_BAR; PG8_MMA(1, 1, At, B1); PG8_BAR;
            PG8_LDB(B0, 1, 0); PG8_SCHED; PG8_LDA(At, 1, 0); PG8_STAGE(PG8_SA(0, 1), a2 + hstepA, voffA);
            PG8_WAIT_L(8); PG8_BAR; PG8_WAIT_L(0); PG8_MMA(0, 0, At, B0); PG8_BAR; PG8_SCHED;
            PG8_LDB(B1, 1, 1); PG8_STAGE(PG8_SB(1, 0), b3, voffB);
            PG8_BAR; PG8_WAIT_L(0); PG8_MMA(0, 1, At, B1); PG8_BAR;
            PG8_LDA(At, 1, 1); PG8_STAGE(PG8_SA(1, 0), a3, voffA);
            PG8_BAR; PG8_WAIT_L(0); PG8_MMA(1, 0, At, B0); PG8_BAR; PG8_SCHED;
            PG8_STAGE(PG8_SB(1, 1), b3 + hstepB, voffB);
            PG8_WAIT_V(6); PG8_BAR; PG8_MMA(1, 1, At, B1); PG8_BAR;
            }
        }
        if constexpr (ALIGN_EPI) { if (wr == 0) PG8_BAR; }
        if constexpr (!Epi::AFTER_DRAIN) { E(acc, cur, wr, wc, fr, fq); S.done(cur); }
        if (!has_next) break;
#pragma unroll
        for (int a = 0; a < 2; ++a)
#pragma unroll
            for (int b = 0; b < 2; ++b)
#pragma unroll
                for (int m = 0; m < 4; ++m)
#pragma unroll
                    for (int n = 0; n < 2; ++n) acc[a][b][m][n] = (f32x4){0.f, 0.f, 0.f, 0.f};
        cur = nxt; cA = nA; cB = nB; ++ui;
        if constexpr (ALIGN_EPI) { if (wr == 1) PG8_BAR; }
    }
    PG8_WAIT_V(0);
    if constexpr (!ALIGN_EPI) { if (wr == 0) PG8_BAR; }
    PG8_BAR;
    if constexpr (Epi::AFTER_DRAIN) { E.fused(acc, cur, wr, wc, fr, fq, lds, wid, lane); S.done(cur); }
#undef PG8_SA
#undef PG8_SB
#undef PG8_STAGE
#undef PG8_LDA
#undef PG8_LDB
#undef PG8_MMA
#undef PG8_WAIT_V
#undef PG8_WAIT_L
#undef PG8_BAR
#undef PG8_SCHED
}
}
#define PG8_SP2 true
#define PG8_ALIGN true
#include <hip/hip_bf16.h>
#include <cmath>
namespace attn_body {
using bf16=__hip_bfloat16;
using bf16x8=__attribute__((ext_vector_type(8)))short;
using s16x4=__attribute__((ext_vector_type(4)))short;
using f32x16=__attribute__((ext_vector_type(16)))float;
using u32x4=__attribute__((ext_vector_type(4)))unsigned;
constexpr int BATCH=2,NHEAD=8,SEQ=8192,D=64,DMQ=NHEAD*D,DMK=128,KVROWS=8320,KVALID=8208;
constexpr int NW=8,QBLK=32,QB=QBLK*NW,KVBLK=64,NQB=SEQ/QB;
constexpr int ATTN_PITCH=DMQ, ATTN_UNIT_ROWS=QB;
__device__ __forceinline__ int crow(int r,int hi){return (r&3)+8*(r>>2)+4*hi;}
#define SBAR() __builtin_amdgcn_sched_barrier(0)
__device__ __forceinline__ void cmask(f32x16&p0,f32x16&p1,int t,int hi){
  const float NEG=-INFINITY; int kb=64*t+4*hi;
  #pragma unroll
  for(int r=0;r<16;++r){int kv=kb+(r&3)+8*(r>>2); if(kv>=KVALID)p0[r]=NEG; if(kv+32>=KVALID)p1[r]=NEG;}
}

constexpr int NSLOT=3, SLOTB=8192;
constexpr int LDS_K=0, LDS_V=NSLOT*SLOTB, LDS_WS=2*NSLOT*SLOTB, LDS_OST=LDS_WS+NW*64*4, LDS_BYTES=LDS_OST+NW*4096;
constexpr float C2=0.125f*1.4426950408889634f;
__device__ __forceinline__ void glds16(const void*gsrc,unsigned lds_dst){unsigned keep;
  asm volatile("s_mov_b32 %0, m0\n\ts_mov_b32 m0, %2\n\ts_nop 0\n\tglobal_load_lds_dwordx4 %1, off\n\ts_mov_b32 m0, %0":"=&s"(keep):"v"(gsrc),"s"(lds_dst):"memory");}
__device__ __forceinline__ float max3f(float a,float b,float c){float r;asm("v_max3_f32 %0, %1, %2, %3":"=v"(r):"v"(a),"v"(b),"v"(c));return r;}
__device__ __forceinline__ float max2f(float a,float b){float r;asm("v_max_f32_e32 %0, %1, %2":"=v"(r):"v"(a),"v"(b));return r;}
__device__ __forceinline__ float fadd_s(float a,float b){float r;asm("v_add_f32_e32 %0, %1, %2":"=v"(r):"v"(a),"v"(b));return r;}
__device__ __forceinline__ float fsub_s(float a,float b){float r;asm("v_sub_f32_e32 %0, %1, %2":"=v"(r):"v"(a),"v"(b));return r;}
typedef float f32x2_t __attribute__((ext_vector_type(2))); typedef __bf16 bf16x2_t __attribute__((ext_vector_type(2)));
__device__ __forceinline__ unsigned cvtpk_s(float lo,float hi){f32x2_t v={lo,hi};bf16x2_t b=__builtin_convertvector(v,bf16x2_t);return __builtin_bit_cast(unsigned,b);}
#define WAIT_BAR(N) asm volatile("s_waitcnt vmcnt(" #N ") lgkmcnt(0)\n\ts_barrier":::"memory")

__device__ __forceinline__ void qkt(f32x16&p0,f32x16&p1,const char*Kslot,const bf16x8*qr,const f32x16&negm,int r32,int hi){
  const char*kb=Kslot+hi*1024+r32*16;
  #pragma unroll
  for(int d0=0;d0<4;++d0){
    const bf16x8 b0=*reinterpret_cast<const bf16x8*>(kb+d0*2048);
    const bf16x8 b1=*reinterpret_cast<const bf16x8*>(kb+d0*2048+512);
    if(d0==0){p0=__builtin_amdgcn_mfma_f32_32x32x16_bf16(b0,qr[0],negm,0,0,0);p1=__builtin_amdgcn_mfma_f32_32x32x16_bf16(b1,qr[0],negm,0,0,0);}
    else{p0=__builtin_amdgcn_mfma_f32_32x32x16_bf16(b0,qr[d0],p0,0,0,0);p1=__builtin_amdgcn_mfma_f32_32x32x16_bf16(b1,qr[d0],p1,0,0,0);}}
}
typedef __attribute__((address_space(3))) const char* lds_cptr;
typedef short v4i16_t __attribute__((ext_vector_type(4)));
__device__ __forceinline__ void kload8(bf16x8*kf,lds_cptr kp){
  kf[0]=*(const __attribute__((address_space(3))) bf16x8*)(kp);      kf[1]=*(const __attribute__((address_space(3))) bf16x8*)(kp+512);
  kf[2]=*(const __attribute__((address_space(3))) bf16x8*)(kp+2048); kf[3]=*(const __attribute__((address_space(3))) bf16x8*)(kp+2560);
  kf[4]=*(const __attribute__((address_space(3))) bf16x8*)(kp+4096); kf[5]=*(const __attribute__((address_space(3))) bf16x8*)(kp+4608);
  kf[6]=*(const __attribute__((address_space(3))) bf16x8*)(kp+6144); kf[7]=*(const __attribute__((address_space(3))) bf16x8*)(kp+6656);
}
__device__ __forceinline__ void kload2(bf16x8*kf,lds_cptr kp,int j){ kf[2*j]=*(const __attribute__((address_space(3))) bf16x8*)(kp+j*2048); kf[2*j+1]=*(const __attribute__((address_space(3))) bf16x8*)(kp+j*2048+512); }
__device__ __forceinline__ s16x4 vtr(lds_cptr p){ return __builtin_bit_cast(s16x4,__builtin_amdgcn_ds_read_tr16_b64_v4i16((__attribute__((address_space(3))) v4i16_t*)p)); }
__device__ __forceinline__ float rowmax(const f32x16&p0,const f32x16&p1){
  float a=max3f(p0[0],p0[1],p1[0]),b=max3f(p0[2],p0[3],p1[1]);a=max3f(a,p1[2],p1[3]);
  #pragma unroll
  for(int r=4;r<16;r+=4){a=max3f(a,p0[r],p0[r+1]);b=max3f(b,p0[r+2],p0[r+3]);a=max3f(a,p1[r],p1[r+1]);b=max3f(b,p1[r+2],p1[r+3]);}
  const float m=max2f(a,b);
  auto rr=__builtin_amdgcn_permlane32_swap(__float_as_uint(m),__float_as_uint(m),false,false);
  return max2f(__uint_as_float(rr[0]),__uint_as_float(rr[1]));
}
__device__ __forceinline__ void pv(f32x16*o,int vb,bf16x8 pa0,bf16x8 pa1,bf16x8 pa2,bf16x8 pa3){
  #pragma unroll
  for(int d0=0;d0<2;++d0){s16x4 lo[4],hi[4];
    #pragma unroll
    for(int ks=0;ks<4;++ks){
      asm volatile("ds_read_b64_tr_b16 %0,%1 offset:%c2":"=&v"(lo[ks]):"v"(vb),"i"(d0*4096+ks*1024):"memory");
      asm volatile("ds_read_b64_tr_b16 %0,%1 offset:%c2":"=&v"(hi[ks]):"v"(vb),"i"(d0*4096+ks*1024+512):"memory");}
    asm volatile("s_waitcnt lgkmcnt(0)":::"memory");SBAR();
    #define PK(k) (bf16x8){lo[k][0],lo[k][1],lo[k][2],lo[k][3],hi[k][0],hi[k][1],hi[k][2],hi[k][3]}
    o[d0]=__builtin_amdgcn_mfma_f32_32x32x16_bf16(pa0,PK(0),o[d0],0,0,0);
    o[d0]=__builtin_amdgcn_mfma_f32_32x32x16_bf16(pa1,PK(1),o[d0],0,0,0);
    o[d0]=__builtin_amdgcn_mfma_f32_32x32x16_bf16(pa2,PK(2),o[d0],0,0,0);
    o[d0]=__builtin_amdgcn_mfma_f32_32x32x16_bf16(pa3,PK(3),o[d0],0,0,0);
    #undef PK
  }
}

#ifndef ATTN_STORE16
#define ATTN_STORE16(p,v) (*(u32x4*)(p)=(v))
#endif
template<int THRL> __device__ __forceinline__ void attn_unit(int b,int h,int qb,const bf16*Q,const bf16*__restrict__ K,const bf16*__restrict__ V,bf16*O,char*shm){
  const int tid=threadIdx.x,lane=tid&63,r32=lane&31,hi=lane>>5; const int wid=__builtin_amdgcn_readfirstlane(tid>>6);
  const long rowbase=(long)b*SEQ, kvbase=(long)b*KVROWS; const int q0=qb*QB;
  const bf16*Qw=Q+(rowbase+q0+wid*QBLK)*DMQ+h*D;
  const bf16*Kh=K+kvbase*DMK+(h>>2)*D,*Vh=V+kvbase*DMK+(h>>2)*D;
  const unsigned lds0=(unsigned)(uintptr_t)shm;
  float*wsf=(float*)(shm+LDS_WS)+wid*64;
  const bf16*ksrc=Kh+(long)lane*DMK+wid*8;
  const bf16*vsrc=Vh+(long)(16*(wid&3)+(lane>>2))*DMK+(wid>>2)*32+(lane&3)*8;
  const unsigned kdst=lds0+LDS_K+wid*1024, vdst=lds0+LDS_V+wid*1024;
  #define DMA_K(t,slot) glds16(ksrc+(long)(t)*KVBLK*DMK,(unsigned)__builtin_amdgcn_readfirstlane(kdst+(slot)))
  #define DMA_V(t,slot) glds16(vsrc+(long)(t)*KVBLK*DMK,(unsigned)__builtin_amdgcn_readfirstlane(vdst+(slot)))
  const int vb0=(int)(lds0+LDS_V)+((lane>>4)&1)*32+(lane&3)*8+(4*hi+((lane&15)>>2))*64;
  const char*Kbase=shm+LDS_K; bf16x8 kf[8];
  const lds_cptr shm3=(lds_cptr)shm; const lds_cptr kp0=shm3+LDS_K+hi*1024+r32*16; const lds_cptr vp0=shm3+LDS_V+((lane>>4)&1)*32+(lane&3)*8+(4*hi+((lane&15)>>2))*64;
  constexpr int NT=KVROWS/KVBLK;
  DMA_K(0,0);DMA_V(0,0);DMA_K(1,SLOTB);
  bf16x8 qr[4];
  #pragma unroll
  for(int d0=0;d0<4;++d0)qr[d0]=*reinterpret_cast<const bf16x8*>(&Qw[(long)r32*DMQ+d0*16+hi*8]);
  float mhat=0.f,l_reg=0.f;f32x16 o[2];o[0]=f32x16{};o[1]=f32x16{};f32x16 negm=f32x16{};asm volatile("":"+v"(negm));
    #define CMASK(P0,P1,t) do{ if((t)>=NT-4)cmask(P0,P1,(t),hi); }while(0)
  bool resc=false;
  #define START(P0,P1) do{ const float rm=rowmax(P0,P1); resc=false; \
    { const float dl=rm; mhat=fadd_s(mhat,dl); \
      _Pragma("unroll") for(int r=0;r<16;++r){P0[r]=fsub_s(P0[r],dl);P1[r]=fsub_s(P1[r],dl);} \
      _Pragma("unroll") for(int r=0;r<16;++r)negm[r]=-mhat; asm volatile("":"+v"(negm)); } \
    _Pragma("unroll") for(int r=0;r<16;++r)P0[r]=__builtin_amdgcn_exp2f(P0[r]); }while(0)
  #define RESC() do{ if(resc){ asm volatile("s_waitcnt lgkmcnt(0)":::"memory"); \
      _Pragma("unroll") for(int d_=0;d_<2;++d_) _Pragma("unroll") for(int r=0;r<16;++r)o[d_][r]*=wsf[crow(r,hi)]; } }while(0)
  f32x16 pA0,pA1,pB0,pB1;
  int sl_prev=0,sl_cur=0,sl_next=SLOTB;
  #define ROT() do{sl_prev=sl_cur;sl_cur=sl_next;sl_next=(sl_next==(NSLOT-1)*SLOTB)?0:sl_next+SLOTB;}while(0)
  DMA_K(2,2*SLOTB);
  WAIT_BAR(3);
  qkt(pA0,pA1,Kbase,qr,negm,r32,hi);asm volatile("s_nop 15\n\ts_nop 7":"+v"(pA0),"+v"(pA1));CMASK(pA0,pA1,0);
  START(pA0,pA1);
  _Pragma("unroll") for(int r=0;r<16;++r)pA1[r]=__builtin_amdgcn_exp2f(pA1[r]);
  WAIT_BAR(0);
  DMA_K(3,0);DMA_V(1,SLOTB);
  ROT();
  kload8(kf,kp0+sl_cur);
  WAIT_BAR(2);
  s16x4 vlo[8],vhi[8]; u32x4 pw0,pw1,pw2,pw3;
  #define PKW(P,B) cvtpk_s(P[B],P[B+1])
  #define PAF(k) __builtin_bit_cast(bf16x8,pw##k)
  #define VFR(i) (bf16x8){vlo[i][0],vlo[i][1],vlo[i][2],vlo[i][3],vhi[i][0],vhi[i][1],vhi[i][2],vhi[i][3]}
  #define PIN(x) asm volatile("":"+v"(x))
  #define MX3(a,b,c) __builtin_fmaxf(__builtin_fmaxf((a),(b)),(c))
  #define GAPA(MF,A0,A1,A2,A3,W0,W1,PW) do{ MF; sacc+=A0; sacc+=A1; sacc+=A2; sacc+=A3; PIN(sacc); W0; W1; PIN(PW); SBAR(); }while(0)
  #define EX(v) __builtin_amdgcn_exp2f(v)
  #define GAPB(MF,X,B) do{ MF; X[B]=EX(X[B]); X[B+1]=EX(X[B+1]); X[B+2]=EX(X[B+2]); X[B+3]=EX(X[B+3]); PIN(X); SBAR(); }while(0)
  #define VRD(i) do{ vlo[i]=vtr(vp_+(((i)>>2)*4096+((i)&3)*1024)); vhi[i]=vtr(vp_+(((i)>>2)*4096+((i)&3)*1024+512)); }while(0)
  #define KRD(G,j) do{ if(G){ kload2(kf,kp0+sl_next,j); SBAR(); } }while(0)
  #define STEP(C0,C1,P0,P1,t,GK,GV,GL) do{ SBAR(); \
    const lds_cptr vp_=vp0+sl_prev; \
    VRD(0); SBAR(); float sacc=(P0[0]+P0[1]); \
    GAPA(C0=__builtin_amdgcn_mfma_f32_32x32x16_bf16(kf[0],qr[0],negm,0,0,0), P0[2],P0[3],P0[4],P0[5],     pw0[0]=PKW(P0,0), pw0[1]=PKW(P0,2), pw0); \
    VRD(4); SBAR(); GAPA(C1=__builtin_amdgcn_mfma_f32_32x32x16_bf16(kf[1],qr[0],negm,0,0,0), P0[6],P0[7],P0[8],P0[9],     pw0[2]=PKW(P0,4), pw0[3]=PKW(P0,6), pw0); \
    VRD(1); SBAR(); GAPA(C0=__builtin_amdgcn_mfma_f32_32x32x16_bf16(kf[2],qr[1],C0,0,0,0),   P0[10],P0[11],P0[12],P0[13], pw1[0]=PKW(P0,8), pw1[1]=PKW(P0,10), pw1); \
    VRD(5); SBAR(); GAPA(C1=__builtin_amdgcn_mfma_f32_32x32x16_bf16(kf[3],qr[1],C1,0,0,0),   P0[14],P0[15],P1[0],P1[1],   pw1[2]=PKW(P0,12),pw1[3]=PKW(P0,14), pw1); \
    VRD(2); SBAR(); GAPA(C0=__builtin_amdgcn_mfma_f32_32x32x16_bf16(kf[4],qr[2],C0,0,0,0),   P1[2],P1[3],P1[4],P1[5],     pw2[0]=PKW(P1,0), pw2[1]=PKW(P1,2), pw2); \
    VRD(6); SBAR(); GAPA(C1=__builtin_amdgcn_mfma_f32_32x32x16_bf16(kf[5],qr[2],C1,0,0,0),   P1[6],P1[7],P1[8],P1[9],     pw2[2]=PKW(P1,4), pw2[3]=PKW(P1,6), pw2); \
    VRD(3); SBAR(); GAPA(C0=__builtin_amdgcn_mfma_f32_32x32x16_bf16(kf[6],qr[3],C0,0,0,0),   P1[10],P1[11],P1[12],P1[13], pw3[0]=PKW(P1,8), pw3[1]=PKW(P1,10), pw3); \
    VRD(7); SBAR(); GAPA(C1=__builtin_amdgcn_mfma_f32_32x32x16_bf16(kf[7],qr[3],C1,0,0,0),   P1[14],P1[15],0.f,0.f,       pw3[2]=PKW(P1,12),pw3[3]=PKW(P1,14), pw3); \
    l_reg+=sacc; \
    if(GK){DMA_K((t)+3,sl_cur);} if(GV){DMA_V((t)+1,sl_next);} \
    CMASK(C0,C1,t); \
    { float a=MX3(C0[0],C0[1],C1[0]),b=MX3(C0[2],C0[3],C1[1]); a=MX3(a,C1[2],C1[3]); \
      _Pragma("unroll") for(int r=4;r<16;r+=4){a=MX3(a,C0[r],C0[r+1]);b=MX3(b,C0[r+2],C0[r+3]);a=MX3(a,C1[r],C1[r+1]);b=MX3(b,C1[r+2],C1[r+3]);} \
      float rm=__builtin_fmaxf(a,b); { auto rr=__builtin_amdgcn_permlane32_swap(__float_as_uint(rm),__float_as_uint(rm),false,false); rm=__builtin_fmaxf(__uint_as_float(rr[0]),__uint_as_float(rr[1])); } \
      resc=false; \
      if(__builtin_expect(__any(rm>(float)THRL),0)){ const float dl=__builtin_fmaxf(rm,0.f); mhat+=dl; \
        _Pragma("unroll") for(int r=0;r<16;++r){C0[r]-=dl;C1[r]-=dl;} \
        _Pragma("unroll") for(int r=0;r<16;++r)negm[r]=-mhat; asm volatile("":"+v"(negm)); \
        const float f=__builtin_amdgcn_exp2f(-dl); l_reg*=f; if(hi==0)wsf[r32]=f; resc=true; } } \
    SBAR(); \
    GAPB(o[0]=__builtin_amdgcn_mfma_f32_32x32x16_bf16(PAF(0),VFR(0),o[0],0,0,0), C0,0); \
    GAPB(o[1]=__builtin_amdgcn_mfma_f32_32x32x16_bf16(PAF(0),VFR(4),o[1],0,0,0), C0,4); \
    KRD(GL,0); GAPB(o[0]=__builtin_amdgcn_mfma_f32_32x32x16_bf16(PAF(1),VFR(1),o[0],0,0,0), C0,8); \
    KRD(GL,1); GAPB(o[1]=__builtin_amdgcn_mfma_f32_32x32x16_bf16(PAF(1),VFR(5),o[1],0,0,0), C0,12); \
    KRD(GL,2); GAPB(o[0]=__builtin_amdgcn_mfma_f32_32x32x16_bf16(PAF(2),VFR(2),o[0],0,0,0), C1,0); \
    KRD(GL,3); GAPB(o[1]=__builtin_amdgcn_mfma_f32_32x32x16_bf16(PAF(2),VFR(6),o[1],0,0,0), C1,4); \
    GAPB(o[0]=__builtin_amdgcn_mfma_f32_32x32x16_bf16(PAF(3),VFR(3),o[0],0,0,0), C1,8); \
    GAPB(o[1]=__builtin_amdgcn_mfma_f32_32x32x16_bf16(PAF(3),VFR(7),o[1],0,0,0), C1,12); \
    }while(0)
  int t=1;
  #undef CMASK
  #define CMASK(P0,P1,t) do{}while(0)
  for(;t+5<NT;t+=2){
    STEP(pB0,pB1,pA0,pA1,t,true,true,true);     WAIT_BAR(2); RESC(); ROT();
    STEP(pA0,pA1,pB0,pB1,t+1,true,true,true);   WAIT_BAR(2); RESC(); ROT();
  }
  #undef CMASK
  #define CMASK(P0,P1,t) do{ if((t)>=NT-4)cmask(P0,P1,(t),hi); }while(0)
  #define ENDW(tt) do{ if((tt)+3<NT){WAIT_BAR(2);} else if((tt)+2<NT){WAIT_BAR(1);} else {WAIT_BAR(0);} }while(0)
  for(;t+1<NT;t+=2){
    STEP(pB0,pB1,pA0,pA1,t,(t+3<NT),(t+1<NT),(t+1<NT));       ENDW(t);   RESC(); ROT();
    STEP(pA0,pA1,pB0,pB1,t+1,(t+4<NT),(t+2<NT),(t+2<NT));     ENDW(t+1); RESC(); ROT();
  }
  STEP(pB0,pB1,pA0,pA1,NT-1,false,false,false); RESC();
  { float sacc=pB0[0]+pB0[1]; _Pragma("unroll") for(int r=2;r<16;++r)sacc+=pB0[r]; _Pragma("unroll") for(int r=0;r<16;++r)sacc+=pB1[r]; l_reg+=sacc;
    pw0=(u32x4){PKW(pB0,0),PKW(pB0,2),PKW(pB0,4),PKW(pB0,6)};pw1=(u32x4){PKW(pB0,8),PKW(pB0,10),PKW(pB0,12),PKW(pB0,14)};pw2=(u32x4){PKW(pB1,0),PKW(pB1,2),PKW(pB1,4),PKW(pB1,6)};pw3=(u32x4){PKW(pB1,8),PKW(pB1,10),PKW(pB1,12),PKW(pB1,14)};
    SBAR(); pv(o,vb0+sl_cur,PAF(0),PAF(1),PAF(2),PAF(3)); }
  #undef PKW
  #undef PAF
  #undef VFR
  #undef PIN
  #undef MX3
  #undef GAPA
  #undef GAPB
  #undef EX
  #undef VRD
  #undef KRD
  #undef STEP
  #undef ENDW
  {auto rr=__builtin_amdgcn_permlane32_swap(__float_as_uint(l_reg),__float_as_uint(l_reg),false,false);l_reg=__uint_as_float(rr[0])+__uint_as_float(rr[1]);}
  if(hi==0)wsf[32+r32]=l_reg;asm volatile("s_waitcnt lgkmcnt(0)":::"memory");
  float rli[16];
  #pragma unroll
  for(int r=0;r<16;++r)rli[r]=__builtin_amdgcn_rcpf(wsf[32+crow(r,hi)]);
  bf16*Ow=O+(rowbase+q0+wid*QBLK)*DMQ+h*D;
  { bf16*stg=(bf16*)(shm+LDS_OST)+wid*2048;
    #pragma unroll
    for(int r=0;r<16;++r){const int orow=crow(r,hi);
      #pragma unroll
      for(int d0=0;d0<2;++d0)stg[orow*64+d0*32+r32]=__float2bfloat16(o[d0][r]*rli[r]);}
    asm volatile("s_waitcnt lgkmcnt(0)":::"memory");
    #pragma unroll
    for(int i=0;i<4;++i){const int row=i*8+(lane>>3),ch=lane&7; const u32x4 v=*(const u32x4*)(stg+row*64+ch*8); ATTN_STORE16(Ow+(long)row*DMQ+ch*8,v);} }
  asm volatile("s_waitcnt lgkmcnt(0)\n\ts_barrier":::"memory");
  #undef DMA_K
  #undef DMA_V
  #undef CMASK
  #undef START
  #undef RESC
  #undef ROT
}
constexpr int ATTN_LDS_BYTES=LDS_BYTES;
struct AttnTensors { const bf16* Q; const bf16* K; const bf16* V; bf16* O; };
struct AttnUnit { int bh; int qb; };
struct StaticOrder {
  int vcu;
  __device__ __forceinline__ explicit StaticOrder(int grid,int block):vcu((block%8)*(grid/8)+block/8){}
  __device__ __forceinline__ bool next(int i,AttnUnit&u)const{ if(i>=2)return false; const int pr=vcu>>6,uu=2*(vcu&63)+i; u.bh=(pr>>1)*NHEAD+(pr&1)*4+(uu>>5); u.qb=uu&31; return true; }
  __device__ __forceinline__ void a_ready(const AttnUnit&)const{}
  __device__ __forceinline__ void done(const AttnUnit&)const{}
};
template<class Sched,int THRL=8> __device__ __forceinline__ void attn_phase(char*lds,const AttnTensors&T,const Sched&S){
  AttnUnit u;
  for(int i=0;S.next(i,u);++i){ S.a_ready(u); attn_unit<THRL>(u.bh/NHEAD,u.bh%NHEAD,u.qb,T.Q,T.K,T.V,T.O,lds); S.done(u); }
}
#undef SBAR
#undef WAIT_BAR
}
#define GAS __attribute__((address_space(1)))
#define LAS __attribute__((address_space(3)))
typedef unsigned short bf16;
typedef unsigned v4u __attribute__((ext_vector_type(4)));
typedef float f32x4 __attribute__((ext_vector_type(4)));
typedef short bf16x8 __attribute__((ext_vector_type(8)));
typedef GAS unsigned gu32;
typedef GAS unsigned long long gu64;
#define RLX_AGENT __ATOMIC_RELAXED, __HIP_MEMORY_SCOPE_AGENT
#define LDS_WAIT() asm volatile("s_waitcnt lgkmcnt(0)" ::: "memory")
#define VM_WAIT() asm volatile("s_waitcnt vmcnt(0)" ::: "memory")
__device__ __forceinline__ unsigned long long rt() { return __builtin_amdgcn_s_memrealtime(); }
__device__ __forceinline__ unsigned f2bf(float f) { unsigned u = __builtin_bit_cast(unsigned, f); return (u + 0x7fffu + ((u >> 16) & 1u)) >> 16; }
__device__ __forceinline__ unsigned pk2(float lo, float hi) { return f2bf(lo) | (f2bf(hi) << 16); }

#define XB_TMO      128
#define XB_XCNT(j)  (256  + 64 * (j))
#define XB_XSUB(j)  (1280 + 64 * (j))
#define XB_XGEN(j)  (2304 + 64 * (j))
#define XB_TOP      3328
#define XB_TOPGEN   3392
#define XCD_BAR_WORDS 3456
#define XB_SPIN_CAP (1u << 18)

__device__ __forceinline__ unsigned xb_ld(unsigned* p)              { return __hip_atomic_load(p, __ATOMIC_RELAXED, __HIP_MEMORY_SCOPE_AGENT); }
__device__ __forceinline__ unsigned xb_add(unsigned* p, unsigned v) { return __hip_atomic_fetch_add(p, v, __ATOMIC_RELAXED, __HIP_MEMORY_SCOPE_AGENT); }
__device__ __forceinline__ unsigned xb_xcc_id() { return (unsigned)__builtin_amdgcn_s_getreg((3 << 11) | 20) & 0xFu; }
#define XB_SPIN(cond, bar) do { unsigned _sp = 0; while (cond) { __builtin_amdgcn_s_sleep(1); \
    if ((++_sp & 255u) == 0u) { if (xb_ld(&(bar)[XB_TMO])) break; if (_sp > XB_SPIN_CAP) { atomicAdd(&(bar)[XB_TMO], 1u); break; } } } } while (0)

struct XcdBarrier {
    unsigned* bar; unsigned x;
    volatile LAS unsigned* st;
};

__device__ __forceinline__ XcdBarrier xcd_barrier_post(unsigned* bar, volatile LAS unsigned* st) {
    XcdBarrier b; b.bar = bar; b.x = xb_xcc_id(); b.st = st;
    if (threadIdx.x == 0) (void)xb_add(&bar[XB_XCNT(b.x)], 1u);
    return b;
}
__device__ __forceinline__ void xcd_barrier_complete(unsigned* bar, unsigned x, unsigned& nloc, unsigned& nx) {
    const unsigned G = gridDim.x * gridDim.y * gridDim.z;
    unsigned sum, cnt, mine, sp = 0u;
    for (;;) {
        sum = 0u; cnt = 0u; mine = 0u;
#pragma unroll
        for (unsigned j = 0; j < 16; ++j) { const unsigned c = xb_ld(&bar[XB_XCNT(j)]); sum += c; cnt += (c > 0u) ? 1u : 0u; mine = (j == x) ? c : mine; }
        if (sum == G) break;
        __builtin_amdgcn_s_sleep(1);
        if ((++sp & 255u) == 0u) { if (xb_ld(&bar[XB_TMO])) break; if (sp > XB_SPIN_CAP) { atomicAdd(&bar[XB_TMO], 1u); break; } }
    }
    nloc = mine > 0u ? mine : 1u; nx = cnt > 0u ? cnt : 1u;
}

__device__ __forceinline__ void xcd_barrier(const XcdBarrier& b) {
    asm volatile("s_waitcnt vmcnt(0)" ::: "memory");
    __syncthreads();
    if (threadIdx.x == 0) {
        unsigned* bar = b.bar;
        __builtin_amdgcn_s_waitcnt(0);
        unsigned nloc = b.st[0], nx = b.st[1];
        if (nloc == 0u) { xcd_barrier_complete(bar, b.x, nloc, nx); b.st[0] = nloc; b.st[1] = nx; }
        const unsigned old = xb_add(&bar[XB_XSUB(b.x)], 1u);
        const unsigned gen = old / nloc;
        if (old + 1u == (gen + 1u) * nloc) {
            __builtin_amdgcn_fence(__ATOMIC_RELEASE, "agent");
            asm volatile("s_waitcnt vmcnt(0)" ::: "memory");
            const unsigned og = xb_add(&bar[XB_TOP], 1u);
            const unsigned tg = og / nx;
            if (og + 1u == (tg + 1u) * nx) xb_add(&bar[XB_TOPGEN], 1u);
            else XB_SPIN(xb_ld(&bar[XB_TOPGEN]) == tg, bar);
            __builtin_amdgcn_fence(__ATOMIC_ACQUIRE, "agent");
            xb_add(&bar[XB_XGEN(b.x)], 1u);
            asm volatile("s_waitcnt vmcnt(0)" ::: "memory");
        } else {
            XB_SPIN(xb_ld(&bar[XB_XGEN(b.x)]) == gen, bar);
            __builtin_amdgcn_fence(__ATOMIC_ACQUIRE, "agent");
            asm volatile("s_waitcnt vmcnt(0)" ::: "memory");
        }
    }
    __syncthreads();
}

constexpr int NWAVES = 8;
constexpr int BATCH = 2, SEQ = 8192, DM = 1024, NMETA = 16;
constexpr int M = BATCH * SEQ;
constexpr int INW = 3328;
constexpr int KVROWS = 8320, KVALID = 8208;
constexpr int NG = 32, NE = 16, CAP = 1024;
constexpr int UGP = 768;
constexpr float LN_EPS = 1e-5f, QK_EPS = 1e-6f, ALPHA = 1.189207115002721f;
constexpr float C2Q = 0.125f * 1.4426950408889634f;

constexpr size_t MiB = 1u << 20;
constexpr size_t WS_CTL = 0, CTL_ZERO_BYTES = 1 * MiB;
constexpr size_t WS_STATS0 = 1 * MiB, WS_STATS1 = WS_STATS0 + 131072, WS_ROPE = WS_STATS1 + 131072, WS_UMETA = WS_ROPE + 32768, WS_GATE2 = WS_UMETA + 32768, WS_IDX2 = WS_GATE2 + 131072;
constexpr size_t WS_SLOTOF = 2 * MiB, WS_AFF = 3 * MiB;
constexpr size_t WS_WGU = 8 * MiB, WS_WD = 72 * MiB;
constexpr size_t WS_WIN = 104 * MiB, WS_WGLU = 111 * MiB, WS_WAB = 112 * MiB, WS_WSB = 113 * MiB, WS_WO = 114 * MiB;
constexpr size_t WS_WST = 116 * MiB, WS_MEXT = 124 * MiB;
constexpr size_t WS_XN = 148 * MiB;
constexpr size_t WS_Q = 181 * MiB, WS_K = 197 * MiB, WS_V = 202 * MiB;
constexpr size_t WS_UG2 = 207 * MiB, WS_S = 231 * MiB;
constexpr size_t WS_END = 247 * MiB;
constexpr size_t WS_YG = WS_XN, WS_Z = WS_XN + 16 * MiB;
constexpr size_t WS_T1 = WS_WST;
constexpr size_t WS_MERGED = WS_UG2;
constexpr size_t WS_H1 = WS_XN;
constexpr size_t WS_XE = WS_Q;
constexpr size_t WS_HB = WS_WIN;
static_assert(WS_XE + 64 * MiB <= WS_END && WS_HB + 64 * MiB <= WS_XE && WS_MERGED + 32 * MiB <= WS_END && WS_T1 + 32 * MiB <= WS_XN, "d_ws overlays");
constexpr int CW_TMO = 0, CW_BAR = 4096;

constexpr int RING_OFF = 0, RING_BYTES = 131072;
constexpr int LDSCTL_OFF = RING_BYTES, MISC_OFF = LDSCTL_OFF + 320;
constexpr int LDS_BYTES = 147456;

typedef unsigned u32x4_t __attribute__((ext_vector_type(4)));
typedef unsigned u32x2_t __attribute__((ext_vector_type(2)));
typedef float f32x2_t2 __attribute__((ext_vector_type(2)));
using pg8::Unit;

struct Frame {
    LAS unsigned char* lds; volatile LAS unsigned* MISC; gu32* ctl;
    int tid, lane, wave, vcu, G;
    unsigned char* ws;
    const float* in[28]; float* out;
};
__device__ __forceinline__ float wave_sum(float v) {
#pragma unroll
    for (int o = 1; o < 64; o <<= 1) v += __shfl_xor(v, o);
    return v;
}
__device__ __forceinline__ float sigm(float x) { return 1.f / (1.f + __expf(-x)); }
__device__ __forceinline__ float bf2f(unsigned short h) { return __uint_as_float((unsigned)h << 16); }
__device__ __forceinline__ float bflo(unsigned w) { return __uint_as_float(w << 16); }
__device__ __forceinline__ float bfhi(unsigned w) { return __uint_as_float(w & 0xffff0000u); }
__device__ __forceinline__ u32x4_t pack8(const f32x4& a, const f32x4& b) { u32x4_t w; w.x = pg8::cvt_pk_bf16(a[0], a[1]); w.y = pg8::cvt_pk_bf16(a[2], a[3]); w.z = pg8::cvt_pk_bf16(b[0], b[1]); w.w = pg8::cvt_pk_bf16(b[2], b[3]); return w; }
__device__ __forceinline__ float gelu_tanh(float y) { const float in = 0.7978845608028654f * (y + 0.044715f * y * y * y); const float e = __expf(2.f * in); return y * (1.f - 1.f / (e + 1.f)); }

struct InProjOrder {
    pg8::StaticOrder so;
    __device__ bool next(int i, Unit& u) const { if (so.next(i, u)) return true; const long L = (long)i * so.G + so.c; if (L >= so.nwg && L < so.nwg + 3) { u.pm = 64; u.pn = 2 + (int)(L - so.nwg); return true; } return false; }
    __device__ __forceinline__ void a_ready(const Unit&) const {}
    __device__ __forceinline__ void done(const Unit&) const {}
};
struct SsmStateOrder {
    int G, c;
    __device__ bool next(int i, Unit& u) const { const int L = i * G + c; if (L >= 64) return false; u.pm = L; u.pn = L >> 1; return true; }
    __device__ __forceinline__ void a_ready(const Unit&) const {}
    __device__ __forceinline__ void done(const Unit&) const {}
};
struct SsmYOrder {
    int G, c;
    __device__ bool next(int i, Unit& u) const { const int L = i * G + c; if (L >= 128) return false; const int g = L >> 2; u.pm = g * 2 + ((L >> 1) & 1); u.pn = g * 2 + (L & 1); return true; }
    __device__ __forceinline__ void a_ready(const Unit&) const {}
    __device__ __forceinline__ void done(const Unit&) const {}
};
struct MoeOrder {
    int G, c, nmi, nnj;
    __device__ bool next(int i, Unit& u) const { const int per = nmi * nnj, nwg = NE * per; const int L = i * G + c; if (L >= nwg) return false;
        const int wgid = (L % 8) * (nwg / 8) + L / 8; const int e = wgid / per, w = wgid % per; u.pm = e * nmi + (w % nmi); u.pn = e * nnj + (w / nmi); return true; }
    __device__ __forceinline__ void a_ready(const Unit&) const {}
    __device__ __forceinline__ void done(const Unit&) const {}
};

typedef float f32x4 __attribute__((ext_vector_type(4)));
#define EPI_LOOP_AM _Pragma("unroll") for (int ai = 0; ai < 2; ++ai) _Pragma("unroll") for (int m = 0; m < 4; ++m)
constexpr int XCH_OFF = 132096;
struct EpiInProj {
    static constexpr bool PERM = true, AFTER_DRAIN = false;
    bf16* Q; bf16* Kb; bf16* Vb; bf16* UG2; bf16* GATES; bf16* UMETA; LAS float* XCH; const float* ngt; const float* RP;
    __device__ __forceinline__ u32x4_t normrope(const f32x4& a0, const f32x4& a1, float rinv, const f32x4& g0, const f32x4& g1, const f32x4& cs, const f32x4& sn, float osc) const {
        const float y0 = a0[0] * rinv * g0[0], y1 = a0[1] * rinv * g0[1], y2 = a0[2] * rinv * g0[2], y3 = a0[3] * rinv * g0[3];
        const float y4 = a1[0] * rinv * g1[0], y5 = a1[1] * rinv * g1[1], y6 = a1[2] * rinv * g1[2], y7 = a1[3] * rinv * g1[3];
        u32x4_t w;
        w.x = pg8::cvt_pk_bf16((y0 * cs[0] - y1 * sn[0]) * osc, (y0 * sn[0] + y1 * cs[0]) * osc);
        w.y = pg8::cvt_pk_bf16((y2 * cs[1] - y3 * sn[1]) * osc, (y2 * sn[1] + y3 * cs[1]) * osc);
        w.z = pg8::cvt_pk_bf16((y4 * cs[2] - y5 * sn[2]) * osc, (y4 * sn[2] + y5 * cs[2]) * osc);
        w.w = pg8::cvt_pk_bf16((y6 * cs[3] - y7 * sn[3]) * osc, (y6 * sn[3] + y7 * cs[3]) * osc);
        return w;
    }
    __device__ __forceinline__ void operator()(const f32x4 (&acc)[2][2][4][2], const Unit& u, int wr, int wc, int fr_, int fq_) const {
        int fr = fr_, fq = fq_; asm volatile("" : "+v"(fr), "+v"(fq));
        const int pn = u.pn, cl0 = wc * 32 + 8 * fq;
        if (pn <= 2) {
            const int nb = pn == 2 ? 1 : 2;
            EPI_LOOP_AM {
#pragma unroll
                for (int bj = 0; bj < 2; ++bj) {
                    if (bj < nb) { const f32x4 a = acc[ai][bj][m][0], c = acc[ai][bj][m][1]; float s = (a[0] * a[0] + a[1] * a[1]) + (a[2] * a[2] + a[3] * a[3]) + (c[0] * c[0] + c[1] * c[1]) + (c[2] * c[2] + c[3] * c[3]);
                        s += __shfl_xor(s, 16); s += __shfl_xor(s, 32);
                        if (fq == 0) XCH[(ai * 128 + wr * 64 + m * 16 + fr) * 8 + bj * 4 + wc] = s; } } }
            asm volatile("s_waitcnt lgkmcnt(0)" ::: "memory"); __builtin_amdgcn_s_barrier(); asm volatile("" ::: "memory");
            const float* gsrc = ngt + (pn == 2 ? 64 : 0) + (wc & 1) * 32 + 8 * fq;
            const f32x4 g0 = *(const f32x4*)gsrc, g1 = *(const f32x4*)(gsrc + 4);
            const float osc = pn == 2 ? 1.f : C2Q;
            const int codd = wc & 1;
            EPI_LOOP_AM {
                if (u.pm == 64 && (wr != 0 || ai != 0 || m != 0)) continue;
                const int rl = ai * 128 + wr * 64 + m * 16 + fr; const int row = u.pm * 256 + rl;
                f32x4 cs = (f32x4){1.f, 1.f, 1.f, 1.f}, sn = (f32x4){0.f, 0.f, 0.f, 0.f};
                if (u.pm != 64) { const int s = row & 8191; const float* tp = codd ? RP + 4096 + (s & 63) * 16 + 4 * fq : RP + (s >> 6) * 16 + 4 * fq; cs = *(const f32x4*)tp; sn = *(const f32x4*)(tp + (codd ? 1024 : 2048)); }
#pragma unroll
                for (int bj = 0; bj < 2; ++bj) {
                    if (bj < nb) {
                        const f32x2_t2 pr = *(const LAS f32x2_t2*)(XCH + rl * 8 + bj * 4 + (wc & 2)); const float tot = pr.x + pr.y;
                        const float rinv = rsqrtf(tot * (1.f / 64.f) + QK_EPS);
                        const u32x4_t w = normrope(acc[ai][bj][m][0], acc[ai][bj][m][1], rinv, g0, g1, cs, sn, osc);
                        if (pn < 2) *(u32x4_t*)(Q + (size_t)row * 512 + pn * 256 + bj * 128 + cl0) = w;
                        else if (u.pm != 64) *(u32x4_t*)(Kb + ((size_t)(row >> 13) * KVROWS + NMETA + (row & 8191)) * 128 + cl0) = w;
                        else { *(u32x4_t*)(Kb + (size_t)fr * 128 + cl0) = w; *(u32x4_t*)(Kb + ((size_t)KVROWS + fr) * 128 + cl0) = w; }
                    } else {
                        const u32x4_t w = pack8(acc[ai][1][m][0], acc[ai][1][m][1]);
                        if (u.pm != 64) *(u32x4_t*)(Vb + ((size_t)(row >> 13) * KVROWS + NMETA + (row & 8191)) * 128 + cl0) = w;
                        else { *(u32x4_t*)(Vb + (size_t)fr * 128 + cl0) = w; *(u32x4_t*)(Vb + ((size_t)KVROWS + fr) * 128 + cl0) = w; }
                    }
                }
            }
            return;
        }
        if (u.pm == 64) {
            if (wr != 0) return;
#pragma unroll
            for (int bj = 0; bj < 2; ++bj) { const int cu = (pn - 3) * 256 + bj * 128 + cl0; *(u32x4_t*)(UMETA + ((size_t)(cu >> 4) * 16 + fr) * 16 + (cu & 15)) = pack8(acc[0][bj][0][0], acc[0][bj][0][1]); }
            return;
        }
        const int row0 = u.pm * 256 + wr * 64 + fr;
        if (pn < 5) {
            EPI_LOOP_AM { const int row = row0 + ai * 128 + m * 16, b = row >> 13, s = row & 8191;
#pragma unroll
                for (int bj = 0; bj < 2; ++bj) { const int cu = (pn - 3) * 256 + bj * 128 + cl0, g = cu >> 4;
                    *(u32x4_t*)(UG2 + ((size_t)(g * 2 + b) * 256 + (s >> 5)) * UGP + (s & 31) * 16 + (cu & 15)) = pack8(acc[ai][bj][m][0], acc[ai][bj][m][1]); } }
        } else {
            EPI_LOOP_AM { const size_t o = (size_t)(row0 + ai * 128 + m * 16) * 2048 + (pn - 5) * 256 + cl0;
#pragma unroll
                for (int bj = 0; bj < 2; ++bj) { f32x4 a = acc[ai][bj][m][0], c = acc[ai][bj][m][1];
#pragma unroll
                    for (int j = 0; j < 4; ++j) { a[j] = sigm(a[j]); c[j] = sigm(c[j]); }
                    *(u32x4_t*)(GATES + o + bj * 128) = pack8(a, c); } }
        }
    }
};
struct EpiSsmState {
    static constexpr bool PERM = false, AFTER_DRAIN = false;
    float* S;
    __device__ __forceinline__ void operator()(const f32x4 (&acc)[2][2][4][2], const Unit& u, int wr, int wc, int fr, int fq) const {
        EPI_LOOP_AM { float* rp = S + ((size_t)u.pm * 256 + ai * 128 + wr * 64 + m * 16 + fr) * 256 + wc * 32 + 4 * fq;
#pragma unroll
            for (int bj = 0; bj < 2; ++bj)
#pragma unroll
                for (int n = 0; n < 2; ++n) *(f32x4*)(rp + bj * 128 + n * 16) = acc[ai][bj][m][n]; }
    }
};
struct EpiSsmY {
    static constexpr bool PERM = true, AFTER_DRAIN = false;
    bf16* YG;
    __device__ __forceinline__ void operator()(const f32x4 (&acc)[2][2][4][2], const Unit& u, int wr, int wc, int fr, int fq) const {
        const int g = u.pm >> 1, b = u.pm & 1, nh = u.pn & 1;
        EPI_LOOP_AM { const int cp = ai * 128 + wr * 64 + m * 16 + fr;
#pragma unroll
            for (int bj = 0; bj < 2; ++bj) { const int nl = nh * 256 + bj * 128 + wc * 32 + 8 * fq, t = nl >> 4, h0 = nl & 15;
                f32x4 a = acc[ai][bj][m][0], c = acc[ai][bj][m][1];
#pragma unroll
                for (int j = 0; j < 4; ++j) { a[j] = gelu_tanh(a[j]); c[j] = gelu_tanh(c[j]); }
                *(u32x4_t*)(YG + ((size_t)b * SEQ + cp * 32 + t) * 512 + g * 16 + h0) = pack8(a, c); } }
    }
};
struct EpiGlu {
    static constexpr bool PERM = true, AFTER_DRAIN = false;
    const bf16* YG; const float* bias; bf16* Z;
    __device__ __forceinline__ void operator()(const f32x4 (&acc)[2][2][4][2], const Unit& u, int wr, int wc, int fr, int fq) const {
        const int row0 = u.pm * 256 + wr * 64 + fr, col0 = u.pn * 256 + wc * 32 + 8 * fq;
        EPI_LOOP_AM { const size_t o = (size_t)(row0 + ai * 128 + m * 16) * 512 + col0;
#pragma unroll
            for (int bj = 0; bj < 2; ++bj) { const u32x4_t y = *(const u32x4_t*)(YG + o + bj * 128);
                const f32x4 b0 = *(const f32x4*)(bias + col0 + bj * 128), b1 = *(const f32x4*)(bias + col0 + bj * 128 + 4);
                f32x4 a = acc[ai][bj][m][0] + b0, c = acc[ai][bj][m][1] + b1;
                a[0] = bflo(y.x) * sigm(a[0]); a[1] = bfhi(y.x) * sigm(a[1]); a[2] = bflo(y.y) * sigm(a[2]); a[3] = bfhi(y.y) * sigm(a[3]);
                c[0] = bflo(y.z) * sigm(c[0]); c[1] = bfhi(y.z) * sigm(c[1]); c[2] = bflo(y.w) * sigm(c[2]); c[3] = bfhi(y.w) * sigm(c[3]);
                *(u32x4_t*)(Z + o + bj * 128) = pack8(a, c); } }
    }
};
template <int SECOND> struct EpiBranch {
    static constexpr bool PERM = true, AFTER_DRAIN = false;
    const bf16* GATES; const bf16* T1; bf16* O;
    __device__ __forceinline__ void operator()(const f32x4 (&acc)[2][2][4][2], const Unit& u, int wr, int wc, int fr, int fq) const {
        const int row0 = u.pm * 256 + wr * 64 + fr, col0 = u.pn * 256 + wc * 32 + 8 * fq;
        EPI_LOOP_AM { const size_t r = (size_t)(row0 + ai * 128 + m * 16);
#pragma unroll
            for (int bj = 0; bj < 2; ++bj) { const u32x4_t gt = *(const u32x4_t*)(GATES + r * 2048 + SECOND * 1024 + col0 + bj * 128);
                f32x4 a = acc[ai][bj][m][0], c = acc[ai][bj][m][1];
                a[0] *= bflo(gt.x); a[1] *= bfhi(gt.x); a[2] *= bflo(gt.y); a[3] *= bfhi(gt.y); c[0] *= bflo(gt.z); c[1] *= bfhi(gt.z); c[2] *= bflo(gt.w); c[3] *= bfhi(gt.w);
                if (SECOND) { const u32x4_t t1 = *(const u32x4_t*)(T1 + r * 1024 + col0 + bj * 128);
                    a[0] += bflo(t1.x); a[1] += bfhi(t1.x); a[2] += bflo(t1.y); a[3] += bfhi(t1.y); c[0] += bflo(t1.z); c[1] += bfhi(t1.z); c[2] += bflo(t1.w); c[3] += bfhi(t1.w); }
                *(u32x4_t*)(O + r * 1024 + col0 + bj * 128) = pack8(a, c); } }
    }
};
struct EpiPre1 {
    static constexpr bool PERM = false, AFTER_DRAIN = false;
    const float* x; const float* g; const float* bb; const f32x2_t2* st; float* out;
    __device__ __forceinline__ void operator()(const f32x4 (&acc)[2][2][4][2], const Unit& u, int wr, int wc, int fr, int fq) const {
        const int row0 = u.pm * 256 + wr * 64 + fr, col0 = u.pn * 256 + wc * 32 + 4 * fq;
        EPI_LOOP_AM { const int row = row0 + ai * 128 + m * 16; const f32x2_t2 s = st[row]; const size_t o = (size_t)row * 1024 + col0;
#pragma unroll
            for (int bj = 0; bj < 2; ++bj)
#pragma unroll
                for (int n = 0; n < 2; ++n) { const int c = bj * 128 + n * 16; const f32x4 xv = *(const f32x4*)(x + o + c), gv = *(const f32x4*)(g + col0 + c), bv = *(const f32x4*)(bb + col0 + c);
                    *(f32x4*)(out + o + c) = ((xv - s.x) * s.y * gv + bv) * ALPHA + acc[ai][bj][m][n]; } }
    }
};
struct EpiMoe1 {
    static constexpr bool PERM = true, AFTER_DRAIN = false;
    bf16* HB;
    __device__ __forceinline__ void operator()(const f32x4 (&acc)[2][2][4][2], const Unit& u, int wr, int wc, int fr, int fq) const {
        const int row0 = u.pm * 256 + wr * 64 + fr, col0 = (u.pn & 7) * 128 + wc * 32 + 8 * fq;
        EPI_LOOP_AM { f32x4 a = acc[ai][0][m][0], c = acc[ai][0][m][1]; const f32x4 ua = acc[ai][1][m][0], uc = acc[ai][1][m][1];
#pragma unroll
            for (int j = 0; j < 4; ++j) { a[j] = a[j] * sigm(a[j]) * ua[j]; c[j] = c[j] * sigm(c[j]) * uc[j]; }
            *(u32x4_t*)(HB + (size_t)(row0 + ai * 128 + m * 16) * 1024 + col0) = pack8(a, c); }
    }
};
struct EpiMoe2 {
    static constexpr bool PERM = true, AFTER_DRAIN = false;
    const float* gate; bf16* YE;
    __device__ __forceinline__ void operator()(const f32x4 (&acc)[2][2][4][2], const Unit& u, int wr, int wc, int fr, int fq) const {
        const int row0 = u.pm * 256 + wr * 64 + fr, col0 = (u.pn & 3) * 256 + wc * 32 + 8 * fq;
        EPI_LOOP_AM { const int row = row0 + ai * 128 + m * 16; const float gt = gate[row];
#pragma unroll
            for (int bj = 0; bj < 2; ++bj) *(u32x4_t*)(YE + (size_t)row * 1024 + col0 + bj * 128) = pack8(acc[ai][bj][m][0] * gt, acc[ai][bj][m][1] * gt); }
    }
};

struct TItem { const float* src; bf16* dst; int N, K; };
__device__ __forceinline__ void titem_load(const TItem& t, f32x4 (&v)[8], int lane) {
    const float* p = t.src + (size_t)(lane >> 3) * t.N + (lane & 7) * 4;
#pragma unroll
    for (int i = 0; i < 8; ++i) v[i] = *(const GAS f32x4*)(p + (size_t)(8 * i) * t.N);
}
__device__ __forceinline__ void titem_store(const TItem& t, const f32x4 (&v)[8], LAS float* scr, int lane) {
#pragma unroll
    for (int i = 0; i < 8; ++i) { LAS float* s = scr + ((lane >> 3) + 8 * i) * 33 + (lane & 7) * 4; s[0] = v[i].x; s[1] = v[i].y; s[2] = v[i].z; s[3] = v[i].w; }
    LDS_WAIT(); asm volatile("" ::: "memory");
    const int c = lane & 7;
#pragma unroll
    for (int j = 0; j < 4; ++j) { const int n = (lane >> 3) + 8 * j; const LAS float* s = scr + (8 * c) * 33 + n;
        v4u o; o.x = pk2(s[0 * 33], s[1 * 33]); o.y = pk2(s[2 * 33], s[3 * 33]); o.z = pk2(s[4 * 33], s[5 * 33]); o.w = pk2(s[6 * 33], s[7 * 33]);
        *(GAS v4u*)(t.dst + (size_t)n * t.K + 8 * c) = o; }
    LDS_WAIT(); asm volatile("" ::: "memory");
}
__device__ __forceinline__ void ssm_par(const Frame& F, int dg, int p, float& lr, float& li, float& cr, float& ci) {
    const float dt = expf(F.in[9][dg]); const float ar = F.in[7][dg * 64 + p], ai = F.in[8][dg * 64 + p];
    lr = ar * dt; li = ai * dt;
    float sn, cs; sincosf(li, &sn, &cs); const float mag = expf(lr);
    const float nr = mag * cs - 1.f, ni = mag * sn, den = ar * ar + ai * ai;
    cr = (nr * ar + ni * ai) / den; ci = (ni * ar - nr * ai) / den;
}
__device__ __forceinline__ void cpow(float lr, float li, float e, float& pr, float& pi) { float sn, cs; sincosf(li * e, &sn, &cs); const float mg = expf(lr * e); pr = mg * cs; pi = mg * sn; }

__device__ __forceinline__ TItem titem_decode(int it, const float* w_in, const float* w_glu, const float* w_ab, const float* w_sb, const float* w_o, const float* w_g, const float* w_u, const float* w_d, unsigned char* ws) {
    constexpr int I_IN = 16 * 104, I_GLU = 8 * 16, I_BR = 8 * 32, I_O = 16 * 32, I_E = 16 * 32;
    TItem t; int r = it;
          if (r < I_IN) { const int kb = r / 104, nb = r % 104; t.src = w_in + (size_t)(64 * kb) * INW + 32 * nb; t.N = INW; t.K = 1024; t.dst = (bf16*)(ws + WS_WIN) + (size_t)(32 * nb) * 1024 + 64 * kb; return t; } r -= I_IN;
          if (r < I_GLU) { const int kb = r / 16, nb = r % 16; t.src = w_glu + (size_t)(64 * kb) * 512 + 32 * nb; t.N = 512; t.K = 512; t.dst = (bf16*)(ws + WS_WGLU) + (size_t)(32 * nb) * 512 + 64 * kb; return t; } r -= I_GLU;
          if (r < I_BR) { const int kb = r / 32, nb = r % 32; t.src = w_ab + (size_t)(64 * kb) * 1024 + 32 * nb; t.N = 1024; t.K = 512; t.dst = (bf16*)(ws + WS_WAB) + (size_t)(32 * nb) * 512 + 64 * kb; return t; } r -= I_BR;
          if (r < I_BR) { const int kb = r / 32, nb = r % 32; t.src = w_sb + (size_t)(64 * kb) * 1024 + 32 * nb; t.N = 1024; t.K = 512; t.dst = (bf16*)(ws + WS_WSB) + (size_t)(32 * nb) * 512 + 64 * kb; return t; } r -= I_BR;
          if (r < I_O) { const int kb = r / 32, nb = r % 32; t.src = w_o + (size_t)(64 * kb) * 1024 + 32 * nb; t.N = 1024; t.K = 1024; t.dst = (bf16*)(ws + WS_WO) + (size_t)(32 * nb) * 1024 + 64 * kb; return t; } r -= I_O;
          const int e = r / (3 * I_E), which = (r / I_E) % 3, q = r % I_E, kb = q / 32, nb = q % 32, n0 = 32 * nb;
          const float* W = (which == 0 ? w_g : which == 1 ? w_u : w_d) + (size_t)e * 1024 * 1024;
          t.src = W + (size_t)(64 * kb) * 1024 + n0; t.N = 1024; t.K = 1024;
          const int drow0 = which < 2 ? e * 2048 + (n0 >> 7) * 256 + which * 128 + (n0 & 127) : e * 1024 + n0;
          t.dst = (bf16*)(ws + (which < 2 ? WS_WGU : WS_WD)) + (size_t)drow0 * 1024 + 64 * kb; return t; }
__device__ __forceinline__ void p0_prologue(Frame& F) {
    const int gw = F.vcu * NWAVES + F.wave, NGW = F.G * NWAVES, lane = F.lane, tid = F.tid;
    unsigned char* ws = F.ws;
    {
        LAS float* POW = (LAS float*)(F.lds + RING_OFF);
        LAS float* BB = POW + 2 * 33 * 64 * 2;
        LAS float* CC = BB + 2 * 64 * 16 * 2;
        LAS float* KT = CC + 2 * 4 * 64 * 2;
        bf16* MEXT = (bf16*)(ws + WS_MEXT);
        for (int it = blockIdx.x; it < 128; it += F.G) {
            const int g = it >> 2, hq = it & 3;
            __syncthreads();
            for (int i = tid; i < 2 * 33 * 64; i += NWAVES * 64) { const int dir = i / (33 * 64), j = (i / 64) % 33, p = i & 63; float lr, li, cr, ci; ssm_par(F, dir * 32 + g, p, lr, li, cr, ci);
                float pr, pi; cpow(lr, li, (float)j, pr, pi); POW[i * 2] = pr; POW[i * 2 + 1] = pi; }
            for (int i = tid; i < 2 * 64 * 16; i += NWAVES * 64) { const int dir = i / 1024, p = (i >> 4) & 63, h = i & 15; float lr, li, cr, ci; ssm_par(F, dir * 32 + g, p, lr, li, cr, ci);
                const size_t o = ((size_t)(dir * 32 + g) * 64 + p) * 16 + h; const float br = F.in[10][o], bi = F.in[11][o]; BB[i * 2] = cr * br - ci * bi; BB[i * 2 + 1] = cr * bi + ci * br; }
            for (int i = tid; i < 2 * 4 * 64; i += NWAVES * 64) { const int dir = i / 256, hl = (i >> 6) & 3, p = i & 63; const size_t o = ((size_t)(dir * 32 + g) * 16 + hq * 4 + hl) * 64 + p; CC[i * 2] = F.in[12][o]; CC[i * 2 + 1] = F.in[13][o]; }
            __syncthreads();
            for (int i = tid; i < 2 * 4 * 32 * 16; i += NWAVES * 64) { const int dir = i / 2048, hl = (i >> 9) & 3, j = (i >> 4) & 31, hi = i & 15; float s = 0.f;
                for (int p = 0; p < 64; ++p) { const float cr = CC[((dir * 4 + hl) * 64 + p) * 2], ci = CC[((dir * 4 + hl) * 64 + p) * 2 + 1], pr = POW[((dir * 33 + j) * 64 + p) * 2], pi = POW[((dir * 33 + j) * 64 + p) * 2 + 1];
                    const float er = cr * pr - ci * pi, ei = cr * pi + ci * pr; const float br = BB[((dir * 64 + p) * 16 + hi) * 2], bi = BB[((dir * 64 + p) * 16 + hi) * 2 + 1]; s += er * br - ei * bi; }
                KT[i] = s; }
            __syncthreads();
            for (int ch = tid; ch < 128 * 96; ch += NWAVES * 64) { const int rl = ch / 96, cc = ch % 96, t = rl >> 2, hl = rl & 3, ho = hq * 4 + hl; float v[8];
                if (cc < 64) { const int s = cc >> 1, hi0 = (cc & 1) * 8;
#pragma unroll
                    for (int j = 0; j < 8; ++j) { const int hi = hi0 + j; float x = 0.f; if (s <= t) x += KT[((0 * 4 + hl) * 32 + (t - s)) * 16 + hi]; if (s >= t) x += KT[((1 * 4 + hl) * 32 + (s - t)) * 16 + hi];
                        if (s == t && hi == ho) x += F.in[14][g * 16 + ho]; v[j] = x; }
                } else { const int kk = (cc - 64) * 8, dir = kk >> 7, reim = (kk >> 6) & 1, p0 = kk & 63, e = dir == 0 ? t + 1 : 32 - t;
#pragma unroll
                    for (int j = 0; j < 8; ++j) { const int p = p0 + j; const float cr = CC[((dir * 4 + hl) * 64 + p) * 2], ci = CC[((dir * 4 + hl) * 64 + p) * 2 + 1], pr = POW[((dir * 33 + e) * 64 + p) * 2], pi = POW[((dir * 33 + e) * 64 + p) * 2 + 1];
                        v[j] = reim == 0 ? (cr * pr - ci * pi) : -(cr * pi + ci * pr); } }
                v4u o; o.x = pk2(v[0], v[1]); o.y = pk2(v[2], v[3]); o.z = pk2(v[4], v[5]); o.w = pk2(v[6], v[7]);
                *(GAS v4u*)(MEXT + ((size_t)g * 512 + t * 16 + ho) * UGP + cc * 8) = o; }
        }
        __syncthreads();
    }
    LAS float* scr = (LAS float*)(F.lds + RING_OFF + F.wave * 16384);
    { bf16* WST = (bf16*)(ws + WS_WST);
      for (int it = gw; it < NG * 256; it += NGW) { const int g = it >> 8, n = it & 255, dir = n >> 7, reim = (n >> 6) & 1, p = n & 63; float lr, li, cr, ci; ssm_par(F, dir * 32 + g, p, lr, li, cr, ci);
          const int t = lane >> 1, h0 = (lane & 1) * 8; float pr, pi; cpow(lr, li, (float)(dir == 0 ? 31 - t : t), pr, pi);
          const float er = pr * cr - pi * ci, ei = pr * ci + pi * cr; const size_t o = ((size_t)(dir * 32 + g) * 64 + p) * 16 + h0; float v[8];
#pragma unroll
          for (int j = 0; j < 8; ++j) { const float br = F.in[10][o + j], bi = F.in[11][o + j]; v[j] = reim == 0 ? (er * br - ei * bi) : (er * bi + ei * br); }
          v4u w; w.x = pk2(v[0], v[1]); w.y = pk2(v[2], v[3]); w.z = pk2(v[4], v[5]); w.w = pk2(v[6], v[7]);
          *(GAS v4u*)(WST + ((size_t)g * 256 + n) * 512 + lane * 8) = w; } }
    { constexpr int I_IN = 16 * 104, I_GLU = 8 * 16, I_BR = 8 * 32, I_O = 16 * 32, I_E = 16 * 32;
      constexpr int NIT = I_IN + I_GLU + 2 * I_BR + I_O + NE * 3 * I_E;
      f32x4 va[8], vb[8]; TItem ta, tb;
      int it = gw;
      if (it < NIT) { ta = titem_decode(it, F.in[4], F.in[15], F.in[17], F.in[18], F.in[19], F.in[23], F.in[24], F.in[25], ws); titem_load(ta, va, lane); }
      while (it < NIT) {
          const int i1 = it + NGW; if (i1 < NIT) { tb = titem_decode(i1, F.in[4], F.in[15], F.in[17], F.in[18], F.in[19], F.in[23], F.in[24], F.in[25], ws); titem_load(tb, vb, lane); }
          titem_store(ta, va, scr, lane);
          if (i1 >= NIT) break;
          const int i2 = i1 + NGW; if (i2 < NIT) { ta = titem_decode(i2, F.in[4], F.in[15], F.in[17], F.in[18], F.in[19], F.in[23], F.in[24], F.in[25], ws); titem_load(ta, va, lane); }
          titem_store(tb, vb, scr, lane);
          it = i2;
      } }
    { bf16* XN = (bf16*)(ws + WS_XN); f32x2_t2* ST = (f32x2_t2*)(ws + WS_STATS0);
      for (int r = gw; r < M + NMETA; r += NGW) { const float* src = r < M ? F.in[0] + (size_t)r * DM : F.in[1] + (size_t)(r - M) * DM;
          const GAS f32x4* xr = (const GAS f32x4*)src + lane; f32x4 v[4]; float s = 0.f;
#pragma unroll
          for (int j = 0; j < 4; ++j) { v[j] = xr[64 * j]; s += (v[j].x + v[j].y) + (v[j].z + v[j].w); }
          const float mean = wave_sum(s) * (1.f / DM); float s2 = 0.f;
#pragma unroll
          for (int j = 0; j < 4; ++j) { v[j] = v[j] - mean; s2 += (v[j].x * v[j].x + v[j].y * v[j].y) + (v[j].z * v[j].z + v[j].w * v[j].w); }
          const float rstd = 1.f / sqrtf(wave_sum(s2) * (1.f / DM) + LN_EPS);
          if (r < M && lane == 0) ST[r] = (f32x2_t2){mean, rstd};
          GAS unsigned long long* o8 = (GAS unsigned long long*)(XN + (size_t)r * DM) + lane;
#pragma unroll
          for (int j = 0; j < 4; ++j) { const f32x4 gg = ((const GAS f32x4*)F.in[2])[lane + 64 * j], bb = ((const GAS f32x4*)F.in[3])[lane + 64 * j]; const f32x4 o = v[j] * rstd * gg + bb;
              o8[64 * j] = (unsigned long long)pk2(o.x, o.y) | ((unsigned long long)pk2(o.z, o.w) << 32); } } }
    { const int gt = F.vcu * (NWAVES * 64) + tid, NT_ = F.G * NWAVES * 64;
      for (int i = gt; i < 2 * 2 * 112 * 16; i += NT_) { const int arr = i / (2 * 112 * 16), b = (i / (112 * 16)) & 1, q = i % (112 * 16);
          *(GAS v4u*)((bf16*)(ws + (arr ? WS_V : WS_K)) + ((size_t)b * KVROWS + KVALID) * 128 + q * 8) = (v4u){0u, 0u, 0u, 0u}; }
      float* RP = (float*)(ws + WS_ROPE);
      for (int i = gt; i < 3072; i += NT_) { const bool isr = i < 2048; const int q = isr ? i : i - 2048, pos = q >> 4, j = q & 15; const float ang = (float)pos * powf(10000.f, -(float)j / 16.f);
          float sn, cs; sincosf(ang, &sn, &cs); if (isr) { RP[q] = cs; RP[2048 + q] = sn; } else { RP[4096 + q] = cs; RP[5120 + q] = sn; } }
      for (int i = gt; i < 128; i += NT_) RP[6144 + i] = i < 64 ? F.in[5][i] : F.in[6][i - 64]; }
}

__device__ __forceinline__ void qk_prep(Frame& F) {
    const int gw = F.vcu * NWAVES + F.wave, NGW = F.G * NWAVES, lane = F.lane;
    bf16* Q = (bf16*)(F.ws + WS_Q); bf16* K = (bf16*)(F.ws + WS_K); const float* RP = (const float*)(F.ws + WS_ROPE);
    constexpr int NQ = M * 8, NK = 2 * KVALID * 2;
    for (int it = gw; it < NQ + NK; it += NGW) {
        bf16* p; int pos; float gsc, osc;
        if (it < NQ) { const int row = it >> 3, h = it & 7; p = Q + (size_t)row * 512 + h * 64; pos = row & 8191; gsc = F.in[5][lane]; osc = C2Q; }
        else { const int r = it - NQ, b = r / (KVALID * 2), q = r % (KVALID * 2), l = q >> 1, kvh = q & 1; p = K + ((size_t)b * KVROWS + l) * 128 + kvh * 64; pos = l - NMETA; gsc = F.in[6][lane]; osc = 1.f; }
        const float x = bf2f(p[lane]);
        const float ss = wave_sum(x * x) * (1.f / 64.f);
        const float y = x * rsqrtf(ss + QK_EPS) * gsc, yo = __shfl_xor(y, 1);
        float cs = 1.f, sn = 0.f;
        if (pos >= 0) { const int j = lane >> 1; if (j < 16) { cs = RP[(pos >> 6) * 16 + j]; sn = RP[2048 + (pos >> 6) * 16 + j]; } else { cs = RP[4096 + (pos & 63) * 16 + j - 16]; sn = RP[5120 + (pos & 63) * 16 + j - 16]; } }
        const float o = ((lane & 1) ? (yo * sn + y * cs) : (y * cs - yo * sn)) * osc;
        p[lane] = (bf16)f2bf(o);
    }
}

__device__ __forceinline__ void ssm_scan(Frame& F) {
    if (F.wave != 0 || blockIdx.x >= 128) return;
    const int it = blockIdx.x, b = it >> 6, g = (it >> 1) & 31, dir = it & 1, p = F.lane;
    float lr, li, cr, ci; ssm_par(F, dir * 32 + g, p, lr, li, cr, ci);
    float a32r, a32i; cpow(lr, li, 32.f, a32r, a32i);
    const float* S = (const float*)(F.ws + WS_S) + (size_t)(g * 2 + b) * 256 * 256 + dir * 128 + p;
    bf16* U = (bf16*)(F.ws + WS_UG2) + (size_t)(g * 2 + b) * 256 * UGP + 512 + dir * 128 + p;
    float sr = 0.f, si = 0.f;
    if (dir == 0) {
        float a1r, a1i; cpow(lr, li, 1.f, a1r, a1i);
        const bf16* um = (const bf16*)(F.ws + WS_UMETA) + (size_t)g * 256; const size_t o = ((size_t)g * 64 + p) * 16;
        float bbr[16], bbi[16];
#pragma unroll
        for (int h = 0; h < 16; ++h) { const float br = F.in[10][o + h], bi = F.in[11][o + h]; bbr[h] = cr * br - ci * bi; bbi[h] = cr * bi + ci * br; }
        for (int t = 0; t < 16; ++t) { float bur = 0.f, bui = 0.f;
#pragma unroll
            for (int h = 0; h < 16; ++h) { const float uv = bf2f(um[t * 16 + h]); bur = fmaf(bbr[h], uv, bur); bui = fmaf(bbi[h], uv, bui); }
            const float nr = a1r * sr - a1i * si + bur, ni = a1r * si + a1i * sr + bui; sr = nr; si = ni; }
    }
    for (int c0 = 0; c0 < 256; c0 += 32) {
        float vr[32], vi[32];
#pragma unroll
        for (int k = 0; k < 32; ++k) { const int c = dir == 0 ? c0 + k : 255 - (c0 + k); vr[k] = S[(size_t)c * 256]; vi[k] = S[(size_t)c * 256 + 64]; }
#pragma unroll
        for (int k = 0; k < 32; ++k) { const int c = dir == 0 ? c0 + k : 255 - (c0 + k);
            U[(size_t)c * UGP] = (bf16)f2bf(sr); U[(size_t)c * UGP + 64] = (bf16)f2bf(si);
            const float nr = a32r * sr - a32i * si + vr[k], ni = a32r * si + a32i * sr + vi[k]; sr = nr; si = ni; }
    }
}

__device__ __forceinline__ float treduce16(const float (&v)[16], int lane) {
    float r8[8], r4[4], r2[2], r1;
    { const bool up = lane & 32;
#pragma unroll
      for (int i = 0; i < 8; ++i) { const float keep = up ? v[i + 8] : v[i], send = up ? v[i] : v[i + 8]; r8[i] = keep + __shfl_xor(send, 32); } }
    { const bool up = lane & 16;
#pragma unroll
      for (int i = 0; i < 4; ++i) { const float keep = up ? r8[i + 4] : r8[i], send = up ? r8[i] : r8[i + 4]; r4[i] = keep + __shfl_xor(send, 16); } }
    { const bool up = lane & 8;
#pragma unroll
      for (int i = 0; i < 2; ++i) { const float keep = up ? r4[i + 2] : r4[i], send = up ? r4[i] : r4[i + 2]; r2[i] = keep + __shfl_xor(send, 8); } }
    { const bool up = lane & 4; const float keep = up ? r2[1] : r2[0], send = up ? r2[0] : r2[1]; r1 = keep + __shfl_xor(send, 4); }
    r1 += __shfl_xor(r1, 2); r1 += __shfl_xor(r1, 1);
    return r1;
}
__device__ __forceinline__ void ln1_router(Frame& F) {
    const int gw = F.vcu * NWAVES + F.wave, NGW = F.G * NWAVES, lane = F.lane;
    LAS float* WRT = (LAS float*)(F.lds + RING_OFF);
    for (int i = F.tid; i < 16 * 1024; i += NWAVES * 64) { const int d = i >> 4, e = i & 15; WRT[e * 1024 + d] = F.in[22][i]; }
    __syncthreads();
    const float* PRE = F.out; bf16* H1 = (bf16*)(F.ws + WS_H1); f32x2_t2* ST = (f32x2_t2*)(F.ws + WS_STATS1); float* AFF = (float*)(F.ws + WS_AFF);
    for (int r = gw; r < M; r += NGW) {
        const GAS f32x4* xr = (const GAS f32x4*)(PRE + (size_t)r * DM) + lane; f32x4 v[4]; float s = 0.f;
#pragma unroll
        for (int j = 0; j < 4; ++j) { v[j] = xr[64 * j]; s += (v[j].x + v[j].y) + (v[j].z + v[j].w); }
        const float mean = wave_sum(s) * (1.f / DM); float s2 = 0.f;
#pragma unroll
        for (int j = 0; j < 4; ++j) { v[j] = v[j] - mean; s2 += (v[j].x * v[j].x + v[j].y * v[j].y) + (v[j].z * v[j].z + v[j].w * v[j].w); }
        const float rstd = 1.f / sqrtf(wave_sum(s2) * (1.f / DM) + LN_EPS);
        if (lane == 0) ST[r] = (f32x2_t2){mean, rstd};
        GAS unsigned long long* o8 = (GAS unsigned long long*)(H1 + (size_t)r * DM) + lane;
#pragma unroll
        for (int j = 0; j < 4; ++j) { const f32x4 gg = ((const GAS f32x4*)F.in[20])[lane + 64 * j], bb = ((const GAS f32x4*)F.in[21])[lane + 64 * j]; v[j] = v[j] * rstd * gg + bb;
            o8[64 * j] = (unsigned long long)pk2(v[j].x, v[j].y) | ((unsigned long long)pk2(v[j].z, v[j].w) << 32); }
        float acc[16];
        asm volatile("" ::: "memory");
#pragma unroll
        for (int e = 0; e < 16; ++e) { float a = 0.f;
#pragma unroll
            for (int j = 0; j < 4; ++j) { const f32x4 w = *(const LAS f32x4*)(WRT + e * 1024 + (lane + 64 * j) * 4); a += (v[j].x * w.x + v[j].y * w.y) + (v[j].z * w.z + v[j].w * w.w); }
            acc[e] = a; }
        const float lg = treduce16(acc, lane);
        float mx = lg;
#pragma unroll
        for (int o = 4; o < 64; o <<= 1) mx = fmaxf(mx, __shfl_xor(mx, o));
        const float ex = expf(lg - mx); float sm = ex;
#pragma unroll
        for (int o = 4; o < 64; o <<= 1) sm += __shfl_xor(sm, o);
        if ((lane & 3) == 0) AFF[((size_t)(r >> 13) * NE + (lane >> 2)) * SEQ + (r & 8191)] = ex / sm;
    }
}

__device__ __forceinline__ void topk_phase(Frame& F) {
    if (blockIdx.x >= BATCH * NE) return;
    const int be = blockIdx.x, b = be >> 4, e = be & 15, t = F.tid, lane = F.lane, w = F.wave;
    LAS int* red = (LAS int*)(F.lds + RING_OFF); LAS int* sc_gt = red + 16; LAS int* sc_eq = sc_gt + 16;
    const float* a = (const float*)(F.ws + WS_AFF) + (size_t)be * SEQ;
    unsigned v[16];
#pragma unroll
    for (int i = 0; i < 16; ++i) v[i] = __float_as_uint(a[t * 16 + i]);
    unsigned thr = 0u;
    for (int bit = 30; bit >= 0; --bit) {
        const unsigned cand = thr | (1u << bit); int c = 0;
#pragma unroll
        for (int i = 0; i < 16; ++i) c += (v[i] >= cand) ? 1 : 0;
#pragma unroll
        for (int o = 32; o > 0; o >>= 1) c += __shfl_xor(c, o);
        __syncthreads();
        if (lane == 0) red[w] = c;
        __syncthreads();
        int total = 0;
#pragma unroll
        for (int k = 0; k < 8; ++k) total += red[k];
        if (total >= CAP) thr = cand;
    }
    int ngt = 0, neq = 0;
#pragma unroll
    for (int i = 0; i < 16; ++i) { ngt += (v[i] > thr) ? 1 : 0; neq += (v[i] == thr) ? 1 : 0; }
    int ig = ngt, ie = neq;
#pragma unroll
    for (int o = 1; o < 64; o <<= 1) { const int pg = __shfl_up(ig, o), pe = __shfl_up(ie, o); if (lane >= o) { ig += pg; ie += pe; } }
    __syncthreads();
    if (lane == 63) { sc_gt[w] = ig; sc_eq[w] = ie; }
    __syncthreads();
    int wg_off = 0, we_off = 0, tot_gt = 0;
#pragma unroll
    for (int k = 0; k < 8; ++k) { const int a = sc_gt[k], c2 = sc_eq[k]; if (k < w) { wg_off += a; we_off += c2; } tot_gt += a; }
    const int quota = CAP - tot_gt; int gpre = wg_off + ig - ngt, epre = we_off + ie - neq;
    int* IDX2 = (int*)(F.ws + WS_IDX2); float* GATE2 = (float*)(F.ws + WS_GATE2); int* SLOTOF = (int*)(F.ws + WS_SLOTOF);
#pragma unroll
    for (int i = 0; i < 16; ++i) {
        const bool gt = v[i] > thr, eq = v[i] == thr, sel = gt || (eq && epre < quota);
        const int tok = t * 16 + i; int so = -1;
        if (sel) { const int slot = gpre + (epre < quota ? epre : quota); so = e * 2048 + b * 1024 + slot; IDX2[so] = b * SEQ + tok; GATE2[so] = __uint_as_float(v[i]); }
        SLOTOF[((size_t)b * SEQ + tok) * NE + e] = so;
        gpre += gt ? 1 : 0; epre += eq ? 1 : 0;
    }
    __syncthreads();
}

__device__ __forceinline__ void gather_phase(Frame& F) {
    const int gw = F.vcu * NWAVES + F.wave, NGW = F.G * NWAVES, lane = F.lane;
    const int* IDX2 = (const int*)(F.ws + WS_IDX2); const bf16* H1 = (const bf16*)(F.ws + WS_H1); bf16* XE = (bf16*)(F.ws + WS_XE);
    for (int r = gw; r < NE * 2048; r += NGW) { const int src = IDX2[r];
        const GAS v4u* s = (const GAS v4u*)(H1 + (size_t)src * DM) + lane; GAS v4u* d = (GAS v4u*)(XE + (size_t)r * DM) + lane;
        const v4u a = s[0], c = s[64]; d[0] = a; d[64] = c; }
}

__device__ __forceinline__ void final_phase(Frame& F) {
    const int gw = F.vcu * NWAVES + F.wave, NGW = F.G * NWAVES, lane = F.lane;
    float* OUT = F.out; const f32x2_t2* ST = (const f32x2_t2*)(F.ws + WS_STATS1); const int* SLOTOF = (const int*)(F.ws + WS_SLOTOF); const bf16* YE = (const bf16*)(F.ws + WS_XE);
    for (int r = gw; r < M; r += NGW) {
        GAS f32x4* xr = (GAS f32x4*)(OUT + (size_t)r * DM) + lane; f32x4 v[4]; const f32x2_t2 st = ST[r];
        const int myslot = SLOTOF[(size_t)r * NE + (lane & 15)];
#pragma unroll
        for (int j = 0; j < 4; ++j) { const f32x4 gg = ((const GAS f32x4*)F.in[20])[lane + 64 * j], bb = ((const GAS f32x4*)F.in[21])[lane + 64 * j]; v[j] = ((xr[64 * j] - st.x) * st.y * gg + bb) * ALPHA; }
        for (int e = 0; e < NE; ++e) { const int sl = __shfl(myslot, e);
            if (sl >= 0) { const GAS u32x2_t* yr = (const GAS u32x2_t*)(YE + (size_t)sl * DM) + lane;
#pragma unroll
                for (int j = 0; j < 4; ++j) { const u32x2_t y = yr[64 * j]; v[j].x += bflo(y.x); v[j].y += bfhi(y.x); v[j].z += bflo(y.y); v[j].w += bfhi(y.y); } } }
        float s = 0.f;
#pragma unroll
        for (int j = 0; j < 4; ++j) s += (v[j].x + v[j].y) + (v[j].z + v[j].w);
        const float mean = wave_sum(s) * (1.f / DM); float s2 = 0.f;
#pragma unroll
        for (int j = 0; j < 4; ++j) { v[j] = v[j] - mean; s2 += (v[j].x * v[j].x + v[j].y * v[j].y) + (v[j].z * v[j].z + v[j].w * v[j].w); }
        const float rstd = 1.f / sqrtf(wave_sum(s2) * (1.f / DM) + LN_EPS);
#pragma unroll
        for (int j = 0; j < 4; ++j) { const f32x4 gg = ((const GAS f32x4*)F.in[26])[lane + 64 * j], bb = ((const GAS f32x4*)F.in[27])[lane + 64 * j]; xr[64 * j] = v[j] * rstd * gg + bb; }
    }
}

#ifndef MK_PER_PHASE
#define MK_PER_PHASE 0
#endif
constexpr int N_PHASES = 16;
struct Args { const float* in[28]; float* out; unsigned char* ws; int ph_lo, ph_hi; };
__global__ void __launch_bounds__(NWAVES * 64, 2) mk_fwd(Args args) {
    extern __shared__ __attribute__((aligned(16))) unsigned char lds[];
    Frame F;
    F.lds = (LAS unsigned char*)lds; F.MISC = (volatile LAS unsigned*)(F.lds + MISC_OFF);
    F.tid = threadIdx.x; F.lane = F.tid & 63; F.wave = __builtin_amdgcn_readfirstlane(F.tid >> 6);
    F.G = gridDim.x; { const int bx = blockIdx.x; F.vcu = (F.G % 8 == 0) ? (bx % 8) * (F.G / 8) + bx / 8 : bx; }
    F.ws = args.ws; F.ctl = (gu32*)(args.ws + WS_CTL); F.out = args.out;
#pragma unroll
    for (int i = 0; i < 28; ++i) F.in[i] = args.in[i];
    for (int u = F.tid; u < (LDS_BYTES - LDSCTL_OFF) / 4; u += NWAVES * 64) ((LAS unsigned*)(F.lds + LDSCTL_OFF))[u] = 0u;
    __syncthreads();
    XcdBarrier bar; bar.bar = (unsigned*)(F.ctl + CW_BAR); bar.x = 0; bar.st = nullptr;
    if (!MK_PER_PHASE) bar = xcd_barrier_post((unsigned*)(F.ctl + CW_BAR), F.MISC + 8);
    const int lo = args.ph_lo, hi = args.ph_hi;
    unsigned char* ws = args.ws;
#ifndef PROBE_LO
#define PROBE_LO -1
#define PROBE_HI -1
#endif
    unsigned long long pr_t0 = 0ull, pr_t1 = 0ull;
#define IN(k) (lo <= (k) && (k) < hi)
#define SEAM(k) do { if (IN(k) && IN((k) + 1)) xcd_barrier(bar); if (PROBE_LO >= 0 && (k) + 1 == PROBE_LO) pr_t0 = rt(); if (PROBE_LO >= 0 && (k) + 1 == PROBE_HI) pr_t1 = rt(); } while (0)
    if (PROBE_LO == 0) pr_t0 = rt();
    using pg8::Gemm; using pg8::gemm_phase;
    if (IN(0)) { p0_prologue(F); } SEAM(0);
    if (IN(1)) { Gemm g{(const bf16*)(ws + WS_XN), (const bf16*)(ws + WS_WIN), 1024, 1024, 1024}; InProjOrder S; S.so.init(M, INW, F.G, (int)blockIdx.x);
        EpiInProj E{(bf16*)(ws + WS_Q), (bf16*)(ws + WS_K), (bf16*)(ws + WS_V), (bf16*)(ws + WS_UG2), (bf16*)args.out, (bf16*)(ws + WS_UMETA), (LAS float*)(F.lds + XCH_OFF), (const float*)(ws + WS_ROPE) + 6144, (const float*)(ws + WS_ROPE)};
        gemm_phase<EpiInProj, InProjOrder, true, true>(F.lds + RING_OFF, g, S, E); } SEAM(1);
    if (IN(2)) {
        Gemm g{(const bf16*)(ws + WS_UG2), (const bf16*)(ws + WS_WST), UGP, 512, 512}; SsmStateOrder S{F.G, (int)blockIdx.x}; EpiSsmState E{(float*)(ws + WS_S)};
        gemm_phase<EpiSsmState, SsmStateOrder, true, true>(F.lds + RING_OFF, g, S, E); } SEAM(2);
    if (IN(3)) { ssm_scan(F); __syncthreads();
        const attn_body::AttnTensors AT{(const attn_body::bf16*)(ws + WS_Q), (const attn_body::bf16*)(ws + WS_K), (const attn_body::bf16*)(ws + WS_V), (attn_body::bf16*)(ws + WS_Q)};
        const attn_body::StaticOrder S((int)F.G, (int)blockIdx.x);
        attn_body::attn_phase<attn_body::StaticOrder>((char*)lds + RING_OFF, AT, S); } SEAM(3);
    if (IN(4)) { Gemm g{(const bf16*)(ws + WS_UG2), (const bf16*)(ws + WS_MEXT), UGP, UGP, UGP}; SsmYOrder S{F.G, (int)blockIdx.x}; EpiSsmY E{(bf16*)(ws + WS_YG)};
        gemm_phase<EpiSsmY, SsmYOrder, true, true>(F.lds + RING_OFF, g, S, E); } SEAM(4);
    if (IN(5)) { Gemm g{(const bf16*)(ws + WS_YG), (const bf16*)(ws + WS_WGLU), 512, 512, 512}; pg8::StaticOrder S; S.init(M, 512, F.G, (int)blockIdx.x); EpiGlu E{(const bf16*)(ws + WS_YG), F.in[16], (bf16*)(ws + WS_Z)};
        gemm_phase<EpiGlu, pg8::StaticOrder, true, true>(F.lds + RING_OFF, g, S, E); } SEAM(5);
    if (IN(6)) { Gemm g{(const bf16*)(ws + WS_Q), (const bf16*)(ws + WS_WAB), 512, 512, 512}; pg8::StaticOrder S; S.init(M, 1024, F.G, (int)blockIdx.x); EpiBranch<0> E{(const bf16*)args.out, nullptr, (bf16*)(ws + WS_T1)};
        gemm_phase<EpiBranch<0>, pg8::StaticOrder, true, true>(F.lds + RING_OFF, g, S, E); } SEAM(6);
    if (IN(7)) { Gemm g{(const bf16*)(ws + WS_Z), (const bf16*)(ws + WS_WSB), 512, 512, 512}; pg8::StaticOrder S; S.init(M, 1024, F.G, (int)blockIdx.x); EpiBranch<1> E{(const bf16*)args.out, (const bf16*)(ws + WS_T1), (bf16*)(ws + WS_MERGED)};
        gemm_phase<EpiBranch<1>, pg8::StaticOrder, true, true>(F.lds + RING_OFF, g, S, E); } SEAM(7);
    if (IN(8)) { Gemm g{(const bf16*)(ws + WS_MERGED), (const bf16*)(ws + WS_WO), 1024, 1024, 1024}; pg8::StaticOrder S; S.init(M, 1024, F.G, (int)blockIdx.x);
        EpiPre1 E{F.in[0], F.in[2], F.in[3], (const f32x2_t2*)(ws + WS_STATS0), args.out};
        gemm_phase<EpiPre1, pg8::StaticOrder, true, true>(F.lds + RING_OFF, g, S, E); } SEAM(8);
    if (IN(9)) { ln1_router(F); } SEAM(9);
    if (IN(10)) { topk_phase(F); } SEAM(10);
    if (IN(11)) { gather_phase(F); } SEAM(11);
    if (IN(12)) { Gemm g{(const bf16*)(ws + WS_XE), (const bf16*)(ws + WS_WGU), 1024, 1024, 1024}; MoeOrder S{F.G, (int)blockIdx.x, 8, 8}; EpiMoe1 E{(bf16*)(ws + WS_HB)};
        gemm_phase<EpiMoe1, MoeOrder, true, true>(F.lds + RING_OFF, g, S, E); } SEAM(12);
    if (IN(13)) { Gemm g{(const bf16*)(ws + WS_HB), (const bf16*)(ws + WS_WD), 1024, 1024, 1024}; MoeOrder S{F.G, (int)blockIdx.x, 8, 4}; EpiMoe2 E{(const float*)(ws + WS_GATE2), (bf16*)(ws + WS_XE)};
        gemm_phase<EpiMoe2, MoeOrder, true, true>(F.lds + RING_OFF, g, S, E); } SEAM(13);
    if (IN(14)) { final_phase(F); }
    if (PROBE_LO >= 0) { if (PROBE_HI == 15) pr_t1 = rt(); if (blockIdx.x == 0) { const unsigned long long span = (pr_t1 - pr_t0) * 8ull, ts = rt(); while (rt() - ts < span) __builtin_amdgcn_s_sleep(8); } }
#undef IN
#undef SEAM
}

extern "C" void kernel_launch(void* const* d_in, const int* in_sizes, int n_in, void* d_out, int out_size, void* d_ws, size_t ws_size, hipStream_t stream) {
    static int grid = 0;
    if (grid == 0) {
        int dev = 0, cus = 0;
        if (hipGetDevice(&dev) != hipSuccess || hipDeviceGetAttribute(&cus, hipDeviceAttributeMultiprocessorCount, dev) != hipSuccess) { fprintf(stderr, "kernel_launch: device query failed\n"); grid = -1; return; }
        if (hipFuncSetAttribute((const void*)mk_fwd, hipFuncAttributeMaxDynamicSharedMemorySize, LDS_BYTES) != hipSuccess) { fprintf(stderr, "kernel_launch: hipFuncSetAttribute failed\n"); grid = -1; return; }
        (void)hipGetLastError();
        grid = cus;
        if (grid != 256 || n_in != 28 || ws_size < WS_END) fprintf(stderr, "kernel_launch: unexpected geometry: %d CUs, %d inputs, %zu bytes of workspace\n", cus, n_in, ws_size);
    }
    if (grid < 0) return;
    (void)hipMemsetAsync((char*)d_ws + WS_CTL, 0, CTL_ZERO_BYTES, stream);
    Args a; memset(&a, 0, sizeof(a));
    for (int i = 0; i < 28; ++i) a.in[i] = (const float*)d_in[i];
    a.out = (float*)d_out; a.ws = (unsigned char*)d_ws;
#if MK_PER_PHASE
    for (int p = 0; p < N_PHASES - 1; ++p) { a.ph_lo = p; a.ph_hi = p + 1; hipLaunchKernelGGL(mk_fwd, dim3(grid), dim3(NWAVES * 64), LDS_BYTES, stream, a); }
#else
    a.ph_lo = 0; a.ph_hi = N_PHASES; hipLaunchKernelGGL(mk_fwd, dim3(grid), dim3(NWAVES * 64), LDS_BYTES, stream, a);
#endif
}
```

```cpp
#include <hip/hip_runtime.h>
#include <cstdio>
#include <cstdint>
#include <cstring>
namespace pg8 {
#define PG8_LAS __attribute__((address_space(3)))
typedef unsigned short bf16_t;
typedef short bf16x8 __attribute__((ext_vector_type(8)));
typedef float f32x4 __attribute__((ext_vector_type(4)));
typedef unsigned u32x4 __attribute__((ext_vector_type(4)));
constexpr int BM = 256, BK = 64, HALF = 128, HTB = HALF * BK * 2  , STAGE_BYTES = 8 * HTB, NXCD = 8, WGM = 8;

__host__ __device__ __forceinline__ int lds_byte(int r, int c) { const int st = (r >> 4) * 2 + (c >> 5), rr = r & 15, cc = c & 31, ob = rr * 64 + cc * 2; return st * 1024 + (ob ^ (((ob >> 9) & 1) << 5)); }
__host__ __device__ __forceinline__ void stage_rc(int b, int& R, int& C) { const int st = b / 1024, sb = b % 1024, swz = sb ^ (((sb >> 9) & 1) << 5); R = (st >> 1) * 16 + swz / 64; C = (st & 1) * 32 + (swz % 64) / 2; }
__host__ __device__ __forceinline__ int perm32(int rho) { const int n = rho >> 4, i = rho & 15; return 8 * (i >> 2) + 4 * n + (i & 3); }

struct Unit { int pm, pn; };
struct Gemm { const bf16_t* A; const bf16_t* Bt; int lda, ldb, K; };

struct StaticOrder {
    int nM, nN, nwg, G, c;
    __host__ __device__ void init(int M, int N, int G_, int c_) { nM = M / BM; nN = N / BM; nwg = nM * nN; G = G_; c = c_; }
    __host__ __device__ bool next(int i, Unit& u) const {
        const long L = (long)i * G + c; if (L >= nwg) return false;
        int wgid = (int)L; { const int q = nwg / NXCD, r = nwg % NXCD, xcd = wgid % NXCD, off = wgid / NXCD; wgid = (xcd < r ? xcd * (q + 1) : r * (q + 1) + (xcd - r) * q) + off; }
        const int nig = WGM * nN, gid = wgid / nig, fm = gid * WGM, gsz = (nM - fm) < WGM ? (nM - fm) : WGM;
        u.pm = fm + ((wgid % nig) % gsz); u.pn = (wgid % nig) / gsz; return true;
    }
    __device__ __forceinline__ void a_ready(const Unit&) const {}
    __device__ __forceinline__ void done(const Unit&) const {}
};

__device__ __forceinline__ unsigned cvt_pk_bf16(float lo, float hi) { unsigned r; asm volatile("v_cvt_pk_bf16_f32 %0, %1, %2" : "=v"(r) : "v"(lo), "v"(hi)); return r; }
typedef float f32x2 __attribute__((ext_vector_type(2)));
template <class Epi, class Sched, bool ALIGN_EPI = false, bool SP2 = false>
__device__ __forceinline__ void gemm_phase(PG8_LAS unsigned char* lds, const Gemm g, const Sched& S, const Epi& E) {
    const int tid = threadIdx.x, wid = __builtin_amdgcn_readfirstlane(tid >> 6), lane = tid & 63, wr = wid >> 2, wc = wid & 3, fr = lane & 15, fq = lane >> 4;
    const int K = g.K, nt = K / BK;
    unsigned voffA[2], voffB[2];
#pragma unroll
    for (int i = 0; i < 2; ++i) { int R, C; stage_rc(tid * 16 + i * 8192, R, C); const int Rb = Epi::PERM ? ((R & ~31) + perm32(R & 31)) : R;
        voffA[i] = (unsigned)(R * g.lda + C) * 2u; voffB[i] = (unsigned)(Rb * g.ldb + C) * 2u; }
    const size_t kstep = (size_t)(BK * 2);
    const size_t hstepA = (size_t)HALF * g.lda * 2, hstepB = (size_t)HALF * g.ldb * 2;
    const size_t tstepA = 2 * hstepA, tstepB = 2 * hstepB;
    const unsigned ldsw = (unsigned)wid * 1024u;
    const int aoff = lds_byte(wr * 64 + fr, fq * 8), boff = lds_byte(wc * 32 + fr, fq * 8);
#define PG8_SA(b, h) (((b) * 2 + (h)) * HTB)
#define PG8_SB(b, h) ((4 + (b) * 2 + (h)) * HTB)
#define PG8_STAGE(bufoff, gbase, voff) do { _Pragma("unroll") for (int _i = 0; _i < 2; ++_i) \
        __builtin_amdgcn_global_load_lds((const unsigned*)((const char*)(gbase) + (voff)[_i]), (PG8_LAS unsigned*)(lds + (bufoff) + ldsw + _i * 8192), 16, 0, 0); } while (0)
#define PG8_LDA(dst, b, h) do { _Pragma("unroll") for (int m = 0; m < 4; ++m) _Pragma("unroll") for (int k = 0; k < 2; ++k) dst[m][k] = *(const PG8_LAS bf16x8*)(lds + PG8_SA(b, h) + aoff + m * 2048 + k * 1024); } while (0)
#define PG8_LDB(dst, b, h) do { _Pragma("unroll") for (int n = 0; n < 2; ++n) _Pragma("unroll") for (int k = 0; k < 2; ++k) dst[n][k] = *(const PG8_LAS bf16x8*)(lds + PG8_SB(b, h) + boff + n * 2048 + k * 1024); } while (0)
#define PG8_MMA(ai, bj, At, Bt) do { __builtin_amdgcn_s_setprio(1); _Pragma("unroll") for (int m = 0; m < 4; ++m) _Pragma("unroll") for (int n = 0; n < 2; ++n) _Pragma("unroll") for (int k = 0; k < 2; ++k) \
        acc[ai][bj][m][n] = __builtin_amdgcn_mfma_f32_16x16x32_bf16(Bt[n][k], At[m][k], acc[ai][bj][m][n], 0, 0, 0); __builtin_amdgcn_s_setprio(0); } while (0)
#define PG8_WAIT_V(n) asm volatile("s_waitcnt vmcnt(" #n ")" ::: "memory")
#define PG8_WAIT_L(n) asm volatile("s_waitcnt lgkmcnt(" #n ")" ::: "memory")
#define PG8_BAR __builtin_amdgcn_s_barrier()
#define PG8_SCHED __builtin_amdgcn_sched_barrier(0)
    Unit cur, nxt; int ui = 0;
    if (!S.next(0, cur)) return;
    f32x4 acc[2][2][4][2];
#pragma unroll
    for (int a = 0; a < 2; ++a)
#pragma unroll
        for (int b = 0; b < 2; ++b)
#pragma unroll
            for (int m = 0; m < 4; ++m)
#pragma unroll
                for (int n = 0; n < 2; ++n) acc[a][b][m][n] = (f32x4){0.f, 0.f, 0.f, 0.f};
    bf16x8 At[4][2], B0[2][2], B1[2][2];
    const char* cA = (const char*)g.A + (size_t)cur.pm * tstepA; const char* cB = (const char*)g.Bt + (size_t)cur.pn * tstepB;
    S.a_ready(cur);
    if constexpr (SP2) {
        PG8_STAGE(PG8_SB(0, 0), cB, voffB); PG8_STAGE(PG8_SB(0, 1), cB + hstepB, voffB); PG8_STAGE(PG8_SA(0, 0), cA, voffA); PG8_STAGE(PG8_SA(0, 1), cA + hstepA, voffA);
        if (wr == 1) PG8_BAR;
        PG8_WAIT_V(2); PG8_BAR;
        PG8_STAGE(PG8_SB(1, 0), cB + kstep, voffB); PG8_STAGE(PG8_SA(1, 0), cA + kstep, voffA); PG8_STAGE(PG8_SB(1, 1), cB + hstepB + kstep, voffB);
        PG8_WAIT_V(6); PG8_BAR;
    } else {
        PG8_STAGE(PG8_SB(0, 0), cB, voffB); PG8_STAGE(PG8_SA(0, 0), cA, voffA); PG8_STAGE(PG8_SB(0, 1), cB + hstepB, voffB); PG8_STAGE(PG8_SA(0, 1), cA + hstepA, voffA);
        if (wr == 1) PG8_BAR;
        PG8_WAIT_V(4); PG8_BAR;
        PG8_STAGE(PG8_SB(1, 0), cB + kstep, voffB); PG8_STAGE(PG8_SA(1, 0), cA + kstep, voffA); PG8_STAGE(PG8_SB(1, 1), cB + hstepB + kstep, voffB);
        PG8_WAIT_V(6); PG8_BAR;
    }
    for (;;) {
        const bool has_next = S.next(ui + 1, nxt);
        const char* nA = has_next ? (const char*)g.A + (size_t)nxt.pm * tstepA : cA; const char* nB = has_next ? (const char*)g.Bt + (size_t)nxt.pn * tstepB : cB;
        for (int t = 0; t < nt; t += 2) {
            const bool last = (t == nt - 2);
            const char* a1 = cA + (size_t)(t + 1) * kstep;
            const char* a2 = last ? nA : cA + (size_t)(t + 2) * kstep; const char* b2 = last ? nB : cB + (size_t)(t + 2) * kstep;
            const char* a3 = a2 + kstep; const char* b3 = b2 + kstep;
            if (last && has_next) S.a_ready(nxt);
            if constexpr (SP2) {
            PG8_LDB(B0, 0, 0); PG8_LDB(B1, 0, 1); PG8_SCHED; PG8_LDA(At, 0, 0); PG8_STAGE(PG8_SA(1, 1), a1 + hstepA, voffA);
            PG8_WAIT_V(8); PG8_WAIT_L(0); PG8_BAR; PG8_MMA(0, 0, At, B0); PG8_MMA(0, 1, At, B1); PG8_BAR; PG8_SCHED;
            PG8_LDA(At, 0, 1); PG8_STAGE(PG8_SB(0, 0), b2, voffB); PG8_STAGE(PG8_SB(0, 1), b2 + hstepB, voffB); PG8_STAGE(PG8_SA(0, 0), a2, voffA);
            PG8_WAIT_V(8); PG8_WAIT_L(0); PG8_BAR; PG8_MMA(1, 0, At, B0); PG8_MMA(1, 1, At, B1); PG8_BAR; PG8_SCHED;
            PG8_LDB(B0, 1, 0); PG8_LDB(B1, 1, 1); PG8_SCHED; PG8_LDA(At, 1, 0); PG8_STAGE(PG8_SA(0, 1), a2 + hstepA, voffA);
            PG8_WAIT_V(8); PG8_WAIT_L(0); PG8_BAR; PG8_MMA(0, 0, At, B0); PG8_MMA(0, 1, At, B1); PG8_BAR; PG8_SCHED;
            PG8_LDA(At, 1, 1); PG8_STAGE(PG8_SB(1, 0), b3, voffB); PG8_STAGE(PG8_SB(1, 1), b3 + hstepB, voffB); PG8_STAGE(PG8_SA(1, 0), a3, voffA);
            PG8_WAIT_V(8); PG8_WAIT_L(0); PG8_BAR; PG8_MMA(1, 0, At, B0); PG8_MMA(1, 1, At, B1); PG8_BAR; PG8_SCHED;
            } else {
            PG8_LDB(B0, 0, 0); PG8_SCHED; PG8_LDA(At, 0, 0); PG8_STAGE(PG8_SA(1, 1), a1 + hstepA, voffA);
            PG8_WAIT_L(8); PG8_BAR; PG8_WAIT_L(0); PG8_MMA(0, 0, At, B0); PG8_BAR; PG8_SCHED;
            PG8_LDB(B1, 0, 1); PG8_STAGE(PG8_SB(0, 0), b2, voffB);
            PG8_BAR; PG8_WAIT_L(0); PG8_MMA(0, 1, At, B1); PG8_BAR;
            PG8_LDA(At, 0, 1); PG8_STAGE(PG8_SA(0, 0), a2, voffA);
            PG8_BAR; PG8_WAIT_L(0); PG8_MMA(1, 0, At, B0); PG8_BAR; PG8_SCHED;
            PG8_STAGE(PG8_SB(0, 1), b2 + hstepB, voffB);
            PG8_WAIT_V(6); PG8_BAR; PG8_MMA(1, 1, At, B1); PG8_BAR;
            PG8_LDB(B0, 1, 0); PG8_SCHED; PG8_LDA(At, 1, 0); PG8_STAGE(PG8_SA(0, 1), a2 + hstepA, voffA);
            PG8_WAIT_L(8); PG8_BAR; PG8_WAIT_L(0); PG8_MMA(0, 0, At, B0); PG8_BAR; PG8_SCHED;
            PG8_LDB(B1, 1, 1); PG8_STAGE(PG8_SB(1, 0), b3, voffB);
            PG8_BAR; PG8_WAIT_L(0); PG8_MMA(0, 1, At, B1); PG8_BAR;
            PG8_LDA(At, 1, 1); PG8_STAGE(PG8_SA(1, 0), a3, voffA);
            PG8_BAR; PG8_WAIT_L(0); PG8_MMA(1, 0, At, B0); PG8_BAR; PG8_SCHED;
            PG8_STAGE(PG8_SB(1, 1), b3 + hstepB, voffB);
            PG8_WAIT_V(6); PG8_BAR; PG8_MMA(1, 1, At, B1); PG8_BAR;
            }
        }
        if constexpr (ALIGN_EPI) { if (wr == 0) PG8_BAR; }
        if constexpr (!Epi::AFTER_DRAIN) { E(acc, cur, wr, wc, fr, fq); S.done(cur); }
        if (!has_next) break;
#pragma unroll
        for (int a = 0; a < 2; ++a)
#pragma unroll
            for (int b = 0; b < 2; ++b)
#pragma unroll
                for (int m = 0; m < 4; ++m)
#pragma unroll
                    for (int n = 0; n < 2; ++n) acc[a][b][m][n] = (f32x4){0.f, 0.f, 0.f, 0.f};
        cur = nxt; cA = nA; cB = nB; ++ui;
        if constexpr (ALIGN_EPI) { if (wr == 1) PG8_BAR; }
    }
    PG8_WAIT_V(0);
    if constexpr (!ALIGN_EPI) { if (wr == 0) PG8_BAR; }
    PG8_BAR;
    if constexpr (Epi::AFTER_DRAIN) { E.fused(acc, cur, wr, wc, fr, fq, lds, wid, lane); S.done(cur); }
#undef PG8_SA
#undef PG8_SB
#undef PG8_STAGE
#undef PG8_LDA
#undef PG8_LDB
#undef PG8_MMA
#undef PG8_WAIT_V
#undef PG8_WAIT_L
#undef PG8_BAR
#undef PG8_SCHED
}
}
#define PG8_SP2 true
#define PG8_ALIGN true
#include <hip/hip_bf16.h>
#include <cmath>
namespace attn_body {
using bf16=__hip_bfloat16;
using bf16x8=__attribute__((ext_vector_type(8)))short;
using s16x4=__attribute__((ext_vector_type(4)))short;
using f32x16=__attribute__((ext_vector_type(16)))float;
using u32x4=__attribute__((ext_vector_type(4)))unsigned;
constexpr int BATCH=2,NHEAD=8,SEQ=8192,D=64,DMQ=NHEAD*D,DMK=128,KVROWS=8320,KVALID=8208;
constexpr int NW=8,QBLK=32,QB=QBLK*NW,KVBLK=64,NQB=SEQ/QB;
constexpr int ATTN_PITCH=DMQ, ATTN_UNIT_ROWS=QB;
__device__ __forceinline__ int crow(int r,int hi){return (r&3)+8*(r>>2)+4*hi;}
#define SBAR() __builtin_amdgcn_sched_barrier(0)
__device__ __forceinline__ void cmask(f32x16&p0,f32x16&p1,int t,int hi){
  const float NEG=-INFINITY; int kb=64*t+4*hi;
  #pragma unroll
  for(int r=0;r<16;++r){int kv=kb+(r&3)+8*(r>>2); if(kv>=KVALID)p0[r]=NEG; if(kv+32>=KVALID)p1[r]=NEG;}
}

constexpr int NSLOT=3, SLOTB=8192;
constexpr int LDS_K=0, LDS_V=NSLOT*SLOTB, LDS_WS=2*NSLOT*SLOTB, LDS_OST=LDS_WS+NW*64*4, LDS_BYTES=LDS_OST+NW*4096;
constexpr float C2=0.125f*1.4426950408889634f;
__device__ __forceinline__ void glds16(const void*gsrc,unsigned lds_dst){unsigned keep;
  asm volatile("s_mov_b32 %0, m0\n\ts_mov_b32 m0, %2\n\ts_nop 0\n\tglobal_load_lds_dwordx4 %1, off\n\ts_mov_b32 m0, %0":"=&s"(keep):"v"(gsrc),"s"(lds_dst):"memory");}
__device__ __forceinline__ float max3f(float a,float b,float c){float r;asm("v_max3_f32 %0, %1, %2, %3":"=v"(r):"v"(a),"v"(b),"v"(c));return r;}
__device__ __forceinline__ float max2f(float a,float b){float r;asm("v_max_f32_e32 %0, %1, %2":"=v"(r):"v"(a),"v"(b));return r;}
__device__ __forceinline__ float fadd_s(float a,float b){float r;asm("v_add_f32_e32 %0, %1, %2":"=v"(r):"v"(a),"v"(b));return r;}
__device__ __forceinline__ float fsub_s(float a,float b){float r;asm("v_sub_f32_e32 %0, %1, %2":"=v"(r):"v"(a),"v"(b));return r;}
typedef float f32x2_t __attribute__((ext_vector_type(2))); typedef __bf16 bf16x2_t __attribute__((ext_vector_type(2)));
__device__ __forceinline__ unsigned cvtpk_s(float lo,float hi){f32x2_t v={lo,hi};bf16x2_t b=__builtin_convertvector(v,bf16x2_t);return __builtin_bit_cast(unsigned,b);}
#define WAIT_BAR(N) asm volatile("s_waitcnt vmcnt(" #N ") lgkmcnt(0)\n\ts_barrier":::"memory")

__device__ __forceinline__ void qkt(f32x16&p0,f32x16&p1,const char*Kslot,const bf16x8*qr,const f32x16&negm,int r32,int hi){
  const char*kb=Kslot+hi*1024+r32*16;
  #pragma unroll
  for(int d0=0;d0<4;++d0){
    const bf16x8 b0=*reinterpret_cast<const bf16x8*>(kb+d0*2048);
    const bf16x8 b1=*reinterpret_cast<const bf16x8*>(kb+d0*2048+512);
    if(d0==0){p0=__builtin_amdgcn_mfma_f32_32x32x16_bf16(b0,qr[0],negm,0,0,0);p1=__builtin_amdgcn_mfma_f32_32x32x16_bf16(b1,qr[0],negm,0,0,0);}
    else{p0=__builtin_amdgcn_mfma_f32_32x32x16_bf16(b0,qr[d0],p0,0,0,0);p1=__builtin_amdgcn_mfma_f32_32x32x16_bf16(b1,qr[d0],p1,0,0,0);}}
}
typedef __attribute__((address_space(3))) const char* lds_cptr;
typedef short v4i16_t __attribute__((ext_vector_type(4)));
__device__ __forceinline__ void kload8(bf16x8*kf,lds_cptr kp){
  kf[0]=*(const __attribute__((address_space(3))) bf16x8*)(kp);      kf[1]=*(const __attribute__((address_space(3))) bf16x8*)(kp+512);
  kf[2]=*(const __attribute__((address_space(3))) bf16x8*)(kp+2048); kf[3]=*(const __attribute__((address_space(3))) bf16x8*)(kp+2560);
  kf[4]=*(const __attribute__((address_space(3))) bf16x8*)(kp+4096); kf[5]=*(const __attribute__((address_space(3))) bf16x8*)(kp+4608);
  kf[6]=*(const __attribute__((address_space(3))) bf16x8*)(kp+6144); kf[7]=*(const __attribute__((address_space(3))) bf16x8*)(kp+6656);
}
__device__ __forceinline__ void kload2(bf16x8*kf,lds_cptr kp,int j){ kf[2*j]=*(const __attribute__((address_space(3))) bf16x8*)(kp+j*2048); kf[2*j+1]=*(const __attribute__((address_space(3))) bf16x8*)(kp+j*2048+512); }
__device__ __forceinline__ s16x4 vtr(lds_cptr p){ return __builtin_bit_cast(s16x4,__builtin_amdgcn_ds_read_tr16_b64_v4i16((__attribute__((address_space(3))) v4i16_t*)p)); }
__device__ __forceinline__ float rowmax(const f32x16&p0,const f32x16&p1){
  float a=max3f(p0[0],p0[1],p1[0]),b=max3f(p0[2],p0[3],p1[1]);a=max3f(a,p1[2],p1[3]);
  #pragma unroll
  for(int r=4;r<16;r+=4){a=max3f(a,p0[r],p0[r+1]);b=max3f(b,p0[r+2],p0[r+3]);a=max3f(a,p1[r],p1[r+1]);b=max3f(b,p1[r+2],p1[r+3]);}
  const float m=max2f(a,b);
  auto rr=__builtin_amdgcn_permlane32_swap(__float_as_uint(m),__float_as_uint(m),false,false);
  return max2f(__uint_as_float(rr[0]),__uint_as_float(rr[1]));
}
__device__ __forceinline__ void pv(f32x16*o,int vb,bf16x8 pa0,bf16x8 pa1,bf16x8 pa2,bf16x8 pa3){
  #pragma unroll
  for(int d0=0;d0<2;++d0){s16x4 lo[4],hi[4];
    #pragma unroll
    for(int ks=0;ks<4;++ks){
      asm volatile("ds_read_b64_tr_b16 %0,%1 offset:%c2":"=&v"(lo[ks]):"v"(vb),"i"(d0*4096+ks*1024):"memory");
      asm volatile("ds_read_b64_tr_b16 %0,%1 offset:%c2":"=&v"(hi[ks]):"v"(vb),"i"(d0*4096+ks*1024+512):"memory");}
    asm volatile("s_waitcnt lgkmcnt(0)":::"memory");SBAR();
    #define PK(k) (bf16x8){lo[k][0],lo[k][1],lo[k][2],lo[k][3],hi[k][0],hi[k][1],hi[k][2],hi[k][3]}
    o[d0]=__builtin_amdgcn_mfma_f32_32x32x16_bf16(pa0,PK(0),o[d0],0,0,0);
    o[d0]=__builtin_amdgcn_mfma_f32_32x32x16_bf16(pa1,PK(1),o[d0],0,0,0);
    o[d0]=__builtin_amdgcn_mfma_f32_32x32x16_bf16(pa2,PK(2),o[d0],0,0,0);
    o[d0]=__builtin_amdgcn_mfma_f32_32x32x16_bf16(pa3,PK(3),o[d0],0,0,0);
    #undef PK
  }
}

#ifndef ATTN_STORE16
#define ATTN_STORE16(p,v) (*(u32x4*)(p)=(v))
#endif
template<int THRL> __device__ __forceinline__ void attn_unit(int b,int h,int qb,const bf16*Q,const bf16*__restrict__ K,const bf16*__restrict__ V,bf16*O,char*shm){
  const int tid=threadIdx.x,lane=tid&63,r32=lane&31,hi=lane>>5; const int wid=__builtin_amdgcn_readfirstlane(tid>>6);
  const long rowbase=(long)b*SEQ, kvbase=(long)b*KVROWS; const int q0=qb*QB;
  const bf16*Qw=Q+(rowbase+q0+wid*QBLK)*DMQ+h*D;
  const bf16*Kh=K+kvbase*DMK+(h>>2)*D,*Vh=V+kvbase*DMK+(h>>2)*D;
  const unsigned lds0=(unsigned)(uintptr_t)shm;
  float*wsf=(float*)(shm+LDS_WS)+wid*64;
  const bf16*ksrc=Kh+(long)lane*DMK+wid*8;
  const bf16*vsrc=Vh+(long)(16*(wid&3)+(lane>>2))*DMK+(wid>>2)*32+(lane&3)*8;
  const unsigned kdst=lds0+LDS_K+wid*1024, vdst=lds0+LDS_V+wid*1024;
  #define DMA_K(t,slot) glds16(ksrc+(long)(t)*KVBLK*DMK,(unsigned)__builtin_amdgcn_readfirstlane(kdst+(slot)))
  #define DMA_V(t,slot) glds16(vsrc+(long)(t)*KVBLK*DMK,(unsigned)__builtin_amdgcn_readfirstlane(vdst+(slot)))
  const int vb0=(int)(lds0+LDS_V)+((lane>>4)&1)*32+(lane&3)*8+(4*hi+((lane&15)>>2))*64;
  const char*Kbase=shm+LDS_K; bf16x8 kf[8];
  const lds_cptr shm3=(lds_cptr)shm; const lds_cptr kp0=shm3+LDS_K+hi*1024+r32*16; const lds_cptr vp0=shm3+LDS_V+((lane>>4)&1)*32+(lane&3)*8+(4*hi+((lane&15)>>2))*64;
  constexpr int NT=KVROWS/KVBLK;
  DMA_K(0,0);DMA_V(0,0);DMA_K(1,SLOTB);
  bf16x8 qr[4];
  #pragma unroll
  for(int d0=0;d0<4;++d0)qr[d0]=*reinterpret_cast<const bf16x8*>(&Qw[(long)r32*DMQ+d0*16+hi*8]);
  float mhat=0.f,l_reg=0.f;f32x16 o[2];o[0]=f32x16{};o[1]=f32x16{};f32x16 negm=f32x16{};asm volatile("":"+v"(negm));
    #define CMASK(P0,P1,t) do{ if((t)>=NT-4)cmask(P0,P1,(t),hi); }while(0)
  bool resc=false;
  #define START(P0,P1) do{ const float rm=rowmax(P0,P1); resc=false; \
    { const float dl=rm; mhat=fadd_s(mhat,dl); \
      _Pragma("unroll") for(int r=0;r<16;++r){P0[r]=fsub_s(P0[r],dl);P1[r]=fsub_s(P1[r],dl);} \
      _Pragma("unroll") for(int r=0;r<16;++r)negm[r]=-mhat; asm volatile("":"+v"(negm)); } \
    _Pragma("unroll") for(int r=0;r<16;++r)P0[r]=__builtin_amdgcn_exp2f(P0[r]); }while(0)
  #define RESC() do{ if(resc){ asm volatile("s_waitcnt lgkmcnt(0)":::"memory"); \
      _Pragma("unroll") for(int d_=0;d_<2;++d_) _Pragma("unroll") for(int r=0;r<16;++r)o[d_][r]*=wsf[crow(r,hi)]; } }while(0)
  f32x16 pA0,pA1,pB0,pB1;
  int sl_prev=0,sl_cur=0,sl_next=SLOTB;
  #define ROT() do{sl_prev=sl_cur;sl_cur=sl_next;sl_next=(sl_next==(NSLOT-1)*SLOTB)?0:sl_next+SLOTB;}while(0)
  DMA_K(2,2*SLOTB);
  WAIT_BAR(3);
  qkt(pA0,pA1,Kbase,qr,negm,r32,hi);asm volatile("s_nop 15\n\ts_nop 7":"+v"(pA0),"+v"(pA1));CMASK(pA0,pA1,0);
  START(pA0,pA1);
  _Pragma("unroll") for(int r=0;r<16;++r)pA1[r]=__builtin_amdgcn_exp2f(pA1[r]);
  WAIT_BAR(0);
  DMA_K(3,0);DMA_V(1,SLOTB);
  ROT();
  kload8(kf,kp0+sl_cur);
  WAIT_BAR(2);
  s16x4 vlo[8],vhi[8]; u32x4 pw0,pw1,pw2,pw3;
  #define PKW(P,B) cvtpk_s(P[B],P[B+1])
  #define PAF(k) __builtin_bit_cast(bf16x8,pw##k)
  #define VFR(i) (bf16x8){vlo[i][0],vlo[i][1],vlo[i][2],vlo[i][3],vhi[i][0],vhi[i][1],vhi[i][2],vhi[i][3]}
  #define PIN(x) asm volatile("":"+v"(x))
  #define MX3(a,b,c) __builtin_fmaxf(__builtin_fmaxf((a),(b)),(c))
  #define GAPA(MF,A0,A1,A2,A3,W0,W1,PW) do{ MF; sacc+=A0; sacc+=A1; sacc+=A2; sacc+=A3; PIN(sacc); W0; W1; PIN(PW); SBAR(); }while(0)
  #define EX(v) __builtin_amdgcn_exp2f(v)
  #define GAPB(MF,X,B) do{ MF; X[B]=EX(X[B]); X[B+1]=EX(X[B+1]); X[B+2]=EX(X[B+2]); X[B+3]=EX(X[B+3]); PIN(X); SBAR(); }while(0)
  #define VRD(i) do{ vlo[i]=vtr(vp_+(((i)>>2)*4096+((i)&3)*1024)); vhi[i]=vtr(vp_+(((i)>>2)*4096+((i)&3)*1024+512)); }while(0)
  #define KRD(G,j) do{ if(G){ kload2(kf,kp0+sl_next,j); SBAR(); } }while(0)
  #define STEP(C0,C1,P0,P1,t,GK,GV,GL) do{ SBAR(); \
    const lds_cptr vp_=vp0+sl_prev; \
    VRD(0); SBAR(); float sacc=(P0[0]+P0[1]); \
    GAPA(C0=__builtin_amdgcn_mfma_f32_32x32x16_bf16(kf[0],qr[0],negm,0,0,0), P0[2],P0[3],P0[4],P0[5],     pw0[0]=PKW(P0,0), pw0[1]=PKW(P0,2), pw0); \
    VRD(4); SBAR(); GAPA(C1=__builtin_amdgcn_mfma_f32_32x32x16_bf16(kf[1],qr[0],negm,0,0,0), P0[6],P0[7],P0[8],P0[9],     pw0[2]=PKW(P0,4), pw0[3]=PKW(P0,6), pw0); \
    VRD(1); SBAR(); GAPA(C0=__builtin_amdgcn_mfma_f32_32x32x16_bf16(kf[2],qr[1],C0,0,0,0),   P0[10],P0[11],P0[12],P0[13], pw1[0]=PKW(P0,8), pw1[1]=PKW(P0,10), pw1); \
    VRD(5); SBAR(); GAPA(C1=__builtin_amdgcn_mfma_f32_32x32x16_bf16(kf[3],qr[1],C1,0,0,0),   P0[14],P0[15],P1[0],P1[1],   pw1[2]=PKW(P0,12),pw1[3]=PKW(P0,14), pw1); \
    VRD(2); SBAR(); GAPA(C0=__builtin_amdgcn_mfma_f32_32x32x16_bf16(kf[4],qr[2],C0,0,0,0),   P1[2],P1[3],P1[4],P1[5],     pw2[0]=PKW(P1,0), pw2[1]=PKW(P1,2), pw2); \
    VRD(6); SBAR(); GAPA(C1=__builtin_amdgcn_mfma_f32_32x32x16_bf16(kf[5],qr[2],C1,0,0,0),   P1[6],P1[7],P1[8],P1[9],     pw2[2]=PKW(P1,4), pw2[3]=PKW(P1,6), pw2); \
    VRD(3); SBAR(); GAPA(C0=__builtin_amdgcn_mfma_f32_32x32x16_bf16(kf[6],qr[3],C0,0,0,0),   P1[10],P1[11],P1[12],P1[13], pw3[0]=PKW(P1,8), pw3[1]=PKW(P1,10), pw3); \
    VRD(7); SBAR(); GAPA(C1=__builtin_amdgcn_mfma_f32_32x32x16_bf16(kf[7],qr[3],C1,0,0,0),   P1[14],P1[15],0.f,0.f,       pw3[2]=PKW(P1,12),pw3[3]=PKW(P1,14), pw3); \
    l_reg+=sacc; \
    if(GK){DMA_K((t)+3,sl_cur);} if(GV){DMA_V((t)+1,sl_next);} \
    CMASK(C0,C1,t); \
    { float a=MX3(C0[0],C0[1],C1[0]),b=MX3(C0[2],C0[3],C1[1]); a=MX3(a,C1[2],C1[3]); \
      _Pragma("unroll") for(int r=4;r<16;r+=4){a=MX3(a,C0[r],C0[r+1]);b=MX3(b,C0[r+2],C0[r+3]);a=MX3(a,C1[r],C1[r+1]);b=MX3(b,C1[r+2],C1[r+3]);} \
      float rm=__builtin_fmaxf(a,b); { auto rr=__builtin_amdgcn_permlane32_swap(__float_as_uint(rm),__float_as_uint(rm),false,false); rm=__builtin_fmaxf(__uint_as_float(rr[0]),__uint_as_float(rr[1])); } \
      resc=false; \
      if(__builtin_expect(__any(rm>(float)THRL),0)){ const float dl=__builtin_fmaxf(rm,0.f); mhat+=dl; \
        _Pragma("unroll") for(int r=0;r<16;++r){C0[r]-=dl;C1[r]-=dl;} \
        _Pragma("unroll") for(int r=0;r<16;++r)negm[r]=-mhat; asm volatile("":"+v"(negm)); \
        const float f=__builtin_amdgcn_exp2f(-dl); l_reg*=f; if(hi==0)wsf[r32]=f; resc=true; } } \
    SBAR(); \
    GAPB(o[0]=__builtin_amdgcn_mfma_f32_32x32x16_bf16(PAF(0),VFR(0),o[0],0,0,0), C0,0); \
    GAPB(o[1]=__builtin_amdgcn_mfma_f32_32x32x16_bf16(PAF(0),VFR(4),o[1],0,0,0), C0,4); \
    KRD(GL,0); GAPB(o[0]=__builtin_amdgcn_mfma_f32_32x32x16_bf16(PAF(1),VFR(1),o[0],0,0,0), C0,8); \
    KRD(GL,1); GAPB(o[1]=__builtin_amdgcn_mfma_f32_32x32x16_bf16(PAF(1),VFR(5),o[1],0,0,0), C0,12); \
    KRD(GL,2); GAPB(o[0]=__builtin_amdgcn_mfma_f32_32x32x16_bf16(PAF(2),VFR(2),o[0],0,0,0), C1,0); \
    KRD(GL,3); GAPB(o[1]=__builtin_amdgcn_mfma_f32_32x32x16_bf16(PAF(2),VFR(6),o[1],0,0,0), C1,4); \
    GAPB(o[0]=__builtin_amdgcn_mfma_f32_32x32x16_bf16(PAF(3),VFR(3),o[0],0,0,0), C1,8); \
    GAPB(o[1]=__builtin_amdgcn_mfma_f32_32x32x16_bf16(PAF(3),VFR(7),o[1],0,0,0), C1,12); \
    }while(0)
  int t=1;
  #undef CMASK
  #define CMASK(P0,P1,t) do{}while(0)
  for(;t+5<NT;t+=2){
    STEP(pB0,pB1,pA0,pA1,t,true,true,true);     WAIT_BAR(2); RESC(); ROT();
    STEP(pA0,pA1,pB0,pB1,t+1,true,true,true);   WAIT_BAR(2); RESC(); ROT();
  }
  #undef CMASK
  #define CMASK(P0,P1,t) do{ if((t)>=NT-4)cmask(P0,P1,(t),hi); }while(0)
  #define ENDW(tt) do{ if((tt)+3<NT){WAIT_BAR(2);} else if((tt)+2<NT){WAIT_BAR(1);} else {WAIT_BAR(0);} }while(0)
  for(;t+1<NT;t+=2){
    STEP(pB0,pB1,pA0,pA1,t,(t+3<NT),(t+1<NT),(t+1<NT));       ENDW(t);   RESC(); ROT();
    STEP(pA0,pA1,pB0,pB1,t+1,(t+4<NT),(t+2<NT),(t+2<NT));     ENDW(t+1); RESC(); ROT();
  }
  STEP(pB0,pB1,pA0,pA1,NT-1,false,false,false); RESC();
  { float sacc=pB0[0]+pB0[1]; _Pragma("unroll") for(int r=2;r<16;++r)sacc+=pB0[r]; _Pragma("unroll") for(int r=0;r<16;++r)sacc+=pB1[r]; l_reg+=sacc;
    pw0=(u32x4){PKW(pB0,0),PKW(pB0,2),PKW(pB0,4),PKW(pB0,6)};pw1=(u32x4){PKW(pB0,8),PKW(pB0,10),PKW(pB0,12),PKW(pB0,14)};pw2=(u32x4){PKW(pB1,0),PKW(pB1,2),PKW(pB1,4),PKW(pB1,6)};pw3=(u32x4){PKW(pB1,8),PKW(pB1,10),PKW(pB1,12),PKW(pB1,14)};
    SBAR(); pv(o,vb0+sl_cur,PAF(0),PAF(1),PAF(2),PAF(3)); }
  #undef PKW
  #undef PAF
  #undef VFR
  #undef PIN
  #undef MX3
  #undef GAPA
  #undef GAPB
  #undef EX
  #undef VRD
  #undef KRD
  #undef STEP
  #undef ENDW
  {auto rr=__builtin_amdgcn_permlane32_swap(__float_as_uint(l_reg),__float_as_uint(l_reg),false,false);l_reg=__uint_as_float(rr[0])+__uint_as_float(rr[1]);}
  if(hi==0)wsf[32+r32]=l_reg;asm volatile("s_waitcnt lgkmcnt(0)":::"memory");
  float rli[16];
  #pragma unroll
  for(int r=0;r<16;++r)rli[r]=__builtin_amdgcn_rcpf(wsf[32+crow(r,hi)]);
  bf16*Ow=O+(rowbase+q0+wid*QBLK)*DMQ+h*D;
  { bf16*stg=(bf16*)(shm+LDS_OST)+wid*2048;
    #pragma unroll
    for(int r=0;r<16;++r){const int orow=crow(r,hi);
      #pragma unroll
      for(int d0=0;d0<2;++d0)stg[orow*64+d0*32+r32]=__float2bfloat16(o[d0][r]*rli[r]);}
    asm volatile("s_waitcnt lgkmcnt(0)":::"memory");
    #pragma unroll
    for(int i=0;i<4;++i){const int row=i*8+(lane>>3),ch=lane&7; const u32x4 v=*(const u32x4*)(stg+row*64+ch*8); ATTN_STORE16(Ow+(long)row*DMQ+ch*8,v);} }
  asm volatile("s_waitcnt lgkmcnt(0)\n\ts_barrier":::"memory");
  #undef DMA_K
  #undef DMA_V
  #undef CMASK
  #undef START
  #undef RESC
  #undef ROT
}
constexpr int ATTN_LDS_BYTES=LDS_BYTES;
struct AttnTensors { const bf16* Q; const bf16* K; const bf16* V; bf16* O; };
struct AttnUnit { int bh; int qb; };
struct StaticOrder {
  int vcu;
  __device__ __forceinline__ explicit StaticOrder(int grid,int block):vcu((block%8)*(grid/8)+block/8){}
  __device__ __forceinline__ bool next(int i,AttnUnit&u)const{ if(i>=2)return false; const int pr=vcu>>6,uu=2*(vcu&63)+i; u.bh=(pr>>1)*NHEAD+(pr&1)*4+(uu>>5); u.qb=uu&31; return true; }
  __device__ __forceinline__ void a_ready(const AttnUnit&)const{}
  __device__ __forceinline__ void done(const AttnUnit&)const{}
};
template<class Sched,int THRL=8> __device__ __forceinline__ void attn_phase(char*lds,const AttnTensors&T,const Sched&S){
  AttnUnit u;
  for(int i=0;S.next(i,u);++i){ S.a_ready(u); attn_unit<THRL>(u.bh/NHEAD,u.bh%NHEAD,u.qb,T.Q,T.K,T.V,T.O,lds); S.done(u); }
}
#undef SBAR
#undef WAIT_BAR
}
#define GAS __attribute__((address_space(1)))
#define LAS __attribute__((address_space(3)))
typedef unsigned short bf16;
typedef unsigned v4u __attribute__((ext_vector_type(4)));
typedef float f32x4 __attribute__((ext_vector_type(4)));
typedef short bf16x8 __attribute__((ext_vector_type(8)));
typedef GAS unsigned gu32;
typedef GAS unsigned long long gu64;
#define RLX_AGENT __ATOMIC_RELAXED, __HIP_MEMORY_SCOPE_AGENT
#define LDS_WAIT() asm volatile("s_waitcnt lgkmcnt(0)" ::: "memory")
#define VM_WAIT() asm volatile("s_waitcnt vmcnt(0)" ::: "memory")
__device__ __forceinline__ unsigned long long rt() { return __builtin_amdgcn_s_memrealtime(); }
__device__ __forceinline__ unsigned f2bf(float f) { unsigned u = __builtin_bit_cast(unsigned, f); return (u + 0x7fffu + ((u >> 16) & 1u)) >> 16; }
__device__ __forceinline__ unsigned pk2(float lo, float hi) { return f2bf(lo) | (f2bf(hi) << 16); }

#define XB_TMO      128
#define XB_XCNT(j)  (256  + 64 * (j))
#define XB_XSUB(j)  (1280 + 64 * (j))
#define XB_XGEN(j)  (2304 + 64 * (j))
#define XB_TOP      3328
#define XB_TOPGEN   3392
#define XCD_BAR_WORDS 3456
#define XB_SPIN_CAP (1u << 18)

__device__ __forceinline__ unsigned xb_ld(unsigned* p)              { return __hip_atomic_load(p, __ATOMIC_RELAXED, __HIP_MEMORY_SCOPE_AGENT); }
__device__ __forceinline__ unsigned xb_add(unsigned* p, unsigned v) { return __hip_atomic_fetch_add(p, v, __ATOMIC_RELAXED, __HIP_MEMORY_SCOPE_AGENT); }
__device__ __forceinline__ unsigned xb_xcc_id() { return (unsigned)__builtin_amdgcn_s_getreg((3 << 11) | 20) & 0xFu; }
#define XB_SPIN(cond, bar) do { unsigned _sp = 0; while (cond) { __builtin_amdgcn_s_sleep(1); \
    if ((++_sp & 255u) == 0u) { if (xb_ld(&(bar)[XB_TMO])) break; if (_sp > XB_SPIN_CAP) { atomicAdd(&(bar)[XB_TMO], 1u); break; } } } } while (0)

struct XcdBarrier {
    unsigned* bar; unsigned x;
    volatile LAS unsigned* st;
};

__device__ __forceinline__ XcdBarrier xcd_barrier_post(unsigned* bar, volatile LAS unsigned* st) {
    XcdBarrier b; b.bar = bar; b.x = xb_xcc_id(); b.st = st;
    if (threadIdx.x == 0) (void)xb_add(&bar[XB_XCNT(b.x)], 1u);
    return b;
}
__device__ __forceinline__ void xcd_barrier_complete(unsigned* bar, unsigned x, unsigned& nloc, unsigned& nx) {
    const unsigned G = gridDim.x * gridDim.y * gridDim.z;
    unsigned sum, cnt, mine, sp = 0u;
    for (;;) {
        sum = 0u; cnt = 0u; mine = 0u;
#pragma unroll
        for (unsigned j = 0; j < 16; ++j) { const unsigned c = xb_ld(&bar[XB_XCNT(j)]); sum += c; cnt += (c > 0u) ? 1u : 0u; mine = (j == x) ? c : mine; }
        if (sum == G) break;
        __builtin_amdgcn_s_sleep(1);
        if ((++sp & 255u) == 0u) { if (xb_ld(&bar[XB_TMO])) break; if (sp > XB_SPIN_CAP) { atomicAdd(&bar[XB_TMO], 1u); break; } }
    }
    nloc = mine > 0u ? mine : 1u; nx = cnt > 0u ? cnt : 1u;
}

__device__ __forceinline__ void xcd_barrier(const XcdBarrier& b) {
    asm volatile("s_waitcnt vmcnt(0)" ::: "memory");
    __syncthreads();
    if (threadIdx.x == 0) {
        unsigned* bar = b.bar;
        __builtin_amdgcn_s_waitcnt(0);
        unsigned nloc = b.st[0], nx = b.st[1];
        if (nloc == 0u) { xcd_barrier_complete(bar, b.x, nloc, nx); b.st[0] = nloc; b.st[1] = nx; }
        const unsigned old = xb_add(&bar[XB_XSUB(b.x)], 1u);
        const unsigned gen = old / nloc;
        if (old + 1u == (gen + 1u) * nloc) {
            __builtin_amdgcn_fence(__ATOMIC_RELEASE, "agent");
            asm volatile("s_waitcnt vmcnt(0)" ::: "memory");
            const unsigned og = xb_add(&bar[XB_TOP], 1u);
            const unsigned tg = og / nx;
            if (og + 1u == (tg + 1u) * nx) xb_add(&bar[XB_TOPGEN], 1u);
            else XB_SPIN(xb_ld(&bar[XB_TOPGEN]) == tg, bar);
            __builtin_amdgcn_fence(__ATOMIC_ACQUIRE, "agent");
            xb_add(&bar[XB_XGEN(b.x)], 1u);
            asm volatile("s_waitcnt vmcnt(0)" ::: "memory");
        } else {
            XB_SPIN(xb_ld(&bar[XB_XGEN(b.x)]) == gen, bar);
            __builtin_amdgcn_fence(__ATOMIC_ACQUIRE, "agent");
            asm volatile("s_waitcnt vmcnt(0)" ::: "memory");
        }
    }
    __syncthreads();
}

constexpr int NWAVES = 8;
constexpr int BATCH = 2, SEQ = 8192, DM = 1024, NMETA = 16;
constexpr int M = BATCH * SEQ;
constexpr int INW = 3328;
constexpr int KVROWS = 8320, KVALID = 8208;
constexpr int NG = 32, NE = 16, CAP = 1024;
constexpr int UGP = 768;
constexpr float LN_EPS = 1e-5f, QK_EPS = 1e-6f, ALPHA = 1.189207115002721f;
constexpr float C2Q = 0.125f * 1.4426950408889634f;

constexpr size_t MiB = 1u << 20;
constexpr size_t WS_CTL = 0, CTL_ZERO_BYTES = 1 * MiB;
constexpr size_t WS_STATS0 = 1 * MiB, WS_STATS1 = WS_STATS0 + 131072, WS_ROPE = WS_STATS1 + 131072, WS_UMETA = WS_ROPE + 32768, WS_GATE2 = WS_UMETA + 32768, WS_IDX2 = WS_GATE2 + 131072;
constexpr size_t WS_SLOTOF = 2 * MiB, WS_AFF = 3 * MiB;
constexpr size_t WS_WGU = 8 * MiB, WS_WD = 72 * MiB;
constexpr size_t WS_WIN = 104 * MiB, WS_WGLU = 111 * MiB, WS_WAB = 112 * MiB, WS_WSB = 113 * MiB, WS_WO = 114 * MiB;
constexpr size_t WS_WST = 116 * MiB, WS_MEXT = 124 * MiB;
constexpr size_t WS_XN = 148 * MiB;
constexpr size_t WS_Q = 181 * MiB, WS_K = 197 * MiB, WS_V = 202 * MiB;
constexpr size_t WS_UG2 = 207 * MiB, WS_S = 231 * MiB;
constexpr size_t WS_END = 247 * MiB;
constexpr size_t WS_YG = WS_XN, WS_Z = WS_XN + 16 * MiB;
constexpr size_t WS_T1 = WS_WST;
constexpr size_t WS_MERGED = WS_UG2;
constexpr size_t WS_H1 = WS_XN;
constexpr size_t WS_XE = WS_Q;
constexpr size_t WS_HB = WS_WIN;
static_assert(WS_XE + 64 * MiB <= WS_END && WS_HB + 64 * MiB <= WS_XE && WS_MERGED + 32 * MiB <= WS_END && WS_T1 + 32 * MiB <= WS_XN, "d_ws overlays");
constexpr int CW_TMO = 0, CW_BAR = 4096;
constexpr int CW_Q = 8192, CW_DONE = 8256;
constexpr int N_DENSE_ITEMS = 16 * 104 + 8 * 16 + 2 * 8 * 32 + 16 * 32, N_EXP_ITEMS = NE * 3 * 16 * 32;

constexpr int RING_OFF = 0, RING_BYTES = 131072;
constexpr int LDSCTL_OFF = RING_BYTES, MISC_OFF = LDSCTL_OFF + 320;
constexpr int LDS_BYTES = 147456;

typedef unsigned u32x4_t __attribute__((ext_vector_type(4)));
typedef unsigned u32x2_t __attribute__((ext_vector_type(2)));
typedef float f32x2_t2 __attribute__((ext_vector_type(2)));
using pg8::Unit;

struct Frame {
    LAS unsigned char* lds; volatile LAS unsigned* MISC; gu32* ctl;
    int tid, lane, wave, vcu, G;
    unsigned char* ws;
    const float* in[28]; float* out;
};
__device__ __forceinline__ float wave_sum(float v) {
#pragma unroll
    for (int o = 1; o < 64; o <<= 1) v += __shfl_xor(v, o);
    return v;
}
__device__ __forceinline__ float sigm(float x) { return 1.f / (1.f + __expf(-x)); }
__device__ __forceinline__ float bf2f(unsigned short h) { return __uint_as_float((unsigned)h << 16); }
__device__ __forceinline__ float bflo(unsigned w) { return __uint_as_float(w << 16); }
__device__ __forceinline__ float bfhi(unsigned w) { return __uint_as_float(w & 0xffff0000u); }
__device__ __forceinline__ u32x4_t pack8(const f32x4& a, const f32x4& b) { u32x4_t w; w.x = pg8::cvt_pk_bf16(a[0], a[1]); w.y = pg8::cvt_pk_bf16(a[2], a[3]); w.z = pg8::cvt_pk_bf16(b[0], b[1]); w.w = pg8::cvt_pk_bf16(b[2], b[3]); return w; }
__device__ __forceinline__ float gelu_tanh(float y) { const float in = 0.7978845608028654f * (y + 0.044715f * y * y * y); const float e = __expf(2.f * in); return y * (1.f - 1.f / (e + 1.f)); }

struct InProjOrder {
    pg8::StaticOrder so;
    __device__ bool next(int i, Unit& u) const { if (so.next(i, u)) return true; const long L = (long)i * so.G + so.c; if (L >= so.nwg && L < so.nwg + 3) { u.pm = 64; u.pn = 2 + (int)(L - so.nwg); return true; } return false; }
    __device__ __forceinline__ void a_ready(const Unit&) const {}
    __device__ __forceinline__ void done(const Unit&) const {}
};
struct SsmStateOrder {
    int G, c;
    __device__ bool next(int i, Unit& u) const { const int L = i * G + c; if (L >= 64) return false; u.pm = L; u.pn = L >> 1; return true; }
    __device__ __forceinline__ void a_ready(const Unit&) const {}
    __device__ __forceinline__ void done(const Unit&) const {}
};
struct SsmYOrder {
    int G, c;
    __device__ bool next(int i, Unit& u) const { const int L = i * G + c; if (L >= 128) return false; const int g = L >> 2; u.pm = g * 2 + ((L >> 1) & 1); u.pn = g * 2 + (L & 1); return true; }
    __device__ __forceinline__ void a_ready(const Unit&) const {}
    __device__ __forceinline__ void done(const Unit&) const {}
};
struct MoeOrder {
    int G, c, nmi, nnj;
    __device__ bool next(int i, Unit& u) const { const int per = nmi * nnj, nwg = NE * per; const int L = i * G + c; if (L >= nwg) return false;
        const int wgid = (L % 8) * (nwg / 8) + L / 8; const int e = wgid / per, w = wgid % per; u.pm = e * nmi + (w % nmi); u.pn = e * nnj + (w / nmi); return true; }
    __device__ __forceinline__ void a_ready(const Unit&) const {}
    __device__ __forceinline__ void done(const Unit&) const {}
};

typedef float f32x4 __attribute__((ext_vector_type(4)));
#define EPI_LOOP_AM _Pragma("unroll") for (int ai = 0; ai < 2; ++ai) _Pragma("unroll") for (int m = 0; m < 4; ++m)
constexpr int XCH_OFF = 132096;
struct EpiInProj {
    static constexpr bool PERM = true, AFTER_DRAIN = false;
    bf16* Q; bf16* Kb; bf16* Vb; bf16* UG2; bf16* GATES; bf16* UMETA; LAS float* XCH; const float* ngt; const float* RP;
    __device__ __forceinline__ u32x4_t normrope(const f32x4& a0, const f32x4& a1, float rinv, const f32x4& g0, const f32x4& g1, const f32x4& cs, const f32x4& sn, float osc) const {
        const float y0 = a0[0] * rinv * g0[0], y1 = a0[1] * rinv * g0[1], y2 = a0[2] * rinv * g0[2], y3 = a0[3] * rinv * g0[3];
        const float y4 = a1[0] * rinv * g1[0], y5 = a1[1] * rinv * g1[1], y6 = a1[2] * rinv * g1[2], y7 = a1[3] * rinv * g1[3];
        u32x4_t w;
        w.x = pg8::cvt_pk_bf16((y0 * cs[0] - y1 * sn[0]) * osc, (y0 * sn[0] + y1 * cs[0]) * osc);
        w.y = pg8::cvt_pk_bf16((y2 * cs[1] - y3 * sn[1]) * osc, (y2 * sn[1] + y3 * cs[1]) * osc);
        w.z = pg8::cvt_pk_bf16((y4 * cs[2] - y5 * sn[2]) * osc, (y4 * sn[2] + y5 * cs[2]) * osc);
        w.w = pg8::cvt_pk_bf16((y6 * cs[3] - y7 * sn[3]) * osc, (y6 * sn[3] + y7 * cs[3]) * osc);
        return w;
    }
    __device__ __forceinline__ void operator()(const f32x4 (&acc)[2][2][4][2], const Unit& u, int wr, int wc, int fr_, int fq_) const {
        int fr = fr_, fq = fq_; asm volatile("" : "+v"(fr), "+v"(fq));
        const int pn = u.pn, cl0 = wc * 32 + 8 * fq;
        if (pn <= 2) {
            const int nb = pn == 2 ? 1 : 2;
            EPI_LOOP_AM {
#pragma unroll
                for (int bj = 0; bj < 2; ++bj) {
                    if (bj < nb) { const f32x4 a = acc[ai][bj][m][0], c = acc[ai][bj][m][1]; float s = (a[0] * a[0] + a[1] * a[1]) + (a[2] * a[2] + a[3] * a[3]) + (c[0] * c[0] + c[1] * c[1]) + (c[2] * c[2] + c[3] * c[3]);
                        s += __shfl_xor(s, 16); s += __shfl_xor(s, 32);
                        if (fq == 0) XCH[(ai * 128 + wr * 64 + m * 16 + fr) * 8 + bj * 4 + wc] = s; } } }
            asm volatile("s_waitcnt lgkmcnt(0)" ::: "memory"); __builtin_amdgcn_s_barrier(); asm volatile("" ::: "memory");
            const float* gsrc = ngt + (pn == 2 ? 64 : 0) + (wc & 1) * 32 + 8 * fq;
            const f32x4 g0 = *(const f32x4*)gsrc, g1 = *(const f32x4*)(gsrc + 4);
            const float osc = pn == 2 ? 1.f : C2Q;
            const int codd = wc & 1;
            EPI_LOOP_AM {
                if (u.pm == 64 && (wr != 0 || ai != 0 || m != 0)) continue;
                const int rl = ai * 128 + wr * 64 + m * 16 + fr; const int row = u.pm * 256 + rl;
                f32x4 cs = (f32x4){1.f, 1.f, 1.f, 1.f}, sn = (f32x4){0.f, 0.f, 0.f, 0.f};
                if (u.pm != 64) { const int s = row & 8191; const float* tp = codd ? RP + 4096 + (s & 63) * 16 + 4 * fq : RP + (s >> 6) * 16 + 4 * fq; cs = *(const f32x4*)tp; sn = *(const f32x4*)(tp + (codd ? 1024 : 2048)); }
#pragma unroll
                for (int bj = 0; bj < 2; ++bj) {
                    if (bj < nb) {
                        const f32x2_t2 pr = *(const LAS f32x2_t2*)(XCH + rl * 8 + bj * 4 + (wc & 2)); const float tot = pr.x + pr.y;
                        const float rinv = rsqrtf(tot * (1.f / 64.f) + QK_EPS);
                        const u32x4_t w = normrope(acc[ai][bj][m][0], acc[ai][bj][m][1], rinv, g0, g1, cs, sn, osc);
                        if (pn < 2) *(u32x4_t*)(Q + (size_t)row * 512 + pn * 256 + bj * 128 + cl0) = w;
                        else if (u.pm != 64) *(u32x4_t*)(Kb + ((size_t)(row >> 13) * KVROWS + NMETA + (row & 8191)) * 128 + cl0) = w;
                        else { *(u32x4_t*)(Kb + (size_t)fr * 128 + cl0) = w; *(u32x4_t*)(Kb + ((size_t)KVROWS + fr) * 128 + cl0) = w; }
                    } else {
                        const u32x4_t w = pack8(acc[ai][1][m][0], acc[ai][1][m][1]);
                        if (u.pm != 64) *(u32x4_t*)(Vb + ((size_t)(row >> 13) * KVROWS + NMETA + (row & 8191)) * 128 + cl0) = w;
                        else { *(u32x4_t*)(Vb + (size_t)fr * 128 + cl0) = w; *(u32x4_t*)(Vb + ((size_t)KVROWS + fr) * 128 + cl0) = w; }
                    }
                }
            }
            return;
        }
        if (u.pm == 64) {
            if (wr != 0) return;
#pragma unroll
            for (int bj = 0; bj < 2; ++bj) { const int cu = (pn - 3) * 256 + bj * 128 + cl0; *(u32x4_t*)(UMETA + ((size_t)(cu >> 4) * 16 + fr) * 16 + (cu & 15)) = pack8(acc[0][bj][0][0], acc[0][bj][0][1]); }
            return;
        }
        const int row0 = u.pm * 256 + wr * 64 + fr;
        if (pn < 5) {
            EPI_LOOP_AM { const int row = row0 + ai * 128 + m * 16, b = row >> 13, s = row & 8191;
#pragma unroll
                for (int bj = 0; bj < 2; ++bj) { const int cu = (pn - 3) * 256 + bj * 128 + cl0, g = cu >> 4;
                    *(u32x4_t*)(UG2 + ((size_t)(g * 2 + b) * 256 + (s >> 5)) * UGP + (s & 31) * 16 + (cu & 15)) = pack8(acc[ai][bj][m][0], acc[ai][bj][m][1]); } }
        } else {
            EPI_LOOP_AM { const size_t o = (size_t)(row0 + ai * 128 + m * 16) * 2048 + (pn - 5) * 256 + cl0;
#pragma unroll
                for (int bj = 0; bj < 2; ++bj) { f32x4 a = acc[ai][bj][m][0], c = acc[ai][bj][m][1];
#pragma unroll
                    for (int j = 0; j < 4; ++j) { a[j] = sigm(a[j]); c[j] = sigm(c[j]); }
                    *(u32x4_t*)(GATES + o + bj * 128) = pack8(a, c); } }
        }
    }
};
struct EpiSsmState {
    static constexpr bool PERM = false, AFTER_DRAIN = false;
    float* S;
    __device__ __forceinline__ void operator()(const f32x4 (&acc)[2][2][4][2], const Unit& u, int wr, int wc, int fr, int fq) const {
        EPI_LOOP_AM { float* rp = S + ((size_t)u.pm * 256 + ai * 128 + wr * 64 + m * 16 + fr) * 256 + wc * 32 + 4 * fq;
#pragma unroll
            for (int bj = 0; bj < 2; ++bj)
#pragma unroll
                for (int n = 0; n < 2; ++n) *(f32x4*)(rp + bj * 128 + n * 16) = acc[ai][bj][m][n]; }
    }
};
struct EpiSsmY {
    static constexpr bool PERM = true, AFTER_DRAIN = false;
    bf16* YG;
    __device__ __forceinline__ void operator()(const f32x4 (&acc)[2][2][4][2], const Unit& u, int wr, int wc, int fr, int fq) const {
        const int g = u.pm >> 1, b = u.pm & 1, nh = u.pn & 1;
        EPI_LOOP_AM { const int cp = ai * 128 + wr * 64 + m * 16 + fr;
#pragma unroll
            for (int bj = 0; bj < 2; ++bj) { const int nl = nh * 256 + bj * 128 + wc * 32 + 8 * fq, t = nl >> 4, h0 = nl & 15;
                f32x4 a = acc[ai][bj][m][0], c = acc[ai][bj][m][1];
#pragma unroll
                for (int j = 0; j < 4; ++j) { a[j] = gelu_tanh(a[j]); c[j] = gelu_tanh(c[j]); }
                *(u32x4_t*)(YG + ((size_t)b * SEQ + cp * 32 + t) * 512 + g * 16 + h0) = pack8(a, c); } }
    }
};
struct EpiGlu {
    static constexpr bool PERM = true, AFTER_DRAIN = false;
    const bf16* YG; const float* bias; bf16* Z;
    __device__ __forceinline__ void operator()(const f32x4 (&acc)[2][2][4][2], const Unit& u, int wr, int wc, int fr, int fq) const {
        const int row0 = u.pm * 256 + wr * 64 + fr, col0 = u.pn * 256 + wc * 32 + 8 * fq;
        EPI_LOOP_AM { const size_t o = (size_t)(row0 + ai * 128 + m * 16) * 512 + col0;
#pragma unroll
            for (int bj = 0; bj < 2; ++bj) { const u32x4_t y = *(const u32x4_t*)(YG + o + bj * 128);
                const f32x4 b0 = *(const f32x4*)(bias + col0 + bj * 128), b1 = *(const f32x4*)(bias + col0 + bj * 128 + 4);
                f32x4 a = acc[ai][bj][m][0] + b0, c = acc[ai][bj][m][1] + b1;
                a[0] = bflo(y.x) * sigm(a[0]); a[1] = bfhi(y.x) * sigm(a[1]); a[2] = bflo(y.y) * sigm(a[2]); a[3] = bfhi(y.y) * sigm(a[3]);
                c[0] = bflo(y.z) * sigm(c[0]); c[1] = bfhi(y.z) * sigm(c[1]); c[2] = bflo(y.w) * sigm(c[2]); c[3] = bfhi(y.w) * sigm(c[3]);
                *(u32x4_t*)(Z + o + bj * 128) = pack8(a, c); } }
    }
};
template <int SECOND> struct EpiBranch {
    static constexpr bool PERM = true, AFTER_DRAIN = false;
    const bf16* GATES; const bf16* T1; bf16* O;
    __device__ __forceinline__ void operator()(const f32x4 (&acc)[2][2][4][2], const Unit& u, int wr, int wc, int fr, int fq) const {
        const int row0 = u.pm * 256 + wr * 64 + fr, col0 = u.pn * 256 + wc * 32 + 8 * fq;
        EPI_LOOP_AM { const size_t r = (size_t)(row0 + ai * 128 + m * 16);
#pragma unroll
            for (int bj = 0; bj < 2; ++bj) { const u32x4_t gt = *(const u32x4_t*)(GATES + r * 2048 + SECOND * 1024 + col0 + bj * 128);
                f32x4 a = acc[ai][bj][m][0], c = acc[ai][bj][m][1];
                a[0] *= bflo(gt.x); a[1] *= bfhi(gt.x); a[2] *= bflo(gt.y); a[3] *= bfhi(gt.y); c[0] *= bflo(gt.z); c[1] *= bfhi(gt.z); c[2] *= bflo(gt.w); c[3] *= bfhi(gt.w);
                if (SECOND) { const u32x4_t t1 = *(const u32x4_t*)(T1 + r * 1024 + col0 + bj * 128);
                    a[0] += bflo(t1.x); a[1] += bfhi(t1.x); a[2] += bflo(t1.y); a[3] += bfhi(t1.y); c[0] += bflo(t1.z); c[1] += bfhi(t1.z); c[2] += bflo(t1.w); c[3] += bfhi(t1.w); }
                *(u32x4_t*)(O + r * 1024 + col0 + bj * 128) = pack8(a, c); } }
    }
};
struct EpiPre1 {
    static constexpr bool PERM = false, AFTER_DRAIN = false;
    const float* x; const float* g; const float* bb; const f32x2_t2* st; float* out;
    __device__ __forceinline__ void operator()(const f32x4 (&acc)[2][2][4][2], const Unit& u, int wr, int wc, int fr, int fq) const {
        const int row0 = u.pm * 256 + wr * 64 + fr, col0 = u.pn * 256 + wc * 32 + 4 * fq;
        EPI_LOOP_AM { const int row = row0 + ai * 128 + m * 16; const f32x2_t2 s = st[row]; const size_t o = (size_t)row * 1024 + col0;
#pragma unroll
            for (int bj = 0; bj < 2; ++bj)
#pragma unroll
                for (int n = 0; n < 2; ++n) { const int c = bj * 128 + n * 16; const f32x4 xv = *(const f32x4*)(x + o + c), gv = *(const f32x4*)(g + col0 + c), bv = *(const f32x4*)(bb + col0 + c);
                    *(f32x4*)(out + o + c) = ((xv - s.x) * s.y * gv + bv) * ALPHA + acc[ai][bj][m][n]; } }
    }
};
struct EpiMoe1 {
    static constexpr bool PERM = true, AFTER_DRAIN = false;
    bf16* HB;
    __device__ __forceinline__ void operator()(const f32x4 (&acc)[2][2][4][2], const Unit& u, int wr, int wc, int fr, int fq) const {
        const int row0 = u.pm * 256 + wr * 64 + fr, col0 = (u.pn & 7) * 128 + wc * 32 + 8 * fq;
        EPI_LOOP_AM { f32x4 a = acc[ai][0][m][0], c = acc[ai][0][m][1]; const f32x4 ua = acc[ai][1][m][0], uc = acc[ai][1][m][1];
#pragma unroll
            for (int j = 0; j < 4; ++j) { a[j] = a[j] * sigm(a[j]) * ua[j]; c[j] = c[j] * sigm(c[j]) * uc[j]; }
            *(u32x4_t*)(HB + (size_t)(row0 + ai * 128 + m * 16) * 1024 + col0) = pack8(a, c); }
    }
};
struct EpiMoe2 {
    static constexpr bool PERM = true, AFTER_DRAIN = false;
    const float* gate; bf16* YE;
    __device__ __forceinline__ void operator()(const f32x4 (&acc)[2][2][4][2], const Unit& u, int wr, int wc, int fr, int fq) const {
        const int row0 = u.pm * 256 + wr * 64 + fr, col0 = (u.pn & 3) * 256 + wc * 32 + 8 * fq;
        EPI_LOOP_AM { const int row = row0 + ai * 128 + m * 16; const float gt = gate[row];
#pragma unroll
            for (int bj = 0; bj < 2; ++bj) *(u32x4_t*)(YE + (size_t)row * 1024 + col0 + bj * 128) = pack8(acc[ai][bj][m][0] * gt, acc[ai][bj][m][1] * gt); }
    }
};

struct TItem { const float* src; bf16* dst; int N, K; };
__device__ __forceinline__ void titem_load(const TItem& t, f32x4 (&v)[8], int lane) {
    const float* p = t.src + (size_t)(lane >> 3) * t.N + (lane & 7) * 4;
#pragma unroll
    for (int i = 0; i < 8; ++i) v[i] = *(const GAS f32x4*)(p + (size_t)(8 * i) * t.N);
}
__device__ __forceinline__ void titem_store(const TItem& t, const f32x4 (&v)[8], LAS float* scr, int lane) {
#pragma unroll
    for (int i = 0; i < 8; ++i) { LAS float* s = scr + ((lane >> 3) + 8 * i) * 33 + (lane & 7) * 4; s[0] = v[i].x; s[1] = v[i].y; s[2] = v[i].z; s[3] = v[i].w; }
    LDS_WAIT(); asm volatile("" ::: "memory");
    const int c = lane & 7;
#pragma unroll
    for (int j = 0; j < 4; ++j) { const int n = (lane >> 3) + 8 * j; const LAS float* s = scr + (8 * c) * 33 + n;
        v4u o; o.x = pk2(s[0 * 33], s[1 * 33]); o.y = pk2(s[2 * 33], s[3 * 33]); o.z = pk2(s[4 * 33], s[5 * 33]); o.w = pk2(s[6 * 33], s[7 * 33]);
        *(GAS v4u*)(t.dst + (size_t)n * t.K + 8 * c) = o; }
    LDS_WAIT(); asm volatile("" ::: "memory");
}
__device__ __forceinline__ void ssm_par(const Frame& F, int dg, int p, float& lr, float& li, float& cr, float& ci) {
    const float dt = expf(F.in[9][dg]); const float ar = F.in[7][dg * 64 + p], ai = F.in[8][dg * 64 + p];
    lr = ar * dt; li = ai * dt;
    float sn, cs; sincosf(li, &sn, &cs); const float mag = expf(lr);
    const float nr = mag * cs - 1.f, ni = mag * sn, den = ar * ar + ai * ai;
    cr = (nr * ar + ni * ai) / den; ci = (ni * ar - nr * ai) / den;
}
__device__ __forceinline__ void cpow(float lr, float li, float e, float& pr, float& pi) { float sn, cs; sincosf(li * e, &sn, &cs); const float mg = expf(lr * e); pr = mg * cs; pi = mg * sn; }

__device__ __forceinline__ void mext_item(Frame& F, int it) {
    const int tid = F.tid; unsigned char* ws = F.ws;
    LAS float* POW = (LAS float*)(F.lds + RING_OFF);
    LAS float* BB = POW + 2 * 33 * 64 * 2;
    LAS float* CC = BB + 2 * 64 * 16 * 2;
    LAS float* KT = CC + 2 * 4 * 64 * 2;
    LAS float* PAR = KT + 2 * 4 * 32 * 16;
    bf16* MEXT = (bf16*)(ws + WS_MEXT);
    const int g = it >> 2, hq = it & 3;
    __syncthreads();
    if (tid < 128) { float lr, li, cr, ci; ssm_par(F, (tid >> 6) * 32 + g, tid & 63, lr, li, cr, ci); PAR[tid * 4] = lr; PAR[tid * 4 + 1] = li; PAR[tid * 4 + 2] = cr; PAR[tid * 4 + 3] = ci; }
    __syncthreads();
    for (int i = tid; i < 2 * 33 * 64; i += NWAVES * 64) { const int dir = i / (33 * 64), j = (i / 64) % 33, p = i & 63;
        float pr, pi; cpow(PAR[(dir * 64 + p) * 4], PAR[(dir * 64 + p) * 4 + 1], (float)j, pr, pi); POW[i * 2] = pr; POW[i * 2 + 1] = pi; }
    for (int i = tid; i < 2 * 64 * 16; i += NWAVES * 64) { const int dir = i / 1024, p = (i >> 4) & 63, h = i & 15; const float cr = PAR[(dir * 64 + p) * 4 + 2], ci = PAR[(dir * 64 + p) * 4 + 3];
        const size_t o = ((size_t)(dir * 32 + g) * 64 + p) * 16 + h; const float br = F.in[10][o], bi = F.in[11][o]; BB[i * 2] = cr * br - ci * bi; BB[i * 2 + 1] = cr * bi + ci * br; }
    for (int i = tid; i < 2 * 4 * 64; i += NWAVES * 64) { const int dir = i / 256, hl = (i >> 6) & 3, p = i & 63; const size_t o = ((size_t)(dir * 32 + g) * 16 + hq * 4 + hl) * 64 + p; CC[i * 2] = F.in[12][o]; CC[i * 2 + 1] = F.in[13][o]; }
    __syncthreads();
    for (int i = tid; i < 2 * 4 * 32 * 16; i += NWAVES * 64) { const int dir = i / 2048, hl = (i >> 9) & 3, j = (i >> 4) & 31, hi = i & 15; float s = 0.f;
        for (int p = 0; p < 64; ++p) { const float cr = CC[((dir * 4 + hl) * 64 + p) * 2], ci = CC[((dir * 4 + hl) * 64 + p) * 2 + 1], pr = POW[((dir * 33 + j) * 64 + p) * 2], pi = POW[((dir * 33 + j) * 64 + p) * 2 + 1];
            const float er = cr * pr - ci * pi, ei = cr * pi + ci * pr; const float br = BB[((dir * 64 + p) * 16 + hi) * 2], bi = BB[((dir * 64 + p) * 16 + hi) * 2 + 1]; s += er * br - ei * bi; }
        KT[i] = s; }
    __syncthreads();
    for (int ch = tid; ch < 128 * 96; ch += NWAVES * 64) { const int rl = ch / 96, cc = ch % 96, t = rl >> 2, hl = rl & 3, ho = hq * 4 + hl; float v[8];
        if (cc < 64) { const int s = cc >> 1, hi0 = (cc & 1) * 8;
#pragma unroll
            for (int j = 0; j < 8; ++j) { const int hi = hi0 + j; float x = 0.f; if (s <= t) x += KT[((0 * 4 + hl) * 32 + (t - s)) * 16 + hi]; if (s >= t) x += KT[((1 * 4 + hl) * 32 + (s - t)) * 16 + hi];
                if (s == t && hi == ho) x += F.in[14][g * 16 + ho]; v[j] = x; }
        } else { const int kk = (cc - 64) * 8, dir = kk >> 7, reim = (kk >> 6) & 1, p0 = kk & 63, e = dir == 0 ? t + 1 : 32 - t;
#pragma unroll
            for (int j = 0; j < 8; ++j) { const int p = p0 + j; const float cr = CC[((dir * 4 + hl) * 64 + p) * 2], ci = CC[((dir * 4 + hl) * 64 + p) * 2 + 1], pr = POW[((dir * 33 + e) * 64 + p) * 2], pi = POW[((dir * 33 + e) * 64 + p) * 2 + 1];
                v[j] = reim == 0 ? (cr * pr - ci * pi) : -(cr * pi + ci * pr); } }
        v4u o; o.x = pk2(v[0], v[1]); o.y = pk2(v[2], v[3]); o.z = pk2(v[4], v[5]); o.w = pk2(v[6], v[7]);
        *(GAS v4u*)(MEXT + ((size_t)g * 512 + t * 16 + ho) * UGP + cc * 8) = o; }
    __syncthreads();
}
__device__ __forceinline__ TItem titem_decode(int it, const float* w_in, const float* w_glu, const float* w_ab, const float* w_sb, const float* w_o, const float* w_g, const float* w_u, const float* w_d, unsigned char* ws) {
    constexpr int I_IN = 16 * 104, I_GLU = 8 * 16, I_BR = 8 * 32, I_O = 16 * 32, I_E = 16 * 32;
    TItem t; int r = it;
          if (r < I_IN) { const int kb = r / 104, nb = r % 104; t.src = w_in + (size_t)(64 * kb) * INW + 32 * nb; t.N = INW; t.K = 1024; t.dst = (bf16*)(ws + WS_WIN) + (size_t)(32 * nb) * 1024 + 64 * kb; return t; } r -= I_IN;
          if (r < I_GLU) { const int kb = r / 16, nb = r % 16; t.src = w_glu + (size_t)(64 * kb) * 512 + 32 * nb; t.N = 512; t.K = 512; t.dst = (bf16*)(ws + WS_WGLU) + (size_t)(32 * nb) * 512 + 64 * kb; return t; } r -= I_GLU;
          if (r < I_BR) { const int kb = r / 32, nb = r % 32; t.src = w_ab + (size_t)(64 * kb) * 1024 + 32 * nb; t.N = 1024; t.K = 512; t.dst = (bf16*)(ws + WS_WAB) + (size_t)(32 * nb) * 512 + 64 * kb; return t; } r -= I_BR;
          if (r < I_BR) { const int kb = r / 32, nb = r % 32; t.src = w_sb + (size_t)(64 * kb) * 1024 + 32 * nb; t.N = 1024; t.K = 512; t.dst = (bf16*)(ws + WS_WSB) + (size_t)(32 * nb) * 512 + 64 * kb; return t; } r -= I_BR;
          if (r < I_O) { const int kb = r / 32, nb = r % 32; t.src = w_o + (size_t)(64 * kb) * 1024 + 32 * nb; t.N = 1024; t.K = 1024; t.dst = (bf16*)(ws + WS_WO) + (size_t)(32 * nb) * 1024 + 64 * kb; return t; } r -= I_O;
          const int e = r / (3 * I_E), which = (r / I_E) % 3, q = r % I_E, kb = q / 32, nb = q % 32, n0 = 32 * nb;
          const float* W = (which == 0 ? w_g : which == 1 ? w_u : w_d) + (size_t)e * 1024 * 1024;
          t.src = W + (size_t)(64 * kb) * 1024 + n0; t.N = 1024; t.K = 1024;
          const int drow0 = which < 2 ? e * 2048 + (n0 >> 7) * 256 + which * 128 + (n0 & 127) : e * 1024 + n0;
          t.dst = (bf16*)(ws + (which < 2 ? WS_WGU : WS_WD)) + (size_t)drow0 * 1024 + 64 * kb; return t; }
__device__ __forceinline__ void bg_convert(Frame& F, int done_word, unsigned n_main) {
    LAS float* scr = (LAS float*)(F.lds + RING_OFF + F.wave * 16384);
    volatile LAS unsigned* bc = F.MISC + 16;
    for (;;) {
        __syncthreads();
        if (F.tid == 0) { unsigned base = 0xffffffffu;
            const bool stop = n_main != 0u && __hip_atomic_load(F.ctl + done_word, RLX_AGENT) >= n_main;
            if (!stop) base = __hip_atomic_fetch_add(F.ctl + CW_Q, 8u, RLX_AGENT);
            bc[0] = base; }
        __syncthreads();
        const unsigned base = bc[0];
        if (base >= (unsigned)N_EXP_ITEMS) break;
        const TItem t = titem_decode(N_DENSE_ITEMS + (int)base + F.wave, F.in[4], F.in[15], F.in[17], F.in[18], F.in[19], F.in[23], F.in[24], F.in[25], F.ws);
        f32x4 v[8]; titem_load(t, v, F.lane); titem_store(t, v, scr, F.lane);
    }
}
__device__ __forceinline__ void main_done(Frame& F, int done_word) { __syncthreads(); if (F.tid == 0) __hip_atomic_fetch_add(F.ctl + done_word, 1u, RLX_AGENT); }
__device__ __forceinline__ void p0_prologue(Frame& F) {
    const int gw = F.vcu * NWAVES + F.wave, NGW = F.G * NWAVES, lane = F.lane, tid = F.tid;
    unsigned char* ws = F.ws;
    LAS float* scr = (LAS float*)(F.lds + RING_OFF + F.wave * 16384);
    { bf16* WST = (bf16*)(ws + WS_WST);
      for (int it = gw; it < NG * 256; it += NGW) { const int g = it >> 8, n = it & 255, dir = n >> 7, reim = (n >> 6) & 1, p = n & 63; float lr, li, cr, ci; ssm_par(F, dir * 32 + g, p, lr, li, cr, ci);
          const int t = lane >> 1, h0 = (lane & 1) * 8; float pr, pi; cpow(lr, li, (float)(dir == 0 ? 31 - t : t), pr, pi);
          const float er = pr * cr - pi * ci, ei = pr * ci + pi * cr; const size_t o = ((size_t)(dir * 32 + g) * 64 + p) * 16 + h0; float v[8];
#pragma unroll
          for (int j = 0; j < 8; ++j) { const float br = F.in[10][o + j], bi = F.in[11][o + j]; v[j] = reim == 0 ? (er * br - ei * bi) : (er * bi + ei * br); }
          v4u w; w.x = pk2(v[0], v[1]); w.y = pk2(v[2], v[3]); w.z = pk2(v[4], v[5]); w.w = pk2(v[6], v[7]);
          *(GAS v4u*)(WST + ((size_t)g * 256 + n) * 512 + lane * 8) = w; } }
    { constexpr int NIT = N_DENSE_ITEMS;
      f32x4 va[8], vb[8]; TItem ta, tb;
      int it = gw;
      if (it < NIT) { ta = titem_decode(it, F.in[4], F.in[15], F.in[17], F.in[18], F.in[19], F.in[23], F.in[24], F.in[25], ws); titem_load(ta, va, lane); }
      while (it < NIT) {
          const int i1 = it + NGW; if (i1 < NIT) { tb = titem_decode(i1, F.in[4], F.in[15], F.in[17], F.in[18], F.in[19], F.in[23], F.in[24], F.in[25], ws); titem_load(tb, vb, lane); }
          titem_store(ta, va, scr, lane);
          if (i1 >= NIT) break;
          const int i2 = i1 + NGW; if (i2 < NIT) { ta = titem_decode(i2, F.in[4], F.in[15], F.in[17], F.in[18], F.in[19], F.in[23], F.in[24], F.in[25], ws); titem_load(ta, va, lane); }
          titem_store(tb, vb, scr, lane);
          it = i2;
      } }
    { bf16* XN = (bf16*)(ws + WS_XN); f32x2_t2* ST = (f32x2_t2*)(ws + WS_STATS0);
      for (int r = gw; r < M + NMETA; r += NGW) { const float* src = r < M ? F.in[0] + (size_t)r * DM : F.in[1] + (size_t)(r - M) * DM;
          const GAS f32x4* xr = (const GAS f32x4*)src + lane; f32x4 v[4]; float s = 0.f;
#pragma unroll
          for (int j = 0; j < 4; ++j) { v[j] = xr[64 * j]; s += (v[j].x + v[j].y) + (v[j].z + v[j].w); }
          const float mean = wave_sum(s) * (1.f / DM); float s2 = 0.f;
#pragma unroll
          for (int j = 0; j < 4; ++j) { v[j] = v[j] - mean; s2 += (v[j].x * v[j].x + v[j].y * v[j].y) + (v[j].z * v[j].z + v[j].w * v[j].w); }
          const float rstd = 1.f / sqrtf(wave_sum(s2) * (1.f / DM) + LN_EPS);
          if (r < M && lane == 0) ST[r] = (f32x2_t2){mean, rstd};
          GAS unsigned long long* o8 = (GAS unsigned long long*)(XN + (size_t)r * DM) + lane;
#pragma unroll
          for (int j = 0; j < 4; ++j) { const f32x4 gg = ((const GAS f32x4*)F.in[2])[lane + 64 * j], bb = ((const GAS f32x4*)F.in[3])[lane + 64 * j]; const f32x4 o = v[j] * rstd * gg + bb;
              o8[64 * j] = (unsigned long long)pk2(o.x, o.y) | ((unsigned long long)pk2(o.z, o.w) << 32); } } }
    { const int gt = F.vcu * (NWAVES * 64) + tid, NT_ = F.G * NWAVES * 64;
      for (int i = gt; i < 2 * 2 * 112 * 16; i += NT_) { const int arr = i / (2 * 112 * 16), b = (i / (112 * 16)) & 1, q = i % (112 * 16);
          *(GAS v4u*)((bf16*)(ws + (arr ? WS_V : WS_K)) + ((size_t)b * KVROWS + KVALID) * 128 + q * 8) = (v4u){0u, 0u, 0u, 0u}; }
      float* RP = (float*)(ws + WS_ROPE);
      for (int i = gt; i < 3072; i += NT_) { const bool isr = i < 2048; const int q = isr ? i : i - 2048, pos = q >> 4, j = q & 15; const float ang = (float)pos * powf(10000.f, -(float)j / 16.f);
          float sn, cs; sincosf(ang, &sn, &cs); if (isr) { RP[q] = cs; RP[2048 + q] = sn; } else { RP[4096 + q] = cs; RP[5120 + q] = sn; } }
      for (int i = gt; i < 128; i += NT_) RP[6144 + i] = i < 64 ? F.in[5][i] : F.in[6][i - 64]; }
}

__device__ __forceinline__ void qk_prep(Frame& F) {
    const int gw = F.vcu * NWAVES + F.wave, NGW = F.G * NWAVES, lane = F.lane;
    bf16* Q = (bf16*)(F.ws + WS_Q); bf16* K = (bf16*)(F.ws + WS_K); const float* RP = (const float*)(F.ws + WS_ROPE);
    constexpr int NQ = M * 8, NK = 2 * KVALID * 2;
    for (int it = gw; it < NQ + NK; it += NGW) {
        bf16* p; int pos; float gsc, osc;
        if (it < NQ) { const int row = it >> 3, h = it & 7; p = Q + (size_t)row * 512 + h * 64; pos = row & 8191; gsc = F.in[5][lane]; osc = C2Q; }
        else { const int r = it - NQ, b = r / (KVALID * 2), q = r % (KVALID * 2), l = q >> 1, kvh = q & 1; p = K + ((size_t)b * KVROWS + l) * 128 + kvh * 64; pos = l - NMETA; gsc = F.in[6][lane]; osc = 1.f; }
        const float x = bf2f(p[lane]);
        const float ss = wave_sum(x * x) * (1.f / 64.f);
        const float y = x * rsqrtf(ss + QK_EPS) * gsc, yo = __shfl_xor(y, 1);
        float cs = 1.f, sn = 0.f;
        if (pos >= 0) { const int j = lane >> 1; if (j < 16) { cs = RP[(pos >> 6) * 16 + j]; sn = RP[2048 + (pos >> 6) * 16 + j]; } else { cs = RP[4096 + (pos & 63) * 16 + j - 16]; sn = RP[5120 + (pos & 63) * 16 + j - 16]; } }
        const float o = ((lane & 1) ? (yo * sn + y * cs) : (y * cs - yo * sn)) * osc;
        p[lane] = (bf16)f2bf(o);
    }
}

__device__ __forceinline__ void ssm_scan(Frame& F) {
    if (F.wave != 0 || blockIdx.x >= 128) return;
    const int it = blockIdx.x, b = it >> 6, g = (it >> 1) & 31, dir = it & 1, p = F.lane;
    float lr, li, cr, ci; ssm_par(F, dir * 32 + g, p, lr, li, cr, ci);
    float a32r, a32i; cpow(lr, li, 32.f, a32r, a32i);
    const float* S = (const float*)(F.ws + WS_S) + (size_t)(g * 2 + b) * 256 * 256 + dir * 128 + p;
    bf16* U = (bf16*)(F.ws + WS_UG2) + (size_t)(g * 2 + b) * 256 * UGP + 512 + dir * 128 + p;
    float sr = 0.f, si = 0.f;
    if (dir == 0) {
        float a1r, a1i; cpow(lr, li, 1.f, a1r, a1i);
        const bf16* um = (const bf16*)(F.ws + WS_UMETA) + (size_t)g * 256; const size_t o = ((size_t)g * 64 + p) * 16;
        float bbr[16], bbi[16];
#pragma unroll
        for (int h = 0; h < 16; ++h) { const float br = F.in[10][o + h], bi = F.in[11][o + h]; bbr[h] = cr * br - ci * bi; bbi[h] = cr * bi + ci * br; }
        for (int t = 0; t < 16; ++t) { float bur = 0.f, bui = 0.f;
#pragma unroll
            for (int h = 0; h < 16; ++h) { const float uv = bf2f(um[t * 16 + h]); bur = fmaf(bbr[h], uv, bur); bui = fmaf(bbi[h], uv, bui); }
            const float nr = a1r * sr - a1i * si + bur, ni = a1r * si + a1i * sr + bui; sr = nr; si = ni; }
    }
    for (int c0 = 0; c0 < 256; c0 += 32) {
        float vr[32], vi[32];
#pragma unroll
        for (int k = 0; k < 32; ++k) { const int c = dir == 0 ? c0 + k : 255 - (c0 + k); vr[k] = S[(size_t)c * 256]; vi[k] = S[(size_t)c * 256 + 64]; }
#pragma unroll
        for (int k = 0; k < 32; ++k) { const int c = dir == 0 ? c0 + k : 255 - (c0 + k);
            U[(size_t)c * UGP] = (bf16)f2bf(sr); U[(size_t)c * UGP + 64] = (bf16)f2bf(si);
            const float nr = a32r * sr - a32i * si + vr[k], ni = a32r * si + a32i * sr + vi[k]; sr = nr; si = ni; }
    }
}

__device__ __forceinline__ float treduce16(const float (&v)[16], int lane) {
    float r8[8], r4[4], r2[2], r1;
    { const bool up = lane & 32;
#pragma unroll
      for (int i = 0; i < 8; ++i) { const float keep = up ? v[i + 8] : v[i], send = up ? v[i] : v[i + 8]; r8[i] = keep + __shfl_xor(send, 32); } }
    { const bool up = lane & 16;
#pragma unroll
      for (int i = 0; i < 4; ++i) { const float keep = up ? r8[i + 4] : r8[i], send = up ? r8[i] : r8[i + 4]; r4[i] = keep + __shfl_xor(send, 16); } }
    { const bool up = lane & 8;
#pragma unroll
      for (int i = 0; i < 2; ++i) { const float keep = up ? r4[i + 2] : r4[i], send = up ? r4[i] : r4[i + 2]; r2[i] = keep + __shfl_xor(send, 8); } }
    { const bool up = lane & 4; const float keep = up ? r2[1] : r2[0], send = up ? r2[0] : r2[1]; r1 = keep + __shfl_xor(send, 4); }
    r1 += __shfl_xor(r1, 2); r1 += __shfl_xor(r1, 1);
    return r1;
}
__device__ __forceinline__ void ln1_router(Frame& F) {
    const int gw = F.vcu * NWAVES + F.wave, NGW = F.G * NWAVES, lane = F.lane;
    LAS float* WRT = (LAS float*)(F.lds + RING_OFF);
    for (int i = F.tid; i < 16 * 1024; i += NWAVES * 64) { const int d = i >> 4, e = i & 15; WRT[e * 1024 + d] = F.in[22][i]; }
    __syncthreads();
    const float* PRE = F.out; bf16* H1 = (bf16*)(F.ws + WS_H1); f32x2_t2* ST = (f32x2_t2*)(F.ws + WS_STATS1); float* AFF = (float*)(F.ws + WS_AFF);
    for (int r = gw; r < M; r += NGW) {
        const GAS f32x4* xr = (const GAS f32x4*)(PRE + (size_t)r * DM) + lane; f32x4 v[4]; float s = 0.f;
#pragma unroll
        for (int j = 0; j < 4; ++j) { v[j] = xr[64 * j]; s += (v[j].x + v[j].y) + (v[j].z + v[j].w); }
        const float mean = wave_sum(s) * (1.f / DM); float s2 = 0.f;
#pragma unroll
        for (int j = 0; j < 4; ++j) { v[j] = v[j] - mean; s2 += (v[j].x * v[j].x + v[j].y * v[j].y) + (v[j].z * v[j].z + v[j].w * v[j].w); }
        const float rstd = 1.f / sqrtf(wave_sum(s2) * (1.f / DM) + LN_EPS);
        if (lane == 0) ST[r] = (f32x2_t2){mean, rstd};
        GAS unsigned long long* o8 = (GAS unsigned long long*)(H1 + (size_t)r * DM) + lane;
#pragma unroll
        for (int j = 0; j < 4; ++j) { const f32x4 gg = ((const GAS f32x4*)F.in[20])[lane + 64 * j], bb = ((const GAS f32x4*)F.in[21])[lane + 64 * j]; v[j] = v[j] * rstd * gg + bb;
            o8[64 * j] = (unsigned long long)pk2(v[j].x, v[j].y) | ((unsigned long long)pk2(v[j].z, v[j].w) << 32); }
        float acc[16];
        asm volatile("" ::: "memory");
#pragma unroll
        for (int e = 0; e < 16; ++e) { float a = 0.f;
#pragma unroll
            for (int j = 0; j < 4; ++j) { const f32x4 w = *(const LAS f32x4*)(WRT + e * 1024 + (lane + 64 * j) * 4); a += (v[j].x * w.x + v[j].y * w.y) + (v[j].z * w.z + v[j].w * w.w); }
            acc[e] = a; }
        const float lg = treduce16(acc, lane);
        float mx = lg;
#pragma unroll
        for (int o = 4; o < 64; o <<= 1) mx = fmaxf(mx, __shfl_xor(mx, o));
        const float ex = expf(lg - mx); float sm = ex;
#pragma unroll
        for (int o = 4; o < 64; o <<= 1) sm += __shfl_xor(sm, o);
        if ((lane & 3) == 0) AFF[((size_t)(r >> 13) * NE + (lane >> 2)) * SEQ + (r & 8191)] = ex / sm;
    }
}

__device__ __forceinline__ void topk_phase(Frame& F) {
    if (blockIdx.x >= BATCH * NE) return;
    const int be = blockIdx.x, b = be >> 4, e = be & 15, t = F.tid, lane = F.lane, w = F.wave;
    LAS int* red = (LAS int*)(F.lds + RING_OFF); LAS int* sc_gt = red + 16; LAS int* sc_eq = sc_gt + 16;
    const float* a = (const float*)(F.ws + WS_AFF) + (size_t)be * SEQ;
    unsigned v[16];
#pragma unroll
    for (int i = 0; i < 16; ++i) v[i] = __float_as_uint(a[t * 16 + i]);
    unsigned thr = 0u;
    for (int bit = 30; bit >= 0; --bit) {
        const unsigned cand = thr | (1u << bit); int c = 0;
#pragma unroll
        for (int i = 0; i < 16; ++i) c += (v[i] >= cand) ? 1 : 0;
#pragma unroll
        for (int o = 32; o > 0; o >>= 1) c += __shfl_xor(c, o);
        __syncthreads();
        if (lane == 0) red[w] = c;
        __syncthreads();
        int total = 0;
#pragma unroll
        for (int k = 0; k < 8; ++k) total += red[k];
        if (total >= CAP) thr = cand;
    }
    int ngt = 0, neq = 0;
#pragma unroll
    for (int i = 0; i < 16; ++i) { ngt += (v[i] > thr) ? 1 : 0; neq += (v[i] == thr) ? 1 : 0; }
    int ig = ngt, ie = neq;
#pragma unroll
    for (int o = 1; o < 64; o <<= 1) { const int pg = __shfl_up(ig, o), pe = __shfl_up(ie, o); if (lane >= o) { ig += pg; ie += pe; } }
    __syncthreads();
    if (lane == 63) { sc_gt[w] = ig; sc_eq[w] = ie; }
    __syncthreads();
    int wg_off = 0, we_off = 0, tot_gt = 0;
#pragma unroll
    for (int k = 0; k < 8; ++k) { const int a = sc_gt[k], c2 = sc_eq[k]; if (k < w) { wg_off += a; we_off += c2; } tot_gt += a; }
    const int quota = CAP - tot_gt; int gpre = wg_off + ig - ngt, epre = we_off + ie - neq;
    int* IDX2 = (int*)(F.ws + WS_IDX2); float* GATE2 = (float*)(F.ws + WS_GATE2); int* SLOTOF = (int*)(F.ws + WS_SLOTOF);
#pragma unroll
    for (int i = 0; i < 16; ++i) {
        const bool gt = v[i] > thr, eq = v[i] == thr, sel = gt || (eq && epre < quota);
        const int tok = t * 16 + i; int so = -1;
        if (sel) { const int slot = gpre + (epre < quota ? epre : quota); so = e * 2048 + b * 1024 + slot; IDX2[so] = b * SEQ + tok; GATE2[so] = __uint_as_float(v[i]); }
        SLOTOF[((size_t)b * SEQ + tok) * NE + e] = so;
        gpre += gt ? 1 : 0; epre += eq ? 1 : 0;
    }
    __syncthreads();
}

__device__ __forceinline__ void gather_phase(Frame& F) {
    const int gw = F.vcu * NWAVES + F.wave, NGW = F.G * NWAVES, lane = F.lane;
    const int* IDX2 = (const int*)(F.ws + WS_IDX2); const bf16* H1 = (const bf16*)(F.ws + WS_H1); bf16* XE = (bf16*)(F.ws + WS_XE);
    for (int r = gw; r < NE * 2048; r += NGW) { const int src = IDX2[r];
        const GAS v4u* s = (const GAS v4u*)(H1 + (size_t)src * DM) + lane; GAS v4u* d = (GAS v4u*)(XE + (size_t)r * DM) + lane;
        const v4u a = s[0], c = s[64]; d[0] = a; d[64] = c; }
}

__device__ __forceinline__ void final_phase(Frame& F) {
    const int gw = F.vcu * NWAVES + F.wave, NGW = F.G * NWAVES, lane = F.lane;
    float* OUT = F.out; const f32x2_t2* ST = (const f32x2_t2*)(F.ws + WS_STATS1); const int* SLOTOF = (const int*)(F.ws + WS_SLOTOF); const bf16* YE = (const bf16*)(F.ws + WS_XE);
    for (int r = gw; r < M; r += NGW) {
        GAS f32x4* xr = (GAS f32x4*)(OUT + (size_t)r * DM) + lane; f32x4 v[4]; const f32x2_t2 st = ST[r];
        const int myslot = SLOTOF[(size_t)r * NE + (lane & 15)];
#pragma unroll
        for (int j = 0; j < 4; ++j) { const f32x4 gg = ((const GAS f32x4*)F.in[20])[lane + 64 * j], bb = ((const GAS f32x4*)F.in[21])[lane + 64 * j]; v[j] = ((xr[64 * j] - st.x) * st.y * gg + bb) * ALPHA; }
        for (int e = 0; e < NE; ++e) { const int sl = __shfl(myslot, e);
            if (sl >= 0) { const GAS u32x2_t* yr = (const GAS u32x2_t*)(YE + (size_t)sl * DM) + lane;
#pragma unroll
                for (int j = 0; j < 4; ++j) { const u32x2_t y = yr[64 * j]; v[j].x += bflo(y.x); v[j].y += bfhi(y.x); v[j].z += bflo(y.y); v[j].w += bfhi(y.y); } } }
        float s = 0.f;
#pragma unroll
        for (int j = 0; j < 4; ++j) s += (v[j].x + v[j].y) + (v[j].z + v[j].w);
        const float mean = wave_sum(s) * (1.f / DM); float s2 = 0.f;
#pragma unroll
        for (int j = 0; j < 4; ++j) { v[j] = v[j] - mean; s2 += (v[j].x * v[j].x + v[j].y * v[j].y) + (v[j].z * v[j].z + v[j].w * v[j].w); }
        const float rstd = 1.f / sqrtf(wave_sum(s2) * (1.f / DM) + LN_EPS);
#pragma unroll
        for (int j = 0; j < 4; ++j) { const f32x4 gg = ((const GAS f32x4*)F.in[26])[lane + 64 * j], bb = ((const GAS f32x4*)F.in[27])[lane + 64 * j]; xr[64 * j] = v[j] * rstd * gg + bb; }
    }
}

#ifndef MK_PER_PHASE
#define MK_PER_PHASE 0
#endif
constexpr int N_PHASES = 16;
struct Args { const float* in[28]; float* out; unsigned char* ws; int ph_lo, ph_hi; };
__global__ void __launch_bounds__(NWAVES * 64, 2) mk_fwd(Args args) {
    extern __shared__ __attribute__((aligned(16))) unsigned char lds[];
    Frame F;
    F.lds = (LAS unsigned char*)lds; F.MISC = (volatile LAS unsigned*)(F.lds + MISC_OFF);
    F.tid = threadIdx.x; F.lane = F.tid & 63; F.wave = __builtin_amdgcn_readfirstlane(F.tid >> 6);
    F.G = gridDim.x; { const int bx = blockIdx.x; F.vcu = (F.G % 8 == 0) ? (bx % 8) * (F.G / 8) + bx / 8 : bx; }
    F.ws = args.ws; F.ctl = (gu32*)(args.ws + WS_CTL); F.out = args.out;
#pragma unroll
    for (int i = 0; i < 28; ++i) F.in[i] = args.in[i];
    for (int u = F.tid; u < (LDS_BYTES - LDSCTL_OFF) / 4; u += NWAVES * 64) ((LAS unsigned*)(F.lds + LDSCTL_OFF))[u] = 0u;
    __syncthreads();
    XcdBarrier bar; bar.bar = (unsigned*)(F.ctl + CW_BAR); bar.x = 0; bar.st = nullptr;
    if (!MK_PER_PHASE) bar = xcd_barrier_post((unsigned*)(F.ctl + CW_BAR), F.MISC + 8);
    const int lo = args.ph_lo, hi = args.ph_hi;
    unsigned char* ws = args.ws;
#ifndef PROBE_LO
#define PROBE_LO -1
#define PROBE_HI -1
#endif
    unsigned long long pr_t0 = 0ull, pr_t1 = 0ull;
#define IN(k) (lo <= (k) && (k) < hi)
#define SEAM(k) do { if (IN(k) && IN((k) + 1)) xcd_barrier(bar); if (PROBE_LO >= 0 && (k) + 1 == PROBE_LO) pr_t0 = rt(); if (PROBE_LO >= 0 && (k) + 1 == PROBE_HI) pr_t1 = rt(); } while (0)
    if (PROBE_LO == 0) pr_t0 = rt();
    using pg8::Gemm; using pg8::gemm_phase;
    if (IN(0)) { p0_prologue(F); } SEAM(0);
    if (IN(1)) { Gemm g{(const bf16*)(ws + WS_XN), (const bf16*)(ws + WS_WIN), 1024, 1024, 1024}; InProjOrder S; S.so.init(M, INW, F.G, (int)blockIdx.x);
        EpiInProj E{(bf16*)(ws + WS_Q), (bf16*)(ws + WS_K), (bf16*)(ws + WS_V), (bf16*)(ws + WS_UG2), (bf16*)args.out, (bf16*)(ws + WS_UMETA), (LAS float*)(F.lds + XCH_OFF), (const float*)(ws + WS_ROPE) + 6144, (const float*)(ws + WS_ROPE)};
        gemm_phase<EpiInProj, InProjOrder, true, true>(F.lds + RING_OFF, g, S, E);
        if ((long)3 * F.G + (long)blockIdx.x < 835) main_done(F, CW_DONE + 64 * 1); else bg_convert(F, CW_DONE + 64 * 1, (unsigned)(835 - 3 * F.G)); } SEAM(1);
    if (IN(2)) {
        Gemm g{(const bf16*)(ws + WS_UG2), (const bf16*)(ws + WS_WST), UGP, 512, 512}; SsmStateOrder S{F.G, (int)blockIdx.x}; EpiSsmState E{(float*)(ws + WS_S)};
        gemm_phase<EpiSsmState, SsmStateOrder, true, true>(F.lds + RING_OFF, g, S, E);
        if (blockIdx.x < 64) main_done(F, CW_DONE + 64 * 2); else { if (blockIdx.x < 192) mext_item(F, (int)blockIdx.x - 64); bg_convert(F, CW_DONE + 64 * 2, 64u); } } SEAM(2);
    if (IN(3)) { ssm_scan(F); __syncthreads();
        const attn_body::AttnTensors AT{(const attn_body::bf16*)(ws + WS_Q), (const attn_body::bf16*)(ws + WS_K), (const attn_body::bf16*)(ws + WS_V), (attn_body::bf16*)(ws + WS_Q)};
        const attn_body::StaticOrder S((int)F.G, (int)blockIdx.x);
        attn_body::attn_phase<attn_body::StaticOrder>((char*)lds + RING_OFF, AT, S); } SEAM(3);
    if (IN(4)) { Gemm g{(const bf16*)(ws + WS_UG2), (const bf16*)(ws + WS_MEXT), UGP, UGP, UGP}; SsmYOrder S{F.G, (int)blockIdx.x}; EpiSsmY E{(bf16*)(ws + WS_YG)};
        gemm_phase<EpiSsmY, SsmYOrder, true, true>(F.lds + RING_OFF, g, S, E);
        if (blockIdx.x < 128) main_done(F, CW_DONE + 64 * 4); else bg_convert(F, CW_DONE + 64 * 4, 128u); } SEAM(4);
    if (IN(5)) { Gemm g{(const bf16*)(ws + WS_YG), (const bf16*)(ws + WS_WGLU), 512, 512, 512}; pg8::StaticOrder S; S.init(M, 512, F.G, (int)blockIdx.x); EpiGlu E{(const bf16*)(ws + WS_YG), F.in[16], (bf16*)(ws + WS_Z)};
        gemm_phase<EpiGlu, pg8::StaticOrder, true, true>(F.lds + RING_OFF, g, S, E);
        if (blockIdx.x < 128) main_done(F, CW_DONE + 64 * 5); else bg_convert(F, CW_DONE + 64 * 5, 128u); } SEAM(5);
    if (IN(6)) { Gemm g{(const bf16*)(ws + WS_Q), (const bf16*)(ws + WS_WAB), 512, 512, 512}; pg8::StaticOrder S; S.init(M, 1024, F.G, (int)blockIdx.x); EpiBranch<0> E{(const bf16*)args.out, nullptr, (bf16*)(ws + WS_T1)};
        gemm_phase<EpiBranch<0>, pg8::StaticOrder, true, true>(F.lds + RING_OFF, g, S, E); } SEAM(6);
    if (IN(7)) { Gemm g{(const bf16*)(ws + WS_Z), (const bf16*)(ws + WS_WSB), 512, 512, 512}; pg8::StaticOrder S; S.init(M, 1024, F.G, (int)blockIdx.x); EpiBranch<1> E{(const bf16*)args.out, (const bf16*)(ws + WS_T1), (bf16*)(ws + WS_MERGED)};
        gemm_phase<EpiBranch<1>, pg8::StaticOrder, true, true>(F.lds + RING_OFF, g, S, E); } SEAM(7);
    if (IN(8)) { Gemm g{(const bf16*)(ws + WS_MERGED), (const bf16*)(ws + WS_WO), 1024, 1024, 1024}; pg8::StaticOrder S; S.init(M, 1024, F.G, (int)blockIdx.x);
        EpiPre1 E{F.in[0], F.in[2], F.in[3], (const f32x2_t2*)(ws + WS_STATS0), args.out};
        gemm_phase<EpiPre1, pg8::StaticOrder, true, true>(F.lds + RING_OFF, g, S, E); } SEAM(8);
    if (IN(9)) { ln1_router(F); } SEAM(9);
    if (IN(10)) { topk_phase(F); if (blockIdx.x < BATCH * NE) main_done(F, CW_DONE + 64 * 10); else bg_convert(F, CW_DONE + 64 * 10, (unsigned)(BATCH * NE)); } SEAM(10);
    if (IN(11)) { gather_phase(F); bg_convert(F, 0, 0u); } SEAM(11);
    if (IN(12)) { Gemm g{(const bf16*)(ws + WS_XE), (const bf16*)(ws + WS_WGU), 1024, 1024, 1024}; MoeOrder S{F.G, (int)blockIdx.x, 8, 8}; EpiMoe1 E{(bf16*)(ws + WS_HB)};
        gemm_phase<EpiMoe1, MoeOrder, true, true>(F.lds + RING_OFF, g, S, E); } SEAM(12);
    if (IN(13)) { Gemm g{(const bf16*)(ws + WS_HB), (const bf16*)(ws + WS_WD), 1024, 1024, 1024}; MoeOrder S{F.G, (int)blockIdx.x, 8, 4}; EpiMoe2 E{(const float*)(ws + WS_GATE2), (bf16*)(ws + WS_XE)};
        gemm_phase<EpiMoe2, MoeOrder, true, true>(F.lds + RING_OFF, g, S, E); } SEAM(13);
    if (IN(14)) { final_phase(F); }
    if (PROBE_LO >= 0) { if (PROBE_HI == 15) pr_t1 = rt(); if (blockIdx.x == 0) { const unsigned long long span = (pr_t1 - pr_t0) * 8ull, ts = rt(); while (rt() - ts < span) __builtin_amdgcn_s_sleep(8); } }
#undef IN
#undef SEAM
}

extern "C" void kernel_launch(void* const* d_in, const int* in_sizes, int n_in, void* d_out, int out_size, void* d_ws, size_t ws_size, hipStream_t stream) {
    static int grid = 0;
    if (grid == 0) {
        int dev = 0, cus = 0;
        if (hipGetDevice(&dev) != hipSuccess || hipDeviceGetAttribute(&cus, hipDeviceAttributeMultiprocessorCount, dev) != hipSuccess) { fprintf(stderr, "kernel_launch: device query failed\n"); grid = -1; return; }
        if (hipFuncSetAttribute((const void*)mk_fwd, hipFuncAttributeMaxDynamicSharedMemorySize, LDS_BYTES) != hipSuccess) { fprintf(stderr, "kernel_launch: hipFuncSetAttribute failed\n"); grid = -1; return; }
        (void)hipGetLastError();
        grid = cus;
        if (grid != 256 || n_in != 28 || ws_size < WS_END) fprintf(stderr, "kernel_launch: unexpected geometry: %d CUs, %d inputs, %zu bytes of workspace\n", cus, n_in, ws_size);
    }
    if (grid < 0) return;
    (void)hipMemsetAsync((char*)d_ws + WS_CTL, 0, CTL_ZERO_BYTES, stream);
    Args a; memset(&a, 0, sizeof(a));
    for (int i = 0; i < 28; ++i) a.in[i] = (const float*)d_in[i];
    a.out = (float*)d_out; a.ws = (unsigned char*)d_ws;
#if MK_PER_PHASE
    for (int p = 0; p < N_PHASES - 1; ++p) { a.ph_lo = p; a.ph_hi = p + 1; hipLaunchKernelGGL(mk_fwd, dim3(grid), dim3(NWAVES * 64), LDS_BYTES, stream, a); }
#else
    a.ph_lo = 0; a.ph_hi = N_PHASES; hipLaunchKernelGGL(mk_fwd, dim3(grid), dim3(NWAVES * 64), LDS_BYTES, stream, a);
#endif
}
```

```cpp
#include <hip/hip_runtime.h>
#include <cstdio>
#include <cstdint>
#include <cstring>
namespace pg8 {
#define PG8_LAS __attribute__((address_space(3)))
typedef unsigned short bf16_t;
typedef short bf16x8 __attribute__((ext_vector_type(8)));
typedef float f32x4 __attribute__((ext_vector_type(4)));
typedef unsigned u32x4 __attribute__((ext_vector_type(4)));
constexpr int BM = 256, BK = 64, HALF = 128, HTB = HALF * BK * 2  , STAGE_BYTES = 8 * HTB, NXCD = 8, WGM = 8;

__host__ __device__ __forceinline__ int lds_byte(int r, int c) { const int st = (r >> 4) * 2 + (c >> 5), rr = r & 15, cc = c & 31, ob = rr * 64 + cc * 2; return st * 1024 + (ob ^ (((ob >> 9) & 1) << 5)); }
__host__ __device__ __forceinline__ void stage_rc(int b, int& R, int& C) { const int st = b / 1024, sb = b % 1024, swz = sb ^ (((sb >> 9) & 1) << 5); R = (st >> 1) * 16 + swz / 64; C = (st & 1) * 32 + (swz % 64) / 2; }
__host__ __device__ __forceinline__ int perm32(int rho) { const int n = rho >> 4, i = rho & 15; return 8 * (i >> 2) + 4 * n + (i & 3); }

struct Unit { int pm, pn; };
struct Gemm { const bf16_t* A; const bf16_t* Bt; int lda, ldb, K; };

struct StaticOrder {
    int nM, nN, nwg, G, c;
    __host__ __device__ void init(int M, int N, int G_, int c_) { nM = M / BM; nN = N / BM; nwg = nM * nN; G = G_; c = c_; }
    __host__ __device__ bool next(int i, Unit& u) const {
        const long L = (long)i * G + c; if (L >= nwg) return false;
        int wgid = (int)L; { const int q = nwg / NXCD, r = nwg % NXCD, xcd = wgid % NXCD, off = wgid / NXCD; wgid = (xcd < r ? xcd * (q + 1) : r * (q + 1) + (xcd - r) * q) + off; }
        const int nig = WGM * nN, gid = wgid / nig, fm = gid * WGM, gsz = (nM - fm) < WGM ? (nM - fm) : WGM;
        u.pm = fm + ((wgid % nig) % gsz); u.pn = (wgid % nig) / gsz; return true;
    }
    __device__ __forceinline__ void a_ready(const Unit&) const {}
    __device__ __forceinline__ void done(const Unit&) const {}
};

__device__ __forceinline__ unsigned cvt_pk_bf16(float lo, float hi) { unsigned r; asm volatile("v_cvt_pk_bf16_f32 %0, %1, %2" : "=v"(r) : "v"(lo), "v"(hi)); return r; }
typedef float f32x2 __attribute__((ext_vector_type(2)));
template <class Epi, class Sched, bool ALIGN_EPI = false, bool SP2 = false>
__device__ __forceinline__ void gemm_phase(PG8_LAS unsigned char* lds, const Gemm g, const Sched& S, const Epi& E) {
    const int tid = threadIdx.x, wid = __builtin_amdgcn_readfirstlane(tid >> 6), lane = tid & 63, wr = wid >> 2, wc = wid & 3, fr = lane & 15, fq = lane >> 4;
    const int K = g.K, nt = K / BK;
    unsigned voffA[2], voffB[2];
#pragma unroll
    for (int i = 0; i < 2; ++i) { int R, C; stage_rc(tid * 16 + i * 8192, R, C); const int Rb = Epi::PERM ? ((R & ~31) + perm32(R & 31)) : R;
        voffA[i] = (unsigned)(R * g.lda + C) * 2u; voffB[i] = (unsigned)(Rb * g.ldb + C) * 2u; }
    const size_t kstep = (size_t)(BK * 2);
    const size_t hstepA = (size_t)HALF * g.lda * 2, hstepB = (size_t)HALF * g.ldb * 2;
    const size_t tstepA = 2 * hstepA, tstepB = 2 * hstepB;
    const unsigned ldsw = (unsigned)wid * 1024u;
    const int aoff = lds_byte(wr * 64 + fr, fq * 8), boff = lds_byte(wc * 32 + fr, fq * 8);
#define PG8_SA(b, h) (((b) * 2 + (h)) * HTB)
#define PG8_SB(b, h) ((4 + (b) * 2 + (h)) * HTB)
#define PG8_STAGE(bufoff, gbase, voff) do { _Pragma("unroll") for (int _i = 0; _i < 2; ++_i) \
        __builtin_amdgcn_global_load_lds((const unsigned*)((const char*)(gbase) + (voff)[_i]), (PG8_LAS unsigned*)(lds + (bufoff) + ldsw + _i * 8192), 16, 0, 0); } while (0)
#define PG8_LDA(dst, b, h) do { _Pragma("unroll") for (int m = 0; m < 4; ++m) _Pragma("unroll") for (int k = 0; k < 2; ++k) dst[m][k] = *(const PG8_LAS bf16x8*)(lds + PG8_SA(b, h) + aoff + m * 2048 + k * 1024); } while (0)
#define PG8_LDB(dst, b, h) do { _Pragma("unroll") for (int n = 0; n < 2; ++n) _Pragma("unroll") for (int k = 0; k < 2; ++k) dst[n][k] = *(const PG8_LAS bf16x8*)(lds + PG8_SB(b, h) + boff + n * 2048 + k * 1024); } while (0)
#define PG8_MMA(ai, bj, At, Bt) do { __builtin_amdgcn_s_setprio(1); _Pragma("unroll") for (int m = 0; m < 4; ++m) _Pragma("unroll") for (int n = 0; n < 2; ++n) _Pragma("unroll") for (int k = 0; k < 2; ++k) \
        acc[ai][bj][m][n] = __builtin_amdgcn_mfma_f32_16x16x32_bf16(Bt[n][k], At[m][k], acc[ai][bj][m][n], 0, 0, 0); __builtin_amdgcn_s_setprio(0); } while (0)
#define PG8_WAIT_V(n) asm volatile("s_waitcnt vmcnt(" #n ")" ::: "memory")
#define PG8_WAIT_L(n) asm volatile("s_waitcnt lgkmcnt(" #n ")" ::: "memory")
#define PG8_BAR __builtin_amdgcn_s_barrier()
#define PG8_SCHED __builtin_amdgcn_sched_barrier(0)
    Unit cur, nxt; int ui = 0;
    if (!S.next(0, cur)) return;
    f32x4 acc[2][2][4][2];
#pragma unroll
    for (int a = 0; a < 2; ++a)
#pragma unroll
        for (int b = 0; b < 2; ++b)
#pragma unroll
            for (int m = 0; m < 4; ++m)
#pragma unroll
                for (int n = 0; n < 2; ++n) acc[a][b][m][n] = (f32x4){0.f, 0.f, 0.f, 0.f};
    bf16x8 At[4][2], B0[2][2], B1[2][2];
    const char* cA = (const char*)g.A + (size_t)cur.pm * tstepA; const char* cB = (const char*)g.Bt + (size_t)cur.pn * tstepB;
    S.a_ready(cur);
    if constexpr (SP2) {
        PG8_STAGE(PG8_SB(0, 0), cB, voffB); PG8_STAGE(PG8_SB(0, 1), cB + hstepB, voffB); PG8_STAGE(PG8_SA(0, 0), cA, voffA); PG8_STAGE(PG8_SA(0, 1), cA + hstepA, voffA);
        if (wr == 1) PG8_BAR;
        PG8_WAIT_V(2); PG8_BAR;
        PG8_STAGE(PG8_SB(1, 0), cB + kstep, voffB); PG8_STAGE(PG8_SA(1, 0), cA + kstep, voffA); PG8_STAGE(PG8_SB(1, 1), cB + hstepB + kstep, voffB);
        PG8_WAIT_V(6); PG8_BAR;
    } else {
        PG8_STAGE(PG8_SB(0, 0), cB, voffB); PG8_STAGE(PG8_SA(0, 0), cA, voffA); PG8_STAGE(PG8_SB(0, 1), cB + hstepB, voffB); PG8_STAGE(PG8_SA(0, 1), cA + hstepA, voffA);
        if (wr == 1) PG8_BAR;
        PG8_WAIT_V(4); PG8_BAR;
        PG8_STAGE(PG8_SB(1, 0), cB + kstep, voffB); PG8_STAGE(PG8_SA(1, 0), cA + kstep, voffA); PG8_STAGE(PG8_SB(1, 1), cB + hstepB + kstep, voffB);
        PG8_WAIT_V(6); PG8_BAR;
    }
    for (;;) {
        const bool has_next = S.next(ui + 1, nxt);
        const char* nA = has_next ? (const char*)g.A + (size_t)nxt.pm * tstepA : cA; const char* nB = has_next ? (const char*)g.Bt + (size_t)nxt.pn * tstepB : cB;
        for (int t = 0; t < nt; t += 2) {
            const bool last = (t == nt - 2);
            const char* a1 = cA + (size_t)(t + 1) * kstep;
            const char* a2 = last ? nA : cA + (size_t)(t + 2) * kstep; const char* b2 = last ? nB : cB + (size_t)(t + 2) * kstep;
            const char* a3 = a2 + kstep; const char* b3 = b2 + kstep;
            if (last && has_next) S.a_ready(nxt);
            if constexpr (SP2) {
            PG8_LDB(B0, 0, 0); PG8_LDB(B1, 0, 1); PG8_SCHED; PG8_LDA(At, 0, 0); PG8_STAGE(PG8_SA(1, 1), a1 + hstepA, voffA);
            PG8_WAIT_V(8); PG8_WAIT_L(0); PG8_BAR; PG8_MMA(0, 0, At, B0); PG8_MMA(0, 1, At, B1); PG8_BAR; PG8_SCHED;
            PG8_LDA(At, 0, 1); PG8_STAGE(PG8_SB(0, 0), b2, voffB); PG8_STAGE(PG8_SB(0, 1), b2 + hstepB, voffB); PG8_STAGE(PG8_SA(0, 0), a2, voffA);
            PG8_WAIT_V(8); PG8_WAIT_L(0); PG8_BAR; PG8_MMA(1, 0, At, B0); PG8_MMA(1, 1, At, B1); PG8_BAR; PG8_SCHED;
            PG8_LDB(B0, 1, 0); PG8_LDB(B1, 1, 1); PG8_SCHED; PG8_LDA(At, 1, 0); PG8_STAGE(PG8_SA(0, 1), a2 + hstepA, voffA);
            PG8_WAIT_V(8); PG8_WAIT_L(0); PG8_BAR; PG8_MMA(0, 0, At, B0); PG8_MMA(0, 1, At, B1); PG8_BAR; PG8_SCHED;
            PG8_LDA(At, 1, 1); PG8_STAGE(PG8_SB(1, 0), b3, voffB); PG8_STAGE(PG8_SB(1, 1), b3 + hstepB, voffB); PG8_STAGE(PG8_SA(1, 0), a3, voffA);
            PG8_WAIT_V(8); PG8_WAIT_L(0); PG8_BAR; PG8_MMA(1, 0, At, B0); PG8_MMA(1, 1, At, B1); PG8_BAR; PG8_SCHED;
            } else {
            PG8_LDB(B0, 0, 0); PG8_SCHED; PG8_LDA(At, 0, 0); PG8_STAGE(PG8_SA(1, 1), a1 + hstepA, voffA);
            PG8_WAIT_L(8); PG8_BAR; PG8_WAIT_L(0); PG8_MMA(0, 0, At, B0); PG8_BAR; PG8_SCHED;
            PG8_LDB(B1, 0, 1); PG8_STAGE(PG8_SB(0, 0), b2, voffB);
            PG8_BAR; PG8_WAIT_L(0); PG8_MMA(0, 1, At, B1); PG8_BAR;
            PG8_LDA(At, 0, 1); PG8_STAGE(PG8_SA(0, 0), a2, voffA);
            PG8_BAR; PG8_WAIT_L(0); PG8_MMA(1, 0, At, B0); PG8_BAR; PG8_SCHED;
            PG8_STAGE(PG8_SB(0, 1), b2 + hstepB, voffB);
            PG8_WAIT_V(6); PG8_BAR; PG8_MMA(1, 1, At, B1); PG8_BAR;
            PG8_LDB(B0, 1, 0); PG8_SCHED; PG8_LDA(At, 1, 0); PG8_STAGE(PG8_SA(0, 1), a2 + hstepA, voffA);
            PG8_WAIT_L(8); PG8_BAR; PG8_WAIT_L(0); PG8_MMA(0, 0, At, B0); PG8_BAR; PG8_SCHED;
            PG8_LDB(B1, 1, 1); PG8_STAGE(PG8_SB(1, 0), b3, voffB);
            PG8_BAR; PG8_WAIT_L(0); PG8_MMA(0, 1, At, B1); PG8_BAR;
            PG8_LDA(At, 1, 1); PG8_STAGE(PG8_SA(1, 0), a3, voffA);
            PG8_BAR; PG8_WAIT_L(0); PG8_MMA(1, 0, At, B0); PG8_BAR; PG8_SCHED;
            PG8_STAGE(PG8_SB(1, 1), b3 + hstepB, voffB);
            PG8_WAIT_V(6); PG8_BAR; PG8_MMA(1, 1, At, B1); PG8_BAR;
            }
        }
        if constexpr (ALIGN_EPI) { if (wr == 0) PG8_BAR; }
        if constexpr (!Epi::AFTER_DRAIN) { E(acc, cur, wr, wc, fr, fq); S.done(cur); }
        if (!has_next) break;
#pragma unroll
        for (int a = 0; a < 2; ++a)
#pragma unroll
            for (int b = 0; b < 2; ++b)
#pragma unroll
                for (int m = 0; m < 4; ++m)
#pragma unroll
                    for (int n = 0; n < 2; ++n) acc[a][b][m][n] = (f32x4){0.f, 0.f, 0.f, 0.f};
        cur = nxt; cA = nA; cB = nB; ++ui;
        if constexpr (ALIGN_EPI) { if (wr == 1) PG8_BAR; }
    }
    PG8_WAIT_V(0);
    if constexpr (!ALIGN_EPI) { if (wr == 0) PG8_BAR; }
    PG8_BAR;
    if constexpr (Epi::AFTER_DRAIN) { E.fused(acc, cur, wr, wc, fr, fq, lds, wid, lane); S.done(cur); }
#undef PG8_SA
#undef PG8_SB
#undef PG8_STAGE
#undef PG8_LDA
#undef PG8_LDB
#undef PG8_MMA
#undef PG8_WAIT_V
#undef PG8_WAIT_L
#undef PG8_BAR
#undef PG8_SCHED
}
}
#define PG8_SP2 true
#define PG8_ALIGN true
#include <hip/hip_bf16.h>
#include <cmath>
namespace attn_body {
using bf16=__hip_bfloat16;
using bf16x8=__attribute__((ext_vector_type(8)))short;
using s16x4=__attribute__((ext_vector_type(4)))short;
using f32x16=__attribute__((ext_vector_type(16)))float;
using u32x4=__attribute__((ext_vector_type(4)))unsigned;
constexpr int BATCH=2,NHEAD=8,SEQ=8192,D=64,DMQ=NHEAD*D,DMK=128,KVROWS=8320,KVALID=8208;
constexpr int NW=8,QBLK=32,QB=QBLK*NW,KVBLK=64,NQB=SEQ/QB;
constexpr int ATTN_PITCH=DMQ, ATTN_UNIT_ROWS=QB;
__device__ __forceinline__ int crow(int r,int hi){return (r&3)+8*(r>>2)+4*hi;}
#define SBAR() __builtin_amdgcn_sched_barrier(0)
__device__ __forceinline__ void cmask(f32x16&p0,f32x16&p1,int t,int hi){
  const float NEG=-INFINITY; int kb=64*t+4*hi;
  #pragma unroll
  for(int r=0;r<16;++r){int kv=kb+(r&3)+8*(r>>2); if(kv>=KVALID)p0[r]=NEG; if(kv+32>=KVALID)p1[r]=NEG;}
}

constexpr int NSLOT=3, SLOTB=8192;
constexpr int LDS_K=0, LDS_V=NSLOT*SLOTB, LDS_WS=2*NSLOT*SLOTB, LDS_OST=LDS_WS+NW*64*4, LDS_BYTES=LDS_OST+NW*4096;
constexpr float C2=0.125f*1.4426950408889634f;
__device__ __forceinline__ void glds16(const void*gsrc,unsigned lds_dst){unsigned keep;
  asm volatile("s_mov_b32 %0, m0\n\ts_mov_b32 m0, %2\n\ts_nop 0\n\tglobal_load_lds_dwordx4 %1, off\n\ts_mov_b32 m0, %0":"=&s"(keep):"v"(gsrc),"s"(lds_dst):"memory");}
__device__ __forceinline__ float max3f(float a,float b,float c){float r;asm("v_max3_f32 %0, %1, %2, %3":"=v"(r):"v"(a),"v"(b),"v"(c));return r;}
__device__ __forceinline__ float max2f(float a,float b){float r;asm("v_max_f32_e32 %0, %1, %2":"=v"(r):"v"(a),"v"(b));return r;}
__device__ __forceinline__ float fadd_s(float a,float b){float r;asm("v_add_f32_e32 %0, %1, %2":"=v"(r):"v"(a),"v"(b));return r;}
__device__ __forceinline__ float fsub_s(float a,float b){float r;asm("v_sub_f32_e32 %0, %1, %2":"=v"(r):"v"(a),"v"(b));return r;}
typedef float f32x2_t __attribute__((ext_vector_type(2))); typedef __bf16 bf16x2_t __attribute__((ext_vector_type(2)));
__device__ __forceinline__ unsigned cvtpk_s(float lo,float hi){f32x2_t v={lo,hi};bf16x2_t b=__builtin_convertvector(v,bf16x2_t);return __builtin_bit_cast(unsigned,b);}
#define WAIT_BAR(N) asm volatile("s_waitcnt vmcnt(" #N ") lgkmcnt(0)\n\ts_barrier":::"memory")

__device__ __forceinline__ void qkt(f32x16&p0,f32x16&p1,const char*Kslot,const bf16x8*qr,const f32x16&negm,int r32,int hi){
  const char*kb=Kslot+hi*1024+r32*16;
  #pragma unroll
  for(int d0=0;d0<4;++d0){
    const bf16x8 b0=*reinterpret_cast<const bf16x8*>(kb+d0*2048);
    const bf16x8 b1=*reinterpret_cast<const bf16x8*>(kb+d0*2048+512);
    if(d0==0){p0=__builtin_amdgcn_mfma_f32_32x32x16_bf16(b0,qr[0],negm,0,0,0);p1=__builtin_amdgcn_mfma_f32_32x32x16_bf16(b1,qr[0],negm,0,0,0);}
    else{p0=__builtin_amdgcn_mfma_f32_32x32x16_bf16(b0,qr[d0],p0,0,0,0);p1=__builtin_amdgcn_mfma_f32_32x32x16_bf16(b1,qr[d0],p1,0,0,0);}}
}
typedef __attribute__((address_space(3))) const char* lds_cptr;
typedef short v4i16_t __attribute__((ext_vector_type(4)));
__device__ __forceinline__ void kload8(bf16x8*kf,lds_cptr kp){
  kf[0]=*(const __attribute__((address_space(3))) bf16x8*)(kp);      kf[1]=*(const __attribute__((address_space(3))) bf16x8*)(kp+512);
  kf[2]=*(const __attribute__((address_space(3))) bf16x8*)(kp+2048); kf[3]=*(const __attribute__((address_space(3))) bf16x8*)(kp+2560);
  kf[4]=*(const __attribute__((address_space(3))) bf16x8*)(kp+4096); kf[5]=*(const __attribute__((address_space(3))) bf16x8*)(kp+4608);
  kf[6]=*(const __attribute__((address_space(3))) bf16x8*)(kp+6144); kf[7]=*(const __attribute__((address_space(3))) bf16x8*)(kp+6656);
}
__device__ __forceinline__ void kload2(bf16x8*kf,lds_cptr kp,int j){ kf[2*j]=*(const __attribute__((address_space(3))) bf16x8*)(kp+j*2048); kf[2*j+1]=*(const __attribute__((address_space(3))) bf16x8*)(kp+j*2048+512); }
__device__ __forceinline__ s16x4 vtr(lds_cptr p){ return __builtin_bit_cast(s16x4,__builtin_amdgcn_ds_read_tr16_b64_v4i16((__attribute__((address_space(3))) v4i16_t*)p)); }
__device__ __forceinline__ float rowmax(const f32x16&p0,const f32x16&p1){
  float a=max3f(p0[0],p0[1],p1[0]),b=max3f(p0[2],p0[3],p1[1]);a=max3f(a,p1[2],p1[3]);
  #pragma unroll
  for(int r=4;r<16;r+=4){a=max3f(a,p0[r],p0[r+1]);b=max3f(b,p0[r+2],p0[r+3]);a=max3f(a,p1[r],p1[r+1]);b=max3f(b,p1[r+2],p1[r+3]);}
  const float m=max2f(a,b);
  auto rr=__builtin_amdgcn_permlane32_swap(__float_as_uint(m),__float_as_uint(m),false,false);
  return max2f(__uint_as_float(rr[0]),__uint_as_float(rr[1]));
}
__device__ __forceinline__ void pv(f32x16*o,int vb,bf16x8 pa0,bf16x8 pa1,bf16x8 pa2,bf16x8 pa3){
  #pragma unroll
  for(int d0=0;d0<2;++d0){s16x4 lo[4],hi[4];
    #pragma unroll
    for(int ks=0;ks<4;++ks){
      asm volatile("ds_read_b64_tr_b16 %0,%1 offset:%c2":"=&v"(lo[ks]):"v"(vb),"i"(d0*4096+ks*1024):"memory");
      asm volatile("ds_read_b64_tr_b16 %0,%1 offset:%c2":"=&v"(hi[ks]):"v"(vb),"i"(d0*4096+ks*1024+512):"memory");}
    asm volatile("s_waitcnt lgkmcnt(0)":::"memory");SBAR();
    #define PK(k) (bf16x8){lo[k][0],lo[k][1],lo[k][2],lo[k][3],hi[k][0],hi[k][1],hi[k][2],hi[k][3]}
    o[d0]=__builtin_amdgcn_mfma_f32_32x32x16_bf16(pa0,PK(0),o[d0],0,0,0);
    o[d0]=__builtin_amdgcn_mfma_f32_32x32x16_bf16(pa1,PK(1),o[d0],0,0,0);
    o[d0]=__builtin_amdgcn_mfma_f32_32x32x16_bf16(pa2,PK(2),o[d0],0,0,0);
    o[d0]=__builtin_amdgcn_mfma_f32_32x32x16_bf16(pa3,PK(3),o[d0],0,0,0);
    #undef PK
  }
}

#ifndef ATTN_STORE16
#define ATTN_STORE16(p,v) (*(u32x4*)(p)=(v))
#endif
template<int THRL> __device__ __forceinline__ void attn_unit(int b,int h,int qb,const bf16*Q,const bf16*__restrict__ K,const bf16*__restrict__ V,bf16*O,char*shm){
  const int tid=threadIdx.x,lane=tid&63,r32=lane&31,hi=lane>>5; const int wid=__builtin_amdgcn_readfirstlane(tid>>6);
  const long rowbase=(long)b*SEQ, kvbase=(long)b*KVROWS; const int q0=qb*QB;
  const bf16*Qw=Q+(rowbase+q0+wid*QBLK)*DMQ+h*D;
  const bf16*Kh=K+kvbase*DMK+(h>>2)*D,*Vh=V+kvbase*DMK+(h>>2)*D;
  const unsigned lds0=(unsigned)(uintptr_t)shm;
  float*wsf=(float*)(shm+LDS_WS)+wid*64;
  const bf16*ksrc=Kh+(long)lane*DMK+wid*8;
  const bf16*vsrc=Vh+(long)(16*(wid&3)+(lane>>2))*DMK+(wid>>2)*32+(lane&3)*8;
  const unsigned kdst=lds0+LDS_K+wid*1024, vdst=lds0+LDS_V+wid*1024;
  #define DMA_K(t,slot) glds16(ksrc+(long)(t)*KVBLK*DMK,(unsigned)__builtin_amdgcn_readfirstlane(kdst+(slot)))
  #define DMA_V(t,slot) glds16(vsrc+(long)(t)*KVBLK*DMK,(unsigned)__builtin_amdgcn_readfirstlane(vdst+(slot)))
  const int vb0=(int)(lds0+LDS_V)+((lane>>4)&1)*32+(lane&3)*8+(4*hi+((lane&15)>>2))*64;
  const char*Kbase=shm+LDS_K; bf16x8 kf[8];
  const lds_cptr shm3=(lds_cptr)shm; const lds_cptr kp0=shm3+LDS_K+hi*1024+r32*16; const lds_cptr vp0=shm3+LDS_V+((lane>>4)&1)*32+(lane&3)*8+(4*hi+((lane&15)>>2))*64;
  constexpr int NT=KVROWS/KVBLK;
  DMA_K(0,0);DMA_V(0,0);DMA_K(1,SLOTB);
  bf16x8 qr[4];
  #pragma unroll
  for(int d0=0;d0<4;++d0)qr[d0]=*reinterpret_cast<const bf16x8*>(&Qw[(long)r32*DMQ+d0*16+hi*8]);
  float mhat=0.f,l_reg=0.f;f32x16 o[2];o[0]=f32x16{};o[1]=f32x16{};f32x16 negm=f32x16{};asm volatile("":"+v"(negm));
    #define CMASK(P0,P1,t) do{ if((t)>=NT-4)cmask(P0,P1,(t),hi); }while(0)
  bool resc=false;
  #define START(P0,P1) do{ const float rm=rowmax(P0,P1); resc=false; \
    { const float dl=rm; mhat=fadd_s(mhat,dl); \
      _Pragma("unroll") for(int r=0;r<16;++r){P0[r]=fsub_s(P0[r],dl);P1[r]=fsub_s(P1[r],dl);} \
      _Pragma("unroll") for(int r=0;r<16;++r)negm[r]=-mhat; asm volatile("":"+v"(negm)); } \
    _Pragma("unroll") for(int r=0;r<16;++r)P0[r]=__builtin_amdgcn_exp2f(P0[r]); }while(0)
  #define RESC() do{ if(resc){ asm volatile("s_waitcnt lgkmcnt(0)":::"memory"); \
      _Pragma("unroll") for(int d_=0;d_<2;++d_) _Pragma("unroll") for(int r=0;r<16;++r)o[d_][r]*=wsf[crow(r,hi)]; } }while(0)
  f32x16 pA0,pA1,pB0,pB1;
  int sl_prev=0,sl_cur=0,sl_next=SLOTB;
  #define ROT() do{sl_prev=sl_cur;sl_cur=sl_next;sl_next=(sl_next==(NSLOT-1)*SLOTB)?0:sl_next+SLOTB;}while(0)
  DMA_K(2,2*SLOTB);
  WAIT_BAR(3);
  qkt(pA0,pA1,Kbase,qr,negm,r32,hi);asm volatile("s_nop 15\n\ts_nop 7":"+v"(pA0),"+v"(pA1));CMASK(pA0,pA1,0);
  START(pA0,pA1);
  _Pragma("unroll") for(int r=0;r<16;++r)pA1[r]=__builtin_amdgcn_exp2f(pA1[r]);
  WAIT_BAR(0);
  DMA_K(3,0);DMA_V(1,SLOTB);
  ROT();
  kload8(kf,kp0+sl_cur);
  WAIT_BAR(2);
  s16x4 vlo[8],vhi[8]; u32x4 pw0,pw1,pw2,pw3;
  #define PKW(P,B) cvtpk_s(P[B],P[B+1])
  #define PAF(k) __builtin_bit_cast(bf16x8,pw##k)
  #define VFR(i) (bf16x8){vlo[i][0],vlo[i][1],vlo[i][2],vlo[i][3],vhi[i][0],vhi[i][1],vhi[i][2],vhi[i][3]}
  #define PIN(x) asm volatile("":"+v"(x))
  #define MX3(a,b,c) __builtin_fmaxf(__builtin_fmaxf((a),(b)),(c))
  #define GAPA(MF,A0,A1,A2,A3,W0,W1,PW) do{ MF; sacc+=A0; sacc+=A1; sacc+=A2; sacc+=A3; PIN(sacc); W0; W1; PIN(PW); SBAR(); }while(0)
  #define EX(v) __builtin_amdgcn_exp2f(v)
  #define GAPB(MF,X,B) do{ MF; X[B]=EX(X[B]); X[B+1]=EX(X[B+1]); X[B+2]=EX(X[B+2]); X[B+3]=EX(X[B+3]); PIN(X); SBAR(); }while(0)
  #define VRD(i) do{ vlo[i]=vtr(vp_+(((i)>>2)*4096+((i)&3)*1024)); vhi[i]=vtr(vp_+(((i)>>2)*4096+((i)&3)*1024+512)); }while(0)
  #define KRD(G,j) do{ if(G){ kload2(kf,kp0+sl_next,j); SBAR(); } }while(0)
  #define STEP(C0,C1,P0,P1,t,GK,GV,GL) do{ SBAR(); \
    const lds_cptr vp_=vp0+sl_prev; \
    VRD(0); SBAR(); float sacc=(P0[0]+P0[1]); \
    GAPA(C0=__builtin_amdgcn_mfma_f32_32x32x16_bf16(kf[0],qr[0],negm,0,0,0), P0[2],P0[3],P0[4],P0[5],     pw0[0]=PKW(P0,0), pw0[1]=PKW(P0,2), pw0); \
    VRD(4); SBAR(); GAPA(C1=__builtin_amdgcn_mfma_f32_32x32x16_bf16(kf[1],qr[0],negm,0,0,0), P0[6],P0[7],P0[8],P0[9],     pw0[2]=PKW(P0,4), pw0[3]=PKW(P0,6), pw0); \
    VRD(1); SBAR(); GAPA(C0=__builtin_amdgcn_mfma_f32_32x32x16_bf16(kf[2],qr[1],C0,0,0,0),   P0[10],P0[11],P0[12],P0[13], pw1[0]=PKW(P0,8), pw1[1]=PKW(P0,10), pw1); \
    VRD(5); SBAR(); GAPA(C1=__builtin_amdgcn_mfma_f32_32x32x16_bf16(kf[3],qr[1],C1,0,0,0),   P0[14],P0[15],P1[0],P1[1],   pw1[2]=PKW(P0,12),pw1[3]=PKW(P0,14), pw1); \
    VRD(2); SBAR(); GAPA(C0=__builtin_amdgcn_mfma_f32_32x32x16_bf16(kf[4],qr[2],C0,0,0,0),   P1[2],P1[3],P1[4],P1[5],     pw2[0]=PKW(P1,0), pw2[1]=PKW(P1,2), pw2); \
    VRD(6); SBAR(); GAPA(C1=__builtin_amdgcn_mfma_f32_32x32x16_bf16(kf[5],qr[2],C1,0,0,0),   P1[6],P1[7],P1[8],P1[9],     pw2[2]=PKW(P1,4), pw2[3]=PKW(P1,6), pw2); \
    VRD(3); SBAR(); GAPA(C0=__builtin_amdgcn_mfma_f32_32x32x16_bf16(kf[6],qr[3],C0,0,0,0),   P1[10],P1[11],P1[12],P1[13], pw3[0]=PKW(P1,8), pw3[1]=PKW(P1,10), pw3); \
    VRD(7); SBAR(); GAPA(C1=__builtin_amdgcn_mfma_f32_32x32x16_bf16(kf[7],qr[3],C1,0,0,0),   P1[14],P1[15],0.f,0.f,       pw3[2]=PKW(P1,12),pw3[3]=PKW(P1,14), pw3); \
    l_reg+=sacc; \
    if(GK){DMA_K((t)+3,sl_cur);} if(GV){DMA_V((t)+1,sl_next);} \
    CMASK(C0,C1,t); \
    { float a=MX3(C0[0],C0[1],C1[0]),b=MX3(C0[2],C0[3],C1[1]); a=MX3(a,C1[2],C1[3]); \
      _Pragma("unroll") for(int r=4;r<16;r+=4){a=MX3(a,C0[r],C0[r+1]);b=MX3(b,C0[r+2],C0[r+3]);a=MX3(a,C1[r],C1[r+1]);b=MX3(b,C1[r+2],C1[r+3]);} \
      float rm=__builtin_fmaxf(a,b); { auto rr=__builtin_amdgcn_permlane32_swap(__float_as_uint(rm),__float_as_uint(rm),false,false); rm=__builtin_fmaxf(__uint_as_float(rr[0]),__uint_as_float(rr[1])); } \
      resc=false; \
      if(__builtin_expect(__any(rm>(float)THRL),0)){ const float dl=__builtin_fmaxf(rm,0.f); mhat+=dl; \
        _Pragma("unroll") for(int r=0;r<16;++r){C0[r]-=dl;C1[r]-=dl;} \
        _Pragma("unroll") for(int r=0;r<16;++r)negm[r]=-mhat; asm volatile("":"+v"(negm)); \
        const float f=__builtin_amdgcn_exp2f(-dl); l_reg*=f; if(hi==0)wsf[r32]=f; resc=true; } } \
    SBAR(); \
    GAPB(o[0]=__builtin_amdgcn_mfma_f32_32x32x16_bf16(PAF(0),VFR(0),o[0],0,0,0), C0,0); \
    GAPB(o[1]=__builtin_amdgcn_mfma_f32_32x32x16_bf16(PAF(0),VFR(4),o[1],0,0,0), C0,4); \
    KRD(GL,0); GAPB(o[0]=__builtin_amdgcn_mfma_f32_32x32x16_bf16(PAF(1),VFR(1),o[0],0,0,0), C0,8); \
    KRD(GL,1); GAPB(o[1]=__builtin_amdgcn_mfma_f32_32x32x16_bf16(PAF(1),VFR(5),o[1],0,0,0), C0,12); \
    KRD(GL,2); GAPB(o[0]=__builtin_amdgcn_mfma_f32_32x32x16_bf16(PAF(2),VFR(2),o[0],0,0,0), C1,0); \
    KRD(GL,3); GAPB(o[1]=__builtin_amdgcn_mfma_f32_32x32x16_bf16(PAF(2),VFR(6),o[1],0,0,0), C1,4); \
    GAPB(o[0]=__builtin_amdgcn_mfma_f32_32x32x16_bf16(PAF(3),VFR(3),o[0],0,0,0), C1,8); \
    GAPB(o[1]=__builtin_amdgcn_mfma_f32_32x32x16_bf16(PAF(3),VFR(7),o[1],0,0,0), C1,12); \
    }while(0)
  int t=1;
  #undef CMASK
  #define CMASK(P0,P1,t) do{}while(0)
  for(;t+5<NT;t+=2){
    STEP(pB0,pB1,pA0,pA1,t,true,true,true);     WAIT_BAR(2); RESC(); ROT();
    STEP(pA0,pA1,pB0,pB1,t+1,true,true,true);   WAIT_BAR(2); RESC(); ROT();
  }
  #undef CMASK
  #define CMASK(P0,P1,t) do{ if((t)>=NT-4)cmask(P0,P1,(t),hi); }while(0)
  #define ENDW(tt) do{ if((tt)+3<NT){WAIT_BAR(2);} else if((tt)+2<NT){WAIT_BAR(1);} else {WAIT_BAR(0);} }while(0)
  for(;t+1<NT;t+=2){
    STEP(pB0,pB1,pA0,pA1,t,(t+3<NT),(t+1<NT),(t+1<NT));       ENDW(t);   RESC(); ROT();
    STEP(pA0,pA1,pB0,pB1,t+1,(t+4<NT),(t+2<NT),(t+2<NT));     ENDW(t+1); RESC(); ROT();
  }
  STEP(pB0,pB1,pA0,pA1,NT-1,false,false,false); RESC();
  { float sacc=pB0[0]+pB0[1]; _Pragma("unroll") for(int r=2;r<16;++r)sacc+=pB0[r]; _Pragma("unroll") for(int r=0;r<16;++r)sacc+=pB1[r]; l_reg+=sacc;
    pw0=(u32x4){PKW(pB0,0),PKW(pB0,2),PKW(pB0,4),PKW(pB0,6)};pw1=(u32x4){PKW(pB0,8),PKW(pB0,10),PKW(pB0,12),PKW(pB0,14)};pw2=(u32x4){PKW(pB1,0),PKW(pB1,2),PKW(pB1,4),PKW(pB1,6)};pw3=(u32x4){PKW(pB1,8),PKW(pB1,10),PKW(pB1,12),PKW(pB1,14)};
    SBAR(); pv(o,vb0+sl_cur,PAF(0),PAF(1),PAF(2),PAF(3)); }
  #undef PKW
  #undef PAF
  #undef VFR
  #undef PIN
  #undef MX3
  #undef GAPA
  #undef GAPB
  #undef EX
  #undef VRD
  #undef KRD
  #undef STEP
  #undef ENDW
  {auto rr=__builtin_amdgcn_permlane32_swap(__float_as_uint(l_reg),__float_as_uint(l_reg),false,false);l_reg=__uint_as_float(rr[0])+__uint_as_float(rr[1]);}
  if(hi==0)wsf[32+r32]=l_reg;asm volatile("s_waitcnt lgkmcnt(0)":::"memory");
  float rli[16];
  #pragma unroll
  for(int r=0;r<16;++r)rli[r]=__builtin_amdgcn_rcpf(wsf[32+crow(r,hi)]);
  bf16*Ow=O+(rowbase+q0+wid*QBLK)*DMQ+h*D;
  { bf16*stg=(bf16*)(shm+LDS_OST)+wid*2048;
    #pragma unroll
    for(int r=0;r<16;++r){const int orow=crow(r,hi);
      #pragma unroll
      for(int d0=0;d0<2;++d0)stg[orow*64+d0*32+r32]=__float2bfloat16(o[d0][r]*rli[r]);}
    asm volatile("s_waitcnt lgkmcnt(0)":::"memory");
    #pragma unroll
    for(int i=0;i<4;++i){const int row=i*8+(lane>>3),ch=lane&7; const u32x4 v=*(const u32x4*)(stg+row*64+ch*8); ATTN_STORE16(Ow+(long)row*DMQ+ch*8,v);} }
  asm volatile("s_waitcnt lgkmcnt(0)\n\ts_barrier":::"memory");
  #undef DMA_K
  #undef DMA_V
  #undef CMASK
  #undef START
  #undef RESC
  #undef ROT
}
constexpr int ATTN_LDS_BYTES=LDS_BYTES;
struct AttnTensors { const bf16* Q; const bf16* K; const bf16* V; bf16* O; };
struct AttnUnit { int bh; int qb; };
struct StaticOrder {
  int vcu;
  __device__ __forceinline__ explicit StaticOrder(int grid,int block):vcu((block%8)*(grid/8)+block/8){}
  __device__ __forceinline__ bool next(int i,AttnUnit&u)const{ if(i>=2)return false; const int pr=vcu>>6,uu=2*(vcu&63)+i; u.bh=(pr>>1)*NHEAD+(pr&1)*4+(uu>>5); u.qb=uu&31; return true; }
  __device__ __forceinline__ void a_ready(const AttnUnit&)const{}
  __device__ __forceinline__ void done(const AttnUnit&)const{}
};
template<class Sched,int THRL=8> __device__ __forceinline__ void attn_phase(char*lds,const AttnTensors&T,const Sched&S){
  AttnUnit u;
  for(int i=0;S.next(i,u);++i){ S.a_ready(u); attn_unit<THRL>(u.bh/NHEAD,u.bh%NHEAD,u.qb,T.Q,T.K,T.V,T.O,lds); S.done(u); }
}
#undef SBAR
#undef WAIT_BAR
}
#define GAS __attribute__((address_space(1)))
#define LAS __attribute__((address_space(3)))
typedef unsigned short bf16;
typedef unsigned v4u __attribute__((ext_vector_type(4)));
typedef float f32x4 __attribute__((ext_vector_type(4)));
typedef short bf16x8 __attribute__((ext_vector_type(8)));
typedef GAS unsigned gu32;
typedef GAS unsigned long long gu64;
#define RLX_AGENT __ATOMIC_RELAXED, __HIP_MEMORY_SCOPE_AGENT
#define LDS_WAIT() asm volatile("s_waitcnt lgkmcnt(0)" ::: "memory")
#define VM_WAIT() asm volatile("s_waitcnt vmcnt(0)" ::: "memory")
__device__ __forceinline__ unsigned long long rt() { return __builtin_amdgcn_s_memrealtime(); }
__device__ __forceinline__ unsigned f2bf(float f) { unsigned u = __builtin_bit_cast(unsigned, f); return (u + 0x7fffu + ((u >> 16) & 1u)) >> 16; }
__device__ __forceinline__ unsigned pk2(float lo, float hi) { return f2bf(lo) | (f2bf(hi) << 16); }

#define XB_TMO      128
#define XB_XCNT(j)  (256  + 64 * (j))
#define XB_XSUB(j)  (1280 + 64 * (j))
#define XB_XGEN(j)  (2304 + 64 * (j))
#define XB_TOP      3328
#define XB_TOPGEN   3392
#define XCD_BAR_WORDS 3456
#define XB_SPIN_CAP (1u << 18)

__device__ __forceinline__ unsigned xb_ld(unsigned* p)              { return __hip_atomic_load(p, __ATOMIC_RELAXED, __HIP_MEMORY_SCOPE_AGENT); }
__device__ __forceinline__ unsigned xb_add(unsigned* p, unsigned v) { return __hip_atomic_fetch_add(p, v, __ATOMIC_RELAXED, __HIP_MEMORY_SCOPE_AGENT); }
__device__ __forceinline__ unsigned xb_xcc_id() { return (unsigned)__builtin_amdgcn_s_getreg((3 << 11) | 20) & 0xFu; }
#define XB_SPIN(cond, bar) do { unsigned _sp = 0; while (cond) { __builtin_amdgcn_s_sleep(1); \
    if ((++_sp & 255u) == 0u) { if (xb_ld(&(bar)[XB_TMO])) break; if (_sp > XB_SPIN_CAP) { atomicAdd(&(bar)[XB_TMO], 1u); break; } } } } while (0)

struct XcdBarrier {
    unsigned* bar; unsigned x;
    volatile LAS unsigned* st;
};

__device__ __forceinline__ XcdBarrier xcd_barrier_post(unsigned* bar, volatile LAS unsigned* st) {
    XcdBarrier b; b.bar = bar; b.x = xb_xcc_id(); b.st = st;
    if (threadIdx.x == 0) (void)xb_add(&bar[XB_XCNT(b.x)], 1u);
    return b;
}
__device__ __forceinline__ void xcd_barrier_complete(unsigned* bar, unsigned x, unsigned& nloc, unsigned& nx) {
    const unsigned G = gridDim.x * gridDim.y * gridDim.z;
    unsigned sum, cnt, mine, sp = 0u;
    for (;;) {
        sum = 0u; cnt = 0u; mine = 0u;
#pragma unroll
        for (unsigned j = 0; j < 16; ++j) { const unsigned c = xb_ld(&bar[XB_XCNT(j)]); sum += c; cnt += (c > 0u) ? 1u : 0u; mine = (j == x) ? c : mine; }
        if (sum == G) break;
        __builtin_amdgcn_s_sleep(1);
        if ((++sp & 255u) == 0u) { if (xb_ld(&bar[XB_TMO])) break; if (sp > XB_SPIN_CAP) { atomicAdd(&bar[XB_TMO], 1u); break; } }
    }
    nloc = mine > 0u ? mine : 1u; nx = cnt > 0u ? cnt : 1u;
}

__device__ __forceinline__ void xcd_barrier(const XcdBarrier& b) {
    asm volatile("s_waitcnt vmcnt(0)" ::: "memory");
    __syncthreads();
    if (threadIdx.x == 0) {
        unsigned* bar = b.bar;
        __builtin_amdgcn_s_waitcnt(0);
        unsigned nloc = b.st[0], nx = b.st[1];
        if (nloc == 0u) { xcd_barrier_complete(bar, b.x, nloc, nx); b.st[0] = nloc; b.st[1] = nx; }
        const unsigned old = xb_add(&bar[XB_XSUB(b.x)], 1u);
        const unsigned gen = old / nloc;
        if (old + 1u == (gen + 1u) * nloc) {
            __builtin_amdgcn_fence(__ATOMIC_RELEASE, "agent");
            asm volatile("s_waitcnt vmcnt(0)" ::: "memory");
            const unsigned og = xb_add(&bar[XB_TOP], 1u);
            const unsigned tg = og / nx;
            if (og + 1u == (tg + 1u) * nx) xb_add(&bar[XB_TOPGEN], 1u);
            else XB_SPIN(xb_ld(&bar[XB_TOPGEN]) == tg, bar);
            __builtin_amdgcn_fence(__ATOMIC_ACQUIRE, "agent");
            xb_add(&bar[XB_XGEN(b.x)], 1u);
            asm volatile("s_waitcnt vmcnt(0)" ::: "memory");
        } else {
            XB_SPIN(xb_ld(&bar[XB_XGEN(b.x)]) == gen, bar);
            __builtin_amdgcn_fence(__ATOMIC_ACQUIRE, "agent");
            asm volatile("s_waitcnt vmcnt(0)" ::: "memory");
        }
    }
    __syncthreads();
}

constexpr int NWAVES = 8;
constexpr int BATCH = 2, SEQ = 8192, DM = 1024, NMETA = 16;
constexpr int M = BATCH * SEQ;
constexpr int INW = 3328;
constexpr int KVROWS = 8320, KVALID = 8208;
constexpr int NG = 32, NE = 16, CAP = 1024;
constexpr int UGP = 768;
constexpr float LN_EPS = 1e-5f, QK_EPS = 1e-6f, ALPHA = 1.189207115002721f;
constexpr float C2Q = 0.125f * 1.4426950408889634f;

constexpr size_t MiB = 1u << 20;
constexpr size_t WS_CTL = 0, CTL_ZERO_BYTES = 1 * MiB;
constexpr size_t WS_STATS0 = 1 * MiB, WS_STATS1 = WS_STATS0 + 131072, WS_ROPE = WS_STATS1 + 131072, WS_UMETA = WS_ROPE + 32768, WS_GATE2 = WS_UMETA + 32768, WS_IDX2 = WS_GATE2 + 131072;
constexpr size_t WS_SLOTOF = 2 * MiB, WS_AFF = 3 * MiB;
constexpr size_t WS_WGU = 8 * MiB, WS_WD = 72 * MiB;
constexpr size_t WS_WIN = 104 * MiB, WS_WGLU = 111 * MiB, WS_WAB = 112 * MiB, WS_WSB = 113 * MiB, WS_WO = 114 * MiB;
constexpr size_t WS_WST = 116 * MiB, WS_MEXT = 124 * MiB;
constexpr size_t WS_XN = 148 * MiB;
constexpr size_t WS_Q = 181 * MiB, WS_K = 197 * MiB, WS_V = 202 * MiB;
constexpr size_t WS_UG2 = 207 * MiB, WS_S = 231 * MiB;
constexpr size_t WS_END = 247 * MiB;
constexpr size_t WS_YG = WS_XN, WS_Z = WS_XN + 16 * MiB;
constexpr size_t WS_T1 = WS_WST;
constexpr size_t WS_MERGED = WS_UG2;
constexpr size_t WS_H1 = WS_XN;
constexpr size_t WS_XE = WS_Q;
constexpr size_t WS_HB = WS_WIN;
static_assert(WS_XE + 64 * MiB <= WS_END && WS_HB + 64 * MiB <= WS_XE && WS_MERGED + 32 * MiB <= WS_END && WS_T1 + 32 * MiB <= WS_XN, "d_ws overlays");
constexpr int CW_TMO = 0, CW_BAR = 4096;
constexpr int CW_Q = 8192, CW_DONE = 8256;
constexpr int N_DENSE_ITEMS = 16 * 104 + 8 * 16 + 2 * 8 * 32 + 16 * 32, N_EXP_ITEMS = NE * 3 * 16 * 32;

constexpr int RING_OFF = 0, RING_BYTES = 131072;
constexpr int LDSCTL_OFF = RING_BYTES, MISC_OFF = LDSCTL_OFF + 320;
constexpr int LDS_BYTES = 147456;

typedef unsigned u32x4_t __attribute__((ext_vector_type(4)));
typedef unsigned u32x2_t __attribute__((ext_vector_type(2)));
typedef float f32x2_t2 __attribute__((ext_vector_type(2)));
using pg8::Unit;

struct Frame {
    LAS unsigned char* lds; volatile LAS unsigned* MISC; gu32* ctl;
    int tid, lane, wave, vcu, G;
    unsigned char* ws;
    const float* in[28]; float* out;
};
__device__ __forceinline__ float wave_sum(float v) {
#pragma unroll
    for (int o = 1; o < 64; o <<= 1) v += __shfl_xor(v, o);
    return v;
}
__device__ __forceinline__ float sigm(float x) { return 1.f / (1.f + __expf(-x)); }
__device__ __forceinline__ float bf2f(unsigned short h) { return __uint_as_float((unsigned)h << 16); }
__device__ __forceinline__ float bflo(unsigned w) { return __uint_as_float(w << 16); }
__device__ __forceinline__ float bfhi(unsigned w) { return __uint_as_float(w & 0xffff0000u); }
__device__ __forceinline__ u32x4_t pack8(const f32x4& a, const f32x4& b) { u32x4_t w; w.x = pg8::cvt_pk_bf16(a[0], a[1]); w.y = pg8::cvt_pk_bf16(a[2], a[3]); w.z = pg8::cvt_pk_bf16(b[0], b[1]); w.w = pg8::cvt_pk_bf16(b[2], b[3]); return w; }
__device__ __forceinline__ float gelu_tanh(float y) { const float in = 0.7978845608028654f * (y + 0.044715f * y * y * y); const float e = __expf(2.f * in); return y * (1.f - 1.f / (e + 1.f)); }

struct InProjOrder {
    pg8::StaticOrder so;
    __device__ bool next(int i, Unit& u) const { if (so.next(i, u)) return true; const long L = (long)i * so.G + so.c; if (L >= so.nwg && L < so.nwg + 3) { u.pm = 64; u.pn = 2 + (int)(L - so.nwg); return true; } return false; }
    __device__ __forceinline__ void a_ready(const Unit&) const {}
    __device__ __forceinline__ void done(const Unit&) const {}
};
struct SsmStateOrder {
    int G, c;
    __device__ bool next(int i, Unit& u) const { const int L = i * G + c; if (L >= 64) return false; u.pm = L; u.pn = L >> 1; return true; }
    __device__ __forceinline__ void a_ready(const Unit&) const {}
    __device__ __forceinline__ void done(const Unit&) const {}
};
struct SsmYOrder {
    int G, c;
    __device__ bool next(int i, Unit& u) const { const int L = i * G + c; if (L >= 128) return false; const int g = L >> 2; u.pm = g * 2 + ((L >> 1) & 1); u.pn = g * 2 + (L & 1); return true; }
    __device__ __forceinline__ void a_ready(const Unit&) const {}
    __device__ __forceinline__ void done(const Unit&) const {}
};
struct MoeOrder {
    int G, c, nmi, nnj;
    __device__ bool next(int i, Unit& u) const { const int per = nmi * nnj, nwg = NE * per; const int L = i * G + c; if (L >= nwg) return false;
        const int wgid = (L % 8) * (nwg / 8) + L / 8; const int e = wgid / per, w = wgid % per; u.pm = e * nmi + (w % nmi); u.pn = e * nnj + (w / nmi); return true; }
    __device__ __forceinline__ void a_ready(const Unit&) const {}
    __device__ __forceinline__ void done(const Unit&) const {}
};

typedef float f32x4 __attribute__((ext_vector_type(4)));
#define EPI_LOOP_AM _Pragma("unroll") for (int ai = 0; ai < 2; ++ai) _Pragma("unroll") for (int m = 0; m < 4; ++m)
constexpr int XCH_OFF = 132096;
struct EpiInProj {
    static constexpr bool PERM = true, AFTER_DRAIN = false;
    bf16* Q; bf16* Kb; bf16* Vb; bf16* UG2; bf16* GATES; bf16* UMETA; LAS float* XCH; const float* ngt; const float* RP;
    __device__ __forceinline__ u32x4_t normrope(const f32x4& a0, const f32x4& a1, float rinv, const f32x4& g0, const f32x4& g1, const f32x4& cs, const f32x4& sn, float osc) const {
        const float y0 = a0[0] * rinv * g0[0], y1 = a0[1] * rinv * g0[1], y2 = a0[2] * rinv * g0[2], y3 = a0[3] * rinv * g0[3];
        const float y4 = a1[0] * rinv * g1[0], y5 = a1[1] * rinv * g1[1], y6 = a1[2] * rinv * g1[2], y7 = a1[3] * rinv * g1[3];
        u32x4_t w;
        w.x = pg8::cvt_pk_bf16((y0 * cs[0] - y1 * sn[0]) * osc, (y0 * sn[0] + y1 * cs[0]) * osc);
        w.y = pg8::cvt_pk_bf16((y2 * cs[1] - y3 * sn[1]) * osc, (y2 * sn[1] + y3 * cs[1]) * osc);
        w.z = pg8::cvt_pk_bf16((y4 * cs[2] - y5 * sn[2]) * osc, (y4 * sn[2] + y5 * cs[2]) * osc);
        w.w = pg8::cvt_pk_bf16((y6 * cs[3] - y7 * sn[3]) * osc, (y6 * sn[3] + y7 * cs[3]) * osc);
        return w;
    }
    __device__ __forceinline__ void operator()(const f32x4 (&acc)[2][2][4][2], const Unit& u, int wr, int wc, int fr_, int fq_) const {
        int fr = fr_, fq = fq_; asm volatile("" : "+v"(fr), "+v"(fq));
        const int pn = u.pn, cl0 = wc * 32 + 8 * fq;
        if (pn <= 2) {
            const int nb = pn == 2 ? 1 : 2;
            EPI_LOOP_AM {
#pragma unroll
                for (int bj = 0; bj < 2; ++bj) {
                    if (bj < nb) { const f32x4 a = acc[ai][bj][m][0], c = acc[ai][bj][m][1]; float s = (a[0] * a[0] + a[1] * a[1]) + (a[2] * a[2] + a[3] * a[3]) + (c[0] * c[0] + c[1] * c[1]) + (c[2] * c[2] + c[3] * c[3]);
                        s += __shfl_xor(s, 16); s += __shfl_xor(s, 32);
                        if (fq == 0) XCH[(ai * 128 + wr * 64 + m * 16 + fr) * 8 + bj * 4 + wc] = s; } } }
            asm volatile("s_waitcnt lgkmcnt(0)" ::: "memory"); __builtin_amdgcn_s_barrier(); asm volatile("" ::: "memory");
            const float* gsrc = ngt + (pn == 2 ? 64 : 0) + (wc & 1) * 32 + 8 * fq;
            const f32x4 g0 = *(const f32x4*)gsrc, g1 = *(const f32x4*)(gsrc + 4);
            const float osc = pn == 2 ? 1.f : C2Q;
            const int codd = wc & 1;
            EPI_LOOP_AM {
                if (u.pm == 64 && (wr != 0 || ai != 0 || m != 0)) continue;
                const int rl = ai * 128 + wr * 64 + m * 16 + fr; const int row = u.pm * 256 + rl;
                f32x4 cs = (f32x4){1.f, 1.f, 1.f, 1.f}, sn = (f32x4){0.f, 0.f, 0.f, 0.f};
                if (u.pm != 64) { const int s = row & 8191; const float* tp = codd ? RP + 4096 + (s & 63) * 16 + 4 * fq : RP + (s >> 6) * 16 + 4 * fq; cs = *(const f32x4*)tp; sn = *(const f32x4*)(tp + (codd ? 1024 : 2048)); }
#pragma unroll
                for (int bj = 0; bj < 2; ++bj) {
                    if (bj < nb) {
                        const f32x2_t2 pr = *(const LAS f32x2_t2*)(XCH + rl * 8 + bj * 4 + (wc & 2)); const float tot = pr.x + pr.y;
                        const float rinv = rsqrtf(tot * (1.f / 64.f) + QK_EPS);
                        const u32x4_t w = normrope(acc[ai][bj][m][0], acc[ai][bj][m][1], rinv, g0, g1, cs, sn, osc);
                        if (pn < 2) *(u32x4_t*)(Q + (size_t)row * 512 + pn * 256 + bj * 128 + cl0) = w;
                        else if (u.pm != 64) *(u32x4_t*)(Kb + ((size_t)(row >> 13) * KVROWS + NMETA + (row & 8191)) * 128 + cl0) = w;
                        else { *(u32x4_t*)(Kb + (size_t)fr * 128 + cl0) = w; *(u32x4_t*)(Kb + ((size_t)KVROWS + fr) * 128 + cl0) = w; }
                    } else {
                        const u32x4_t w = pack8(acc[ai][1][m][0], acc[ai][1][m][1]);
                        if (u.pm != 64) *(u32x4_t*)(Vb + ((size_t)(row >> 13) * KVROWS + NMETA + (row & 8191)) * 128 + cl0) = w;
                        else { *(u32x4_t*)(Vb + (size_t)fr * 128 + cl0) = w; *(u32x4_t*)(Vb + ((size_t)KVROWS + fr) * 128 + cl0) = w; }
                    }
                }
            }
            return;
        }
        if (u.pm == 64) {
            if (wr != 0) return;
#pragma unroll
            for (int bj = 0; bj < 2; ++bj) { const int cu = (pn - 3) * 256 + bj * 128 + cl0; *(u32x4_t*)(UMETA + ((size_t)(cu >> 4) * 16 + fr) * 16 + (cu & 15)) = pack8(acc[0][bj][0][0], acc[0][bj][0][1]); }
            return;
        }
        const int row0 = u.pm * 256 + wr * 64 + fr;
        if (pn < 5) {
            EPI_LOOP_AM { const int row = row0 + ai * 128 + m * 16, b = row >> 13, s = row & 8191;
#pragma unroll
                for (int bj = 0; bj < 2; ++bj) { const int cu = (pn - 3) * 256 + bj * 128 + cl0, g = cu >> 4;
                    *(u32x4_t*)(UG2 + ((size_t)(g * 2 + b) * 256 + (s >> 5)) * UGP + (s & 31) * 16 + (cu & 15)) = pack8(acc[ai][bj][m][0], acc[ai][bj][m][1]); } }
        } else {
            EPI_LOOP_AM { const size_t o = (size_t)(row0 + ai * 128 + m * 16) * 2048 + (pn - 5) * 256 + cl0;
#pragma unroll
                for (int bj = 0; bj < 2; ++bj) { f32x4 a = acc[ai][bj][m][0], c = acc[ai][bj][m][1];
#pragma unroll
                    for (int j = 0; j < 4; ++j) { a[j] = sigm(a[j]); c[j] = sigm(c[j]); }
                    *(u32x4_t*)(GATES + o + bj * 128) = pack8(a, c); } }
        }
    }
};
struct EpiSsmState {
    static constexpr bool PERM = false, AFTER_DRAIN = false;
    float* S;
    __device__ __forceinline__ void operator()(const f32x4 (&acc)[2][2][4][2], const Unit& u, int wr, int wc, int fr, int fq) const {
        EPI_LOOP_AM { float* rp = S + ((size_t)u.pm * 256 + ai * 128 + wr * 64 + m * 16 + fr) * 256 + wc * 32 + 4 * fq;
#pragma unroll
            for (int bj = 0; bj < 2; ++bj)
#pragma unroll
                for (int n = 0; n < 2; ++n) *(f32x4*)(rp + bj * 128 + n * 16) = acc[ai][bj][m][n]; }
    }
};
struct EpiSsmY {
    static constexpr bool PERM = true, AFTER_DRAIN = false;
    bf16* YG;
    __device__ __forceinline__ void operator()(const f32x4 (&acc)[2][2][4][2], const Unit& u, int wr, int wc, int fr, int fq) const {
        const int g = u.pm >> 1, b = u.pm & 1, nh = u.pn & 1;
        EPI_LOOP_AM { const int cp = ai * 128 + wr * 64 + m * 16 + fr;
#pragma unroll
            for (int bj = 0; bj < 2; ++bj) { const int nl = nh * 256 + bj * 128 + wc * 32 + 8 * fq, t = nl >> 4, h0 = nl & 15;
                f32x4 a = acc[ai][bj][m][0], c = acc[ai][bj][m][1];
#pragma unroll
                for (int j = 0; j < 4; ++j) { a[j] = gelu_tanh(a[j]); c[j] = gelu_tanh(c[j]); }
                *(u32x4_t*)(YG + ((size_t)b * SEQ + cp * 32 + t) * 512 + g * 16 + h0) = pack8(a, c); } }
    }
};
struct EpiGlu {
    static constexpr bool PERM = true, AFTER_DRAIN = false;
    const bf16* YG; const float* bias; bf16* Z;
    __device__ __forceinline__ void operator()(const f32x4 (&acc)[2][2][4][2], const Unit& u, int wr, int wc, int fr, int fq) const {
        const int row0 = u.pm * 256 + wr * 64 + fr, col0 = u.pn * 256 + wc * 32 + 8 * fq;
        EPI_LOOP_AM { const size_t o = (size_t)(row0 + ai * 128 + m * 16) * 512 + col0;
#pragma unroll
            for (int bj = 0; bj < 2; ++bj) { const u32x4_t y = *(const u32x4_t*)(YG + o + bj * 128);
                const f32x4 b0 = *(const f32x4*)(bias + col0 + bj * 128), b1 = *(const f32x4*)(bias + col0 + bj * 128 + 4);
                f32x4 a = acc[ai][bj][m][0] + b0, c = acc[ai][bj][m][1] + b1;
                a[0] = bflo(y.x) * sigm(a[0]); a[1] = bfhi(y.x) * sigm(a[1]); a[2] = bflo(y.y) * sigm(a[2]); a[3] = bfhi(y.y) * sigm(a[3]);
                c[0] = bflo(y.z) * sigm(c[0]); c[1] = bfhi(y.z) * sigm(c[1]); c[2] = bflo(y.w) * sigm(c[2]); c[3] = bfhi(y.w) * sigm(c[3]);
                *(u32x4_t*)(Z + o + bj * 128) = pack8(a, c); } }
    }
};
template <int SECOND> struct EpiBranch {
    static constexpr bool PERM = true, AFTER_DRAIN = false;
    const bf16* GATES; const bf16* T1; bf16* O;
    __device__ __forceinline__ void operator()(const f32x4 (&acc)[2][2][4][2], const Unit& u, int wr, int wc, int fr, int fq) const {
        const int row0 = u.pm * 256 + wr * 64 + fr, col0 = u.pn * 256 + wc * 32 + 8 * fq;
        EPI_LOOP_AM { const size_t r = (size_t)(row0 + ai * 128 + m * 16);
#pragma unroll
            for (int bj = 0; bj < 2; ++bj) { const u32x4_t gt = *(const u32x4_t*)(GATES + r * 2048 + SECOND * 1024 + col0 + bj * 128);
                f32x4 a = acc[ai][bj][m][0], c = acc[ai][bj][m][1];
                a[0] *= bflo(gt.x); a[1] *= bfhi(gt.x); a[2] *= bflo(gt.y); a[3] *= bfhi(gt.y); c[0] *= bflo(gt.z); c[1] *= bfhi(gt.z); c[2] *= bflo(gt.w); c[3] *= bfhi(gt.w);
                if (SECOND) { const u32x4_t t1 = *(const u32x4_t*)(T1 + r * 1024 + col0 + bj * 128);
                    a[0] += bflo(t1.x); a[1] += bfhi(t1.x); a[2] += bflo(t1.y); a[3] += bfhi(t1.y); c[0] += bflo(t1.z); c[1] += bfhi(t1.z); c[2] += bflo(t1.w); c[3] += bfhi(t1.w); }
                *(u32x4_t*)(O + r * 1024 + col0 + bj * 128) = pack8(a, c); } }
    }
};
struct EpiPre1 {
    static constexpr bool PERM = false, AFTER_DRAIN = false;
    const float* x; const float* g; const float* bb; const f32x2_t2* st; float* out;
    __device__ __forceinline__ void operator()(const f32x4 (&acc)[2][2][4][2], const Unit& u, int wr, int wc, int fr, int fq) const {
        const int row0 = u.pm * 256 + wr * 64 + fr, col0 = u.pn * 256 + wc * 32 + 4 * fq;
        EPI_LOOP_AM { const int row = row0 + ai * 128 + m * 16; const f32x2_t2 s = st[row]; const size_t o = (size_t)row * 1024 + col0;
#pragma unroll
            for (int bj = 0; bj < 2; ++bj)
#pragma unroll
                for (int n = 0; n < 2; ++n) { const int c = bj * 128 + n * 16; const f32x4 xv = *(const f32x4*)(x + o + c), gv = *(const f32x4*)(g + col0 + c), bv = *(const f32x4*)(bb + col0 + c);
                    *(f32x4*)(out + o + c) = ((xv - s.x) * s.y * gv + bv) * ALPHA + acc[ai][bj][m][n]; } }
    }
};
struct EpiMoe1 {
    static constexpr bool PERM = true, AFTER_DRAIN = false;
    bf16* HB;
    __device__ __forceinline__ void operator()(const f32x4 (&acc)[2][2][4][2], const Unit& u, int wr, int wc, int fr, int fq) const {
        const int row0 = u.pm * 256 + wr * 64 + fr, col0 = (u.pn & 7) * 128 + wc * 32 + 8 * fq;
        EPI_LOOP_AM { f32x4 a = acc[ai][0][m][0], c = acc[ai][0][m][1]; const f32x4 ua = acc[ai][1][m][0], uc = acc[ai][1][m][1];
#pragma unroll
            for (int j = 0; j < 4; ++j) { a[j] = a[j] * sigm(a[j]) * ua[j]; c[j] = c[j] * sigm(c[j]) * uc[j]; }
            *(u32x4_t*)(HB + (size_t)(row0 + ai * 128 + m * 16) * 1024 + col0) = pack8(a, c); }
    }
};
struct EpiMoe2 {
    static constexpr bool PERM = true, AFTER_DRAIN = false;
    const float* gate; bf16* YE;
    __device__ __forceinline__ void operator()(const f32x4 (&acc)[2][2][4][2], const Unit& u, int wr, int wc, int fr, int fq) const {
        const int row0 = u.pm * 256 + wr * 64 + fr, col0 = (u.pn & 3) * 256 + wc * 32 + 8 * fq;
        EPI_LOOP_AM { const int row = row0 + ai * 128 + m * 16; const float gt = gate[row];
#pragma unroll
            for (int bj = 0; bj < 2; ++bj) *(u32x4_t*)(YE + (size_t)row * 1024 + col0 + bj * 128) = pack8(acc[ai][bj][m][0] * gt, acc[ai][bj][m][1] * gt); }
    }
};

struct TItem { const float* src; bf16* dst; int N, K; };
__device__ __forceinline__ void titem_load(const TItem& t, f32x4 (&v)[8], int lane) {
    const float* p = t.src + (size_t)(lane >> 3) * t.N + (lane & 7) * 4;
#pragma unroll
    for (int i = 0; i < 8; ++i) v[i] = *(const GAS f32x4*)(p + (size_t)(8 * i) * t.N);
}
__device__ __forceinline__ void titem_store(const TItem& t, const f32x4 (&v)[8], LAS float* scr, int lane) {
#pragma unroll
    for (int i = 0; i < 8; ++i) { LAS float* s = scr + ((lane >> 3) + 8 * i) * 33 + (lane & 7) * 4; s[0] = v[i].x; s[1] = v[i].y; s[2] = v[i].z; s[3] = v[i].w; }
    LDS_WAIT(); asm volatile("" ::: "memory");
    const int c = lane & 7;
#pragma unroll
    for (int j = 0; j < 4; ++j) { const int n = (lane >> 3) + 8 * j; const LAS float* s = scr + (8 * c) * 33 + n;
        v4u o; o.x = pk2(s[0 * 33], s[1 * 33]); o.y = pk2(s[2 * 33], s[3 * 33]); o.z = pk2(s[4 * 33], s[5 * 33]); o.w = pk2(s[6 * 33], s[7 * 33]);
        *(GAS v4u*)(t.dst + (size_t)n * t.K + 8 * c) = o; }
    LDS_WAIT(); asm volatile("" ::: "memory");
}
__device__ __forceinline__ void ssm_par(const Frame& F, int dg, int p, float& lr, float& li, float& cr, float& ci) {
    const float dt = expf(F.in[9][dg]); const float ar = F.in[7][dg * 64 + p], ai = F.in[8][dg * 64 + p];
    lr = ar * dt; li = ai * dt;
    float sn, cs; sincosf(li, &sn, &cs); const float mag = expf(lr);
    const float nr = mag * cs - 1.f, ni = mag * sn, den = ar * ar + ai * ai;
    cr = (nr * ar + ni * ai) / den; ci = (ni * ar - nr * ai) / den;
}
__device__ __forceinline__ void cpow(float lr, float li, float e, float& pr, float& pi) { float sn, cs; sincosf(li * e, &sn, &cs); const float mg = expf(lr * e); pr = mg * cs; pi = mg * sn; }

__device__ __forceinline__ void mext_item(Frame& F, int it) {
    const int tid = F.tid; unsigned char* ws = F.ws;
    LAS float* POW = (LAS float*)(F.lds + RING_OFF);
    LAS float* BB = POW + 2 * 33 * 64 * 2;
    LAS float* CC = BB + 2 * 64 * 16 * 2;
    LAS float* KT = CC + 2 * 4 * 64 * 2;
    LAS float* PAR = KT + 2 * 4 * 32 * 16;
    bf16* MEXT = (bf16*)(ws + WS_MEXT);
    const int g = it >> 2, hq = it & 3;
    __syncthreads();
    if (tid < 128) { float lr, li, cr, ci; ssm_par(F, (tid >> 6) * 32 + g, tid & 63, lr, li, cr, ci); PAR[tid * 4] = lr; PAR[tid * 4 + 1] = li; PAR[tid * 4 + 2] = cr; PAR[tid * 4 + 3] = ci; }
    __syncthreads();
    for (int i = tid; i < 2 * 33 * 64; i += NWAVES * 64) { const int dir = i / (33 * 64), j = (i / 64) % 33, p = i & 63;
        float pr, pi; cpow(PAR[(dir * 64 + p) * 4], PAR[(dir * 64 + p) * 4 + 1], (float)j, pr, pi); POW[i * 2] = pr; POW[i * 2 + 1] = pi; }
    for (int i = tid; i < 2 * 64 * 16; i += NWAVES * 64) { const int dir = i / 1024, p = (i >> 4) & 63, h = i & 15; const float cr = PAR[(dir * 64 + p) * 4 + 2], ci = PAR[(dir * 64 + p) * 4 + 3];
        const size_t o = ((size_t)(dir * 32 + g) * 64 + p) * 16 + h; const float br = F.in[10][o], bi = F.in[11][o]; BB[i * 2] = cr * br - ci * bi; BB[i * 2 + 1] = cr * bi + ci * br; }
    for (int i = tid; i < 2 * 4 * 64; i += NWAVES * 64) { const int dir = i / 256, hl = (i >> 6) & 3, p = i & 63; const size_t o = ((size_t)(dir * 32 + g) * 16 + hq * 4 + hl) * 64 + p; CC[i * 2] = F.in[12][o]; CC[i * 2 + 1] = F.in[13][o]; }
    __syncthreads();
    { const int wv = F.wave, dir = wv >> 2, hl = wv & 3, jg = F.lane >> 4, hi = F.lane & 15;
      float acc[8];
#pragma unroll
      for (int jj = 0; jj < 8; ++jj) acc[jj] = 0.f;
#pragma unroll 1
      for (int ph = 0; ph < 2; ++ph) {
          float gr[32], gi[32];
#pragma unroll
          for (int q = 0; q < 32; ++q) { const int p = ph * 32 + q; const f32x2_t2 c = *(const LAS f32x2_t2*)(CC + ((dir * 4 + hl) * 64 + p) * 2), bq = *(const LAS f32x2_t2*)(BB + ((dir * 64 + p) * 16 + hi) * 2);
              gr[q] = c.x * bq.x - c.y * bq.y; gi[q] = c.x * bq.y + c.y * bq.x; }
#pragma unroll
          for (int jj = 0; jj < 8; ++jj) { const LAS f32x4* pw = (const LAS f32x4*)(POW + ((dir * 33 + jg * 8 + jj) * 64 + ph * 32) * 2); float s = acc[jj];
#pragma unroll
              for (int q = 0; q < 16; ++q) { const f32x4 w = pw[q]; s += w.x * gr[2 * q] - w.y * gi[2 * q]; s += w.z * gr[2 * q + 1] - w.w * gi[2 * q + 1]; }
              acc[jj] = s; }
      }
#pragma unroll
      for (int jj = 0; jj < 8; ++jj) KT[((dir * 4 + hl) * 32 + jg * 8 + jj) * 16 + hi] = acc[jj]; }
    __syncthreads();
    for (int ch = tid; ch < 128 * 96; ch += NWAVES * 64) { const int rl = ch / 96, cc = ch % 96, t = rl >> 2, hl = rl & 3, ho = hq * 4 + hl; float v[8];
        if (cc < 64) { const int s = cc >> 1, hi0 = (cc & 1) * 8;
#pragma unroll
            for (int j = 0; j < 8; ++j) { const int hi = hi0 + j; float x = 0.f; if (s <= t) x += KT[((0 * 4 + hl) * 32 + (t - s)) * 16 + hi]; if (s >= t) x += KT[((1 * 4 + hl) * 32 + (s - t)) * 16 + hi];
                if (s == t && hi == ho) x += F.in[14][g * 16 + ho]; v[j] = x; }
        } else { const int kk = (cc - 64) * 8, dir = kk >> 7, reim = (kk >> 6) & 1, p0 = kk & 63, e = dir == 0 ? t + 1 : 32 - t;
#pragma unroll
            for (int j = 0; j < 8; ++j) { const int p = p0 + j; const float cr = CC[((dir * 4 + hl) * 64 + p) * 2], ci = CC[((dir * 4 + hl) * 64 + p) * 2 + 1], pr = POW[((dir * 33 + e) * 64 + p) * 2], pi = POW[((dir * 33 + e) * 64 + p) * 2 + 1];
                v[j] = reim == 0 ? (cr * pr - ci * pi) : -(cr * pi + ci * pr); } }
        v4u o; o.x = pk2(v[0], v[1]); o.y = pk2(v[2], v[3]); o.z = pk2(v[4], v[5]); o.w = pk2(v[6], v[7]);
        *(GAS v4u*)(MEXT + ((size_t)g * 512 + t * 16 + ho) * UGP + cc * 8) = o; }
    __syncthreads();
}
__device__ __forceinline__ TItem titem_decode(int it, const float* w_in, const float* w_glu, const float* w_ab, const float* w_sb, const float* w_o, const float* w_g, const float* w_u, const float* w_d, unsigned char* ws) {
    constexpr int I_IN = 16 * 104, I_GLU = 8 * 16, I_BR = 8 * 32, I_O = 16 * 32, I_E = 16 * 32;
    TItem t; int r = it;
          if (r < I_IN) { const int kb = r / 104, nb = r % 104; t.src = w_in + (size_t)(64 * kb) * INW + 32 * nb; t.N = INW; t.K = 1024; t.dst = (bf16*)(ws + WS_WIN) + (size_t)(32 * nb) * 1024 + 64 * kb; return t; } r -= I_IN;
          if (r < I_GLU) { const int kb = r / 16, nb = r % 16; t.src = w_glu + (size_t)(64 * kb) * 512 + 32 * nb; t.N = 512; t.K = 512; t.dst = (bf16*)(ws + WS_WGLU) + (size_t)(32 * nb) * 512 + 64 * kb; return t; } r -= I_GLU;
          if (r < I_BR) { const int kb = r / 32, nb = r % 32; t.src = w_ab + (size_t)(64 * kb) * 1024 + 32 * nb; t.N = 1024; t.K = 512; t.dst = (bf16*)(ws + WS_WAB) + (size_t)(32 * nb) * 512 + 64 * kb; return t; } r -= I_BR;
          if (r < I_BR) { const int kb = r / 32, nb = r % 32; t.src = w_sb + (size_t)(64 * kb) * 1024 + 32 * nb; t.N = 1024; t.K = 512; t.dst = (bf16*)(ws + WS_WSB) + (size_t)(32 * nb) * 512 + 64 * kb; return t; } r -= I_BR;
          if (r < I_O) { const int kb = r / 32, nb = r % 32; t.src = w_o + (size_t)(64 * kb) * 1024 + 32 * nb; t.N = 1024; t.K = 1024; t.dst = (bf16*)(ws + WS_WO) + (size_t)(32 * nb) * 1024 + 64 * kb; return t; } r -= I_O;
          const int e = r / (3 * I_E), which = (r / I_E) % 3, q = r % I_E, kb = q / 32, nb = q % 32, n0 = 32 * nb;
          const float* W = (which == 0 ? w_g : which == 1 ? w_u : w_d) + (size_t)e * 1024 * 1024;
          t.src = W + (size_t)(64 * kb) * 1024 + n0; t.N = 1024; t.K = 1024;
          const int drow0 = which < 2 ? e * 2048 + (n0 >> 7) * 256 + which * 128 + (n0 & 127) : e * 1024 + n0;
          t.dst = (bf16*)(ws + (which < 2 ? WS_WGU : WS_WD)) + (size_t)drow0 * 1024 + 64 * kb; return t; }
__device__ __forceinline__ void bg_convert(Frame& F, int done_word, unsigned n_main) {
    LAS float* scr = (LAS float*)(F.lds + RING_OFF + F.wave * 16384);
    volatile LAS unsigned* bc = F.MISC + 16;
    for (;;) {
        __syncthreads();
        if (F.tid == 0) { unsigned base = 0xffffffffu;
            const bool stop = n_main != 0u && __hip_atomic_load(F.ctl + done_word, RLX_AGENT) >= n_main;
            if (!stop) base = __hip_atomic_fetch_add(F.ctl + CW_Q, 8u, RLX_AGENT);
            bc[0] = base; }
        __syncthreads();
        const unsigned base = bc[0];
        if (base >= (unsigned)N_EXP_ITEMS) break;
        const TItem t = titem_decode(N_DENSE_ITEMS + (int)base + F.wave, F.in[4], F.in[15], F.in[17], F.in[18], F.in[19], F.in[23], F.in[24], F.in[25], F.ws);
        f32x4 v[8]; titem_load(t, v, F.lane); titem_store(t, v, scr, F.lane);
    }
}
__device__ __forceinline__ void main_done(Frame& F, int done_word) { __syncthreads(); if (F.tid == 0) __hip_atomic_fetch_add(F.ctl + done_word, 1u, RLX_AGENT); }
__device__ __forceinline__ void p0_prologue(Frame& F) {
    const int gw = F.vcu * NWAVES + F.wave, NGW = F.G * NWAVES, lane = F.lane, tid = F.tid;
    unsigned char* ws = F.ws;
    LAS float* scr = (LAS float*)(F.lds + RING_OFF + F.wave * 16384);
    { bf16* WST = (bf16*)(ws + WS_WST);
      for (int it = gw; it < NG * 256; it += NGW) { const int g = it >> 8, n = it & 255, dir = n >> 7, reim = (n >> 6) & 1, p = n & 63; float lr, li, cr, ci; ssm_par(F, dir * 32 + g, p, lr, li, cr, ci);
          const int t = lane >> 1, h0 = (lane & 1) * 8; float pr, pi; cpow(lr, li, (float)(dir == 0 ? 31 - t : t), pr, pi);
          const float er = pr * cr - pi * ci, ei = pr * ci + pi * cr; const size_t o = ((size_t)(dir * 32 + g) * 64 + p) * 16 + h0; float v[8];
#pragma unroll
          for (int j = 0; j < 8; ++j) { const float br = F.in[10][o + j], bi = F.in[11][o + j]; v[j] = reim == 0 ? (er * br - ei * bi) : (er * bi + ei * br); }
          v4u w; w.x = pk2(v[0], v[1]); w.y = pk2(v[2], v[3]); w.z = pk2(v[4], v[5]); w.w = pk2(v[6], v[7]);
          *(GAS v4u*)(WST + ((size_t)g * 256 + n) * 512 + lane * 8) = w; } }
    { constexpr int NIT = N_DENSE_ITEMS;
      f32x4 va[8], vb[8]; TItem ta, tb;
      int it = gw;
      if (it < NIT) { ta = titem_decode(it, F.in[4], F.in[15], F.in[17], F.in[18], F.in[19], F.in[23], F.in[24], F.in[25], ws); titem_load(ta, va, lane); }
      while (it < NIT) {
          const int i1 = it + NGW; if (i1 < NIT) { tb = titem_decode(i1, F.in[4], F.in[15], F.in[17], F.in[18], F.in[19], F.in[23], F.in[24], F.in[25], ws); titem_load(tb, vb, lane); }
          titem_store(ta, va, scr, lane);
          if (i1 >= NIT) break;
          const int i2 = i1 + NGW; if (i2 < NIT) { ta = titem_decode(i2, F.in[4], F.in[15], F.in[17], F.in[18], F.in[19], F.in[23], F.in[24], F.in[25], ws); titem_load(ta, va, lane); }
          titem_store(tb, vb, scr, lane);
          it = i2;
      } }
    { bf16* XN = (bf16*)(ws + WS_XN); f32x2_t2* ST = (f32x2_t2*)(ws + WS_STATS0);
      for (int r = gw; r < M + NMETA; r += NGW) { const float* src = r < M ? F.in[0] + (size_t)r * DM : F.in[1] + (size_t)(r - M) * DM;
          const GAS f32x4* xr = (const GAS f32x4*)src + lane; f32x4 v[4]; float s = 0.f;
#pragma unroll
          for (int j = 0; j < 4; ++j) { v[j] = xr[64 * j]; s += (v[j].x + v[j].y) + (v[j].z + v[j].w); }
          const float mean = wave_sum(s) * (1.f / DM); float s2 = 0.f;
#pragma unroll
          for (int j = 0; j < 4; ++j) { v[j] = v[j] - mean; s2 += (v[j].x * v[j].x + v[j].y * v[j].y) + (v[j].z * v[j].z + v[j].w * v[j].w); }
          const float rstd = 1.f / sqrtf(wave_sum(s2) * (1.f / DM) + LN_EPS);
          if (r < M && lane == 0) ST[r] = (f32x2_t2){mean, rstd};
          GAS unsigned long long* o8 = (GAS unsigned long long*)(XN + (size_t)r * DM) + lane;
#pragma unroll
          for (int j = 0; j < 4; ++j) { const f32x4 gg = ((const GAS f32x4*)F.in[2])[lane + 64 * j], bb = ((const GAS f32x4*)F.in[3])[lane + 64 * j]; const f32x4 o = v[j] * rstd * gg + bb;
              o8[64 * j] = (unsigned long long)pk2(o.x, o.y) | ((unsigned long long)pk2(o.z, o.w) << 32); } } }
    { const int gt = F.vcu * (NWAVES * 64) + tid, NT_ = F.G * NWAVES * 64;
      for (int i = gt; i < 2 * 2 * 112 * 16; i += NT_) { const int arr = i / (2 * 112 * 16), b = (i / (112 * 16)) & 1, q = i % (112 * 16);
          *(GAS v4u*)((bf16*)(ws + (arr ? WS_V : WS_K)) + ((size_t)b * KVROWS + KVALID) * 128 + q * 8) = (v4u){0u, 0u, 0u, 0u}; }
      float* RP = (float*)(ws + WS_ROPE);
      for (int i = gt; i < 3072; i += NT_) { const bool isr = i < 2048; const int q = isr ? i : i - 2048, pos = q >> 4, j = q & 15; const float ang = (float)pos * powf(10000.f, -(float)j / 16.f);
          float sn, cs; sincosf(ang, &sn, &cs); if (isr) { RP[q] = cs; RP[2048 + q] = sn; } else { RP[4096 + q] = cs; RP[5120 + q] = sn; } }
      for (int i = gt; i < 128; i += NT_) RP[6144 + i] = i < 64 ? F.in[5][i] : F.in[6][i - 64]; }
}

__device__ __forceinline__ void qk_prep(Frame& F) {
    const int gw = F.vcu * NWAVES + F.wave, NGW = F.G * NWAVES, lane = F.lane;
    bf16* Q = (bf16*)(F.ws + WS_Q); bf16* K = (bf16*)(F.ws + WS_K); const float* RP = (const float*)(F.ws + WS_ROPE);
    constexpr int NQ = M * 8, NK = 2 * KVALID * 2;
    for (int it = gw; it < NQ + NK; it += NGW) {
        bf16* p; int pos; float gsc, osc;
        if (it < NQ) { const int row = it >> 3, h = it & 7; p = Q + (size_t)row * 512 + h * 64; pos = row & 8191; gsc = F.in[5][lane]; osc = C2Q; }
        else { const int r = it - NQ, b = r / (KVALID * 2), q = r % (KVALID * 2), l = q >> 1, kvh = q & 1; p = K + ((size_t)b * KVROWS + l) * 128 + kvh * 64; pos = l - NMETA; gsc = F.in[6][lane]; osc = 1.f; }
        const float x = bf2f(p[lane]);
        const float ss = wave_sum(x * x) * (1.f / 64.f);
        const float y = x * rsqrtf(ss + QK_EPS) * gsc, yo = __shfl_xor(y, 1);
        float cs = 1.f, sn = 0.f;
        if (pos >= 0) { const int j = lane >> 1; if (j < 16) { cs = RP[(pos >> 6) * 16 + j]; sn = RP[2048 + (pos >> 6) * 16 + j]; } else { cs = RP[4096 + (pos & 63) * 16 + j - 16]; sn = RP[5120 + (pos & 63) * 16 + j - 16]; } }
        const float o = ((lane & 1) ? (yo * sn + y * cs) : (y * cs - yo * sn)) * osc;
        p[lane] = (bf16)f2bf(o);
    }
}

__device__ __forceinline__ void ssm_scan(Frame& F) {
    if (F.wave != 0 || blockIdx.x >= 128) return;
    const int it = blockIdx.x, b = it >> 6, g = (it >> 1) & 31, dir = it & 1, p = F.lane;
    float lr, li, cr, ci; ssm_par(F, dir * 32 + g, p, lr, li, cr, ci);
    float a32r, a32i; cpow(lr, li, 32.f, a32r, a32i);
    const float* S = (const float*)(F.ws + WS_S) + (size_t)(g * 2 + b) * 256 * 256 + dir * 128 + p;
    bf16* U = (bf16*)(F.ws + WS_UG2) + (size_t)(g * 2 + b) * 256 * UGP + 512 + dir * 128 + p;
    float sr = 0.f, si = 0.f;
    if (dir == 0) {
        float a1r, a1i; cpow(lr, li, 1.f, a1r, a1i);
        const bf16* um = (const bf16*)(F.ws + WS_UMETA) + (size_t)g * 256; const size_t o = ((size_t)g * 64 + p) * 16;
        float bbr[16], bbi[16];
#pragma unroll
        for (int h = 0; h < 16; ++h) { const float br = F.in[10][o + h], bi = F.in[11][o + h]; bbr[h] = cr * br - ci * bi; bbi[h] = cr * bi + ci * br; }
        for (int t = 0; t < 16; ++t) { float bur = 0.f, bui = 0.f;
#pragma unroll
            for (int h = 0; h < 16; ++h) { const float uv = bf2f(um[t * 16 + h]); bur = fmaf(bbr[h], uv, bur); bui = fmaf(bbi[h], uv, bui); }
            const float nr = a1r * sr - a1i * si + bur, ni = a1r * si + a1i * sr + bui; sr = nr; si = ni; }
    }
    for (int c0 = 0; c0 < 256; c0 += 32) {
        float vr[32], vi[32];
#pragma unroll
        for (int k = 0; k < 32; ++k) { const int c = dir == 0 ? c0 + k : 255 - (c0 + k); vr[k] = S[(size_t)c * 256]; vi[k] = S[(size_t)c * 256 + 64]; }
#pragma unroll
        for (int k = 0; k < 32; ++k) { const int c = dir == 0 ? c0 + k : 255 - (c0 + k);
            U[(size_t)c * UGP] = (bf16)f2bf(sr); U[(size_t)c * UGP + 64] = (bf16)f2bf(si);
            const float nr = a32r * sr - a32i * si + vr[k], ni = a32r * si + a32i * sr + vi[k]; sr = nr; si = ni; }
    }
}

__device__ __forceinline__ float treduce16(const float (&v)[16], int lane) {
    float r8[8], r4[4], r2[2], r1;
    { const bool up = lane & 32;
#pragma unroll
      for (int i = 0; i < 8; ++i) { const float keep = up ? v[i + 8] : v[i], send = up ? v[i] : v[i + 8]; r8[i] = keep + __shfl_xor(send, 32); } }
    { const bool up = lane & 16;
#pragma unroll
      for (int i = 0; i < 4; ++i) { const float keep = up ? r8[i + 4] : r8[i], send = up ? r8[i] : r8[i + 4]; r4[i] = keep + __shfl_xor(send, 16); } }
    { const bool up = lane & 8;
#pragma unroll
      for (int i = 0; i < 2; ++i) { const float keep = up ? r4[i + 2] : r4[i], send = up ? r4[i] : r4[i + 2]; r2[i] = keep + __shfl_xor(send, 8); } }
    { const bool up = lane & 4; const float keep = up ? r2[1] : r2[0], send = up ? r2[0] : r2[1]; r1 = keep + __shfl_xor(send, 4); }
    r1 += __shfl_xor(r1, 2); r1 += __shfl_xor(r1, 1);
    return r1;
}
__device__ __forceinline__ void ln1_router(Frame& F) {
    const int gw = F.vcu * NWAVES + F.wave, NGW = F.G * NWAVES, lane = F.lane;
    LAS float* WRT = (LAS float*)(F.lds + RING_OFF);
    for (int i = F.tid; i < 16 * 1024; i += NWAVES * 64) { const int d = i >> 4, e = i & 15; WRT[e * 1024 + d] = F.in[22][i]; }
    __syncthreads();
    const float* PRE = F.out; bf16* H1 = (bf16*)(F.ws + WS_H1); f32x2_t2* ST = (f32x2_t2*)(F.ws + WS_STATS1); float* AFF = (float*)(F.ws + WS_AFF);
    for (int r = gw; r < M; r += NGW) {
        const GAS f32x4* xr = (const GAS f32x4*)(PRE + (size_t)r * DM) + lane; f32x4 v[4]; float s = 0.f;
#pragma unroll
        for (int j = 0; j < 4; ++j) { v[j] = xr[64 * j]; s += (v[j].x + v[j].y) + (v[j].z + v[j].w); }
        const float mean = wave_sum(s) * (1.f / DM); float s2 = 0.f;
#pragma unroll
        for (int j = 0; j < 4; ++j) { v[j] = v[j] - mean; s2 += (v[j].x * v[j].x + v[j].y * v[j].y) + (v[j].z * v[j].z + v[j].w * v[j].w); }
        const float rstd = 1.f / sqrtf(wave_sum(s2) * (1.f / DM) + LN_EPS);
        if (lane == 0) ST[r] = (f32x2_t2){mean, rstd};
        GAS unsigned long long* o8 = (GAS unsigned long long*)(H1 + (size_t)r * DM) + lane;
#pragma unroll
        for (int j = 0; j < 4; ++j) { const f32x4 gg = ((const GAS f32x4*)F.in[20])[lane + 64 * j], bb = ((const GAS f32x4*)F.in[21])[lane + 64 * j]; v[j] = v[j] * rstd * gg + bb;
            o8[64 * j] = (unsigned long long)pk2(v[j].x, v[j].y) | ((unsigned long long)pk2(v[j].z, v[j].w) << 32); }
        float acc[16];
        asm volatile("" ::: "memory");
#pragma unroll
        for (int e = 0; e < 16; ++e) { float a = 0.f;
#pragma unroll
            for (int j = 0; j < 4; ++j) { const f32x4 w = *(const LAS f32x4*)(WRT + e * 1024 + (lane + 64 * j) * 4); a += (v[j].x * w.x + v[j].y * w.y) + (v[j].z * w.z + v[j].w * w.w); }
            acc[e] = a; }
        const float lg = treduce16(acc, lane);
        float mx = lg;
#pragma unroll
        for (int o = 4; o < 64; o <<= 1) mx = fmaxf(mx, __shfl_xor(mx, o));
        const float ex = expf(lg - mx); float sm = ex;
#pragma unroll
        for (int o = 4; o < 64; o <<= 1) sm += __shfl_xor(sm, o);
        if ((lane & 3) == 0) AFF[((size_t)(r >> 13) * NE + (lane >> 2)) * SEQ + (r & 8191)] = ex / sm;
    }
}

__device__ __forceinline__ void topk_phase(Frame& F) {
    if (blockIdx.x >= BATCH * NE) return;
    const int be = blockIdx.x, b = be >> 4, e = be & 15, t = F.tid, lane = F.lane, w = F.wave;
    LAS int* red = (LAS int*)(F.lds + RING_OFF); LAS int* sc_gt = red + 16; LAS int* sc_eq = sc_gt + 16;
    const float* a = (const float*)(F.ws + WS_AFF) + (size_t)be * SEQ;
    unsigned v[16];
#pragma unroll
    for (int i = 0; i < 16; ++i) v[i] = __float_as_uint(a[t * 16 + i]);
    unsigned thr = 0u;
    for (int bit = 30; bit >= 0; --bit) {
        const unsigned cand = thr | (1u << bit); int c = 0;
#pragma unroll
        for (int i = 0; i < 16; ++i) c += (v[i] >= cand) ? 1 : 0;
#pragma unroll
        for (int o = 32; o > 0; o >>= 1) c += __shfl_xor(c, o);
        __syncthreads();
        if (lane == 0) red[w] = c;
        __syncthreads();
        int total = 0;
#pragma unroll
        for (int k = 0; k < 8; ++k) total += red[k];
        if (total >= CAP) thr = cand;
    }
    int ngt = 0, neq = 0;
#pragma unroll
    for (int i = 0; i < 16; ++i) { ngt += (v[i] > thr) ? 1 : 0; neq += (v[i] == thr) ? 1 : 0; }
    int ig = ngt, ie = neq;
#pragma unroll
    for (int o = 1; o < 64; o <<= 1) { const int pg = __shfl_up(ig, o), pe = __shfl_up(ie, o); if (lane >= o) { ig += pg; ie += pe; } }
    __syncthreads();
    if (lane == 63) { sc_gt[w] = ig; sc_eq[w] = ie; }
    __syncthreads();
    int wg_off = 0, we_off = 0, tot_gt = 0;
#pragma unroll
    for (int k = 0; k < 8; ++k) { const int a = sc_gt[k], c2 = sc_eq[k]; if (k < w) { wg_off += a; we_off += c2; } tot_gt += a; }
    const int quota = CAP - tot_gt; int gpre = wg_off + ig - ngt, epre = we_off + ie - neq;
    int* IDX2 = (int*)(F.ws + WS_IDX2); float* GATE2 = (float*)(F.ws + WS_GATE2); int* SLOTOF = (int*)(F.ws + WS_SLOTOF);
#pragma unroll
    for (int i = 0; i < 16; ++i) {
        const bool gt = v[i] > thr, eq = v[i] == thr, sel = gt || (eq && epre < quota);
        const int tok = t * 16 + i; int so = -1;
        if (sel) { const int slot = gpre + (epre < quota ? epre : quota); so = e * 2048 + b * 1024 + slot; IDX2[so] = b * SEQ + tok; GATE2[so] = __uint_as_float(v[i]); }
        SLOTOF[((size_t)b * SEQ + tok) * NE + e] = so;
        gpre += gt ? 1 : 0; epre += eq ? 1 : 0;
    }
    __syncthreads();
}

__device__ __forceinline__ void gather_phase(Frame& F) {
    const int gw = F.vcu * NWAVES + F.wave, NGW = F.G * NWAVES, lane = F.lane;
    const int* IDX2 = (const int*)(F.ws + WS_IDX2); const bf16* H1 = (const bf16*)(F.ws + WS_H1); bf16* XE = (bf16*)(F.ws + WS_XE);
    for (int r = gw; r < NE * 2048; r += NGW) { const int src = IDX2[r];
        const GAS v4u* s = (const GAS v4u*)(H1 + (size_t)src * DM) + lane; GAS v4u* d = (GAS v4u*)(XE + (size_t)r * DM) + lane;
        const v4u a = s[0], c = s[64]; d[0] = a; d[64] = c; }
}

__device__ __forceinline__ void final_phase(Frame& F) {
    const int gw = F.vcu * NWAVES + F.wave, NGW = F.G * NWAVES, lane = F.lane;
    float* OUT = F.out; const f32x2_t2* ST = (const f32x2_t2*)(F.ws + WS_STATS1); const int* SLOTOF = (const int*)(F.ws + WS_SLOTOF); const bf16* YE = (const bf16*)(F.ws + WS_XE);
    for (int r = gw; r < M; r += NGW) {
        GAS f32x4* xr = (GAS f32x4*)(OUT + (size_t)r * DM) + lane; f32x4 v[4]; const f32x2_t2 st = ST[r];
        const int myslot = SLOTOF[(size_t)r * NE + (lane & 15)];
#pragma unroll
        for (int j = 0; j < 4; ++j) { const f32x4 gg = ((const GAS f32x4*)F.in[20])[lane + 64 * j], bb = ((const GAS f32x4*)F.in[21])[lane + 64 * j]; v[j] = ((xr[64 * j] - st.x) * st.y * gg + bb) * ALPHA; }
        for (int e = 0; e < NE; ++e) { const int sl = __shfl(myslot, e);
            if (sl >= 0) { const GAS u32x2_t* yr = (const GAS u32x2_t*)(YE + (size_t)sl * DM) + lane;
#pragma unroll
                for (int j = 0; j < 4; ++j) { const u32x2_t y = yr[64 * j]; v[j].x += bflo(y.x); v[j].y += bfhi(y.x); v[j].z += bflo(y.y); v[j].w += bfhi(y.y); } } }
        float s = 0.f;
#pragma unroll
        for (int j = 0; j < 4; ++j) s += (v[j].x + v[j].y) + (v[j].z + v[j].w);
        const float mean = wave_sum(s) * (1.f / DM); float s2 = 0.f;
#pragma unroll
        for (int j = 0; j < 4; ++j) { v[j] = v[j] - mean; s2 += (v[j].x * v[j].x + v[j].y * v[j].y) + (v[j].z * v[j].z + v[j].w * v[j].w); }
        const float rstd = 1.f / sqrtf(wave_sum(s2) * (1.f / DM) + LN_EPS);
#pragma unroll
        for (int j = 0; j < 4; ++j) { const f32x4 gg = ((const GAS f32x4*)F.in[26])[lane + 64 * j], bb = ((const GAS f32x4*)F.in[27])[lane + 64 * j]; xr[64 * j] = v[j] * rstd * gg + bb; }
    }
}

#ifndef MK_PER_PHASE
#define MK_PER_PHASE 0
#endif
constexpr int N_PHASES = 16;
struct Args { const float* in[28]; float* out; unsigned char* ws; int ph_lo, ph_hi; };
__global__ void __launch_bounds__(NWAVES * 64, 2) mk_fwd(Args args) {
    extern __shared__ __attribute__((aligned(16))) unsigned char lds[];
    Frame F;
    F.lds = (LAS unsigned char*)lds; F.MISC = (volatile LAS unsigned*)(F.lds + MISC_OFF);
    F.tid = threadIdx.x; F.lane = F.tid & 63; F.wave = __builtin_amdgcn_readfirstlane(F.tid >> 6);
    F.G = gridDim.x; { const int bx = blockIdx.x; F.vcu = (F.G % 8 == 0) ? (bx % 8) * (F.G / 8) + bx / 8 : bx; }
    F.ws = args.ws; F.ctl = (gu32*)(args.ws + WS_CTL); F.out = args.out;
#pragma unroll
    for (int i = 0; i < 28; ++i) F.in[i] = args.in[i];
    for (int u = F.tid; u < (LDS_BYTES - LDSCTL_OFF) / 4; u += NWAVES * 64) ((LAS unsigned*)(F.lds + LDSCTL_OFF))[u] = 0u;
    __syncthreads();
    XcdBarrier bar; bar.bar = (unsigned*)(F.ctl + CW_BAR); bar.x = 0; bar.st = nullptr;
    if (!MK_PER_PHASE) bar = xcd_barrier_post((unsigned*)(F.ctl + CW_BAR), F.MISC + 8);
    const int lo = args.ph_lo, hi = args.ph_hi;
    unsigned char* ws = args.ws;
#ifndef PROBE_LO
#define PROBE_LO -1
#define PROBE_HI -1
#endif
    unsigned long long pr_t0 = 0ull, pr_t1 = 0ull;
#define IN(k) (lo <= (k) && (k) < hi)
#define SEAM(k) do { if (IN(k) && IN((k) + 1)) xcd_barrier(bar); if (PROBE_LO >= 0 && (k) + 1 == PROBE_LO) pr_t0 = rt(); if (PROBE_LO >= 0 && (k) + 1 == PROBE_HI) pr_t1 = rt(); } while (0)
    if (PROBE_LO == 0) pr_t0 = rt();
    using pg8::Gemm; using pg8::gemm_phase;
    if (IN(0)) { p0_prologue(F); } SEAM(0);
    if (IN(1)) { Gemm g{(const bf16*)(ws + WS_XN), (const bf16*)(ws + WS_WIN), 1024, 1024, 1024}; InProjOrder S; S.so.init(M, INW, F.G, (int)blockIdx.x);
        EpiInProj E{(bf16*)(ws + WS_Q), (bf16*)(ws + WS_K), (bf16*)(ws + WS_V), (bf16*)(ws + WS_UG2), (bf16*)args.out, (bf16*)(ws + WS_UMETA), (LAS float*)(F.lds + XCH_OFF), (const float*)(ws + WS_ROPE) + 6144, (const float*)(ws + WS_ROPE)};
        gemm_phase<EpiInProj, InProjOrder, true, true>(F.lds + RING_OFF, g, S, E);
        if ((long)3 * F.G + (long)blockIdx.x < 835) main_done(F, CW_DONE + 64 * 1); else bg_convert(F, CW_DONE + 64 * 1, (unsigned)(835 - 3 * F.G)); } SEAM(1);
    if (IN(2)) {
        Gemm g{(const bf16*)(ws + WS_UG2), (const bf16*)(ws + WS_WST), UGP, 512, 512}; SsmStateOrder S{F.G, (int)blockIdx.x}; EpiSsmState E{(float*)(ws + WS_S)};
        gemm_phase<EpiSsmState, SsmStateOrder, true, true>(F.lds + RING_OFF, g, S, E);
        if (blockIdx.x < 64) main_done(F, CW_DONE + 64 * 2); else { if (blockIdx.x < 192) mext_item(F, (int)blockIdx.x - 64); bg_convert(F, CW_DONE + 64 * 2, 64u); } } SEAM(2);
    if (IN(3)) { ssm_scan(F); __syncthreads();
        const attn_body::AttnTensors AT{(const attn_body::bf16*)(ws + WS_Q), (const attn_body::bf16*)(ws + WS_K), (const attn_body::bf16*)(ws + WS_V), (attn_body::bf16*)(ws + WS_Q)};
        const attn_body::StaticOrder S((int)F.G, (int)blockIdx.x);
        attn_body::attn_phase<attn_body::StaticOrder>((char*)lds + RING_OFF, AT, S); } SEAM(3);
    if (IN(4)) { Gemm g{(const bf16*)(ws + WS_UG2), (const bf16*)(ws + WS_MEXT), UGP, UGP, UGP}; SsmYOrder S{F.G, (int)blockIdx.x}; EpiSsmY E{(bf16*)(ws + WS_YG)};
        gemm_phase<EpiSsmY, SsmYOrder, true, true>(F.lds + RING_OFF, g, S, E);
        if (blockIdx.x < 128) main_done(F, CW_DONE + 64 * 4); else bg_convert(F, CW_DONE + 64 * 4, 128u); } SEAM(4);
    if (IN(5)) { Gemm g{(const bf16*)(ws + WS_YG), (const bf16*)(ws + WS_WGLU), 512, 512, 512}; pg8::StaticOrder S; S.init(M, 512, F.G, (int)blockIdx.x); EpiGlu E{(const bf16*)(ws + WS_YG), F.in[16], (bf16*)(ws + WS_Z)};
        gemm_phase<EpiGlu, pg8::StaticOrder, true, true>(F.lds + RING_OFF, g, S, E);
        if (blockIdx.x < 128) main_done(F, CW_DONE + 64 * 5); else bg_convert(F, CW_DONE + 64 * 5, 128u); } SEAM(5);
    if (IN(6)) { Gemm g{(const bf16*)(ws + WS_Q), (const bf16*)(ws + WS_WAB), 512, 512, 512}; pg8::StaticOrder S; S.init(M, 1024, F.G, (int)blockIdx.x); EpiBranch<0> E{(const bf16*)args.out, nullptr, (bf16*)(ws + WS_T1)};
        gemm_phase<EpiBranch<0>, pg8::StaticOrder, true, true>(F.lds + RING_OFF, g, S, E); } SEAM(6);
    if (IN(7)) { Gemm g{(const bf16*)(ws + WS_Z), (const bf16*)(ws + WS_WSB), 512, 512, 512}; pg8::StaticOrder S; S.init(M, 1024, F.G, (int)blockIdx.x); EpiBranch<1> E{(const bf16*)args.out, (const bf16*)(ws + WS_T1), (bf16*)(ws + WS_MERGED)};
        gemm_phase<EpiBranch<1>, pg8::StaticOrder, true, true>(F.lds + RING_OFF, g, S, E); } SEAM(7);
    if (IN(8)) { Gemm g{(const bf16*)(ws + WS_MERGED), (const bf16*)(ws + WS_WO), 1024, 1024, 1024}; pg8::StaticOrder S; S.init(M, 1024, F.G, (int)blockIdx.x);
        EpiPre1 E{F.in[0], F.in[2], F.in[3], (const f32x2_t2*)(ws + WS_STATS0), args.out};
        gemm_phase<EpiPre1, pg8::StaticOrder, true, true>(F.lds + RING_OFF, g, S, E); } SEAM(8);
    if (IN(9)) { ln1_router(F); } SEAM(9);
    if (IN(10)) { topk_phase(F); if (blockIdx.x < BATCH * NE) main_done(F, CW_DONE + 64 * 10); else bg_convert(F, CW_DONE + 64 * 10, (unsigned)(BATCH * NE)); } SEAM(10);
    if (IN(11)) { gather_phase(F); bg_convert(F, 0, 0u); } SEAM(11);
    if (IN(12)) { Gemm g{(const bf16*)(ws + WS_XE), (const bf16*)(ws + WS_WGU), 1024, 1024, 1024}; MoeOrder S{F.G, (int)blockIdx.x, 8, 8}; EpiMoe1 E{(bf16*)(ws + WS_HB)};
        gemm_phase<EpiMoe1, MoeOrder, true, true>(F.lds + RING_OFF, g, S, E); } SEAM(12);
    if (IN(13)) { Gemm g{(const bf16*)(ws + WS_HB), (const bf16*)(ws + WS_WD), 1024, 1024, 1024}; MoeOrder S{F.G, (int)blockIdx.x, 8, 4}; EpiMoe2 E{(const float*)(ws + WS_GATE2), (bf16*)(ws + WS_XE)};
        gemm_phase<EpiMoe2, MoeOrder, true, true>(F.lds + RING_OFF, g, S, E); } SEAM(13);
    if (IN(14)) { final_phase(F); }
    if (PROBE_LO >= 0) { if (PROBE_HI == 15) pr_t1 = rt(); if (blockIdx.x == 0) { const unsigned long long span = (pr_t1 - pr_t0) * 8ull, ts = rt(); while (rt() - ts < span) __builtin_amdgcn_s_sleep(8); } }
#undef IN
#undef SEAM
}

extern "C" void kernel_launch(void* const* d_in, const int* in_sizes, int n_in, void* d_out, int out_size, void* d_ws, size_t ws_size, hipStream_t stream) {
    static int grid = 0;
    if (grid == 0) {
        int dev = 0, cus = 0;
        if (hipGetDevice(&dev) != hipSuccess || hipDeviceGetAttribute(&cus, hipDeviceAttributeMultiprocessorCount, dev) != hipSuccess) { fprintf(stderr, "kernel_launch: device query failed\n"); grid = -1; return; }
        if (hipFuncSetAttribute((const void*)mk_fwd, hipFuncAttributeMaxDynamicSharedMemorySize, LDS_BYTES) != hipSuccess) { fprintf(stderr, "kernel_launch: hipFuncSetAttribute failed\n"); grid = -1; return; }
        (void)hipGetLastError();
        grid = cus;
        if (grid != 256 || n_in != 28 || ws_size < WS_END) fprintf(stderr, "kernel_launch: unexpected geometry: %d CUs, %d inputs, %zu bytes of workspace\n", cus, n_in, ws_size);
    }
    if (grid < 0) return;
    (void)hipMemsetAsync((char*)d_ws + WS_CTL, 0, CTL_ZERO_BYTES, stream);
    Args a; memset(&a, 0, sizeof(a));
    for (int i = 0; i < 28; ++i) a.in[i] = (const float*)d_in[i];
    a.out = (float*)d_out; a.ws = (unsigned char*)d_ws;
#if MK_PER_PHASE
    for (int p = 0; p < N_PHASES - 1; ++p) { a.ph_lo = p; a.ph_hi = p + 1; hipLaunchKernelGGL(mk_fwd, dim3(grid), dim3(NWAVES * 64), LDS_BYTES, stream, a); }
#else
    a.ph_lo = 0; a.ph_hi = N_PHASES; hipLaunchKernelGGL(mk_fwd, dim3(grid), dim3(NWAVES * 64), LDS_BYTES, stream, a);
#endif
}
```

```cpp
#include <hip/hip_runtime.h>
#include <cstdio>
#include <cstdint>
#include <cstring>
namespace pg8 {
#define PG8_LAS __attribute__((address_space(3)))
typedef unsigned short bf16_t;
typedef short bf16x8 __attribute__((ext_vector_type(8)));
typedef float f32x4 __attribute__((ext_vector_type(4)));
typedef unsigned u32x4 __attribute__((ext_vector_type(4)));
constexpr int BM = 256, BK = 64, HALF = 128, HTB = HALF * BK * 2  , STAGE_BYTES = 8 * HTB, NXCD = 8, WGM = 8;

__host__ __device__ __forceinline__ int lds_byte(int r, int c) { const int st = (r >> 4) * 2 + (c >> 5), rr = r & 15, cc = c & 31, ob = rr * 64 + cc * 2; return st * 1024 + (ob ^ (((ob >> 9) & 1) << 5)); }
__host__ __device__ __forceinline__ void stage_rc(int b, int& R, int& C) { const int st = b / 1024, sb = b % 1024, swz = sb ^ (((sb >> 9) & 1) << 5); R = (st >> 1) * 16 + swz / 64; C = (st & 1) * 32 + (swz % 64) / 2; }
__host__ __device__ __forceinline__ int perm32(int rho) { const int n = rho >> 4, i = rho & 15; return 8 * (i >> 2) + 4 * n + (i & 3); }

struct Unit { int pm, pn; };
struct Gemm { const bf16_t* A; const bf16_t* Bt; int lda, ldb, K; };

struct StaticOrder {
    int nM, nN, nwg, G, c;
    __host__ __device__ void init(int M, int N, int G_, int c_) { nM = M / BM; nN = N / BM; nwg = nM * nN; G = G_; c = c_; }
    __host__ __device__ bool next(int i, Unit& u) const {
        const long L = (long)i * G + c; if (L >= nwg) return false;
        int wgid = (int)L; { const int q = nwg / NXCD, r = nwg % NXCD, xcd = wgid % NXCD, off = wgid / NXCD; wgid = (xcd < r ? xcd * (q + 1) : r * (q + 1) + (xcd - r) * q) + off; }
        const int nig = WGM * nN, gid = wgid / nig, fm = gid * WGM, gsz = (nM - fm) < WGM ? (nM - fm) : WGM;
        u.pm = fm + ((wgid % nig) % gsz); u.pn = (wgid % nig) / gsz; return true;
    }
    __device__ __forceinline__ void a_ready(const Unit&) const {}
    __device__ __forceinline__ void done(const Unit&) const {}
};

__device__ __forceinline__ unsigned cvt_pk_bf16(float lo, float hi) { unsigned r; asm volatile("v_cvt_pk_bf16_f32 %0, %1, %2" : "=v"(r) : "v"(lo), "v"(hi)); return r; }
typedef float f32x2 __attribute__((ext_vector_type(2)));
template <class Epi, class Sched, bool ALIGN_EPI = false, bool SP2 = false>
__device__ __forceinline__ void gemm_phase(PG8_LAS unsigned char* lds, const Gemm g, const Sched& S, const Epi& E) {
    const int tid = threadIdx.x, wid = __builtin_amdgcn_readfirstlane(tid >> 6), lane = tid & 63, wr = wid >> 2, wc = wid & 3, fr = lane & 15, fq = lane >> 4;
    const int K = g.K, nt = K / BK;
    unsigned voffA[2], voffB[2];
#pragma unroll
    for (int i = 0; i < 2; ++i) { int R, C; stage_rc(tid * 16 + i * 8192, R, C); const int Rb = Epi::PERM ? ((R & ~31) + perm32(R & 31)) : R;
        voffA[i] = (unsigned)(R * g.lda + C) * 2u; voffB[i] = (unsigned)(Rb * g.ldb + C) * 2u; }
    const size_t kstep = (size_t)(BK * 2);
    const size_t hstepA = (size_t)HALF * g.lda * 2, hstepB = (size_t)HALF * g.ldb * 2;
    const size_t tstepA = 2 * hstepA, tstepB = 2 * hstepB;
    const unsigned ldsw = (unsigned)wid * 1024u;
    const int aoff = lds_byte(wr * 64 + fr, fq * 8), boff = lds_byte(wc * 32 + fr, fq * 8);
#define PG8_SA(b, h) (((b) * 2 + (h)) * HTB)
#define PG8_SB(b, h) ((4 + (b) * 2 + (h)) * HTB)
#define PG8_STAGE(bufoff, gbase, voff) do { _Pragma("unroll") for (int _i = 0; _i < 2; ++_i) \
        __builtin_amdgcn_global_load_lds((const unsigned*)((const char*)(gbase) + (voff)[_i]), (PG8_LAS unsigned*)(lds + (bufoff) + ldsw + _i * 8192), 16, 0, 0); } while (0)
#define PG8_LDA(dst, b, h) do { _Pragma("unroll") for (int m = 0; m < 4; ++m) _Pragma("unroll") for (int k = 0; k < 2; ++k) dst[m][k] = *(const PG8_LAS bf16x8*)(lds + PG8_SA(b, h) + aoff + m * 2048 + k * 1024); } while (0)
#define PG8_LDB(dst, b, h) do { _Pragma("unroll") for (int n = 0; n < 2; ++n) _Pragma("unroll") for (int k = 0; k < 2; ++k) dst[n][k] = *(const PG8_LAS bf16x8*)(lds + PG8_SB(b, h) + boff + n * 2048 + k * 1024); } while (0)
#define PG8_MMA(ai, bj, At, Bt) do { __builtin_amdgcn_s_setprio(1); _Pragma("unroll") for (int m = 0; m < 4; ++m) _Pragma("unroll") for (int n = 0; n < 2; ++n) _Pragma("unroll") for (int k = 0; k < 2; ++k) \
        acc[ai][bj][m][n] = __builtin_amdgcn_mfma_f32_16x16x32_bf16(Bt[n][k], At[m][k], acc[ai][bj][m][n], 0, 0, 0); __builtin_amdgcn_s_setprio(0); } while (0)
#define PG8_WAIT_V(n) asm volatile("s_waitcnt vmcnt(" #n ")" ::: "memory")
#define PG8_WAIT_L(n) asm volatile("s_waitcnt lgkmcnt(" #n ")" ::: "memory")
#define PG8_BAR __builtin_amdgcn_s_barrier()
#define PG8_SCHED __builtin_amdgcn_sched_barrier(0)
    Unit cur, nxt; int ui = 0;
    if (!S.next(0, cur)) return;
    f32x4 acc[2][2][4][2];
#pragma unroll
    for (int a = 0; a < 2; ++a)
#pragma unroll
        for (int b = 0; b < 2; ++b)
#pragma unroll
            for (int m = 0; m < 4; ++m)
#pragma unroll
                for (int n = 0; n < 2; ++n) acc[a][b][m][n] = (f32x4){0.f, 0.f, 0.f, 0.f};
    bf16x8 At[4][2], B0[2][2], B1[2][2];
    const char* cA = (const char*)g.A + (size_t)cur.pm * tstepA; const char* cB = (const char*)g.Bt + (size_t)cur.pn * tstepB;
    S.a_ready(cur);
    if constexpr (SP2) {
        PG8_STAGE(PG8_SB(0, 0), cB, voffB); PG8_STAGE(PG8_SB(0, 1), cB + hstepB, voffB); PG8_STAGE(PG8_SA(0, 0), cA, voffA); PG8_STAGE(PG8_SA(0, 1), cA + hstepA, voffA);
        if (wr == 1) PG8_BAR;
        PG8_WAIT_V(2); PG8_BAR;
        PG8_STAGE(PG8_SB(1, 0), cB + kstep, voffB); PG8_STAGE(PG8_SA(1, 0), cA + kstep, voffA); PG8_STAGE(PG8_SB(1, 1), cB + hstepB + kstep, voffB);
        PG8_WAIT_V(6); PG8_BAR;
    } else {
        PG8_STAGE(PG8_SB(0, 0), cB, voffB); PG8_STAGE(PG8_SA(0, 0), cA, voffA); PG8_STAGE(PG8_SB(0, 1), cB + hstepB, voffB); PG8_STAGE(PG8_SA(0, 1), cA + hstepA, voffA);
        if (wr == 1) PG8_BAR;
        PG8_WAIT_V(4); PG8_BAR;
        PG8_STAGE(PG8_SB(1, 0), cB + kstep, voffB); PG8_STAGE(PG8_SA(1, 0), cA + kstep, voffA); PG8_STAGE(PG8_SB(1, 1), cB + hstepB + kstep, voffB);
        PG8_WAIT_V(6); PG8_BAR;
    }
    for (;;) {
        const bool has_next = S.next(ui + 1, nxt);
        const char* nA = has_next ? (const char*)g.A + (size_t)nxt.pm * tstepA : cA; const char* nB = has_next ? (const char*)g.Bt + (size_t)nxt.pn * tstepB : cB;
        for (int t = 0; t < nt; t += 2) {
            const bool last = (t == nt - 2);
            const char* a1 = cA + (size_t)(t + 1) * kstep;
            const char* a2 = last ? nA : cA + (size_t)(t + 2) * kstep; const char* b2 = last ? nB : cB + (size_t)(t + 2) * kstep;
            const char* a3 = a2 + kstep; const char* b3 = b2 + kstep;
            if (last && has_next) S.a_ready(nxt);
            if constexpr (SP2) {
            PG8_LDB(B0, 0, 0); PG8_LDB(B1, 0, 1); PG8_SCHED; PG8_LDA(At, 0, 0); PG8_STAGE(PG8_SA(1, 1), a1 + hstepA, voffA);
            PG8_WAIT_V(8); PG8_WAIT_L(0); PG8_BAR; PG8_MMA(0, 0, At, B0); PG8_MMA(0, 1, At, B1); PG8_BAR; PG8_SCHED;
            PG8_LDA(At, 0, 1); PG8_STAGE(PG8_SB(0, 0), b2, voffB); PG8_STAGE(PG8_SB(0, 1), b2 + hstepB, voffB); PG8_STAGE(PG8_SA(0, 0), a2, voffA);
            PG8_WAIT_V(8); PG8_WAIT_L(0); PG8_BAR; PG8_MMA(1, 0, At, B0); PG8_MMA(1, 1, At, B1); PG8_BAR; PG8_SCHED;
            PG8_LDB(B0, 1, 0); PG8_LDB(B1, 1, 1); PG8_SCHED; PG8_LDA(At, 1, 0); PG8_STAGE(PG8_SA(0, 1), a2 + hstepA, voffA);
            PG8_WAIT_V(8); PG8_WAIT_L(0); PG8_BAR; PG8_MMA(0, 0, At, B0); PG8_MMA(0, 1, At, B1); PG8_BAR; PG8_SCHED;
            PG8_LDA(At, 1, 1); PG8_STAGE(PG8_SB(1, 0), b3, voffB); PG8_STAGE(PG8_SB(1, 1), b3 + hstepB, voffB); PG8_STAGE(PG8_SA(1, 0), a3, voffA);
            PG8_WAIT_V(8); PG8_WAIT_L(0); PG8_BAR; PG8_MMA(1, 0, At, B0); PG8_MMA(1, 1, At, B1); PG8_BAR; PG8_SCHED;
            } else {
            PG8_LDB(B0, 0, 0); PG8_SCHED; PG8_LDA(At, 0, 0); PG8_STAGE(PG8_SA(1, 1), a1 + hstepA, voffA);
            PG8_WAIT_L(8); PG8_BAR; PG8_WAIT_L(0); PG8_MMA(0, 0, At, B0); PG8_BAR; PG8_SCHED;
            PG8_LDB(B1, 0, 1); PG8_STAGE(PG8_SB(0, 0), b2, voffB);
            PG8_BAR; PG8_WAIT_L(0); PG8_MMA(0, 1, At, B1); PG8_BAR;
            PG8_LDA(At, 0, 1); PG8_STAGE(PG8_SA(0, 0), a2, voffA);
            PG8_BAR; PG8_WAIT_L(0); PG8_MMA(1, 0, At, B0); PG8_BAR; PG8_SCHED;
            PG8_STAGE(PG8_SB(0, 1), b2 + hstepB, voffB);
            PG8_WAIT_V(6); PG8_BAR; PG8_MMA(1, 1, At, B1); PG8_BAR;
            PG8_LDB(B0, 1, 0); PG8_SCHED; PG8_LDA(At, 1, 0); PG8_STAGE(PG8_SA(0, 1), a2 + hstepA, voffA);
            PG8_WAIT_L(8); PG8_BAR; PG8_WAIT_L(0); PG8_MMA(0, 0, At, B0); PG8_BAR; PG8_SCHED;
            PG8_LDB(B1, 1, 1); PG8_STAGE(PG8_SB(1, 0), b3, voffB);
            PG8_BAR; PG8_WAIT_L(0); PG8_MMA(0, 1, At, B1); PG8_BAR;
            PG8_LDA(At, 1, 1); PG8_STAGE(PG8_SA(1, 0), a3, voffA);
            PG8_BAR; PG8_WAIT_L(0); PG8_MMA(1, 0, At, B0); PG8_BAR; PG8_SCHED;
            PG8_STAGE(PG8_SB(1, 1), b3 + hstepB, voffB);
            PG8_WAIT_V(6); PG8_BAR; PG8_MMA(1, 1, At, B1); PG8_BAR;
            }
        }
        if constexpr (ALIGN_EPI) { if (wr == 0) PG8_BAR; }
        if constexpr (!Epi::AFTER_DRAIN) { E(acc, cur, wr, wc, fr, fq); S.done(cur); }
        if (!has_next) break;
#pragma unroll
        for (int a = 0; a < 2; ++a)
#pragma unroll
            for (int b = 0; b < 2; ++b)
#pragma unroll
                for (int m = 0; m < 4; ++m)
#pragma unroll
                    for (int n = 0; n < 2; ++n) acc[a][b][m][n] = (f32x4){0.f, 0.f, 0.f, 0.f};
        cur = nxt; cA = nA; cB = nB; ++ui;
        if constexpr (ALIGN_EPI) { if (wr == 1) PG8_BAR; }
    }
    PG8_WAIT_V(0);
    if constexpr (!ALIGN_EPI) { if (wr == 0) PG8_BAR; }
    PG8_BAR;
    if constexpr (Epi::AFTER_DRAIN) { E.fused(acc, cur, wr, wc, fr, fq, lds, wid, lane); S.done(cur); }
#undef PG8_SA
#undef PG8_SB
#undef PG8_STAGE
#undef PG8_LDA
#undef PG8_LDB
#undef PG8_MMA
#undef PG8_WAIT_V
#undef PG8_WAIT_L
#undef PG8_BAR
#undef PG8_SCHED
}
}
#define PG8_SP2 true
#define PG8_ALIGN true
#include <hip/hip_bf16.h>
#include <cmath>
namespace attn_body {
using bf16=__hip_bfloat16;
using bf16x8=__attribute__((ext_vector_type(8)))short;
using s16x4=__attribute__((ext_vector_type(4)))short;
using f32x16=__attribute__((ext_vector_type(16)))float;
using u32x4=__attribute__((ext_vector_type(4)))unsigned;
constexpr int BATCH=2,NHEAD=8,SEQ=8192,D=64,DMQ=NHEAD*D,DMK=128,KVROWS=8320,KVALID=8208;
constexpr int NW=8,QBLK=32,QB=QBLK*NW,KVBLK=64,NQB=SEQ/QB;
constexpr int ATTN_PITCH=DMQ, ATTN_UNIT_ROWS=QB;
__device__ __forceinline__ int crow(int r,int hi){return (r&3)+8*(r>>2)+4*hi;}
#define SBAR() __builtin_amdgcn_sched_barrier(0)
__device__ __forceinline__ void cmask(f32x16&p0,f32x16&p1,int t,int hi){
  const float NEG=-INFINITY; int kb=64*t+4*hi;
  #pragma unroll
  for(int r=0;r<16;++r){int kv=kb+(r&3)+8*(r>>2); if(kv>=KVALID)p0[r]=NEG; if(kv+32>=KVALID)p1[r]=NEG;}
}

constexpr int NSLOT=3, SLOTB=8192;
constexpr int LDS_K=0, LDS_V=NSLOT*SLOTB, LDS_WS=2*NSLOT*SLOTB, LDS_OST=LDS_WS+NW*64*4, LDS_BYTES=LDS_OST+NW*4096;
constexpr float C2=0.125f*1.4426950408889634f;
__device__ __forceinline__ void glds16(const void*gsrc,unsigned lds_dst){unsigned keep;
  asm volatile("s_mov_b32 %0, m0\n\ts_mov_b32 m0, %2\n\ts_nop 0\n\tglobal_load_lds_dwordx4 %1, off\n\ts_mov_b32 m0, %0":"=&s"(keep):"v"(gsrc),"s"(lds_dst):"memory");}
__device__ __forceinline__ float max3f(float a,float b,float c){float r;asm("v_max3_f32 %0, %1, %2, %3":"=v"(r):"v"(a),"v"(b),"v"(c));return r;}
__device__ __forceinline__ float max2f(float a,float b){float r;asm("v_max_f32_e32 %0, %1, %2":"=v"(r):"v"(a),"v"(b));return r;}
__device__ __forceinline__ float fadd_s(float a,float b){float r;asm("v_add_f32_e32 %0, %1, %2":"=v"(r):"v"(a),"v"(b));return r;}
__device__ __forceinline__ float fsub_s(float a,float b){float r;asm("v_sub_f32_e32 %0, %1, %2":"=v"(r):"v"(a),"v"(b));return r;}
typedef float f32x2_t __attribute__((ext_vector_type(2))); typedef __bf16 bf16x2_t __attribute__((ext_vector_type(2)));
__device__ __forceinline__ unsigned cvtpk_s(float lo,float hi){f32x2_t v={lo,hi};bf16x2_t b=__builtin_convertvector(v,bf16x2_t);return __builtin_bit_cast(unsigned,b);}
#define WAIT_BAR(N) asm volatile("s_waitcnt vmcnt(" #N ") lgkmcnt(0)\n\ts_barrier":::"memory")

__device__ __forceinline__ void qkt(f32x16&p0,f32x16&p1,const char*Kslot,const bf16x8*qr,const f32x16&negm,int r32,int hi){
  const char*kb=Kslot+hi*1024+r32*16;
  #pragma unroll
  for(int d0=0;d0<4;++d0){
    const bf16x8 b0=*reinterpret_cast<const bf16x8*>(kb+d0*2048);
    const bf16x8 b1=*reinterpret_cast<const bf16x8*>(kb+d0*2048+512);
    if(d0==0){p0=__builtin_amdgcn_mfma_f32_32x32x16_bf16(b0,qr[0],negm,0,0,0);p1=__builtin_amdgcn_mfma_f32_32x32x16_bf16(b1,qr[0],negm,0,0,0);}
    else{p0=__builtin_amdgcn_mfma_f32_32x32x16_bf16(b0,qr[d0],p0,0,0,0);p1=__builtin_amdgcn_mfma_f32_32x32x16_bf16(b1,qr[d0],p1,0,0,0);}}
}
typedef __attribute__((address_space(3))) const char* lds_cptr;
typedef short v4i16_t __attribute__((ext_vector_type(4)));
__device__ __forceinline__ void kload8(bf16x8*kf,lds_cptr kp){
  kf[0]=*(const __attribute__((address_space(3))) bf16x8*)(kp);      kf[1]=*(const __attribute__((address_space(3))) bf16x8*)(kp+512);
  kf[2]=*(const __attribute__((address_space(3))) bf16x8*)(kp+2048); kf[3]=*(const __attribute__((address_space(3))) bf16x8*)(kp+2560);
  kf[4]=*(const __attribute__((address_space(3))) bf16x8*)(kp+4096); kf[5]=*(const __attribute__((address_space(3))) bf16x8*)(kp+4608);
  kf[6]=*(const __attribute__((address_space(3))) bf16x8*)(kp+6144); kf[7]=*(const __attribute__((address_space(3))) bf16x8*)(kp+6656);
}
__device__ __forceinline__ void kload2(bf16x8*kf,lds_cptr kp,int j){ kf[2*j]=*(const __attribute__((address_space(3))) bf16x8*)(kp+j*2048); kf[2*j+1]=*(const __attribute__((address_space(3))) bf16x8*)(kp+j*2048+512); }
__device__ __forceinline__ s16x4 vtr(lds_cptr p){ return __builtin_bit_cast(s16x4,__builtin_amdgcn_ds_read_tr16_b64_v4i16((__attribute__((address_space(3))) v4i16_t*)p)); }
__device__ __forceinline__ float rowmax(const f32x16&p0,const f32x16&p1){
  float a=max3f(p0[0],p0[1],p1[0]),b=max3f(p0[2],p0[3],p1[1]);a=max3f(a,p1[2],p1[3]);
  #pragma unroll
  for(int r=4;r<16;r+=4){a=max3f(a,p0[r],p0[r+1]);b=max3f(b,p0[r+2],p0[r+3]);a=max3f(a,p1[r],p1[r+1]);b=max3f(b,p1[r+2],p1[r+3]);}
  const float m=max2f(a,b);
  auto rr=__builtin_amdgcn_permlane32_swap(__float_as_uint(m),__float_as_uint(m),false,false);
  return max2f(__uint_as_float(rr[0]),__uint_as_float(rr[1]));
}
__device__ __forceinline__ void pv(f32x16*o,int vb,bf16x8 pa0,bf16x8 pa1,bf16x8 pa2,bf16x8 pa3){
  #pragma unroll
  for(int d0=0;d0<2;++d0){s16x4 lo[4],hi[4];
    #pragma unroll
    for(int ks=0;ks<4;++ks){
      asm volatile("ds_read_b64_tr_b16 %0,%1 offset:%c2":"=&v"(lo[ks]):"v"(vb),"i"(d0*4096+ks*1024):"memory");
      asm volatile("ds_read_b64_tr_b16 %0,%1 offset:%c2":"=&v"(hi[ks]):"v"(vb),"i"(d0*4096+ks*1024+512):"memory");}
    asm volatile("s_waitcnt lgkmcnt(0)":::"memory");SBAR();
    #define PK(k) (bf16x8){lo[k][0],lo[k][1],lo[k][2],lo[k][3],hi[k][0],hi[k][1],hi[k][2],hi[k][3]}
    o[d0]=__builtin_amdgcn_mfma_f32_32x32x16_bf16(pa0,PK(0),o[d0],0,0,0);
    o[d0]=__builtin_amdgcn_mfma_f32_32x32x16_bf16(pa1,PK(1),o[d0],0,0,0);
    o[d0]=__builtin_amdgcn_mfma_f32_32x32x16_bf16(pa2,PK(2),o[d0],0,0,0);
    o[d0]=__builtin_amdgcn_mfma_f32_32x32x16_bf16(pa3,PK(3),o[d0],0,0,0);
    #undef PK
  }
}

#ifndef ATTN_STORE16
#define ATTN_STORE16(p,v) (*(u32x4*)(p)=(v))
#endif
template<int THRL> __device__ __forceinline__ void attn_unit(int b,int h,int qb,const bf16*Q,const bf16*__restrict__ K,const bf16*__restrict__ V,bf16*O,char*shm){
  const int tid=threadIdx.x,lane=tid&63,r32=lane&31,hi=lane>>5; const int wid=__builtin_amdgcn_readfirstlane(tid>>6);
  const long rowbase=(long)b*SEQ, kvbase=(long)b*KVROWS; const int q0=qb*QB;
  const bf16*Qw=Q+(rowbase+q0+wid*QBLK)*DMQ+h*D;
  const bf16*Kh=K+kvbase*DMK+(h>>2)*D,*Vh=V+kvbase*DMK+(h>>2)*D;
  const unsigned lds0=(unsigned)(uintptr_t)shm;
  float*wsf=(float*)(shm+LDS_WS)+wid*64;
  const bf16*ksrc=Kh+(long)lane*DMK+wid*8;
  const bf16*vsrc=Vh+(long)(16*(wid&3)+(lane>>2))*DMK+(wid>>2)*32+(lane&3)*8;
  const unsigned kdst=lds0+LDS_K+wid*1024, vdst=lds0+LDS_V+wid*1024;
  #define DMA_K(t,slot) glds16(ksrc+(long)(t)*KVBLK*DMK,(unsigned)__builtin_amdgcn_readfirstlane(kdst+(slot)))
  #define DMA_V(t,slot) glds16(vsrc+(long)(t)*KVBLK*DMK,(unsigned)__builtin_amdgcn_readfirstlane(vdst+(slot)))
  const int vb0=(int)(lds0+LDS_V)+((lane>>4)&1)*32+(lane&3)*8+(4*hi+((lane&15)>>2))*64;
  const char*Kbase=shm+LDS_K; bf16x8 kf[8];
  const lds_cptr shm3=(lds_cptr)shm; const lds_cptr kp0=shm3+LDS_K+hi*1024+r32*16; const lds_cptr vp0=shm3+LDS_V+((lane>>4)&1)*32+(lane&3)*8+(4*hi+((lane&15)>>2))*64;
  constexpr int NT=KVROWS/KVBLK;
  DMA_K(0,0);DMA_V(0,0);DMA_K(1,SLOTB);
  bf16x8 qr[4];
  #pragma unroll
  for(int d0=0;d0<4;++d0)qr[d0]=*reinterpret_cast<const bf16x8*>(&Qw[(long)r32*DMQ+d0*16+hi*8]);
  float mhat=0.f,l_reg=0.f;f32x16 o[2];o[0]=f32x16{};o[1]=f32x16{};f32x16 negm=f32x16{};asm volatile("":"+v"(negm));
    #define CMASK(P0,P1,t) do{ if((t)>=NT-4)cmask(P0,P1,(t),hi); }while(0)
  bool resc=false;
  #define START(P0,P1) do{ const float rm=rowmax(P0,P1); resc=false; \
    { const float dl=rm; mhat=fadd_s(mhat,dl); \
      _Pragma("unroll") for(int r=0;r<16;++r){P0[r]=fsub_s(P0[r],dl);P1[r]=fsub_s(P1[r],dl);} \
      _Pragma("unroll") for(int r=0;r<16;++r)negm[r]=-mhat; asm volatile("":"+v"(negm)); } \
    _Pragma("unroll") for(int r=0;r<16;++r)P0[r]=__builtin_amdgcn_exp2f(P0[r]); }while(0)
  #define RESC() do{ if(resc){ asm volatile("s_waitcnt lgkmcnt(0)":::"memory"); \
      _Pragma("unroll") for(int d_=0;d_<2;++d_) _Pragma("unroll") for(int r=0;r<16;++r)o[d_][r]*=wsf[crow(r,hi)]; } }while(0)
  f32x16 pA0,pA1,pB0,pB1;
  int sl_prev=0,sl_cur=0,sl_next=SLOTB;
  #define ROT() do{sl_prev=sl_cur;sl_cur=sl_next;sl_next=(sl_next==(NSLOT-1)*SLOTB)?0:sl_next+SLOTB;}while(0)
  DMA_K(2,2*SLOTB);
  WAIT_BAR(3);
  qkt(pA0,pA1,Kbase,qr,negm,r32,hi);asm volatile("s_nop 15\n\ts_nop 7":"+v"(pA0),"+v"(pA1));CMASK(pA0,pA1,0);
  START(pA0,pA1);
  _Pragma("unroll") for(int r=0;r<16;++r)pA1[r]=__builtin_amdgcn_exp2f(pA1[r]);
  WAIT_BAR(0);
  DMA_K(3,0);DMA_V(1,SLOTB);
  ROT();
  kload8(kf,kp0+sl_cur);
  WAIT_BAR(2);
  s16x4 vlo[8],vhi[8]; u32x4 pw0,pw1,pw2,pw3;
  #define PKW(P,B) cvtpk_s(P[B],P[B+1])
  #define PAF(k) __builtin_bit_cast(bf16x8,pw##k)
  #define VFR(i) (bf16x8){vlo[i][0],vlo[i][1],vlo[i][2],vlo[i][3],vhi[i][0],vhi[i][1],vhi[i][2],vhi[i][3]}
  #define PIN(x) asm volatile("":"+v"(x))
  #define MX3(a,b,c) __builtin_fmaxf(__builtin_fmaxf((a),(b)),(c))
  #define GAPA(MF,A0,A1,A2,A3,W0,W1,PW) do{ MF; sacc+=A0; sacc+=A1; sacc+=A2; sacc+=A3; PIN(sacc); W0; W1; PIN(PW); SBAR(); }while(0)
  #define EX(v) __builtin_amdgcn_exp2f(v)
  #define GAPB(MF,X,B) do{ MF; X[B]=EX(X[B]); X[B+1]=EX(X[B+1]); X[B+2]=EX(X[B+2]); X[B+3]=EX(X[B+3]); PIN(X); SBAR(); }while(0)
  #define VRD(i) do{ vlo[i]=vtr(vp_+(((i)>>2)*4096+((i)&3)*1024)); vhi[i]=vtr(vp_+(((i)>>2)*4096+((i)&3)*1024+512)); }while(0)
  #define KRD(G,j) do{ if(G){ kload2(kf,kp0+sl_next,j); SBAR(); } }while(0)
  #define STEP(C0,C1,P0,P1,t,GK,GV,GL) do{ SBAR(); \
    const lds_cptr vp_=vp0+sl_prev; \
    VRD(0); SBAR(); float sacc=(P0[0]+P0[1]); \
    GAPA(C0=__builtin_amdgcn_mfma_f32_32x32x16_bf16(kf[0],qr[0],negm,0,0,0), P0[2],P0[3],P0[4],P0[5],     pw0[0]=PKW(P0,0), pw0[1]=PKW(P0,2), pw0); \
    VRD(4); SBAR(); GAPA(C1=__builtin_amdgcn_mfma_f32_32x32x16_bf16(kf[1],qr[0],negm,0,0,0), P0[6],P0[7],P0[8],P0[9],     pw0[2]=PKW(P0,4), pw0[3]=PKW(P0,6), pw0); \
    VRD(1); SBAR(); GAPA(C0=__builtin_amdgcn_mfma_f32_32x32x16_bf16(kf[2],qr[1],C0,0,0,0),   P0[10],P0[11],P0[12],P0[13], pw1[0]=PKW(P0,8), pw1[1]=PKW(P0,10), pw1); \
    VRD(5); SBAR(); GAPA(C1=__builtin_amdgcn_mfma_f32_32x32x16_bf16(kf[3],qr[1],C1,0,0,0),   P0[14],P0[15],P1[0],P1[1],   pw1[2]=PKW(P0,12),pw1[3]=PKW(P0,14), pw1); \
    VRD(2); SBAR(); GAPA(C0=__builtin_amdgcn_mfma_f32_32x32x16_bf16(kf[4],qr[2],C0,0,0,0),   P1[2],P1[3],P1[4],P1[5],     pw2[0]=PKW(P1,0), pw2[1]=PKW(P1,2), pw2); \
    VRD(6); SBAR(); GAPA(C1=__builtin_amdgcn_mfma_f32_32x32x16_bf16(kf[5],qr[2],C1,0,0,0),   P1[6],P1[7],P1[8],P1[9],     pw2[2]=PKW(P1,4), pw2[3]=PKW(P1,6), pw2); \
    VRD(3); SBAR(); GAPA(C0=__builtin_amdgcn_mfma_f32_32x32x16_bf16(kf[6],qr[3],C0,0,0,0),   P1[10],P1[11],P1[12],P1[13], pw3[0]=PKW(P1,8), pw3[1]=PKW(P1,10), pw3); \
    VRD(7); SBAR(); GAPA(C1=__builtin_amdgcn_mfma_f32_32x32x16_bf16(kf[7],qr[3],C1,0,0,0),   P1[14],P1[15],0.f,0.f,       pw3[2]=PKW(P1,12),pw3[3]=PKW(P1,14), pw3); \
    l_reg+=sacc; \
    if(GK){DMA_K((t)+3,sl_cur);} if(GV){DMA_V((t)+1,sl_next);} \
    CMASK(C0,C1,t); \
    { float a=MX3(C0[0],C0[1],C1[0]),b=MX3(C0[2],C0[3],C1[1]); a=MX3(a,C1[2],C1[3]); \
      _Pragma("unroll") for(int r=4;r<16;r+=4){a=MX3(a,C0[r],C0[r+1]);b=MX3(b,C0[r+2],C0[r+3]);a=MX3(a,C1[r],C1[r+1]);b=MX3(b,C1[r+2],C1[r+3]);} \
      float rm=__builtin_fmaxf(a,b); { auto rr=__builtin_amdgcn_permlane32_swap(__float_as_uint(rm),__float_as_uint(rm),false,false); rm=__builtin_fmaxf(__uint_as_float(rr[0]),__uint_as_float(rr[1])); } \
      resc=false; \
      if(__builtin_expect(__any(rm>(float)THRL),0)){ const float dl=__builtin_fmaxf(rm,0.f); mhat+=dl; \
        _Pragma("unroll") for(int r=0;r<16;++r){C0[r]-=dl;C1[r]-=dl;} \
        _Pragma("unroll") for(int r=0;r<16;++r)negm[r]=-mhat; asm volatile("":"+v"(negm)); \
        const float f=__builtin_amdgcn_exp2f(-dl); l_reg*=f; if(hi==0)wsf[r32]=f; resc=true; } } \
    SBAR(); \
    GAPB(o[0]=__builtin_amdgcn_mfma_f32_32x32x16_bf16(PAF(0),VFR(0),o[0],0,0,0), C0,0); \
    GAPB(o[1]=__builtin_amdgcn_mfma_f32_32x32x16_bf16(PAF(0),VFR(4),o[1],0,0,0), C0,4); \
    KRD(GL,0); GAPB(o[0]=__builtin_amdgcn_mfma_f32_32x32x16_bf16(PAF(1),VFR(1),o[0],0,0,0), C0,8); \
    KRD(GL,1); GAPB(o[1]=__builtin_amdgcn_mfma_f32_32x32x16_bf16(PAF(1),VFR(5),o[1],0,0,0), C0,12); \
    KRD(GL,2); GAPB(o[0]=__builtin_amdgcn_mfma_f32_32x32x16_bf16(PAF(2),VFR(2),o[0],0,0,0), C1,0); \
    KRD(GL,3); GAPB(o[1]=__builtin_amdgcn_mfma_f32_32x32x16_bf16(PAF(2),VFR(6),o[1],0,0,0), C1,4); \
    GAPB(o[0]=__builtin_amdgcn_mfma_f32_32x32x16_bf16(PAF(3),VFR(3),o[0],0,0,0), C1,8); \
    GAPB(o[1]=__builtin_amdgcn_mfma_f32_32x32x16_bf16(PAF(3),VFR(7),o[1],0,0,0), C1,12); \
    }while(0)
  int t=1;
  #undef CMASK
  #define CMASK(P0,P1,t) do{}while(0)
  for(;t+5<NT;t+=2){
    STEP(pB0,pB1,pA0,pA1,t,true,true,true);     WAIT_BAR(2); RESC(); ROT();
    STEP(pA0,pA1,pB0,pB1,t+1,true,true,true);   WAIT_BAR(2); RESC(); ROT();
  }
  #undef CMASK
  #define CMASK(P0,P1,t) do{ if((t)>=NT-4)cmask(P0,P1,(t),hi); }while(0)
  #define ENDW(tt) do{ if((tt)+3<NT){WAIT_BAR(2);} else if((tt)+2<NT){WAIT_BAR(1);} else {WAIT_BAR(0);} }while(0)
  for(;t+1<NT;t+=2){
    STEP(pB0,pB1,pA0,pA1,t,(t+3<NT),(t+1<NT),(t+1<NT));       ENDW(t);   RESC(); ROT();
    STEP(pA0,pA1,pB0,pB1,t+1,(t+4<NT),(t+2<NT),(t+2<NT));     ENDW(t+1); RESC(); ROT();
  }
  STEP(pB0,pB1,pA0,pA1,NT-1,false,false,false); RESC();
  { float sacc=pB0[0]+pB0[1]; _Pragma("unroll") for(int r=2;r<16;++r)sacc+=pB0[r]; _Pragma("unroll") for(int r=0;r<16;++r)sacc+=pB1[r]; l_reg+=sacc;
    pw0=(u32x4){PKW(pB0,0),PKW(pB0,2),PKW(pB0,4),PKW(pB0,6)};pw1=(u32x4){PKW(pB0,8),PKW(pB0,10),PKW(pB0,12),PKW(pB0,14)};pw2=(u32x4){PKW(pB1,0),PKW(pB1,2),PKW(pB1,4),PKW(pB1,6)};pw3=(u32x4){PKW(pB1,8),PKW(pB1,10),PKW(pB1,12),PKW(pB1,14)};
    SBAR(); pv(o,vb0+sl_cur,PAF(0),PAF(1),PAF(2),PAF(3)); }
  #undef PKW
  #undef PAF
  #undef VFR
  #undef PIN
  #undef MX3
  #undef GAPA
  #undef GAPB
  #undef EX
  #undef VRD
  #undef KRD
  #undef STEP
  #undef ENDW
  {auto rr=__builtin_amdgcn_permlane32_swap(__float_as_uint(l_reg),__float_as_uint(l_reg),false,false);l_reg=__uint_as_float(rr[0])+__uint_as_float(rr[1]);}
  if(hi==0)wsf[32+r32]=l_reg;asm volatile("s_waitcnt lgkmcnt(0)":::"memory");
  float rli[16];
  #pragma unroll
  for(int r=0;r<16;++r)rli[r]=__builtin_amdgcn_rcpf(wsf[32+crow(r,hi)]);
  bf16*Ow=O+(rowbase+q0+wid*QBLK)*DMQ+h*D;
  { bf16*stg=(bf16*)(shm+LDS_OST)+wid*2048;
    #pragma unroll
    for(int r=0;r<16;++r){const int orow=crow(r,hi);
      #pragma unroll
      for(int d0=0;d0<2;++d0)stg[orow*64+d0*32+r32]=__float2bfloat16(o[d0][r]*rli[r]);}
    asm volatile("s_waitcnt lgkmcnt(0)":::"memory");
    #pragma unroll
    for(int i=0;i<4;++i){const int row=i*8+(lane>>3),ch=lane&7; const u32x4 v=*(const u32x4*)(stg+row*64+ch*8); ATTN_STORE16(Ow+(long)row*DMQ+ch*8,v);} }
  asm volatile("s_waitcnt lgkmcnt(0)\n\ts_barrier":::"memory");
  #undef DMA_K
  #undef DMA_V
  #undef CMASK
  #undef START
  #undef RESC
  #undef ROT
}
constexpr int ATTN_LDS_BYTES=LDS_BYTES;
struct AttnTensors { const bf16* Q; const bf16* K; const bf16* V; bf16* O; };
struct AttnUnit { int bh; int qb; };
struct StaticOrder {
  int vcu;
  __device__ __forceinline__ explicit StaticOrder(int grid,int block):vcu((block%8)*(grid/8)+block/8){}
  __device__ __forceinline__ bool next(int i,AttnUnit&u)const{ if(i>=2)return false; const int pr=vcu>>6,uu=2*(vcu&63)+i; u.bh=(pr>>1)*NHEAD+(pr&1)*4+(uu>>5); u.qb=uu&31; return true; }
  __device__ __forceinline__ void a_ready(const AttnUnit&)const{}
  __device__ __forceinline__ void done(const AttnUnit&)const{}
};
template<class Sched,int THRL=8> __device__ __forceinline__ void attn_phase(char*lds,const AttnTensors&T,const Sched&S){
  AttnUnit u;
  for(int i=0;S.next(i,u);++i){ S.a_ready(u); attn_unit<THRL>(u.bh/NHEAD,u.bh%NHEAD,u.qb,T.Q,T.K,T.V,T.O,lds); S.done(u); }
}
#undef SBAR
#undef WAIT_BAR
}
#define GAS __attribute__((address_space(1)))
#define LAS __attribute__((address_space(3)))
typedef unsigned short bf16;
typedef unsigned v4u __attribute__((ext_vector_type(4)));
typedef float f32x4 __attribute__((ext_vector_type(4)));
typedef short bf16x8 __attribute__((ext_vector_type(8)));
typedef GAS unsigned gu32;
typedef GAS unsigned long long gu64;
#define RLX_AGENT __ATOMIC_RELAXED, __HIP_MEMORY_SCOPE_AGENT
#define LDS_WAIT() asm volatile("s_waitcnt lgkmcnt(0)" ::: "memory")
#define VM_WAIT() asm volatile("s_waitcnt vmcnt(0)" ::: "memory")
__device__ __forceinline__ unsigned long long rt() { return __builtin_amdgcn_s_memrealtime(); }
__device__ __forceinline__ unsigned f2bf(float f) { unsigned u = __builtin_bit_cast(unsigned, f); return (u + 0x7fffu + ((u >> 16) & 1u)) >> 16; }
__device__ __forceinline__ unsigned pk2(float lo, float hi) { return f2bf(lo) | (f2bf(hi) << 16); }

#define XB_TMO      128
#define XB_XCNT(j)  (256  + 64 * (j))
#define XB_XSUB(j)  (1280 + 64 * (j))
#define XB_XGEN(j)  (2304 + 64 * (j))
#define XB_TOP      3328
#define XB_TOPGEN   3392
#define XCD_BAR_WORDS 3456
#define XB_SPIN_CAP (1u << 18)

__device__ __forceinline__ unsigned xb_ld(unsigned* p)              { return __hip_atomic_load(p, __ATOMIC_RELAXED, __HIP_MEMORY_SCOPE_AGENT); }
__device__ __forceinline__ unsigned xb_add(unsigned* p, unsigned v) { return __hip_atomic_fetch_add(p, v, __ATOMIC_RELAXED, __HIP_MEMORY_SCOPE_AGENT); }
__device__ __forceinline__ unsigned xb_xcc_id() { return (unsigned)__builtin_amdgcn_s_getreg((3 << 11) | 20) & 0xFu; }
#define XB_SPIN(cond, bar) do { unsigned _sp = 0; while (cond) { __builtin_amdgcn_s_sleep(1); \
    if ((++_sp & 255u) == 0u) { if (xb_ld(&(bar)[XB_TMO])) break; if (_sp > XB_SPIN_CAP) { atomicAdd(&(bar)[XB_TMO], 1u); break; } } } } while (0)

struct XcdBarrier {
    unsigned* bar; unsigned x;
    volatile LAS unsigned* st;
};

__device__ __forceinline__ XcdBarrier xcd_barrier_post(unsigned* bar, volatile LAS unsigned* st) {
    XcdBarrier b; b.bar = bar; b.x = xb_xcc_id(); b.st = st;
    if (threadIdx.x == 0) (void)xb_add(&bar[XB_XCNT(b.x)], 1u);
    return b;
}
__device__ __forceinline__ void xcd_barrier_complete(unsigned* bar, unsigned x, unsigned& nloc, unsigned& nx) {
    const unsigned G = gridDim.x * gridDim.y * gridDim.z;
    unsigned sum, cnt, mine, sp = 0u;
    for (;;) {
        sum = 0u; cnt = 0u; mine = 0u;
#pragma unroll
        for (unsigned j = 0; j < 16; ++j) { const unsigned c = xb_ld(&bar[XB_XCNT(j)]); sum += c; cnt += (c > 0u) ? 1u : 0u; mine = (j == x) ? c : mine; }
        if (sum == G) break;
        __builtin_amdgcn_s_sleep(1);
        if ((++sp & 255u) == 0u) { if (xb_ld(&bar[XB_TMO])) break; if (sp > XB_SPIN_CAP) { atomicAdd(&bar[XB_TMO], 1u); break; } }
    }
    nloc = mine > 0u ? mine : 1u; nx = cnt > 0u ? cnt : 1u;
}

__device__ __forceinline__ void xcd_barrier(const XcdBarrier& b) {
    asm volatile("s_waitcnt vmcnt(0)" ::: "memory");
    __syncthreads();
    if (threadIdx.x == 0) {
        unsigned* bar = b.bar;
        __builtin_amdgcn_s_waitcnt(0);
        unsigned nloc = b.st[0], nx = b.st[1];
        if (nloc == 0u) { xcd_barrier_complete(bar, b.x, nloc, nx); b.st[0] = nloc; b.st[1] = nx; }
        const unsigned old = xb_add(&bar[XB_XSUB(b.x)], 1u);
        const unsigned gen = old / nloc;
        if (old + 1u == (gen + 1u) * nloc) {
            __builtin_amdgcn_fence(__ATOMIC_RELEASE, "agent");
            asm volatile("s_waitcnt vmcnt(0)" ::: "memory");
            const unsigned og = xb_add(&bar[XB_TOP], 1u);
            const unsigned tg = og / nx;
            if (og + 1u == (tg + 1u) * nx) xb_add(&bar[XB_TOPGEN], 1u);
            else XB_SPIN(xb_ld(&bar[XB_TOPGEN]) == tg, bar);
            __builtin_amdgcn_fence(__ATOMIC_ACQUIRE, "agent");
            xb_add(&bar[XB_XGEN(b.x)], 1u);
            asm volatile("s_waitcnt vmcnt(0)" ::: "memory");
        } else {
            XB_SPIN(xb_ld(&bar[XB_XGEN(b.x)]) == gen, bar);
            __builtin_amdgcn_fence(__ATOMIC_ACQUIRE, "agent");
            asm volatile("s_waitcnt vmcnt(0)" ::: "memory");
        }
    }
    __syncthreads();
}

constexpr int NWAVES = 8;
constexpr int BATCH = 2, SEQ = 8192, DM = 1024, NMETA = 16;
constexpr int M = BATCH * SEQ;
constexpr int INW = 3328;
constexpr int KVROWS = 8320, KVALID = 8208;
constexpr int NG = 32, NE = 16, CAP = 1024;
constexpr int UGP = 768;
constexpr float LN_EPS = 1e-5f, QK_EPS = 1e-6f, ALPHA = 1.189207115002721f;
constexpr float C2Q = 0.125f * 1.4426950408889634f;

constexpr size_t MiB = 1u << 20;
constexpr size_t WS_CTL = 0, CTL_ZERO_BYTES = 1 * MiB;
constexpr size_t WS_STATS0 = 1 * MiB, WS_STATS1 = WS_STATS0 + 131072, WS_ROPE = WS_STATS1 + 131072, WS_UMETA = WS_ROPE + 32768, WS_GATE2 = WS_UMETA + 32768, WS_IDX2 = WS_GATE2 + 131072;
constexpr size_t WS_SLOTOF = 2 * MiB, WS_AFF = 3 * MiB;
constexpr size_t WS_WGU = 8 * MiB, WS_WD = 72 * MiB;
constexpr size_t WS_WIN = 104 * MiB, WS_WGLU = 111 * MiB, WS_WAB = 112 * MiB, WS_WSB = 113 * MiB, WS_WO = 114 * MiB;
constexpr size_t WS_WST = 116 * MiB, WS_MEXT = 124 * MiB;
constexpr size_t WS_XN = 148 * MiB;
constexpr size_t WS_Q = 181 * MiB, WS_K = 197 * MiB, WS_V = 202 * MiB;
constexpr size_t WS_UG2 = 207 * MiB, WS_S = 231 * MiB;
constexpr size_t WS_END = 247 * MiB;
constexpr size_t WS_YG = WS_XN, WS_Z = WS_XN + 16 * MiB;
constexpr size_t WS_T1 = WS_WST;
constexpr size_t WS_MERGED = WS_UG2;
constexpr size_t WS_H1 = WS_XN;
constexpr size_t WS_XE = WS_Q;
constexpr size_t WS_HB = WS_WIN;
static_assert(WS_XE + 64 * MiB <= WS_END && WS_HB + 64 * MiB <= WS_XE && WS_MERGED + 32 * MiB <= WS_END && WS_T1 + 32 * MiB <= WS_XN, "d_ws overlays");
constexpr int CW_TMO = 0, CW_BAR = 4096;
constexpr int CW_Q = 8192, CW_QM = 8192 + 4096, CW_DONE = 8256;
constexpr int N_DENSE_ITEMS = 16 * 104 + 8 * 16 + 2 * 8 * 32 + 16 * 32, N_EXP_ITEMS = NE * 3 * 16 * 32;

constexpr int RING_OFF = 0, RING_BYTES = 131072;
constexpr int LDSCTL_OFF = RING_BYTES, MISC_OFF = LDSCTL_OFF + 320;
constexpr int LDS_BYTES = 147456;

typedef unsigned u32x4_t __attribute__((ext_vector_type(4)));
typedef unsigned u32x2_t __attribute__((ext_vector_type(2)));
typedef float f32x2_t2 __attribute__((ext_vector_type(2)));
using pg8::Unit;

struct Frame {
    LAS unsigned char* lds; volatile LAS unsigned* MISC; gu32* ctl;
    int tid, lane, wave, vcu, G;
    unsigned char* ws;
    const float* in[28]; float* out;
};
__device__ __forceinline__ float wave_sum(float v) {
#pragma unroll
    for (int o = 1; o < 64; o <<= 1) v += __shfl_xor(v, o);
    return v;
}
__device__ __forceinline__ float sigm(float x) { return 1.f / (1.f + __expf(-x)); }
__device__ __forceinline__ float bf2f(unsigned short h) { return __uint_as_float((unsigned)h << 16); }
__device__ __forceinline__ float bflo(unsigned w) { return __uint_as_float(w << 16); }
__device__ __forceinline__ float bfhi(unsigned w) { return __uint_as_float(w & 0xffff0000u); }
__device__ __forceinline__ u32x4_t pack8(const f32x4& a, const f32x4& b) { u32x4_t w; w.x = pg8::cvt_pk_bf16(a[0], a[1]); w.y = pg8::cvt_pk_bf16(a[2], a[3]); w.z = pg8::cvt_pk_bf16(b[0], b[1]); w.w = pg8::cvt_pk_bf16(b[2], b[3]); return w; }
__device__ __forceinline__ float gelu_tanh(float y) { const float in = 0.7978845608028654f * (y + 0.044715f * y * y * y); const float e = __expf(2.f * in); return y * (1.f - 1.f / (e + 1.f)); }

struct InProjOrder {
    pg8::StaticOrder so;
    __device__ bool next(int i, Unit& u) const { if (so.next(i, u)) return true; const long L = (long)i * so.G + so.c; if (L >= so.nwg && L < so.nwg + 3) { u.pm = 64; u.pn = 2 + (int)(L - so.nwg); return true; } return false; }
    __device__ __forceinline__ void a_ready(const Unit&) const {}
    __device__ __forceinline__ void done(const Unit&) const {}
};
struct SsmStateOrder {
    int G, c;
    __device__ bool next(int i, Unit& u) const { const int L = i * G + c; if (L >= 64) return false; u.pm = L; u.pn = L >> 1; return true; }
    __device__ __forceinline__ void a_ready(const Unit&) const {}
    __device__ __forceinline__ void done(const Unit&) const {}
};
struct SsmYOrder {
    int G, c;
    __device__ bool next(int i, Unit& u) const { const int L = i * G + c; if (L >= 128) return false; const int g = L >> 2; u.pm = g * 2 + ((L >> 1) & 1); u.pn = g * 2 + (L & 1); return true; }
    __device__ __forceinline__ void a_ready(const Unit&) const {}
    __device__ __forceinline__ void done(const Unit&) const {}
};
struct MoeOrder {
    int G, c, nmi, nnj;
    __device__ bool next(int i, Unit& u) const { const int per = nmi * nnj, nwg = NE * per; const int L = i * G + c; if (L >= nwg) return false;
        const int wgid = (L % 8) * (nwg / 8) + L / 8; const int e = wgid / per, w = wgid % per; u.pm = e * nmi + (w % nmi); u.pn = e * nnj + (w / nmi); return true; }
    __device__ __forceinline__ void a_ready(const Unit&) const {}
    __device__ __forceinline__ void done(const Unit&) const {}
};

typedef float f32x4 __attribute__((ext_vector_type(4)));
#define EPI_LOOP_AM _Pragma("unroll") for (int ai = 0; ai < 2; ++ai) _Pragma("unroll") for (int m = 0; m < 4; ++m)
constexpr int XCH_OFF = 132096;
struct EpiInProj {
    static constexpr bool PERM = true, AFTER_DRAIN = false;
    bf16* Q; bf16* Kb; bf16* Vb; bf16* UG2; bf16* GATES; bf16* UMETA; LAS float* XCH; const float* ngt; const float* RP;
    __device__ __forceinline__ u32x4_t normrope(const f32x4& a0, const f32x4& a1, float rinv, const f32x4& g0, const f32x4& g1, const f32x4& cs, const f32x4& sn, float osc) const {
        const float y0 = a0[0] * rinv * g0[0], y1 = a0[1] * rinv * g0[1], y2 = a0[2] * rinv * g0[2], y3 = a0[3] * rinv * g0[3];
        const float y4 = a1[0] * rinv * g1[0], y5 = a1[1] * rinv * g1[1], y6 = a1[2] * rinv * g1[2], y7 = a1[3] * rinv * g1[3];
        u32x4_t w;
        w.x = pg8::cvt_pk_bf16((y0 * cs[0] - y1 * sn[0]) * osc, (y0 * sn[0] + y1 * cs[0]) * osc);
        w.y = pg8::cvt_pk_bf16((y2 * cs[1] - y3 * sn[1]) * osc, (y2 * sn[1] + y3 * cs[1]) * osc);
        w.z = pg8::cvt_pk_bf16((y4 * cs[2] - y5 * sn[2]) * osc, (y4 * sn[2] + y5 * cs[2]) * osc);
        w.w = pg8::cvt_pk_bf16((y6 * cs[3] - y7 * sn[3]) * osc, (y6 * sn[3] + y7 * cs[3]) * osc);
        return w;
    }
    __device__ __forceinline__ void operator()(const f32x4 (&acc)[2][2][4][2], const Unit& u, int wr, int wc, int fr_, int fq_) const {
        int fr = fr_, fq = fq_; asm volatile("" : "+v"(fr), "+v"(fq));
        const int pn = u.pn, cl0 = wc * 32 + 8 * fq;
        if (pn <= 2) {
            const int nb = pn == 2 ? 1 : 2;
            EPI_LOOP_AM {
#pragma unroll
                for (int bj = 0; bj < 2; ++bj) {
                    if (bj < nb) { const f32x4 a = acc[ai][bj][m][0], c = acc[ai][bj][m][1]; float s = (a[0] * a[0] + a[1] * a[1]) + (a[2] * a[2] + a[3] * a[3]) + (c[0] * c[0] + c[1] * c[1]) + (c[2] * c[2] + c[3] * c[3]);
                        s += __shfl_xor(s, 16); s += __shfl_xor(s, 32);
                        if (fq == 0) XCH[(ai * 128 + wr * 64 + m * 16 + fr) * 8 + bj * 4 + wc] = s; } } }
            asm volatile("s_waitcnt lgkmcnt(0)" ::: "memory"); __builtin_amdgcn_s_barrier(); asm volatile("" ::: "memory");
            const float* gsrc = ngt + (pn == 2 ? 64 : 0) + (wc & 1) * 32 + 8 * fq;
            const f32x4 g0 = *(const f32x4*)gsrc, g1 = *(const f32x4*)(gsrc + 4);
            const float osc = pn == 2 ? 1.f : C2Q;
            const int codd = wc & 1;
            EPI_LOOP_AM {
                if (u.pm == 64 && (wr != 0 || ai != 0 || m != 0)) continue;
                const int rl = ai * 128 + wr * 64 + m * 16 + fr; const int row = u.pm * 256 + rl;
                f32x4 cs = (f32x4){1.f, 1.f, 1.f, 1.f}, sn = (f32x4){0.f, 0.f, 0.f, 0.f};
                if (u.pm != 64) { const int s = row & 8191; const float* tp = codd ? RP + 4096 + (s & 63) * 16 + 4 * fq : RP + (s >> 6) * 16 + 4 * fq; cs = *(const f32x4*)tp; sn = *(const f32x4*)(tp + (codd ? 1024 : 2048)); }
#pragma unroll
                for (int bj = 0; bj < 2; ++bj) {
                    if (bj < nb) {
                        const f32x2_t2 pr = *(const LAS f32x2_t2*)(XCH + rl * 8 + bj * 4 + (wc & 2)); const float tot = pr.x + pr.y;
                        const float rinv = rsqrtf(tot * (1.f / 64.f) + QK_EPS);
                        const u32x4_t w = normrope(acc[ai][bj][m][0], acc[ai][bj][m][1], rinv, g0, g1, cs, sn, osc);
                        if (pn < 2) *(u32x4_t*)(Q + (size_t)row * 512 + pn * 256 + bj * 128 + cl0) = w;
                        else if (u.pm != 64) *(u32x4_t*)(Kb + ((size_t)(row >> 13) * KVROWS + NMETA + (row & 8191)) * 128 + cl0) = w;
                        else { *(u32x4_t*)(Kb + (size_t)fr * 128 + cl0) = w; *(u32x4_t*)(Kb + ((size_t)KVROWS + fr) * 128 + cl0) = w; }
                    } else {
                        const u32x4_t w = pack8(acc[ai][1][m][0], acc[ai][1][m][1]);
                        if (u.pm != 64) *(u32x4_t*)(Vb + ((size_t)(row >> 13) * KVROWS + NMETA + (row & 8191)) * 128 + cl0) = w;
                        else { *(u32x4_t*)(Vb + (size_t)fr * 128 + cl0) = w; *(u32x4_t*)(Vb + ((size_t)KVROWS + fr) * 128 + cl0) = w; }
                    }
                }
            }
            return;
        }
        if (u.pm == 64) {
            if (wr != 0) return;
#pragma unroll
            for (int bj = 0; bj < 2; ++bj) { const int cu = (pn - 3) * 256 + bj * 128 + cl0; *(u32x4_t*)(UMETA + ((size_t)(cu >> 4) * 16 + fr) * 16 + (cu & 15)) = pack8(acc[0][bj][0][0], acc[0][bj][0][1]); }
            return;
        }
        const int row0 = u.pm * 256 + wr * 64 + fr;
        if (pn < 5) {
            EPI_LOOP_AM { const int row = row0 + ai * 128 + m * 16, b = row >> 13, s = row & 8191;
#pragma unroll
                for (int bj = 0; bj < 2; ++bj) { const int cu = (pn - 3) * 256 + bj * 128 + cl0, g = cu >> 4;
                    *(u32x4_t*)(UG2 + ((size_t)(g * 2 + b) * 256 + (s >> 5)) * UGP + (s & 31) * 16 + (cu & 15)) = pack8(acc[ai][bj][m][0], acc[ai][bj][m][1]); } }
        } else {
            EPI_LOOP_AM { const size_t o = (size_t)(row0 + ai * 128 + m * 16) * 2048 + (pn - 5) * 256 + cl0;
#pragma unroll
                for (int bj = 0; bj < 2; ++bj) { f32x4 a = acc[ai][bj][m][0], c = acc[ai][bj][m][1];
#pragma unroll
                    for (int j = 0; j < 4; ++j) { a[j] = sigm(a[j]); c[j] = sigm(c[j]); }
                    *(u32x4_t*)(GATES + o + bj * 128) = pack8(a, c); } }
        }
    }
};
struct EpiSsmState {
    static constexpr bool PERM = false, AFTER_DRAIN = false;
    float* S;
    __device__ __forceinline__ void operator()(const f32x4 (&acc)[2][2][4][2], const Unit& u, int wr, int wc, int fr, int fq) const {
        EPI_LOOP_AM { float* rp = S + ((size_t)u.pm * 256 + ai * 128 + wr * 64 + m * 16 + fr) * 256 + wc * 32 + 4 * fq;
#pragma unroll
            for (int bj = 0; bj < 2; ++bj)
#pragma unroll
                for (int n = 0; n < 2; ++n) *(f32x4*)(rp + bj * 128 + n * 16) = acc[ai][bj][m][n]; }
    }
};
struct EpiSsmY {
    static constexpr bool PERM = true, AFTER_DRAIN = false;
    bf16* YG;
    __device__ __forceinline__ void operator()(const f32x4 (&acc)[2][2][4][2], const Unit& u, int wr, int wc, int fr, int fq) const {
        const int g = u.pm >> 1, b = u.pm & 1, nh = u.pn & 1;
        EPI_LOOP_AM { const int cp = ai * 128 + wr * 64 + m * 16 + fr;
#pragma unroll
            for (int bj = 0; bj < 2; ++bj) { const int nl = nh * 256 + bj * 128 + wc * 32 + 8 * fq, t = nl >> 4, h0 = nl & 15;
                f32x4 a = acc[ai][bj][m][0], c = acc[ai][bj][m][1];
#pragma unroll
                for (int j = 0; j < 4; ++j) { a[j] = gelu_tanh(a[j]); c[j] = gelu_tanh(c[j]); }
                *(u32x4_t*)(YG + ((size_t)b * SEQ + cp * 32 + t) * 512 + g * 16 + h0) = pack8(a, c); } }
    }
};
struct EpiGlu {
    static constexpr bool PERM = true, AFTER_DRAIN = false;
    const bf16* YG; const float* bias; bf16* Z;
    __device__ __forceinline__ void operator()(const f32x4 (&acc)[2][2][4][2], const Unit& u, int wr, int wc, int fr, int fq) const {
        const int row0 = u.pm * 256 + wr * 64 + fr, col0 = u.pn * 256 + wc * 32 + 8 * fq;
        EPI_LOOP_AM { const size_t o = (size_t)(row0 + ai * 128 + m * 16) * 512 + col0;
#pragma unroll
            for (int bj = 0; bj < 2; ++bj) { const u32x4_t y = *(const u32x4_t*)(YG + o + bj * 128);
                const f32x4 b0 = *(const f32x4*)(bias + col0 + bj * 128), b1 = *(const f32x4*)(bias + col0 + bj * 128 + 4);
                f32x4 a = acc[ai][bj][m][0] + b0, c = acc[ai][bj][m][1] + b1;
                a[0] = bflo(y.x) * sigm(a[0]); a[1] = bfhi(y.x) * sigm(a[1]); a[2] = bflo(y.y) * sigm(a[2]); a[3] = bfhi(y.y) * sigm(a[3]);
                c[0] = bflo(y.z) * sigm(c[0]); c[1] = bfhi(y.z) * sigm(c[1]); c[2] = bflo(y.w) * sigm(c[2]); c[3] = bfhi(y.w) * sigm(c[3]);
                *(u32x4_t*)(Z + o + bj * 128) = pack8(a, c); } }
    }
};
template <int SECOND> struct EpiBranch {
    static constexpr bool PERM = true, AFTER_DRAIN = false;
    const bf16* GATES; const bf16* T1; bf16* O;
    __device__ __forceinline__ void operator()(const f32x4 (&acc)[2][2][4][2], const Unit& u, int wr, int wc, int fr, int fq) const {
        const int row0 = u.pm * 256 + wr * 64 + fr, col0 = u.pn * 256 + wc * 32 + 8 * fq;
        EPI_LOOP_AM { const size_t r = (size_t)(row0 + ai * 128 + m * 16);
#pragma unroll
            for (int bj = 0; bj < 2; ++bj) { const u32x4_t gt = *(const u32x4_t*)(GATES + r * 2048 + SECOND * 1024 + col0 + bj * 128);
                f32x4 a = acc[ai][bj][m][0], c = acc[ai][bj][m][1];
                a[0] *= bflo(gt.x); a[1] *= bfhi(gt.x); a[2] *= bflo(gt.y); a[3] *= bfhi(gt.y); c[0] *= bflo(gt.z); c[1] *= bfhi(gt.z); c[2] *= bflo(gt.w); c[3] *= bfhi(gt.w);
                if (SECOND) { const u32x4_t t1 = *(const u32x4_t*)(T1 + r * 1024 + col0 + bj * 128);
                    a[0] += bflo(t1.x); a[1] += bfhi(t1.x); a[2] += bflo(t1.y); a[3] += bfhi(t1.y); c[0] += bflo(t1.z); c[1] += bfhi(t1.z); c[2] += bflo(t1.w); c[3] += bfhi(t1.w); }
                *(u32x4_t*)(O + r * 1024 + col0 + bj * 128) = pack8(a, c); } }
    }
};
struct EpiPre1 {
    static constexpr bool PERM = false, AFTER_DRAIN = false;
    const float* x; const float* g; const float* bb; const f32x2_t2* st; float* out;
    __device__ __forceinline__ void operator()(const f32x4 (&acc)[2][2][4][2], const Unit& u, int wr, int wc, int fr, int fq) const {
        const int row0 = u.pm * 256 + wr * 64 + fr, col0 = u.pn * 256 + wc * 32 + 4 * fq;
        EPI_LOOP_AM { const int row = row0 + ai * 128 + m * 16; const f32x2_t2 s = st[row]; const size_t o = (size_t)row * 1024 + col0;
#pragma unroll
            for (int bj = 0; bj < 2; ++bj)
#pragma unroll
                for (int n = 0; n < 2; ++n) { const int c = bj * 128 + n * 16; const f32x4 xv = *(const f32x4*)(x + o + c), gv = *(const f32x4*)(g + col0 + c), bv = *(const f32x4*)(bb + col0 + c);
                    *(f32x4*)(out + o + c) = ((xv - s.x) * s.y * gv + bv) * ALPHA + acc[ai][bj][m][n]; } }
    }
};
struct EpiMoe1 {
    static constexpr bool PERM = true, AFTER_DRAIN = false;
    bf16* HB;
    __device__ __forceinline__ void operator()(const f32x4 (&acc)[2][2][4][2], const Unit& u, int wr, int wc, int fr, int fq) const {
        const int row0 = u.pm * 256 + wr * 64 + fr, col0 = (u.pn & 7) * 128 + wc * 32 + 8 * fq;
        EPI_LOOP_AM { f32x4 a = acc[ai][0][m][0], c = acc[ai][0][m][1]; const f32x4 ua = acc[ai][1][m][0], uc = acc[ai][1][m][1];
#pragma unroll
            for (int j = 0; j < 4; ++j) { a[j] = a[j] * sigm(a[j]) * ua[j]; c[j] = c[j] * sigm(c[j]) * uc[j]; }
            *(u32x4_t*)(HB + (size_t)(row0 + ai * 128 + m * 16) * 1024 + col0) = pack8(a, c); }
    }
};
struct EpiMoe2 {
    static constexpr bool PERM = true, AFTER_DRAIN = false;
    const float* gate; bf16* YE;
    __device__ __forceinline__ void operator()(const f32x4 (&acc)[2][2][4][2], const Unit& u, int wr, int wc, int fr, int fq) const {
        const int row0 = u.pm * 256 + wr * 64 + fr, col0 = (u.pn & 3) * 256 + wc * 32 + 8 * fq;
        EPI_LOOP_AM { const int row = row0 + ai * 128 + m * 16; const float gt = gate[row];
#pragma unroll
            for (int bj = 0; bj < 2; ++bj) *(u32x4_t*)(YE + (size_t)row * 1024 + col0 + bj * 128) = pack8(acc[ai][bj][m][0] * gt, acc[ai][bj][m][1] * gt); }
    }
};

struct TItem { const float* src; bf16* dst; int N, K; };
__device__ __forceinline__ void titem_load(const TItem& t, f32x4 (&v)[8], int lane) {
    const float* p = t.src + (size_t)(lane >> 3) * t.N + (lane & 7) * 4;
#pragma unroll
    for (int i = 0; i < 8; ++i) v[i] = *(const GAS f32x4*)(p + (size_t)(8 * i) * t.N);
}
__device__ __forceinline__ void titem_store(const TItem& t, const f32x4 (&v)[8], LAS float* scr, int lane) {
#pragma unroll
    for (int i = 0; i < 8; ++i) { LAS float* s = scr + ((lane >> 3) + 8 * i) * 33 + (lane & 7) * 4; s[0] = v[i].x; s[1] = v[i].y; s[2] = v[i].z; s[3] = v[i].w; }
    LDS_WAIT(); asm volatile("" ::: "memory");
    const int c = lane & 7;
#pragma unroll
    for (int j = 0; j < 4; ++j) { const int n = (lane >> 3) + 8 * j; const LAS float* s = scr + (8 * c) * 33 + n;
        v4u o; o.x = pk2(s[0 * 33], s[1 * 33]); o.y = pk2(s[2 * 33], s[3 * 33]); o.z = pk2(s[4 * 33], s[5 * 33]); o.w = pk2(s[6 * 33], s[7 * 33]);
        *(GAS v4u*)(t.dst + (size_t)n * t.K + 8 * c) = o; }
    LDS_WAIT(); asm volatile("" ::: "memory");
}
__device__ __forceinline__ void ssm_par(const Frame& F, int dg, int p, float& lr, float& li, float& cr, float& ci) {
    const float dt = expf(F.in[9][dg]); const float ar = F.in[7][dg * 64 + p], ai = F.in[8][dg * 64 + p];
    lr = ar * dt; li = ai * dt;
    float sn, cs; sincosf(li, &sn, &cs); const float mag = expf(lr);
    const float nr = mag * cs - 1.f, ni = mag * sn, den = ar * ar + ai * ai;
    cr = (nr * ar + ni * ai) / den; ci = (ni * ar - nr * ai) / den;
}
__device__ __forceinline__ void cpow(float lr, float li, float e, float& pr, float& pi) { float sn, cs; sincosf(li * e, &sn, &cs); const float mg = expf(lr * e); pr = mg * cs; pi = mg * sn; }

__device__ __forceinline__ void mext_item(Frame& F, int it) {
    const int tid = F.tid; unsigned char* ws = F.ws;
    LAS float* POW = (LAS float*)(F.lds + RING_OFF);
    LAS float* BB = POW + 2 * 33 * 64 * 2;
    LAS float* CC = BB + 2 * 64 * 16 * 2;
    LAS float* KT = CC + 2 * 4 * 64 * 2;
    LAS float* PAR = KT + 2 * 4 * 32 * 16;
    bf16* MEXT = (bf16*)(ws + WS_MEXT);
    const int g = it >> 2, hq = it & 3;
    __syncthreads();
    if (tid < 128) { float lr, li, cr, ci; ssm_par(F, (tid >> 6) * 32 + g, tid & 63, lr, li, cr, ci); PAR[tid * 4] = lr; PAR[tid * 4 + 1] = li; PAR[tid * 4 + 2] = cr; PAR[tid * 4 + 3] = ci; }
    __syncthreads();
    if (tid < 128) { const int dir = tid >> 6, p = tid & 63; float a1r, a1i; cpow(PAR[tid * 4], PAR[tid * 4 + 1], 1.f, a1r, a1i); float pr = 1.f, pi = 0.f;
        for (int j = 0; j <= 32; ++j) { POW[((dir * 33 + j) * 64 + p) * 2] = pr; POW[((dir * 33 + j) * 64 + p) * 2 + 1] = pi; const float nr = pr * a1r - pi * a1i, ni = pr * a1i + pi * a1r; pr = nr; pi = ni; } }
    for (int i = tid; i < 2 * 64 * 16; i += NWAVES * 64) { const int dir = i / 1024, p = (i >> 4) & 63, h = i & 15; const float cr = PAR[(dir * 64 + p) * 4 + 2], ci = PAR[(dir * 64 + p) * 4 + 3];
        const size_t o = ((size_t)(dir * 32 + g) * 64 + p) * 16 + h; const float br = F.in[10][o], bi = F.in[11][o]; BB[i * 2] = cr * br - ci * bi; BB[i * 2 + 1] = cr * bi + ci * br; }
    for (int i = tid; i < 2 * 4 * 64; i += NWAVES * 64) { const int dir = i / 256, hl = (i >> 6) & 3, p = i & 63; const size_t o = ((size_t)(dir * 32 + g) * 16 + hq * 4 + hl) * 64 + p; CC[i * 2] = F.in[12][o]; CC[i * 2 + 1] = F.in[13][o]; }
    __syncthreads();
    { const int wv = F.wave, dir = wv >> 2, hl = wv & 3, jg = F.lane >> 4, hi = F.lane & 15;
      float acc[8];
#pragma unroll
      for (int jj = 0; jj < 8; ++jj) acc[jj] = 0.f;
#pragma unroll 1
      for (int ph = 0; ph < 2; ++ph) {
          float gr[32], gi[32];
#pragma unroll
          for (int q = 0; q < 32; ++q) { const int p = ph * 32 + q; const f32x2_t2 c = *(const LAS f32x2_t2*)(CC + ((dir * 4 + hl) * 64 + p) * 2), bq = *(const LAS f32x2_t2*)(BB + ((dir * 64 + p) * 16 + hi) * 2);
              gr[q] = c.x * bq.x - c.y * bq.y; gi[q] = c.x * bq.y + c.y * bq.x; }
#pragma unroll
          for (int jj = 0; jj < 8; ++jj) { const LAS f32x4* pw = (const LAS f32x4*)(POW + ((dir * 33 + jg * 8 + jj) * 64 + ph * 32) * 2); float s = acc[jj];
#pragma unroll
              for (int q = 0; q < 16; ++q) { const f32x4 w = pw[q]; s += w.x * gr[2 * q] - w.y * gi[2 * q]; s += w.z * gr[2 * q + 1] - w.w * gi[2 * q + 1]; }
              acc[jj] = s; }
      }
#pragma unroll
      for (int jj = 0; jj < 8; ++jj) KT[((dir * 4 + hl) * 32 + jg * 8 + jj) * 16 + hi] = acc[jj]; }
    __syncthreads();
    LAS float* KC = PAR + 2 * 64 * 4;
    for (int i = tid; i < 4 * 63 * 16; i += NWAVES * 64) { const int hl = i / (63 * 16), r = i % (63 * 16), d = (r >> 4) - 31, hi = r & 15; float x = 0.f;
        if (d >= 0) x += KT[((0 * 4 + hl) * 32 + d) * 16 + hi]; if (d <= 0) x += KT[((1 * 4 + hl) * 32 - d) * 16 + hi];
        if (d == 0 && hi == hq * 4 + hl) x += F.in[14][g * 16 + hi];
        KC[(hl * 64 + d + 31) * 16 + hi] = x; }
    __syncthreads();
    for (int ch = tid; ch < 128 * 96; ch += NWAVES * 64) { const int rl = ch / 96, cc = ch % 96, t = rl >> 2, hl = rl & 3, ho = hq * 4 + hl; float v[8];
        if (cc < 64) { const int s = cc >> 1, hi0 = (cc & 1) * 8; const LAS f32x4* kp = (const LAS f32x4*)(KC + (hl * 64 + t - s + 31) * 16 + hi0); const f32x4 a = kp[0], c = kp[1];
            v[0] = a.x; v[1] = a.y; v[2] = a.z; v[3] = a.w; v[4] = c.x; v[5] = c.y; v[6] = c.z; v[7] = c.w;
        } else { const int kk = (cc - 64) * 8, dir = kk >> 7, reim = (kk >> 6) & 1, p0 = kk & 63, e = dir == 0 ? t + 1 : 32 - t;
#pragma unroll
            for (int j = 0; j < 8; ++j) { const int p = p0 + j; const float cr = CC[((dir * 4 + hl) * 64 + p) * 2], ci = CC[((dir * 4 + hl) * 64 + p) * 2 + 1], pr = POW[((dir * 33 + e) * 64 + p) * 2], pi = POW[((dir * 33 + e) * 64 + p) * 2 + 1];
                v[j] = reim == 0 ? (cr * pr - ci * pi) : -(cr * pi + ci * pr); } }
        v4u o; o.x = pk2(v[0], v[1]); o.y = pk2(v[2], v[3]); o.z = pk2(v[4], v[5]); o.w = pk2(v[6], v[7]);
        *(GAS v4u*)(MEXT + ((size_t)g * 512 + t * 16 + ho) * UGP + cc * 8) = o; }
    __syncthreads();
}
__device__ __forceinline__ TItem titem_decode(int it, const float* w_in, const float* w_glu, const float* w_ab, const float* w_sb, const float* w_o, const float* w_g, const float* w_u, const float* w_d, unsigned char* ws) {
    constexpr int I_IN = 16 * 104, I_GLU = 8 * 16, I_BR = 8 * 32, I_O = 16 * 32, I_E = 16 * 32;
    TItem t; int r = it;
          if (r < I_IN) { const int kb = r / 104, nb = r % 104; t.src = w_in + (size_t)(64 * kb) * INW + 32 * nb; t.N = INW; t.K = 1024; t.dst = (bf16*)(ws + WS_WIN) + (size_t)(32 * nb) * 1024 + 64 * kb; return t; } r -= I_IN;
          if (r < I_GLU) { const int kb = r / 16, nb = r % 16; t.src = w_glu + (size_t)(64 * kb) * 512 + 32 * nb; t.N = 512; t.K = 512; t.dst = (bf16*)(ws + WS_WGLU) + (size_t)(32 * nb) * 512 + 64 * kb; return t; } r -= I_GLU;
          if (r < I_BR) { const int kb = r / 32, nb = r % 32; t.src = w_ab + (size_t)(64 * kb) * 1024 + 32 * nb; t.N = 1024; t.K = 512; t.dst = (bf16*)(ws + WS_WAB) + (size_t)(32 * nb) * 512 + 64 * kb; return t; } r -= I_BR;
          if (r < I_BR) { const int kb = r / 32, nb = r % 32; t.src = w_sb + (size_t)(64 * kb) * 1024 + 32 * nb; t.N = 1024; t.K = 512; t.dst = (bf16*)(ws + WS_WSB) + (size_t)(32 * nb) * 512 + 64 * kb; return t; } r -= I_BR;
          if (r < I_O) { const int kb = r / 32, nb = r % 32; t.src = w_o + (size_t)(64 * kb) * 1024 + 32 * nb; t.N = 1024; t.K = 1024; t.dst = (bf16*)(ws + WS_WO) + (size_t)(32 * nb) * 1024 + 64 * kb; return t; } r -= I_O;
          const int e = r / (3 * I_E), which = (r / I_E) % 3, q = r % I_E, kb = q / 32, nb = q % 32, n0 = 32 * nb;
          const float* W = (which == 0 ? w_g : which == 1 ? w_u : w_d) + (size_t)e * 1024 * 1024;
          t.src = W + (size_t)(64 * kb) * 1024 + n0; t.N = 1024; t.K = 1024;
          const int drow0 = which < 2 ? e * 2048 + (n0 >> 7) * 256 + which * 128 + (n0 & 127) : e * 1024 + n0;
          t.dst = (bf16*)(ws + (which < 2 ? WS_WGU : WS_WD)) + (size_t)drow0 * 1024 + 64 * kb; return t; }
__device__ __forceinline__ void bg_convert(Frame& F, int done_word, unsigned n_main) {
    LAS float* scr = (LAS float*)(F.lds + RING_OFF + F.wave * 16384);
    volatile LAS unsigned* bc = F.MISC + 16;
    for (;;) {
        __syncthreads();
        if (F.tid == 0) { unsigned base = 0xffffffffu;
            const bool stop = n_main != 0u && __hip_atomic_load(F.ctl + done_word, RLX_AGENT) >= n_main;
            if (!stop) base = __hip_atomic_fetch_add(F.ctl + CW_Q, 8u, RLX_AGENT);
            bc[0] = base; }
        __syncthreads();
        const unsigned base = bc[0];
        if (base >= (unsigned)N_EXP_ITEMS) break;
        const TItem t = titem_decode(N_DENSE_ITEMS + (int)base + F.wave, F.in[4], F.in[15], F.in[17], F.in[18], F.in[19], F.in[23], F.in[24], F.in[25], F.ws);
        f32x4 v[8]; titem_load(t, v, F.lane); titem_store(t, v, scr, F.lane);
    }
}
__device__ __forceinline__ void bg_work(Frame& F, int done_word, unsigned n_main) {
    volatile LAS unsigned* bc = F.MISC + 17;
    for (;;) {
        __syncthreads();
        if (F.tid == 0) bc[0] = __hip_atomic_fetch_add(F.ctl + CW_QM, 1u, RLX_AGENT);
        __syncthreads();
        const unsigned it = bc[0];
        if (it >= 128u) break;
        mext_item(F, (int)it);
    }
    bg_convert(F, done_word, n_main);
}
__device__ __forceinline__ void main_done(Frame& F, int done_word) { __syncthreads(); if (F.tid == 0) __hip_atomic_fetch_add(F.ctl + done_word, 1u, RLX_AGENT); }
__device__ __forceinline__ void p0_prologue(Frame& F) {
    const int gw = F.vcu * NWAVES + F.wave, NGW = F.G * NWAVES, lane = F.lane, tid = F.tid;
    unsigned char* ws = F.ws;
    LAS float* scr = (LAS float*)(F.lds + RING_OFF + F.wave * 16384);
    { bf16* WST = (bf16*)(ws + WS_WST);
      for (int it = gw; it < NG * 256; it += NGW) { const int g = it >> 8, n = it & 255, dir = n >> 7, reim = (n >> 6) & 1, p = n & 63; float lr, li, cr, ci; ssm_par(F, dir * 32 + g, p, lr, li, cr, ci);
          const int t = lane >> 1, h0 = (lane & 1) * 8; float pr, pi; cpow(lr, li, (float)(dir == 0 ? 31 - t : t), pr, pi);
          const float er = pr * cr - pi * ci, ei = pr * ci + pi * cr; const size_t o = ((size_t)(dir * 32 + g) * 64 + p) * 16 + h0; float v[8];
#pragma unroll
          for (int j = 0; j < 8; ++j) { const float br = F.in[10][o + j], bi = F.in[11][o + j]; v[j] = reim == 0 ? (er * br - ei * bi) : (er * bi + ei * br); }
          v4u w; w.x = pk2(v[0], v[1]); w.y = pk2(v[2], v[3]); w.z = pk2(v[4], v[5]); w.w = pk2(v[6], v[7]);
          *(GAS v4u*)(WST + ((size_t)g * 256 + n) * 512 + lane * 8) = w; } }
    { constexpr int NIT = N_DENSE_ITEMS;
      f32x4 va[8], vb[8]; TItem ta, tb;
      int it = gw;
      if (it < NIT) { ta = titem_decode(it, F.in[4], F.in[15], F.in[17], F.in[18], F.in[19], F.in[23], F.in[24], F.in[25], ws); titem_load(ta, va, lane); }
      while (it < NIT) {
          const int i1 = it + NGW; if (i1 < NIT) { tb = titem_decode(i1, F.in[4], F.in[15], F.in[17], F.in[18], F.in[19], F.in[23], F.in[24], F.in[25], ws); titem_load(tb, vb, lane); }
          titem_store(ta, va, scr, lane);
          if (i1 >= NIT) break;
          const int i2 = i1 + NGW; if (i2 < NIT) { ta = titem_decode(i2, F.in[4], F.in[15], F.in[17], F.in[18], F.in[19], F.in[23], F.in[24], F.in[25], ws); titem_load(ta, va, lane); }
          titem_store(tb, vb, scr, lane);
          it = i2;
      } }
    { bf16* XN = (bf16*)(ws + WS_XN); f32x2_t2* ST = (f32x2_t2*)(ws + WS_STATS0);
      for (int r = gw; r < M + NMETA; r += NGW) { const float* src = r < M ? F.in[0] + (size_t)r * DM : F.in[1] + (size_t)(r - M) * DM;
          const GAS f32x4* xr = (const GAS f32x4*)src + lane; f32x4 v[4]; float s = 0.f;
#pragma unroll
          for (int j = 0; j < 4; ++j) { v[j] = xr[64 * j]; s += (v[j].x + v[j].y) + (v[j].z + v[j].w); }
          const float mean = wave_sum(s) * (1.f / DM); float s2 = 0.f;
#pragma unroll
          for (int j = 0; j < 4; ++j) { v[j] = v[j] - mean; s2 += (v[j].x * v[j].x + v[j].y * v[j].y) + (v[j].z * v[j].z + v[j].w * v[j].w); }
          const float rstd = 1.f / sqrtf(wave_sum(s2) * (1.f / DM) + LN_EPS);
          if (r < M && lane == 0) ST[r] = (f32x2_t2){mean, rstd};
          GAS unsigned long long* o8 = (GAS unsigned long long*)(XN + (size_t)r * DM) + lane;
#pragma unroll
          for (int j = 0; j < 4; ++j) { const f32x4 gg = ((const GAS f32x4*)F.in[2])[lane + 64 * j], bb = ((const GAS f32x4*)F.in[3])[lane + 64 * j]; const f32x4 o = v[j] * rstd * gg + bb;
              o8[64 * j] = (unsigned long long)pk2(o.x, o.y) | ((unsigned long long)pk2(o.z, o.w) << 32); } } }
    { const int gt = F.vcu * (NWAVES * 64) + tid, NT_ = F.G * NWAVES * 64;
      for (int i = gt; i < 2 * 2 * 112 * 16; i += NT_) { const int arr = i / (2 * 112 * 16), b = (i / (112 * 16)) & 1, q = i % (112 * 16);
          *(GAS v4u*)((bf16*)(ws + (arr ? WS_V : WS_K)) + ((size_t)b * KVROWS + KVALID) * 128 + q * 8) = (v4u){0u, 0u, 0u, 0u}; }
      float* RP = (float*)(ws + WS_ROPE);
      for (int i = gt; i < 3072; i += NT_) { const bool isr = i < 2048; const int q = isr ? i : i - 2048, pos = q >> 4, j = q & 15; const float ang = (float)pos * powf(10000.f, -(float)j / 16.f);
          float sn, cs; sincosf(ang, &sn, &cs); if (isr) { RP[q] = cs; RP[2048 + q] = sn; } else { RP[4096 + q] = cs; RP[5120 + q] = sn; } }
      for (int i = gt; i < 128; i += NT_) RP[6144 + i] = i < 64 ? F.in[5][i] : F.in[6][i - 64]; }
}

__device__ __forceinline__ void qk_prep(Frame& F) {
    const int gw = F.vcu * NWAVES + F.wave, NGW = F.G * NWAVES, lane = F.lane;
    bf16* Q = (bf16*)(F.ws + WS_Q); bf16* K = (bf16*)(F.ws + WS_K); const float* RP = (const float*)(F.ws + WS_ROPE);
    constexpr int NQ = M * 8, NK = 2 * KVALID * 2;
    for (int it = gw; it < NQ + NK; it += NGW) {
        bf16* p; int pos; float gsc, osc;
        if (it < NQ) { const int row = it >> 3, h = it & 7; p = Q + (size_t)row * 512 + h * 64; pos = row & 8191; gsc = F.in[5][lane]; osc = C2Q; }
        else { const int r = it - NQ, b = r / (KVALID * 2), q = r % (KVALID * 2), l = q >> 1, kvh = q & 1; p = K + ((size_t)b * KVROWS + l) * 128 + kvh * 64; pos = l - NMETA; gsc = F.in[6][lane]; osc = 1.f; }
        const float x = bf2f(p[lane]);
        const float ss = wave_sum(x * x) * (1.f / 64.f);
        const float y = x * rsqrtf(ss + QK_EPS) * gsc, yo = __shfl_xor(y, 1);
        float cs = 1.f, sn = 0.f;
        if (pos >= 0) { const int j = lane >> 1; if (j < 16) { cs = RP[(pos >> 6) * 16 + j]; sn = RP[2048 + (pos >> 6) * 16 + j]; } else { cs = RP[4096 + (pos & 63) * 16 + j - 16]; sn = RP[5120 + (pos & 63) * 16 + j - 16]; } }
        const float o = ((lane & 1) ? (yo * sn + y * cs) : (y * cs - yo * sn)) * osc;
        p[lane] = (bf16)f2bf(o);
    }
}

__device__ __forceinline__ void ssm_scan(Frame& F) {
    if (F.wave != 0 || blockIdx.x >= 128) return;
    const int it = blockIdx.x, b = it >> 6, g = (it >> 1) & 31, dir = it & 1, p = F.lane;
    float lr, li, cr, ci; ssm_par(F, dir * 32 + g, p, lr, li, cr, ci);
    float a32r, a32i; cpow(lr, li, 32.f, a32r, a32i);
    const float* S = (const float*)(F.ws + WS_S) + (size_t)(g * 2 + b) * 256 * 256 + dir * 128 + p;
    bf16* U = (bf16*)(F.ws + WS_UG2) + (size_t)(g * 2 + b) * 256 * UGP + 512 + dir * 128 + p;
    float sr = 0.f, si = 0.f;
    if (dir == 0) {
        float a1r, a1i; cpow(lr, li, 1.f, a1r, a1i);
        const bf16* um = (const bf16*)(F.ws + WS_UMETA) + (size_t)g * 256; const size_t o = ((size_t)g * 64 + p) * 16;
        float bbr[16], bbi[16];
#pragma unroll
        for (int h = 0; h < 16; ++h) { const float br = F.in[10][o + h], bi = F.in[11][o + h]; bbr[h] = cr * br - ci * bi; bbi[h] = cr * bi + ci * br; }
        for (int t = 0; t < 16; ++t) { float bur = 0.f, bui = 0.f;
#pragma unroll
            for (int h = 0; h < 16; ++h) { const float uv = bf2f(um[t * 16 + h]); bur = fmaf(bbr[h], uv, bur); bui = fmaf(bbi[h], uv, bui); }
            const float nr = a1r * sr - a1i * si + bur, ni = a1r * si + a1i * sr + bui; sr = nr; si = ni; }
    }
    for (int c0 = 0; c0 < 256; c0 += 32) {
        float vr[32], vi[32];
#pragma unroll
        for (int k = 0; k < 32; ++k) { const int c = dir == 0 ? c0 + k : 255 - (c0 + k); vr[k] = S[(size_t)c * 256]; vi[k] = S[(size_t)c * 256 + 64]; }
#pragma unroll
        for (int k = 0; k < 32; ++k) { const int c = dir == 0 ? c0 + k : 255 - (c0 + k);
            U[(size_t)c * UGP] = (bf16)f2bf(sr); U[(size_t)c * UGP + 64] = (bf16)f2bf(si);
            const float nr = a32r * sr - a32i * si + vr[k], ni = a32r * si + a32i * sr + vi[k]; sr = nr; si = ni; }
    }
}

__device__ __forceinline__ float treduce16(const float (&v)[16], int lane) {
    float r8[8], r4[4], r2[2], r1;
    { const bool up = lane & 32;
#pragma unroll
      for (int i = 0; i < 8; ++i) { const float keep = up ? v[i + 8] : v[i], send = up ? v[i] : v[i + 8]; r8[i] = keep + __shfl_xor(send, 32); } }
    { const bool up = lane & 16;
#pragma unroll
      for (int i = 0; i < 4; ++i) { const float keep = up ? r8[i + 4] : r8[i], send = up ? r8[i] : r8[i + 4]; r4[i] = keep + __shfl_xor(send, 16); } }
    { const bool up = lane & 8;
#pragma unroll
      for (int i = 0; i < 2; ++i) { const float keep = up ? r4[i + 2] : r4[i], send = up ? r4[i] : r4[i + 2]; r2[i] = keep + __shfl_xor(send, 8); } }
    { const bool up = lane & 4; const float keep = up ? r2[1] : r2[0], send = up ? r2[0] : r2[1]; r1 = keep + __shfl_xor(send, 4); }
    r1 += __shfl_xor(r1, 2); r1 += __shfl_xor(r1, 1);
    return r1;
}
__device__ __forceinline__ void ln1_router(Frame& F) {
    const int gw = F.vcu * NWAVES + F.wave, NGW = F.G * NWAVES, lane = F.lane;
    LAS float* WRT = (LAS float*)(F.lds + RING_OFF);
    for (int i = F.tid; i < 16 * 1024; i += NWAVES * 64) { const int d = i >> 4, e = i & 15; WRT[e * 1024 + d] = F.in[22][i]; }
    __syncthreads();
    const float* PRE = F.out; bf16* H1 = (bf16*)(F.ws + WS_H1); f32x2_t2* ST = (f32x2_t2*)(F.ws + WS_STATS1); float* AFF = (float*)(F.ws + WS_AFF);
    for (int r = gw; r < M; r += NGW) {
        const GAS f32x4* xr = (const GAS f32x4*)(PRE + (size_t)r * DM) + lane; f32x4 v[4]; float s = 0.f;
#pragma unroll
        for (int j = 0; j < 4; ++j) { v[j] = xr[64 * j]; s += (v[j].x + v[j].y) + (v[j].z + v[j].w); }
        const float mean = wave_sum(s) * (1.f / DM); float s2 = 0.f;
#pragma unroll
        for (int j = 0; j < 4; ++j) { v[j] = v[j] - mean; s2 += (v[j].x * v[j].x + v[j].y * v[j].y) + (v[j].z * v[j].z + v[j].w * v[j].w); }
        const float rstd = 1.f / sqrtf(wave_sum(s2) * (1.f / DM) + LN_EPS);
        if (lane == 0) ST[r] = (f32x2_t2){mean, rstd};
        GAS unsigned long long* o8 = (GAS unsigned long long*)(H1 + (size_t)r * DM) + lane;
#pragma unroll
        for (int j = 0; j < 4; ++j) { const f32x4 gg = ((const GAS f32x4*)F.in[20])[lane + 64 * j], bb = ((const GAS f32x4*)F.in[21])[lane + 64 * j]; v[j] = v[j] * rstd * gg + bb;
            o8[64 * j] = (unsigned long long)pk2(v[j].x, v[j].y) | ((unsigned long long)pk2(v[j].z, v[j].w) << 32); }
        float acc[16];
        asm volatile("" ::: "memory");
#pragma unroll
        for (int e = 0; e < 16; ++e) { float a = 0.f;
#pragma unroll
            for (int j = 0; j < 4; ++j) { const f32x4 w = *(const LAS f32x4*)(WRT + e * 1024 + (lane + 64 * j) * 4); a += (v[j].x * w.x + v[j].y * w.y) + (v[j].z * w.z + v[j].w * w.w); }
            acc[e] = a; }
        const float lg = treduce16(acc, lane);
        float mx = lg;
#pragma unroll
        for (int o = 4; o < 64; o <<= 1) mx = fmaxf(mx, __shfl_xor(mx, o));
        const float ex = expf(lg - mx); float sm = ex;
#pragma unroll
        for (int o = 4; o < 64; o <<= 1) sm += __shfl_xor(sm, o);
        if ((lane & 3) == 0) AFF[((size_t)(r >> 13) * NE + (lane >> 2)) * SEQ + (r & 8191)] = ex / sm;
    }
}

__device__ __forceinline__ void topk_phase(Frame& F) {
    if (blockIdx.x >= BATCH * NE) return;
    const int be = blockIdx.x, b = be >> 4, e = be & 15, t = F.tid, lane = F.lane, w = F.wave;
    LAS int* red = (LAS int*)(F.lds + RING_OFF); LAS int* sc_gt = red + 16; LAS int* sc_eq = sc_gt + 16;
    const float* a = (const float*)(F.ws + WS_AFF) + (size_t)be * SEQ;
    unsigned v[16];
#pragma unroll
    for (int i = 0; i < 16; ++i) v[i] = __float_as_uint(a[t * 16 + i]);
    unsigned thr = 0u;
    for (int bit = 30; bit >= 0; --bit) {
        const unsigned cand = thr | (1u << bit); int c = 0;
#pragma unroll
        for (int i = 0; i < 16; ++i) c += (v[i] >= cand) ? 1 : 0;
#pragma unroll
        for (int o = 32; o > 0; o >>= 1) c += __shfl_xor(c, o);
        __syncthreads();
        if (lane == 0) red[w] = c;
        __syncthreads();
        int total = 0;
#pragma unroll
        for (int k = 0; k < 8; ++k) total += red[k];
        if (total >= CAP) thr = cand;
    }
    int ngt = 0, neq = 0;
#pragma unroll
    for (int i = 0; i < 16; ++i) { ngt += (v[i] > thr) ? 1 : 0; neq += (v[i] == thr) ? 1 : 0; }
    int ig = ngt, ie = neq;
#pragma unroll
    for (int o = 1; o < 64; o <<= 1) { const int pg = __shfl_up(ig, o), pe = __shfl_up(ie, o); if (lane >= o) { ig += pg; ie += pe; } }
    __syncthreads();
    if (lane == 63) { sc_gt[w] = ig; sc_eq[w] = ie; }
    __syncthreads();
    int wg_off = 0, we_off = 0, tot_gt = 0;
#pragma unroll
    for (int k = 0; k < 8; ++k) { const int a = sc_gt[k], c2 = sc_eq[k]; if (k < w) { wg_off += a; we_off += c2; } tot_gt += a; }
    const int quota = CAP - tot_gt; int gpre = wg_off + ig - ngt, epre = we_off + ie - neq;
    int* IDX2 = (int*)(F.ws + WS_IDX2); float* GATE2 = (float*)(F.ws + WS_GATE2); int* SLOTOF = (int*)(F.ws + WS_SLOTOF);
#pragma unroll
    for (int i = 0; i < 16; ++i) {
        const bool gt = v[i] > thr, eq = v[i] == thr, sel = gt || (eq && epre < quota);
        const int tok = t * 16 + i; int so = -1;
        if (sel) { const int slot = gpre + (epre < quota ? epre : quota); so = e * 2048 + b * 1024 + slot; IDX2[so] = b * SEQ + tok; GATE2[so] = __uint_as_float(v[i]); }
        SLOTOF[((size_t)b * SEQ + tok) * NE + e] = so;
        gpre += gt ? 1 : 0; epre += eq ? 1 : 0;
    }
    __syncthreads();
}

__device__ __forceinline__ void gather_phase(Frame& F) {
    const int gw = F.vcu * NWAVES + F.wave, NGW = F.G * NWAVES, lane = F.lane;
    const int* IDX2 = (const int*)(F.ws + WS_IDX2); const bf16* H1 = (const bf16*)(F.ws + WS_H1); bf16* XE = (bf16*)(F.ws + WS_XE);
    for (int r = gw; r < NE * 2048; r += NGW) { const int src = IDX2[r];
        const GAS v4u* s = (const GAS v4u*)(H1 + (size_t)src * DM) + lane; GAS v4u* d = (GAS v4u*)(XE + (size_t)r * DM) + lane;
        const v4u a = s[0], c = s[64]; d[0] = a; d[64] = c; }
}

__device__ __forceinline__ void final_phase(Frame& F) {
    const int gw = F.vcu * NWAVES + F.wave, NGW = F.G * NWAVES, lane = F.lane;
    float* OUT = F.out; const f32x2_t2* ST = (const f32x2_t2*)(F.ws + WS_STATS1); const int* SLOTOF = (const int*)(F.ws + WS_SLOTOF); const bf16* YE = (const bf16*)(F.ws + WS_XE);
    for (int r = gw; r < M; r += NGW) {
        GAS f32x4* xr = (GAS f32x4*)(OUT + (size_t)r * DM) + lane; f32x4 v[4]; const f32x2_t2 st = ST[r];
        const int myslot = SLOTOF[(size_t)r * NE + (lane & 15)];
#pragma unroll
        for (int j = 0; j < 4; ++j) { const f32x4 gg = ((const GAS f32x4*)F.in[20])[lane + 64 * j], bb = ((const GAS f32x4*)F.in[21])[lane + 64 * j]; v[j] = ((xr[64 * j] - st.x) * st.y * gg + bb) * ALPHA; }
        for (int e = 0; e < NE; ++e) { const int sl = __shfl(myslot, e);
            if (sl >= 0) { const GAS u32x2_t* yr = (const GAS u32x2_t*)(YE + (size_t)sl * DM) + lane;
#pragma unroll
                for (int j = 0; j < 4; ++j) { const u32x2_t y = yr[64 * j]; v[j].x += bflo(y.x); v[j].y += bfhi(y.x); v[j].z += bflo(y.y); v[j].w += bfhi(y.y); } } }
        float s = 0.f;
#pragma unroll
        for (int j = 0; j < 4; ++j) s += (v[j].x + v[j].y) + (v[j].z + v[j].w);
        const float mean = wave_sum(s) * (1.f / DM); float s2 = 0.f;
#pragma unroll
        for (int j = 0; j < 4; ++j) { v[j] = v[j] - mean; s2 += (v[j].x * v[j].x + v[j].y * v[j].y) + (v[j].z * v[j].z + v[j].w * v[j].w); }
        const float rstd = 1.f / sqrtf(wave_sum(s2) * (1.f / DM) + LN_EPS);
#pragma unroll
        for (int j = 0; j < 4; ++j) { const f32x4 gg = ((const GAS f32x4*)F.in[26])[lane + 64 * j], bb = ((const GAS f32x4*)F.in[27])[lane + 64 * j]; xr[64 * j] = v[j] * rstd * gg + bb; }
    }
}

#ifndef MK_PER_PHASE
#define MK_PER_PHASE 0
#endif
constexpr int N_PHASES = 16;
struct Args { const float* in[28]; float* out; unsigned char* ws; int ph_lo, ph_hi; };
__global__ void __launch_bounds__(NWAVES * 64, 2) mk_fwd(Args args) {
    extern __shared__ __attribute__((aligned(16))) unsigned char lds[];
    Frame F;
    F.lds = (LAS unsigned char*)lds; F.MISC = (volatile LAS unsigned*)(F.lds + MISC_OFF);
    F.tid = threadIdx.x; F.lane = F.tid & 63; F.wave = __builtin_amdgcn_readfirstlane(F.tid >> 6);
    F.G = gridDim.x; { const int bx = blockIdx.x; F.vcu = (F.G % 8 == 0) ? (bx % 8) * (F.G / 8) + bx / 8 : bx; }
    F.ws = args.ws; F.ctl = (gu32*)(args.ws + WS_CTL); F.out = args.out;
#pragma unroll
    for (int i = 0; i < 28; ++i) F.in[i] = args.in[i];
    for (int u = F.tid; u < (LDS_BYTES - LDSCTL_OFF) / 4; u += NWAVES * 64) ((LAS unsigned*)(F.lds + LDSCTL_OFF))[u] = 0u;
    __syncthreads();
    XcdBarrier bar; bar.bar = (unsigned*)(F.ctl + CW_BAR); bar.x = 0; bar.st = nullptr;
    if (!MK_PER_PHASE) bar = xcd_barrier_post((unsigned*)(F.ctl + CW_BAR), F.MISC + 8);
    const int lo = args.ph_lo, hi = args.ph_hi;
    unsigned char* ws = args.ws;
#ifndef PROBE_LO
#define PROBE_LO -1
#define PROBE_HI -1
#endif
    unsigned long long pr_t0 = 0ull, pr_t1 = 0ull;
#define IN(k) (lo <= (k) && (k) < hi)
#define SEAM(k) do { if (IN(k) && IN((k) + 1)) xcd_barrier(bar); if (PROBE_LO >= 0 && (k) + 1 == PROBE_LO) pr_t0 = rt(); if (PROBE_LO >= 0 && (k) + 1 == PROBE_HI) pr_t1 = rt(); } while (0)
    if (PROBE_LO == 0) pr_t0 = rt();
    using pg8::Gemm; using pg8::gemm_phase;
    if (IN(0)) { p0_prologue(F); } SEAM(0);
    if (IN(1)) { Gemm g{(const bf16*)(ws + WS_XN), (const bf16*)(ws + WS_WIN), 1024, 1024, 1024}; InProjOrder S; S.so.init(M, INW, F.G, (int)blockIdx.x);
        EpiInProj E{(bf16*)(ws + WS_Q), (bf16*)(ws + WS_K), (bf16*)(ws + WS_V), (bf16*)(ws + WS_UG2), (bf16*)args.out, (bf16*)(ws + WS_UMETA), (LAS float*)(F.lds + XCH_OFF), (const float*)(ws + WS_ROPE) + 6144, (const float*)(ws + WS_ROPE)};
        gemm_phase<EpiInProj, InProjOrder, true, true>(F.lds + RING_OFF, g, S, E);
        if ((long)3 * F.G + (long)blockIdx.x < 835) main_done(F, CW_DONE + 64 * 1); else bg_work(F, CW_DONE + 64 * 1, (unsigned)(835 - 3 * F.G)); } SEAM(1);
    if (IN(2)) {
        Gemm g{(const bf16*)(ws + WS_UG2), (const bf16*)(ws + WS_WST), UGP, 512, 512}; SsmStateOrder S{F.G, (int)blockIdx.x}; EpiSsmState E{(float*)(ws + WS_S)};
        gemm_phase<EpiSsmState, SsmStateOrder, true, true>(F.lds + RING_OFF, g, S, E);
        if (blockIdx.x < 64) main_done(F, CW_DONE + 64 * 2); else bg_work(F, CW_DONE + 64 * 2, 64u); } SEAM(2);
    if (IN(3)) { ssm_scan(F); __syncthreads();
        const attn_body::AttnTensors AT{(const attn_body::bf16*)(ws + WS_Q), (const attn_body::bf16*)(ws + WS_K), (const attn_body::bf16*)(ws + WS_V), (attn_body::bf16*)(ws + WS_Q)};
        const attn_body::StaticOrder S((int)F.G, (int)blockIdx.x);
        attn_body::attn_phase<attn_body::StaticOrder>((char*)lds + RING_OFF, AT, S); } SEAM(3);
    if (IN(4)) { Gemm g{(const bf16*)(ws + WS_UG2), (const bf16*)(ws + WS_MEXT), UGP, UGP, UGP}; SsmYOrder S{F.G, (int)blockIdx.x}; EpiSsmY E{(bf16*)(ws + WS_YG)};
        gemm_phase<EpiSsmY, SsmYOrder, true, true>(F.lds + RING_OFF, g, S, E);
        if (blockIdx.x < 128) main_done(F, CW_DONE + 64 * 4); else bg_convert(F, CW_DONE + 64 * 4, 128u); } SEAM(4);
    if (IN(5)) { Gemm g{(const bf16*)(ws + WS_YG), (const bf16*)(ws + WS_WGLU), 512, 512, 512}; pg8::StaticOrder S; S.init(M, 512, F.G, (int)blockIdx.x); EpiGlu E{(const bf16*)(ws + WS_YG), F.in[16], (bf16*)(ws + WS_Z)};
        gemm_phase<EpiGlu, pg8::StaticOrder, true, true>(F.lds + RING_OFF, g, S, E);
        if (blockIdx.x < 128) main_done(F, CW_DONE + 64 * 5); else bg_convert(F, CW_DONE + 64 * 5, 128u); } SEAM(5);
    if (IN(6)) { Gemm g{(const bf16*)(ws + WS_Q), (const bf16*)(ws + WS_WAB), 512, 512, 512}; pg8::StaticOrder S; S.init(M, 1024, F.G, (int)blockIdx.x); EpiBranch<0> E{(const bf16*)args.out, nullptr, (bf16*)(ws + WS_T1)};
        gemm_phase<EpiBranch<0>, pg8::StaticOrder, true, true>(F.lds + RING_OFF, g, S, E); } SEAM(6);
    if (IN(7)) { Gemm g{(const bf16*)(ws + WS_Z), (const bf16*)(ws + WS_WSB), 512, 512, 512}; pg8::StaticOrder S; S.init(M, 1024, F.G, (int)blockIdx.x); EpiBranch<1> E{(const bf16*)args.out, (const bf16*)(ws + WS_T1), (bf16*)(ws + WS_MERGED)};
        gemm_phase<EpiBranch<1>, pg8::StaticOrder, true, true>(F.lds + RING_OFF, g, S, E); } SEAM(7);
    if (IN(8)) { Gemm g{(const bf16*)(ws + WS_MERGED), (const bf16*)(ws + WS_WO), 1024, 1024, 1024}; pg8::StaticOrder S; S.init(M, 1024, F.G, (int)blockIdx.x);
        EpiPre1 E{F.in[0], F.in[2], F.in[3], (const f32x2_t2*)(ws + WS_STATS0), args.out};
        gemm_phase<EpiPre1, pg8::StaticOrder, true, true>(F.lds + RING_OFF, g, S, E); } SEAM(8);
    if (IN(9)) { ln1_router(F); } SEAM(9);
    if (IN(10)) { topk_phase(F); if (blockIdx.x < BATCH * NE) main_done(F, CW_DONE + 64 * 10); else bg_convert(F, CW_DONE + 64 * 10, (unsigned)(BATCH * NE)); } SEAM(10);
    if (IN(11)) { gather_phase(F); bg_convert(F, 0, 0u); } SEAM(11);
    if (IN(12)) { Gemm g{(const bf16*)(ws + WS_XE), (const bf16*)(ws + WS_WGU), 1024, 1024, 1024}; MoeOrder S{F.G, (int)blockIdx.x, 8, 8}; EpiMoe1 E{(bf16*)(ws + WS_HB)};
        gemm_phase<EpiMoe1, MoeOrder, true, true>(F.lds + RING_OFF, g, S, E); } SEAM(12);
    if (IN(13)) { Gemm g{(const bf16*)(ws + WS_HB), (const bf16*)(ws + WS_WD), 1024, 1024, 1024}; MoeOrder S{F.G, (int)blockIdx.x, 8, 4}; EpiMoe2 E{(const float*)(ws + WS_GATE2), (bf16*)(ws + WS_XE)};
        gemm_phase<EpiMoe2, MoeOrder, true, true>(F.lds + RING_OFF, g, S, E); } SEAM(13);
    if (IN(14)) { final_phase(F); }
    if (PROBE_LO >= 0) { if (PROBE_HI == 15) pr_t1 = rt(); if (blockIdx.x == 0) { const unsigned long long span = (pr_t1 - pr_t0) * 8ull, ts = rt(); while (rt() - ts < span) __builtin_amdgcn_s_sleep(8); } }
#undef IN
#undef SEAM
}

extern "C" void kernel_launch(void* const* d_in, const int* in_sizes, int n_in, void* d_out, int out_size, void* d_ws, size_t ws_size, hipStream_t stream) {
    static int grid = 0;
    if (grid == 0) {
        int dev = 0, cus = 0;
        if (hipGetDevice(&dev) != hipSuccess || hipDeviceGetAttribute(&cus, hipDeviceAttributeMultiprocessorCount, dev) != hipSuccess) { fprintf(stderr, "kernel_launch: device query failed\n"); grid = -1; return; }
        if (hipFuncSetAttribute((const void*)mk_fwd, hipFuncAttributeMaxDynamicSharedMemorySize, LDS_BYTES) != hipSuccess) { fprintf(stderr, "kernel_launch: hipFuncSetAttribute failed\n"); grid = -1; return; }
        (void)hipGetLastError();
        grid = cus;
        if (grid != 256 || n_in != 28 || ws_size < WS_END) fprintf(stderr, "kernel_launch: unexpected geometry: %d CUs, %d inputs, %zu bytes of workspace\n", cus, n_in, ws_size);
    }
    if (grid < 0) return;
    (void)hipMemsetAsync((char*)d_ws + WS_CTL, 0, CTL_ZERO_BYTES, stream);
    Args a; memset(&a, 0, sizeof(a));
    for (int i = 0; i < 28; ++i) a.in[i] = (const float*)d_in[i];
    a.out = (float*)d_out; a.ws = (unsigned char*)d_ws;
#if MK_PER_PHASE
    for (int p = 0; p < N_PHASES - 1; ++p) { a.ph_lo = p; a.ph_hi = p + 1; hipLaunchKernelGGL(mk_fwd, dim3(grid), dim3(NWAVES * 64), LDS_BYTES, stream, a); }
#else
    a.ph_lo = 0; a.ph_hi = N_PHASES; hipLaunchKernelGGL(mk_fwd, dim3(grid), dim3(NWAVES * 64), LDS_BYTES, stream, a);
#endif
}
```

```cpp
#include <hip/hip_runtime.h>
#include <cstdio>
#include <cstdint>
#include <cstring>
namespace pg8 {
#define PG8_LAS __attribute__((address_space(3)))
typedef unsigned short bf16_t;
typedef short bf16x8 __attribute__((ext_vector_type(8)));
typedef float f32x4 __attribute__((ext_vector_type(4)));
typedef unsigned u32x4 __attribute__((ext_vector_type(4)));
constexpr int BM = 256, BK = 64, HALF = 128, HTB = HALF * BK * 2  , STAGE_BYTES = 8 * HTB, NXCD = 8, WGM = 8;

__host__ __device__ __forceinline__ int lds_byte(int r, int c) { const int st = (r >> 4) * 2 + (c >> 5), rr = r & 15, cc = c & 31, ob = rr * 64 + cc * 2; return st * 1024 + (ob ^ (((ob >> 9) & 1) << 5)); }
__host__ __device__ __forceinline__ void stage_rc(int b, int& R, int& C) { const int st = b / 1024, sb = b % 1024, swz = sb ^ (((sb >> 9) & 1) << 5); R = (st >> 1) * 16 + swz / 64; C = (st & 1) * 32 + (swz % 64) / 2; }
__host__ __device__ __forceinline__ int perm32(int rho) { const int n = rho >> 4, i = rho & 15; return 8 * (i >> 2) + 4 * n + (i & 3); }

struct Unit { int pm, pn; };
struct Gemm { const bf16_t* A; const bf16_t* Bt; int lda, ldb, K; };

struct StaticOrder {
    int nM, nN, nwg, G, c;
    __host__ __device__ void init(int M, int N, int G_, int c_) { nM = M / BM; nN = N / BM; nwg = nM * nN; G = G_; c = c_; }
    __host__ __device__ bool next(int i, Unit& u) const {
        const long L = (long)i * G + c; if (L >= nwg) return false;
        int wgid = (int)L; { const int q = nwg / NXCD, r = nwg % NXCD, xcd = wgid % NXCD, off = wgid / NXCD; wgid = (xcd < r ? xcd * (q + 1) : r * (q + 1) + (xcd - r) * q) + off; }
        const int nig = WGM * nN, gid = wgid / nig, fm = gid * WGM, gsz = (nM - fm) < WGM ? (nM - fm) : WGM;
        u.pm = fm + ((wgid % nig) % gsz); u.pn = (wgid % nig) / gsz; return true;
    }
    __device__ __forceinline__ void a_ready(const Unit&) const {}
    __device__ __forceinline__ void done(const Unit&) const {}
};

__device__ __forceinline__ unsigned cvt_pk_bf16(float lo, float hi) { unsigned r; asm volatile("v_cvt_pk_bf16_f32 %0, %1, %2" : "=v"(r) : "v"(lo), "v"(hi)); return r; }
typedef float f32x2 __attribute__((ext_vector_type(2)));
template <class Epi, class Sched, bool ALIGN_EPI = false, bool SP2 = false>
__device__ __forceinline__ void gemm_phase(PG8_LAS unsigned char* lds, const Gemm g, const Sched& S, const Epi& E) {
    const int tid = threadIdx.x, wid = __builtin_amdgcn_readfirstlane(tid >> 6), lane = tid & 63, wr = wid >> 2, wc = wid & 3, fr = lane & 15, fq = lane >> 4;
    const int K = g.K, nt = K / BK;
    unsigned voffA[2], voffB[2];
#pragma unroll
    for (int i = 0; i < 2; ++i) { int R, C; stage_rc(tid * 16 + i * 8192, R, C); const int Rb = Epi::PERM ? ((R & ~31) + perm32(R & 31)) : R;
        voffA[i] = (unsigned)(R * g.lda + C) * 2u; voffB[i] = (unsigned)(Rb * g.ldb + C) * 2u; }
    const size_t kstep = (size_t)(BK * 2);
    const size_t hstepA = (size_t)HALF * g.lda * 2, hstepB = (size_t)HALF * g.ldb * 2;
    const size_t tstepA = 2 * hstepA, tstepB = 2 * hstepB;
    const unsigned ldsw = (unsigned)wid * 1024u;
    const int aoff = lds_byte(wr * 64 + fr, fq * 8), boff = lds_byte(wc * 32 + fr, fq * 8);
#define PG8_SA(b, h) (((b) * 2 + (h)) * HTB)
#define PG8_SB(b, h) ((4 + (b) * 2 + (h)) * HTB)
#define PG8_STAGE(bufoff, gbase, voff) do { _Pragma("unroll") for (int _i = 0; _i < 2; ++_i) \
        __builtin_amdgcn_global_load_lds((const unsigned*)((const char*)(gbase) + (voff)[_i]), (PG8_LAS unsigned*)(lds + (bufoff) + ldsw + _i * 8192), 16, 0, 0); } while (0)
#define PG8_LDA(dst, b, h) do { _Pragma("unroll") for (int m = 0; m < 4; ++m) _Pragma("unroll") for (int k = 0; k < 2; ++k) dst[m][k] = *(const PG8_LAS bf16x8*)(lds + PG8_SA(b, h) + aoff + m * 2048 + k * 1024); } while (0)
#define PG8_LDB(dst, b, h) do { _Pragma("unroll") for (int n = 0; n < 2; ++n) _Pragma("unroll") for (int k = 0; k < 2; ++k) dst[n][k] = *(const PG8_LAS bf16x8*)(lds + PG8_SB(b, h) + boff + n * 2048 + k * 1024); } while (0)
#define PG8_MMA(ai, bj, At, Bt) do { __builtin_amdgcn_s_setprio(1); _Pragma("unroll") for (int m = 0; m < 4; ++m) _Pragma("unroll") for (int n = 0; n < 2; ++n) _Pragma("unroll") for (int k = 0; k < 2; ++k) \
        acc[ai][bj][m][n] = __builtin_amdgcn_mfma_f32_16x16x32_bf16(Bt[n][k], At[m][k], acc[ai][bj][m][n], 0, 0, 0); __builtin_amdgcn_s_setprio(0); } while (0)
#define PG8_WAIT_V(n) asm volatile("s_waitcnt vmcnt(" #n ")" ::: "memory")
#define PG8_WAIT_L(n) asm volatile("s_waitcnt lgkmcnt(" #n ")" ::: "memory")
#define PG8_BAR __builtin_amdgcn_s_barrier()
#define PG8_SCHED __builtin_amdgcn_sched_barrier(0)
    Unit cur, nxt; int ui = 0;
    if (!S.next(0, cur)) return;
    f32x4 acc[2][2][4][2];
#pragma unroll
    for (int a = 0; a < 2; ++a)
#pragma unroll
        for (int b = 0; b < 2; ++b)
#pragma unroll
            for (int m = 0; m < 4; ++m)
#pragma unroll
                for (int n = 0; n < 2; ++n) acc[a][b][m][n] = (f32x4){0.f, 0.f, 0.f, 0.f};
    bf16x8 At[4][2], B0[2][2], B1[2][2];
    const char* cA = (const char*)g.A + (size_t)cur.pm * tstepA; const char* cB = (const char*)g.Bt + (size_t)cur.pn * tstepB;
    S.a_ready(cur);
    if constexpr (SP2) {
        PG8_STAGE(PG8_SB(0, 0), cB, voffB); PG8_STAGE(PG8_SB(0, 1), cB + hstepB, voffB); PG8_STAGE(PG8_SA(0, 0), cA, voffA); PG8_STAGE(PG8_SA(0, 1), cA + hstepA, voffA);
        if (wr == 1) PG8_BAR;
        PG8_WAIT_V(2); PG8_BAR;
        PG8_STAGE(PG8_SB(1, 0), cB + kstep, voffB); PG8_STAGE(PG8_SA(1, 0), cA + kstep, voffA); PG8_STAGE(PG8_SB(1, 1), cB + hstepB + kstep, voffB);
        PG8_WAIT_V(6); PG8_BAR;
    } else {
        PG8_STAGE(PG8_SB(0, 0), cB, voffB); PG8_STAGE(PG8_SA(0, 0), cA, voffA); PG8_STAGE(PG8_SB(0, 1), cB + hstepB, voffB); PG8_STAGE(PG8_SA(0, 1), cA + hstepA, voffA);
        if (wr == 1) PG8_BAR;
        PG8_WAIT_V(4); PG8_BAR;
        PG8_STAGE(PG8_SB(1, 0), cB + kstep, voffB); PG8_STAGE(PG8_SA(1, 0), cA + kstep, voffA); PG8_STAGE(PG8_SB(1, 1), cB + hstepB + kstep, voffB);
        PG8_WAIT_V(6); PG8_BAR;
    }
    for (;;) {
        const bool has_next = S.next(ui + 1, nxt);
        const char* nA = has_next ? (const char*)g.A + (size_t)nxt.pm * tstepA : cA; const char* nB = has_next ? (const char*)g.Bt + (size_t)nxt.pn * tstepB : cB;
        for (int t = 0; t < nt; t += 2) {
            const bool last = (t == nt - 2);
            const char* a1 = cA + (size_t)(t + 1) * kstep;
            const char* a2 = last ? nA : cA + (size_t)(t + 2) * kstep; const char* b2 = last ? nB : cB + (size_t)(t + 2) * kstep;
            const char* a3 = a2 + kstep; const char* b3 = b2 + kstep;
            if (last && has_next) S.a_ready(nxt);
            if constexpr (SP2) {
            PG8_LDB(B0, 0, 0); PG8_LDB(B1, 0, 1); PG8_SCHED; PG8_LDA(At, 0, 0); PG8_STAGE(PG8_SA(1, 1), a1 + hstepA, voffA);
            PG8_WAIT_V(8); PG8_WAIT_L(0); PG8_BAR; PG8_MMA(0, 0, At, B0); PG8_MMA(0, 1, At, B1); PG8_BAR; PG8_SCHED;
            PG8_LDA(At, 0, 1); PG8_STAGE(PG8_SB(0, 0), b2, voffB); PG8_STAGE(PG8_SB(0, 1), b2 + hstepB, voffB); PG8_STAGE(PG8_SA(0, 0), a2, voffA);
            PG8_WAIT_V(8); PG8_WAIT_L(0); PG8_BAR; PG8_MMA(1, 0, At, B0); PG8_MMA(1, 1, At, B1); PG8_BAR; PG8_SCHED;
            PG8_LDB(B0, 1, 0); PG8_LDB(B1, 1, 1); PG8_SCHED; PG8_LDA(At, 1, 0); PG8_STAGE(PG8_SA(0, 1), a2 + hstepA, voffA);
            PG8_WAIT_V(8); PG8_WAIT_L(0); PG8_BAR; PG8_MMA(0, 0, At, B0); PG8_MMA(0, 1, At, B1); PG8_BAR; PG8_SCHED;
            PG8_LDA(At, 1, 1); PG8_STAGE(PG8_SB(1, 0), b3, voffB); PG8_STAGE(PG8_SB(1, 1), b3 + hstepB, voffB); PG8_STAGE(PG8_SA(1, 0), a3, voffA);
            PG8_WAIT_V(8); PG8_WAIT_L(0); PG8_BAR; PG8_MMA(1, 0, At, B0); PG8_MMA(1, 1, At, B1); PG8_BAR; PG8_SCHED;
            } else {
            PG8_LDB(B0, 0, 0); PG8_SCHED; PG8_LDA(At, 0, 0); PG8_STAGE(PG8_SA(1, 1), a1 + hstepA, voffA);
            PG8_WAIT_L(8); PG8_BAR; PG8_WAIT_L(0); PG8_MMA(0, 0, At, B0); PG8_BAR; PG8_SCHED;
            PG8_LDB(B1, 0, 1); PG8_STAGE(PG8_SB(0, 0), b2, voffB);
            PG8_BAR; PG8_WAIT_L(0); PG8_MMA(0, 1, At, B1); PG8_BAR;
            PG8_LDA(At, 0, 1); PG8_STAGE(PG8_SA(0, 0), a2, voffA);
            PG8_BAR; PG8_WAIT_L(0); PG8_MMA(1, 0, At, B0); PG8_BAR; PG8_SCHED;
            PG8_STAGE(PG8_SB(0, 1), b2 + hstepB, voffB);
            PG8_WAIT_V(6); PG8_BAR; PG8_MMA(1, 1, At, B1); PG8_BAR;
            PG8_LDB(B0, 1, 0); PG8_SCHED; PG8_LDA(At, 1, 0); PG8_STAGE(PG8_SA(0, 1), a2 + hstepA, voffA);
            PG8_WAIT_L(8); PG8_BAR; PG8_WAIT_L(0); PG8_MMA(0, 0, At, B0); PG8_BAR; PG8_SCHED;
            PG8_LDB(B1, 1, 1); PG8_STAGE(PG8_SB(1, 0), b3, voffB);
            PG8_BAR; PG8_WAIT_L(0); PG8_MMA(0, 1, At, B1); PG8_BAR;
            PG8_LDA(At, 1, 1); PG8_STAGE(PG8_SA(1, 0), a3, voffA);
            PG8_BAR; PG8_WAIT_L(0); PG8_MMA(1, 0, At, B0); PG8_BAR; PG8_SCHED;
            PG8_STAGE(PG8_SB(1, 1), b3 + hstepB, voffB);
            PG8_WAIT_V(6); PG8_BAR; PG8_MMA(1, 1, At, B1); PG8_BAR;
            }
        }
        if constexpr (ALIGN_EPI) { if (wr == 0) PG8_BAR; }
        if constexpr (!Epi::AFTER_DRAIN) { E(acc, cur, wr, wc, fr, fq); S.done(cur); }
        if (!has_next) break;
#pragma unroll
        for (int a = 0; a < 2; ++a)
#pragma unroll
            for (int b = 0; b < 2; ++b)
#pragma unroll
                for (int m = 0; m < 4; ++m)
#pragma unroll
                    for (int n = 0; n < 2; ++n) acc[a][b][m][n] = (f32x4){0.f, 0.f, 0.f, 0.f};
        cur = nxt; cA = nA; cB = nB; ++ui;
        if constexpr (ALIGN_EPI) { if (wr == 1) PG8_BAR; }
    }
    PG8_WAIT_V(0);
    if constexpr (!ALIGN_EPI) { if (wr == 0) PG8_BAR; }
    PG8_BAR;
    if constexpr (Epi::AFTER_DRAIN) { E.fused(acc, cur, wr, wc, fr, fq, lds, wid, lane); S.done(cur); }
#undef PG8_SA
#undef PG8_SB
#undef PG8_STAGE
#undef PG8_LDA
#undef PG8_LDB
#undef PG8_MMA
#undef PG8_WAIT_V
#undef PG8_WAIT_L
#undef PG8_BAR
#undef PG8_SCHED
}
}
#define PG8_SP2 true
#define PG8_ALIGN true
#include <hip/hip_bf16.h>
#include <cmath>
namespace attn_body {
using bf16=__hip_bfloat16;
using bf16x8=__attribute__((ext_vector_type(8)))short;
using s16x4=__attribute__((ext_vector_type(4)))short;
using f32x16=__attribute__((ext_vector_type(16)))float;
using u32x4=__attribute__((ext_vector_type(4)))unsigned;
constexpr int BATCH=2,NHEAD=8,SEQ=8192,D=64,DMQ=NHEAD*D,DMK=128,KVROWS=8320,KVALID=8208;
constexpr int NW=8,QBLK=32,QB=QBLK*NW,KVBLK=64,NQB=SEQ/QB;
constexpr int ATTN_PITCH=DMQ, ATTN_UNIT_ROWS=QB;
__device__ __forceinline__ int crow(int r,int hi){return (r&3)+8*(r>>2)+4*hi;}
#define SBAR() __builtin_amdgcn_sched_barrier(0)
__device__ __forceinline__ void cmask(f32x16&p0,f32x16&p1,int t,int hi){
  const float NEG=-INFINITY; int kb=64*t+4*hi;
  #pragma unroll
  for(int r=0;r<16;++r){int kv=kb+(r&3)+8*(r>>2); if(kv>=KVALID)p0[r]=NEG; if(kv+32>=KVALID)p1[r]=NEG;}
}

constexpr int NSLOT=3, SLOTB=8192;
constexpr int LDS_K=0, LDS_V=NSLOT*SLOTB, LDS_WS=2*NSLOT*SLOTB, LDS_OST=LDS_WS+NW*64*4, LDS_BYTES=LDS_OST+NW*4096;
constexpr float C2=0.125f*1.4426950408889634f;
__device__ __forceinline__ void glds16(const void*gsrc,unsigned lds_dst){unsigned keep;
  asm volatile("s_mov_b32 %0, m0\n\ts_mov_b32 m0, %2\n\ts_nop 0\n\tglobal_load_lds_dwordx4 %1, off\n\ts_mov_b32 m0, %0":"=&s"(keep):"v"(gsrc),"s"(lds_dst):"memory");}
__device__ __forceinline__ float max3f(float a,float b,float c){float r;asm("v_max3_f32 %0, %1, %2, %3":"=v"(r):"v"(a),"v"(b),"v"(c));return r;}
__device__ __forceinline__ float max2f(float a,float b){float r;asm("v_max_f32_e32 %0, %1, %2":"=v"(r):"v"(a),"v"(b));return r;}
__device__ __forceinline__ float fadd_s(float a,float b){float r;asm("v_add_f32_e32 %0, %1, %2":"=v"(r):"v"(a),"v"(b));return r;}
__device__ __forceinline__ float fsub_s(float a,float b){float r;asm("v_sub_f32_e32 %0, %1, %2":"=v"(r):"v"(a),"v"(b));return r;}
typedef float f32x2_t __attribute__((ext_vector_type(2))); typedef __bf16 bf16x2_t __attribute__((ext_vector_type(2)));
__device__ __forceinline__ unsigned cvtpk_s(float lo,float hi){f32x2_t v={lo,hi};bf16x2_t b=__builtin_convertvector(v,bf16x2_t);return __builtin_bit_cast(unsigned,b);}
#define WAIT_BAR(N) asm volatile("s_waitcnt vmcnt(" #N ") lgkmcnt(0)\n\ts_barrier":::"memory")

__device__ __forceinline__ void qkt(f32x16&p0,f32x16&p1,const char*Kslot,const bf16x8*qr,const f32x16&negm,int r32,int hi){
  const char*kb=Kslot+hi*1024+r32*16;
  #pragma unroll
  for(int d0=0;d0<4;++d0){
    const bf16x8 b0=*reinterpret_cast<const bf16x8*>(kb+d0*2048);
    const bf16x8 b1=*reinterpret_cast<const bf16x8*>(kb+d0*2048+512);
    if(d0==0){p0=__builtin_amdgcn_mfma_f32_32x32x16_bf16(b0,qr[0],negm,0,0,0);p1=__builtin_amdgcn_mfma_f32_32x32x16_bf16(b1,qr[0],negm,0,0,0);}
    else{p0=__builtin_amdgcn_mfma_f32_32x32x16_bf16(b0,qr[d0],p0,0,0,0);p1=__builtin_amdgcn_mfma_f32_32x32x16_bf16(b1,qr[d0],p1,0,0,0);}}
}
typedef __attribute__((address_space(3))) const char* lds_cptr;
typedef short v4i16_t __attribute__((ext_vector_type(4)));
__device__ __forceinline__ void kload8(bf16x8*kf,lds_cptr kp){
  kf[0]=*(const __attribute__((address_space(3))) bf16x8*)(kp);      kf[1]=*(const __attribute__((address_space(3))) bf16x8*)(kp+512);
  kf[2]=*(const __attribute__((address_space(3))) bf16x8*)(kp+2048); kf[3]=*(const __attribute__((address_space(3))) bf16x8*)(kp+2560);
  kf[4]=*(const __attribute__((address_space(3))) bf16x8*)(kp+4096); kf[5]=*(const __attribute__((address_space(3))) bf16x8*)(kp+4608);
  kf[6]=*(const __attribute__((address_space(3))) bf16x8*)(kp+6144); kf[7]=*(const __attribute__((address_space(3))) bf16x8*)(kp+6656);
}
__device__ __forceinline__ void kload2(bf16x8*kf,lds_cptr kp,int j){ kf[2*j]=*(const __attribute__((address_space(3))) bf16x8*)(kp+j*2048); kf[2*j+1]=*(const __attribute__((address_space(3))) bf16x8*)(kp+j*2048+512); }
__device__ __forceinline__ s16x4 vtr(lds_cptr p){ return __builtin_bit_cast(s16x4,__builtin_amdgcn_ds_read_tr16_b64_v4i16((__attribute__((address_space(3))) v4i16_t*)p)); }
__device__ __forceinline__ float rowmax(const f32x16&p0,const f32x16&p1){
  float a=max3f(p0[0],p0[1],p1[0]),b=max3f(p0[2],p0[3],p1[1]);a=max3f(a,p1[2],p1[3]);
  #pragma unroll
  for(int r=4;r<16;r+=4){a=max3f(a,p0[r],p0[r+1]);b=max3f(b,p0[r+2],p0[r+3]);a=max3f(a,p1[r],p1[r+1]);b=max3f(b,p1[r+2],p1[r+3]);}
  const float m=max2f(a,b);
  auto rr=__builtin_amdgcn_permlane32_swap(__float_as_uint(m),__float_as_uint(m),false,false);
  return max2f(__uint_as_float(rr[0]),__uint_as_float(rr[1]));
}
__device__ __forceinline__ void pv(f32x16*o,int vb,bf16x8 pa0,bf16x8 pa1,bf16x8 pa2,bf16x8 pa3){
  #pragma unroll
  for(int d0=0;d0<2;++d0){s16x4 lo[4],hi[4];
    #pragma unroll
    for(int ks=0;ks<4;++ks){
      asm volatile("ds_read_b64_tr_b16 %0,%1 offset:%c2":"=&v"(lo[ks]):"v"(vb),"i"(d0*4096+ks*1024):"memory");
      asm volatile("ds_read_b64_tr_b16 %0,%1 offset:%c2":"=&v"(hi[ks]):"v"(vb),"i"(d0*4096+ks*1024+512):"memory");}
    asm volatile("s_waitcnt lgkmcnt(0)":::"memory");SBAR();
    #define PK(k) (bf16x8){lo[k][0],lo[k][1],lo[k][2],lo[k][3],hi[k][0],hi[k][1],hi[k][2],hi[k][3]}
    o[d0]=__builtin_amdgcn_mfma_f32_32x32x16_bf16(pa0,PK(0),o[d0],0,0,0);
    o[d0]=__builtin_amdgcn_mfma_f32_32x32x16_bf16(pa1,PK(1),o[d0],0,0,0);
    o[d0]=__builtin_amdgcn_mfma_f32_32x32x16_bf16(pa2,PK(2),o[d0],0,0,0);
    o[d0]=__builtin_amdgcn_mfma_f32_32x32x16_bf16(pa3,PK(3),o[d0],0,0,0);
    #undef PK
  }
}

#ifndef ATTN_STORE16
#define ATTN_STORE16(p,v) (*(u32x4*)(p)=(v))
#endif
template<int THRL> __device__ __forceinline__ void attn_unit(int b,int h,int qb,const bf16*Q,const bf16*__restrict__ K,const bf16*__restrict__ V,bf16*O,char*shm){
  const int tid=threadIdx.x,lane=tid&63,r32=lane&31,hi=lane>>5; const int wid=__builtin_amdgcn_readfirstlane(tid>>6);
  const long rowbase=(long)b*SEQ, kvbase=(long)b*KVROWS; const int q0=qb*QB;
  const bf16*Qw=Q+(rowbase+q0+wid*QBLK)*DMQ+h*D;
  const bf16*Kh=K+kvbase*DMK+(h>>2)*D,*Vh=V+kvbase*DMK+(h>>2)*D;
  const unsigned lds0=(unsigned)(uintptr_t)shm;
  float*wsf=(float*)(shm+LDS_WS)+wid*64;
  const bf16*ksrc=Kh+(long)lane*DMK+wid*8;
  const bf16*vsrc=Vh+(long)(16*(wid&3)+(lane>>2))*DMK+(wid>>2)*32+(lane&3)*8;
  const unsigned kdst=lds0+LDS_K+wid*1024, vdst=lds0+LDS_V+wid*1024;
  #define DMA_K(t,slot) glds16(ksrc+(long)(t)*KVBLK*DMK,(unsigned)__builtin_amdgcn_readfirstlane(kdst+(slot)))
  #define DMA_V(t,slot) glds16(vsrc+(long)(t)*KVBLK*DMK,(unsigned)__builtin_amdgcn_readfirstlane(vdst+(slot)))
  const int vb0=(int)(lds0+LDS_V)+((lane>>4)&1)*32+(lane&3)*8+(4*hi+((lane&15)>>2))*64;
  const char*Kbase=shm+LDS_K; bf16x8 kf[8];
  const lds_cptr shm3=(lds_cptr)shm; const lds_cptr kp0=shm3+LDS_K+hi*1024+r32*16; const lds_cptr vp0=shm3+LDS_V+((lane>>4)&1)*32+(lane&3)*8+(4*hi+((lane&15)>>2))*64;
  constexpr int NT=KVROWS/KVBLK;
  DMA_K(0,0);DMA_V(0,0);DMA_K(1,SLOTB);
  bf16x8 qr[4];
  #pragma unroll
  for(int d0=0;d0<4;++d0)qr[d0]=*reinterpret_cast<const bf16x8*>(&Qw[(long)r32*DMQ+d0*16+hi*8]);
  float mhat=0.f,l_reg=0.f;f32x16 o[2];o[0]=f32x16{};o[1]=f32x16{};f32x16 negm=f32x16{};asm volatile("":"+v"(negm));
    #define CMASK(P0,P1,t) do{ if((t)>=NT-4)cmask(P0,P1,(t),hi); }while(0)
  bool resc=false;
  #define START(P0,P1) do{ const float rm=rowmax(P0,P1); resc=false; \
    { const float dl=rm; mhat=fadd_s(mhat,dl); \
      _Pragma("unroll") for(int r=0;r<16;++r){P0[r]=fsub_s(P0[r],dl);P1[r]=fsub_s(P1[r],dl);} \
      _Pragma("unroll") for(int r=0;r<16;++r)negm[r]=-mhat; asm volatile("":"+v"(negm)); } \
    _Pragma("unroll") for(int r=0;r<16;++r)P0[r]=__builtin_amdgcn_exp2f(P0[r]); }while(0)
  #define RESC() do{ if(resc){ asm volatile("s_waitcnt lgkmcnt(0)":::"memory"); \
      _Pragma("unroll") for(int d_=0;d_<2;++d_) _Pragma("unroll") for(int r=0;r<16;++r)o[d_][r]*=wsf[crow(r,hi)]; } }while(0)
  f32x16 pA0,pA1,pB0,pB1;
  int sl_prev=0,sl_cur=0,sl_next=SLOTB;
  #define ROT() do{sl_prev=sl_cur;sl_cur=sl_next;sl_next=(sl_next==(NSLOT-1)*SLOTB)?0:sl_next+SLOTB;}while(0)
  DMA_K(2,2*SLOTB);
  WAIT_BAR(3);
  qkt(pA0,pA1,Kbase,qr,negm,r32,hi);asm volatile("s_nop 15\n\ts_nop 7":"+v"(pA0),"+v"(pA1));CMASK(pA0,pA1,0);
  START(pA0,pA1);
  _Pragma("unroll") for(int r=0;r<16;++r)pA1[r]=__builtin_amdgcn_exp2f(pA1[r]);
  WAIT_BAR(0);
  DMA_K(3,0);DMA_V(1,SLOTB);
  ROT();
  kload8(kf,kp0+sl_cur);
  WAIT_BAR(2);
  s16x4 vlo[8],vhi[8]; u32x4 pw0,pw1,pw2,pw3;
  #define PKW(P,B) cvtpk_s(P[B],P[B+1])
  #define PAF(k) __builtin_bit_cast(bf16x8,pw##k)
  #define VFR(i) (bf16x8){vlo[i][0],vlo[i][1],vlo[i][2],vlo[i][3],vhi[i][0],vhi[i][1],vhi[i][2],vhi[i][3]}
  #define PIN(x) asm volatile("":"+v"(x))
  #define MX3(a,b,c) __builtin_fmaxf(__builtin_fmaxf((a),(b)),(c))
  #define GAPA(MF,A0,A1,A2,A3,W0,W1,PW) do{ MF; sacc+=A0; sacc+=A1; sacc+=A2; sacc+=A3; PIN(sacc); W0; W1; PIN(PW); SBAR(); }while(0)
  #define EX(v) __builtin_amdgcn_exp2f(v)
  #define GAPB(MF,X,B) do{ MF; X[B]=EX(X[B]); X[B+1]=EX(X[B+1]); X[B+2]=EX(X[B+2]); X[B+3]=EX(X[B+3]); PIN(X); SBAR(); }while(0)
  #define VRD(i) do{ vlo[i]=vtr(vp_+(((i)>>2)*4096+((i)&3)*1024)); vhi[i]=vtr(vp_+(((i)>>2)*4096+((i)&3)*1024+512)); }while(0)
  #define KRD(G,j) do{ if(G){ kload2(kf,kp0+sl_next,j); SBAR(); } }while(0)
  #define STEP(C0,C1,P0,P1,t,GK,GV,GL) do{ SBAR(); \
    const lds_cptr vp_=vp0+sl_prev; \
    VRD(0); SBAR(); float sacc=(P0[0]+P0[1]); \
    GAPA(C0=__builtin_amdgcn_mfma_f32_32x32x16_bf16(kf[0],qr[0],negm,0,0,0), P0[2],P0[3],P0[4],P0[5],     pw0[0]=PKW(P0,0), pw0[1]=PKW(P0,2), pw0); \
    VRD(4); SBAR(); GAPA(C1=__builtin_amdgcn_mfma_f32_32x32x16_bf16(kf[1],qr[0],negm,0,0,0), P0[6],P0[7],P0[8],P0[9],     pw0[2]=PKW(P0,4), pw0[3]=PKW(P0,6), pw0); \
    VRD(1); SBAR(); GAPA(C0=__builtin_amdgcn_mfma_f32_32x32x16_bf16(kf[2],qr[1],C0,0,0,0),   P0[10],P0[11],P0[12],P0[13], pw1[0]=PKW(P0,8), pw1[1]=PKW(P0,10), pw1); \
    VRD(5); SBAR(); GAPA(C1=__builtin_amdgcn_mfma_f32_32x32x16_bf16(kf[3],qr[1],C1,0,0,0),   P0[14],P0[15],P1[0],P1[1],   pw1[2]=PKW(P0,12),pw1[3]=PKW(P0,14), pw1); \
    VRD(2); SBAR(); GAPA(C0=__builtin_amdgcn_mfma_f32_32x32x16_bf16(kf[4],qr[2],C0,0,0,0),   P1[2],P1[3],P1[4],P1[5],     pw2[0]=PKW(P1,0), pw2[1]=PKW(P1,2), pw2); \
    VRD(6); SBAR(); GAPA(C1=__builtin_amdgcn_mfma_f32_32x32x16_bf16(kf[5],qr[2],C1,0,0,0),   P1[6],P1[7],P1[8],P1[9],     pw2[2]=PKW(P1,4), pw2[3]=PKW(P1,6), pw2); \
    VRD(3); SBAR(); GAPA(C0=__builtin_amdgcn_mfma_f32_32x32x16_bf16(kf[6],qr[3],C0,0,0,0),   P1[10],P1[11],P1[12],P1[13], pw3[0]=PKW(P1,8), pw3[1]=PKW(P1,10), pw3); \
    VRD(7); SBAR(); GAPA(C1=__builtin_amdgcn_mfma_f32_32x32x16_bf16(kf[7],qr[3],C1,0,0,0),   P1[14],P1[15],0.f,0.f,       pw3[2]=PKW(P1,12),pw3[3]=PKW(P1,14), pw3); \
    l_reg+=sacc; \
    if(GK){DMA_K((t)+3,sl_cur);} if(GV){DMA_V((t)+1,sl_next);} \
    CMASK(C0,C1,t); \
    { float a=MX3(C0[0],C0[1],C1[0]),b=MX3(C0[2],C0[3],C1[1]); a=MX3(a,C1[2],C1[3]); \
      _Pragma("unroll") for(int r=4;r<16;r+=4){a=MX3(a,C0[r],C0[r+1]);b=MX3(b,C0[r+2],C0[r+3]);a=MX3(a,C1[r],C1[r+1]);b=MX3(b,C1[r+2],C1[r+3]);} \
      float rm=__builtin_fmaxf(a,b); { auto rr=__builtin_amdgcn_permlane32_swap(__float_as_uint(rm),__float_as_uint(rm),false,false); rm=__builtin_fmaxf(__uint_as_float(rr[0]),__uint_as_float(rr[1])); } \
      resc=false; \
      if(__builtin_expect(__any(rm>(float)THRL),0)){ const float dl=__builtin_fmaxf(rm,0.f); mhat+=dl; \
        _Pragma("unroll") for(int r=0;r<16;++r){C0[r]-=dl;C1[r]-=dl;} \
        _Pragma("unroll") for(int r=0;r<16;++r)negm[r]=-mhat; asm volatile("":"+v"(negm)); \
        const float f=__builtin_amdgcn_exp2f(-dl); l_reg*=f; if(hi==0)wsf[r32]=f; resc=true; } } \
    SBAR(); \
    GAPB(o[0]=__builtin_amdgcn_mfma_f32_32x32x16_bf16(PAF(0),VFR(0),o[0],0,0,0), C0,0); \
    GAPB(o[1]=__builtin_amdgcn_mfma_f32_32x32x16_bf16(PAF(0),VFR(4),o[1],0,0,0), C0,4); \
    KRD(GL,0); GAPB(o[0]=__builtin_amdgcn_mfma_f32_32x32x16_bf16(PAF(1),VFR(1),o[0],0,0,0), C0,8); \
    KRD(GL,1); GAPB(o[1]=__builtin_amdgcn_mfma_f32_32x32x16_bf16(PAF(1),VFR(5),o[1],0,0,0), C0,12); \
    KRD(GL,2); GAPB(o[0]=__builtin_amdgcn_mfma_f32_32x32x16_bf16(PAF(2),VFR(2),o[0],0,0,0), C1,0); \
    KRD(GL,3); GAPB(o[1]=__builtin_amdgcn_mfma_f32_32x32x16_bf16(PAF(2),VFR(6),o[1],0,0,0), C1,4); \
    GAPB(o[0]=__builtin_amdgcn_mfma_f32_32x32x16_bf16(PAF(3),VFR(3),o[0],0,0,0), C1,8); \
    GAPB(o[1]=__builtin_amdgcn_mfma_f32_32x32x16_bf16(PAF(3),VFR(7),o[1],0,0,0), C1,12); \
    }while(0)
  int t=1;
  #undef CMASK
  #define CMASK(P0,P1,t) do{}while(0)
  for(;t+5<NT;t+=2){
    STEP(pB0,pB1,pA0,pA1,t,true,true,true);     WAIT_BAR(2); RESC(); ROT();
    STEP(pA0,pA1,pB0,pB1,t+1,true,true,true);   WAIT_BAR(2); RESC(); ROT();
  }
  #undef CMASK
  #define CMASK(P0,P1,t) do{ if((t)>=NT-4)cmask(P0,P1,(t),hi); }while(0)
  #define ENDW(tt) do{ if((tt)+3<NT){WAIT_BAR(2);} else if((tt)+2<NT){WAIT_BAR(1);} else {WAIT_BAR(0);} }while(0)
  for(;t+1<NT;t+=2){
    STEP(pB0,pB1,pA0,pA1,t,(t+3<NT),(t+1<NT),(t+1<NT));       ENDW(t);   RESC(); ROT();
    STEP(pA0,pA1,pB0,pB1,t+1,(t+4<NT),(t+2<NT),(t+2<NT));     ENDW(t+1); RESC(); ROT();
  }
  STEP(pB0,pB1,pA0,pA1,NT-1,false,false,false); RESC();
  { float sacc=pB0[0]+pB0[1]; _Pragma("unroll") for(int r=2;r<16;++r)sacc+=pB0[r]; _Pragma("unroll") for(int r=0;r<16;++r)sacc+=pB1[r]; l_reg+=sacc;
    pw0=(u32x4){PKW(pB0,0),PKW(pB0,2),PKW(pB0,4),PKW(pB0,6)};pw1=(u32x4){PKW(pB0,8),PKW(pB0,10),PKW(pB0,12),PKW(pB0,14)};pw2=(u32x4){PKW(pB1,0),PKW(pB1,2),PKW(pB1,4),PKW(pB1,6)};pw3=(u32x4){PKW(pB1,8),PKW(pB1,10),PKW(pB1,12),PKW(pB1,14)};
    SBAR(); pv(o,vb0+sl_cur,PAF(0),PAF(1),PAF(2),PAF(3)); }
  #undef PKW
  #undef PAF
  #undef VFR
  #undef PIN
  #undef MX3
  #undef GAPA
  #undef GAPB
  #undef EX
  #undef VRD
  #undef KRD
  #undef STEP
  #undef ENDW
  {auto rr=__builtin_amdgcn_permlane32_swap(__float_as_uint(l_reg),__float_as_uint(l_reg),false,false);l_reg=__uint_as_float(rr[0])+__uint_as_float(rr[1]);}
  if(hi==0)wsf[32+r32]=l_reg;asm volatile("s_waitcnt lgkmcnt(0)":::"memory");
  float rli[16];
  #pragma unroll
  for(int r=0;r<16;++r)rli[r]=__builtin_amdgcn_rcpf(wsf[32+crow(r,hi)]);
  bf16*Ow=O+(rowbase+q0+wid*QBLK)*DMQ+h*D;
  { bf16*stg=(bf16*)(shm+LDS_OST)+wid*2048;
    #pragma unroll
    for(int r=0;r<16;++r){const int orow=crow(r,hi);
      #pragma unroll
      for(int d0=0;d0<2;++d0)stg[orow*64+d0*32+r32]=__float2bfloat16(o[d0][r]*rli[r]);}
    asm volatile("s_waitcnt lgkmcnt(0)":::"memory");
    #pragma unroll
    for(int i=0;i<4;++i){const int row=i*8+(lane>>3),ch=lane&7; const u32x4 v=*(const u32x4*)(stg+row*64+ch*8); ATTN_STORE16(Ow+(long)row*DMQ+ch*8,v);} }
  asm volatile("s_waitcnt lgkmcnt(0)\n\ts_barrier":::"memory");
  #undef DMA_K
  #undef DMA_V
  #undef CMASK
  #undef START
  #undef RESC
  #undef ROT
}
constexpr int ATTN_LDS_BYTES=LDS_BYTES;
struct AttnTensors { const bf16* Q; const bf16* K; const bf16* V; bf16* O; };
struct AttnUnit { int bh; int qb; };
struct StaticOrder {
  int vcu;
  __device__ __forceinline__ explicit StaticOrder(int grid,int block):vcu((block%8)*(grid/8)+block/8){}
  __device__ __forceinline__ bool next(int i,AttnUnit&u)const{ if(i>=2)return false; const int pr=vcu>>6,uu=2*(vcu&63)+i; u.bh=(pr>>1)*NHEAD+(pr&1)*4+(uu>>5); u.qb=uu&31; return true; }
  __device__ __forceinline__ void a_ready(const AttnUnit&)const{}
  __device__ __forceinline__ void done(const AttnUnit&)const{}
};
template<class Sched,int THRL=8> __device__ __forceinline__ void attn_phase(char*lds,const AttnTensors&T,const Sched&S){
  AttnUnit u;
  for(int i=0;S.next(i,u);++i){ S.a_ready(u); attn_unit<THRL>(u.bh/NHEAD,u.bh%NHEAD,u.qb,T.Q,T.K,T.V,T.O,lds); S.done(u); }
}
#undef SBAR
#undef WAIT_BAR
}
#define GAS __attribute__((address_space(1)))
#define LAS __attribute__((address_space(3)))
typedef unsigned short bf16;
typedef unsigned v4u __attribute__((ext_vector_type(4)));
typedef float f32x4 __attribute__((ext_vector_type(4)));
typedef short bf16x8 __attribute__((ext_vector_type(8)));
typedef GAS unsigned gu32;
typedef GAS unsigned long long gu64;
#define RLX_AGENT __ATOMIC_RELAXED, __HIP_MEMORY_SCOPE_AGENT
#define LDS_WAIT() asm volatile("s_waitcnt lgkmcnt(0)" ::: "memory")
#define VM_WAIT() asm volatile("s_waitcnt vmcnt(0)" ::: "memory")
__device__ __forceinline__ unsigned long long rt() { return __builtin_amdgcn_s_memrealtime(); }
__device__ __forceinline__ unsigned f2bf(float f) { unsigned u = __builtin_bit_cast(unsigned, f); return (u + 0x7fffu + ((u >> 16) & 1u)) >> 16; }
__device__ __forceinline__ unsigned pk2(float lo, float hi) { return f2bf(lo) | (f2bf(hi) << 16); }

#define XB_TMO      128
#define XB_XCNT(j)  (256  + 64 * (j))
#define XB_XSUB(j)  (1280 + 64 * (j))
#define XB_XGEN(j)  (2304 + 64 * (j))
#define XB_TOP      3328
#define XB_TOPGEN   3392
#define XCD_BAR_WORDS 3456
#define XB_SPIN_CAP (1u << 18)

__device__ __forceinline__ unsigned xb_ld(unsigned* p)              { return __hip_atomic_load(p, __ATOMIC_RELAXED, __HIP_MEMORY_SCOPE_AGENT); }
__device__ __forceinline__ unsigned xb_add(unsigned* p, unsigned v) { return __hip_atomic_fetch_add(p, v, __ATOMIC_RELAXED, __HIP_MEMORY_SCOPE_AGENT); }
__device__ __forceinline__ unsigned xb_xcc_id() { return (unsigned)__builtin_amdgcn_s_getreg((3 << 11) | 20) & 0xFu; }
#define XB_SPIN(cond, bar) do { unsigned _sp = 0; while (cond) { __builtin_amdgcn_s_sleep(1); \
    if ((++_sp & 255u) == 0u) { if (xb_ld(&(bar)[XB_TMO])) break; if (_sp > XB_SPIN_CAP) { atomicAdd(&(bar)[XB_TMO], 1u); break; } } } } while (0)

struct XcdBarrier {
    unsigned* bar; unsigned x;
    volatile LAS unsigned* st;
};

__device__ __forceinline__ XcdBarrier xcd_barrier_post(unsigned* bar, volatile LAS unsigned* st) {
    XcdBarrier b; b.bar = bar; b.x = xb_xcc_id(); b.st = st;
    if (threadIdx.x == 0) (void)xb_add(&bar[XB_XCNT(b.x)], 1u);
    return b;
}
__device__ __forceinline__ void xcd_barrier_complete(unsigned* bar, unsigned x, unsigned& nloc, unsigned& nx) {
    const unsigned G = gridDim.x * gridDim.y * gridDim.z;
    unsigned sum, cnt, mine, sp = 0u;
    for (;;) {
        sum = 0u; cnt = 0u; mine = 0u;
#pragma unroll
        for (unsigned j = 0; j < 16; ++j) { const unsigned c = xb_ld(&bar[XB_XCNT(j)]); sum += c; cnt += (c > 0u) ? 1u : 0u; mine = (j == x) ? c : mine; }
        if (sum == G) break;
        __builtin_amdgcn_s_sleep(1);
        if ((++sp & 255u) == 0u) { if (xb_ld(&bar[XB_TMO])) break; if (sp > XB_SPIN_CAP) { atomicAdd(&bar[XB_TMO], 1u); break; } }
    }
    nloc = mine > 0u ? mine : 1u; nx = cnt > 0u ? cnt : 1u;
}

__device__ __forceinline__ void xcd_barrier(const XcdBarrier& b) {
    asm volatile("s_waitcnt vmcnt(0)" ::: "memory");
    __syncthreads();
    if (threadIdx.x == 0) {
        unsigned* bar = b.bar;
        __builtin_amdgcn_s_waitcnt(0);
        unsigned nloc = b.st[0], nx = b.st[1];
        if (nloc == 0u) { xcd_barrier_complete(bar, b.x, nloc, nx); b.st[0] = nloc; b.st[1] = nx; }
        const unsigned old = xb_add(&bar[XB_XSUB(b.x)], 1u);
        const unsigned gen = old / nloc;
        if (old + 1u == (gen + 1u) * nloc) {
            __builtin_amdgcn_fence(__ATOMIC_RELEASE, "agent");
            asm volatile("s_waitcnt vmcnt(0)" ::: "memory");
            const unsigned og = xb_add(&bar[XB_TOP], 1u);
            const unsigned tg = og / nx;
            if (og + 1u == (tg + 1u) * nx) xb_add(&bar[XB_TOPGEN], 1u);
            else XB_SPIN(xb_ld(&bar[XB_TOPGEN]) == tg, bar);
            __builtin_amdgcn_fence(__ATOMIC_ACQUIRE, "agent");
            xb_add(&bar[XB_XGEN(b.x)], 1u);
            asm volatile("s_waitcnt vmcnt(0)" ::: "memory");
        } else {
            XB_SPIN(xb_ld(&bar[XB_XGEN(b.x)]) == gen, bar);
            __builtin_amdgcn_fence(__ATOMIC_ACQUIRE, "agent");
            asm volatile("s_waitcnt vmcnt(0)" ::: "memory");
        }
    }
    __syncthreads();
}

constexpr int NWAVES = 8;
constexpr int BATCH = 2, SEQ = 8192, DM = 1024, NMETA = 16;
constexpr int M = BATCH * SEQ;
constexpr int INW = 3328;
constexpr int KVROWS = 8320, KVALID = 8208;
constexpr int NG = 32, NE = 16, CAP = 1024;
constexpr int UGP = 768;
constexpr float LN_EPS = 1e-5f, QK_EPS = 1e-6f, ALPHA = 1.189207115002721f;
constexpr float C2Q = 0.125f * 1.4426950408889634f;

constexpr size_t MiB = 1u << 20;
constexpr size_t WS_CTL = 0, CTL_ZERO_BYTES = 1 * MiB;
constexpr size_t WS_STATS0 = 1 * MiB, WS_STATS1 = WS_STATS0 + 131072, WS_ROPE = WS_STATS1 + 131072, WS_UMETA = WS_ROPE + 32768, WS_GATE2 = WS_UMETA + 32768, WS_IDX2 = WS_GATE2 + 131072;
constexpr size_t WS_SLOTOF = 2 * MiB, WS_AFF = 3 * MiB;
constexpr size_t WS_WGU = 8 * MiB, WS_WD = 72 * MiB;
constexpr size_t WS_WIN = 104 * MiB, WS_WGLU = 111 * MiB, WS_WAB = 112 * MiB, WS_WSB = 113 * MiB, WS_WO = 114 * MiB;
constexpr size_t WS_WST = 116 * MiB, WS_MEXT = 124 * MiB;
constexpr size_t WS_XN = 148 * MiB;
constexpr size_t WS_Q = 181 * MiB, WS_K = 197 * MiB, WS_V = 202 * MiB;
constexpr size_t WS_UG2 = 207 * MiB, WS_S = 231 * MiB;
constexpr size_t WS_END = 247 * MiB;
constexpr size_t WS_YG = WS_XN, WS_Z = WS_XN + 16 * MiB;
constexpr size_t WS_T1 = WS_WST;
constexpr size_t WS_MERGED = WS_UG2;
constexpr size_t WS_H1 = WS_XN;
constexpr size_t WS_XE = WS_Q;
constexpr size_t WS_HB = WS_WIN;
static_assert(WS_XE + 64 * MiB <= WS_END && WS_HB + 64 * MiB <= WS_XE && WS_MERGED + 32 * MiB <= WS_END && WS_T1 + 32 * MiB <= WS_XN, "d_ws overlays");
constexpr int CW_TMO = 0, CW_BAR = 4096;
constexpr int CW_Q = 8192, CW_QM = 8192 + 4096, CW_DONE = 8256;
constexpr int N_DENSE_ITEMS = 16 * 104 + 8 * 16 + 2 * 8 * 32 + 16 * 32, N_EXP_ITEMS = NE * 3 * 16 * 32;

constexpr int RING_OFF = 0, RING_BYTES = 131072;
constexpr int LDSCTL_OFF = RING_BYTES, MISC_OFF = LDSCTL_OFF + 320;
constexpr int LDS_BYTES = 147456;

typedef unsigned u32x4_t __attribute__((ext_vector_type(4)));
typedef unsigned u32x2_t __attribute__((ext_vector_type(2)));
typedef float f32x2_t2 __attribute__((ext_vector_type(2)));
using pg8::Unit;

struct Frame {
    LAS unsigned char* lds; volatile LAS unsigned* MISC; gu32* ctl;
    int tid, lane, wave, vcu, G;
    unsigned char* ws;
    const float* in[28]; float* out;
};
__device__ __forceinline__ float wave_sum(float v) {
#pragma unroll
    for (int o = 1; o < 64; o <<= 1) v += __shfl_xor(v, o);
    return v;
}
__device__ __forceinline__ float sigm(float x) { return 1.f / (1.f + __expf(-x)); }
__device__ __forceinline__ float bf2f(unsigned short h) { return __uint_as_float((unsigned)h << 16); }
__device__ __forceinline__ float bflo(unsigned w) { return __uint_as_float(w << 16); }
__device__ __forceinline__ float bfhi(unsigned w) { return __uint_as_float(w & 0xffff0000u); }
__device__ __forceinline__ u32x4_t pack8(const f32x4& a, const f32x4& b) { u32x4_t w; w.x = pg8::cvt_pk_bf16(a[0], a[1]); w.y = pg8::cvt_pk_bf16(a[2], a[3]); w.z = pg8::cvt_pk_bf16(b[0], b[1]); w.w = pg8::cvt_pk_bf16(b[2], b[3]); return w; }
__device__ __forceinline__ float gelu_tanh(float y) { const float in = 0.7978845608028654f * (y + 0.044715f * y * y * y); const float e = __expf(2.f * in); return y * (1.f - 1.f / (e + 1.f)); }

struct InProjOrder {
    pg8::StaticOrder so;
    __device__ bool next(int i, Unit& u) const { if (so.next(i, u)) return true; const long L = (long)i * so.G + so.c; if (L >= so.nwg && L < so.nwg + 3) { u.pm = 64; u.pn = 2 + (int)(L - so.nwg); return true; } return false; }
    __device__ __forceinline__ void a_ready(const Unit&) const {}
    __device__ __forceinline__ void done(const Unit&) const {}
};
struct SsmStateOrder {
    int G, c;
    __device__ bool next(int i, Unit& u) const { const int L = i * G + c; if (L >= 64) return false; u.pm = L; u.pn = L >> 1; return true; }
    __device__ __forceinline__ void a_ready(const Unit&) const {}
    __device__ __forceinline__ void done(const Unit&) const {}
};
struct SsmYOrder {
    int G, c;
    __device__ bool next(int i, Unit& u) const { const int L = i * G + c; if (L >= 128) return false; const int g = L >> 2; u.pm = g * 2 + ((L >> 1) & 1); u.pn = g * 2 + (L & 1); return true; }
    __device__ __forceinline__ void a_ready(const Unit&) const {}
    __device__ __forceinline__ void done(const Unit&) const {}
};
struct MoeOrder {
    int G, c, nmi, nnj;
    __device__ bool next(int i, Unit& u) const { const int per = nmi * nnj, nwg = NE * per; const int L = i * G + c; if (L >= nwg) return false;
        const int wgid = (L % 8) * (nwg / 8) + L / 8; const int e = wgid / per, w = wgid % per; u.pm = e * nmi + (w % nmi); u.pn = e * nnj + (w / nmi); return true; }
    __device__ __forceinline__ void a_ready(const Unit&) const {}
    __device__ __forceinline__ void done(const Unit&) const {}
};

typedef float f32x4 __attribute__((ext_vector_type(4)));
#define EPI_LOOP_AM _Pragma("unroll") for (int ai = 0; ai < 2; ++ai) _Pragma("unroll") for (int m = 0; m < 4; ++m)
constexpr int XCH_OFF = 132096;
struct EpiInProj {
    static constexpr bool PERM = true, AFTER_DRAIN = false;
    bf16* Q; bf16* Kb; bf16* Vb; bf16* UG2; bf16* GATES; bf16* UMETA; LAS float* XCH; const float* ngt; const float* RP;
    __device__ __forceinline__ u32x4_t normrope(const f32x4& a0, const f32x4& a1, float rinv, const f32x4& g0, const f32x4& g1, const f32x4& cs, const f32x4& sn, float osc) const {
        const float y0 = a0[0] * rinv * g0[0], y1 = a0[1] * rinv * g0[1], y2 = a0[2] * rinv * g0[2], y3 = a0[3] * rinv * g0[3];
        const float y4 = a1[0] * rinv * g1[0], y5 = a1[1] * rinv * g1[1], y6 = a1[2] * rinv * g1[2], y7 = a1[3] * rinv * g1[3];
        u32x4_t w;
        w.x = pg8::cvt_pk_bf16((y0 * cs[0] - y1 * sn[0]) * osc, (y0 * sn[0] + y1 * cs[0]) * osc);
        w.y = pg8::cvt_pk_bf16((y2 * cs[1] - y3 * sn[1]) * osc, (y2 * sn[1] + y3 * cs[1]) * osc);
        w.z = pg8::cvt_pk_bf16((y4 * cs[2] - y5 * sn[2]) * osc, (y4 * sn[2] + y5 * cs[2]) * osc);
        w.w = pg8::cvt_pk_bf16((y6 * cs[3] - y7 * sn[3]) * osc, (y6 * sn[3] + y7 * cs[3]) * osc);
        return w;
    }
    __device__ __forceinline__ void operator()(const f32x4 (&acc)[2][2][4][2], const Unit& u, int wr, int wc, int fr_, int fq_) const {
        int fr = fr_, fq = fq_; asm volatile("" : "+v"(fr), "+v"(fq));
        const int pn = u.pn, cl0 = wc * 32 + 8 * fq;
        if (pn <= 2) {
            const int nb = pn == 2 ? 1 : 2;
            EPI_LOOP_AM {
#pragma unroll
                for (int bj = 0; bj < 2; ++bj) {
                    if (bj < nb) { const f32x4 a = acc[ai][bj][m][0], c = acc[ai][bj][m][1]; float s = (a[0] * a[0] + a[1] * a[1]) + (a[2] * a[2] + a[3] * a[3]) + (c[0] * c[0] + c[1] * c[1]) + (c[2] * c[2] + c[3] * c[3]);
                        s += __shfl_xor(s, 16); s += __shfl_xor(s, 32);
                        if (fq == 0) XCH[(ai * 128 + wr * 64 + m * 16 + fr) * 8 + bj * 4 + wc] = s; } } }
            asm volatile("s_waitcnt lgkmcnt(0)" ::: "memory"); __builtin_amdgcn_s_barrier(); asm volatile("" ::: "memory");
            const float* gsrc = ngt + (pn == 2 ? 64 : 0) + (wc & 1) * 32 + 8 * fq;
            const f32x4 g0 = *(const f32x4*)gsrc, g1 = *(const f32x4*)(gsrc + 4);
            const float osc = pn == 2 ? 1.f : C2Q;
            const int codd = wc & 1;
            EPI_LOOP_AM {
                if (u.pm == 64 && (wr != 0 || ai != 0 || m != 0)) continue;
                const int rl = ai * 128 + wr * 64 + m * 16 + fr; const int row = u.pm * 256 + rl;
                f32x4 cs = (f32x4){1.f, 1.f, 1.f, 1.f}, sn = (f32x4){0.f, 0.f, 0.f, 0.f};
                if (u.pm != 64) { const int s = row & 8191; const float* tp = codd ? RP + 4096 + (s & 63) * 16 + 4 * fq : RP + (s >> 6) * 16 + 4 * fq; cs = *(const f32x4*)tp; sn = *(const f32x4*)(tp + (codd ? 1024 : 2048)); }
#pragma unroll
                for (int bj = 0; bj < 2; ++bj) {
                    if (bj < nb) {
                        const f32x2_t2 pr = *(const LAS f32x2_t2*)(XCH + rl * 8 + bj * 4 + (wc & 2)); const float tot = pr.x + pr.y;
                        const float rinv = rsqrtf(tot * (1.f / 64.f) + QK_EPS);
                        const u32x4_t w = normrope(acc[ai][bj][m][0], acc[ai][bj][m][1], rinv, g0, g1, cs, sn, osc);
                        if (pn < 2) *(u32x4_t*)(Q + (size_t)row * 512 + pn * 256 + bj * 128 + cl0) = w;
                        else if (u.pm != 64) *(u32x4_t*)(Kb + ((size_t)(row >> 13) * KVROWS + NMETA + (row & 8191)) * 128 + cl0) = w;
                        else { *(u32x4_t*)(Kb + (size_t)fr * 128 + cl0) = w; *(u32x4_t*)(Kb + ((size_t)KVROWS + fr) * 128 + cl0) = w; }
                    } else {
                        const u32x4_t w = pack8(acc[ai][1][m][0], acc[ai][1][m][1]);
                        if (u.pm != 64) *(u32x4_t*)(Vb + ((size_t)(row >> 13) * KVROWS + NMETA + (row & 8191)) * 128 + cl0) = w;
                        else { *(u32x4_t*)(Vb + (size_t)fr * 128 + cl0) = w; *(u32x4_t*)(Vb + ((size_t)KVROWS + fr) * 128 + cl0) = w; }
                    }
                }
            }
            return;
        }
        if (u.pm == 64) {
            if (wr != 0) return;
#pragma unroll
            for (int bj = 0; bj < 2; ++bj) { const int cu = (pn - 3) * 256 + bj * 128 + cl0; *(u32x4_t*)(UMETA + ((size_t)(cu >> 4) * 16 + fr) * 16 + (cu & 15)) = pack8(acc[0][bj][0][0], acc[0][bj][0][1]); }
            return;
        }
        const int row0 = u.pm * 256 + wr * 64 + fr;
        if (pn < 5) {
            EPI_LOOP_AM { const int row = row0 + ai * 128 + m * 16, b = row >> 13, s = row & 8191;
#pragma unroll
                for (int bj = 0; bj < 2; ++bj) { const int cu = (pn - 3) * 256 + bj * 128 + cl0, g = cu >> 4;
                    *(u32x4_t*)(UG2 + ((size_t)(g * 2 + b) * 256 + (s >> 5)) * UGP + (s & 31) * 16 + (cu & 15)) = pack8(acc[ai][bj][m][0], acc[ai][bj][m][1]); } }
        } else {
            EPI_LOOP_AM { const size_t o = (size_t)(row0 + ai * 128 + m * 16) * 2048 + (pn - 5) * 256 + cl0;
#pragma unroll
                for (int bj = 0; bj < 2; ++bj) { f32x4 a = acc[ai][bj][m][0], c = acc[ai][bj][m][1];
#pragma unroll
                    for (int j = 0; j < 4; ++j) { a[j] = sigm(a[j]); c[j] = sigm(c[j]); }
                    *(u32x4_t*)(GATES + o + bj * 128) = pack8(a, c); } }
        }
    }
};
struct EpiSsmState {
    static constexpr bool PERM = false, AFTER_DRAIN = false;
    float* S;
    __device__ __forceinline__ void operator()(const f32x4 (&acc)[2][2][4][2], const Unit& u, int wr, int wc, int fr, int fq) const {
        EPI_LOOP_AM { float* rp = S + ((size_t)u.pm * 256 + ai * 128 + wr * 64 + m * 16 + fr) * 256 + wc * 32 + 4 * fq;
#pragma unroll
            for (int bj = 0; bj < 2; ++bj)
#pragma unroll
                for (int n = 0; n < 2; ++n) *(f32x4*)(rp + bj * 128 + n * 16) = acc[ai][bj][m][n]; }
    }
};
struct EpiSsmY {
    static constexpr bool PERM = true, AFTER_DRAIN = false;
    bf16* YG;
    __device__ __forceinline__ void operator()(const f32x4 (&acc)[2][2][4][2], const Unit& u, int wr, int wc, int fr, int fq) const {
        const int g = u.pm >> 1, b = u.pm & 1, nh = u.pn & 1;
        EPI_LOOP_AM { const int cp = ai * 128 + wr * 64 + m * 16 + fr;
#pragma unroll
            for (int bj = 0; bj < 2; ++bj) { const int nl = nh * 256 + bj * 128 + wc * 32 + 8 * fq, t = nl >> 4, h0 = nl & 15;
                f32x4 a = acc[ai][bj][m][0], c = acc[ai][bj][m][1];
#pragma unroll
                for (int j = 0; j < 4; ++j) { a[j] = gelu_tanh(a[j]); c[j] = gelu_tanh(c[j]); }
                *(u32x4_t*)(YG + ((size_t)b * SEQ + cp * 32 + t) * 512 + g * 16 + h0) = pack8(a, c); } }
    }
};
struct EpiGlu {
    static constexpr bool PERM = true, AFTER_DRAIN = false;
    const bf16* YG; const float* bias; bf16* Z;
    __device__ __forceinline__ void operator()(const f32x4 (&acc)[2][2][4][2], const Unit& u, int wr, int wc, int fr, int fq) const {
        const int row0 = u.pm * 256 + wr * 64 + fr, col0 = u.pn * 256 + wc * 32 + 8 * fq;
        EPI_LOOP_AM { const size_t o = (size_t)(row0 + ai * 128 + m * 16) * 512 + col0;
#pragma unroll
            for (int bj = 0; bj < 2; ++bj) { const u32x4_t y = *(const u32x4_t*)(YG + o + bj * 128);
                const f32x4 b0 = *(const f32x4*)(bias + col0 + bj * 128), b1 = *(const f32x4*)(bias + col0 + bj * 128 + 4);
                f32x4 a = acc[ai][bj][m][0] + b0, c = acc[ai][bj][m][1] + b1;
                a[0] = bflo(y.x) * sigm(a[0]); a[1] = bfhi(y.x) * sigm(a[1]); a[2] = bflo(y.y) * sigm(a[2]); a[3] = bfhi(y.y) * sigm(a[3]);
                c[0] = bflo(y.z) * sigm(c[0]); c[1] = bfhi(y.z) * sigm(c[1]); c[2] = bflo(y.w) * sigm(c[2]); c[3] = bfhi(y.w) * sigm(c[3]);
                *(u32x4_t*)(Z + o + bj * 128) = pack8(a, c); } }
    }
};
template <int SECOND> struct EpiBranch {
    static constexpr bool PERM = true, AFTER_DRAIN = false;
    const bf16* GATES; const bf16* T1; bf16* O;
    __device__ __forceinline__ void operator()(const f32x4 (&acc)[2][2][4][2], const Unit& u, int wr, int wc, int fr, int fq) const {
        const int row0 = u.pm * 256 + wr * 64 + fr, col0 = u.pn * 256 + wc * 32 + 8 * fq;
        EPI_LOOP_AM { const size_t r = (size_t)(row0 + ai * 128 + m * 16);
#pragma unroll
            for (int bj = 0; bj < 2; ++bj) { const u32x4_t gt = *(const u32x4_t*)(GATES + r * 2048 + SECOND * 1024 + col0 + bj * 128);
                f32x4 a = acc[ai][bj][m][0], c = acc[ai][bj][m][1];
                a[0] *= bflo(gt.x); a[1] *= bfhi(gt.x); a[2] *= bflo(gt.y); a[3] *= bfhi(gt.y); c[0] *= bflo(gt.z); c[1] *= bfhi(gt.z); c[2] *= bflo(gt.w); c[3] *= bfhi(gt.w);
                if (SECOND) { const u32x4_t t1 = *(const u32x4_t*)(T1 + r * 1024 + col0 + bj * 128);
                    a[0] += bflo(t1.x); a[1] += bfhi(t1.x); a[2] += bflo(t1.y); a[3] += bfhi(t1.y); c[0] += bflo(t1.z); c[1] += bfhi(t1.z); c[2] += bflo(t1.w); c[3] += bfhi(t1.w); }
                *(u32x4_t*)(O + r * 1024 + col0 + bj * 128) = pack8(a, c); } }
    }
};
struct EpiPre1 {
    static constexpr bool PERM = false, AFTER_DRAIN = false;
    const float* x; const float* g; const float* bb; const f32x2_t2* st; float* out;
    __device__ __forceinline__ void operator()(const f32x4 (&acc)[2][2][4][2], const Unit& u, int wr, int wc, int fr, int fq) const {
        const int row0 = u.pm * 256 + wr * 64 + fr, col0 = u.pn * 256 + wc * 32 + 4 * fq;
        EPI_LOOP_AM { const int row = row0 + ai * 128 + m * 16; const f32x2_t2 s = st[row]; const size_t o = (size_t)row * 1024 + col0;
#pragma unroll
            for (int bj = 0; bj < 2; ++bj)
#pragma unroll
                for (int n = 0; n < 2; ++n) { const int c = bj * 128 + n * 16; const f32x4 xv = *(const f32x4*)(x + o + c), gv = *(const f32x4*)(g + col0 + c), bv = *(const f32x4*)(bb + col0 + c);
                    *(f32x4*)(out + o + c) = ((xv - s.x) * s.y * gv + bv) * ALPHA + acc[ai][bj][m][n]; } }
    }
};
struct EpiMoe1 {
    static constexpr bool PERM = true, AFTER_DRAIN = false;
    bf16* HB;
    __device__ __forceinline__ void operator()(const f32x4 (&acc)[2][2][4][2], const Unit& u, int wr, int wc, int fr, int fq) const {
        const int row0 = u.pm * 256 + wr * 64 + fr, col0 = (u.pn & 7) * 128 + wc * 32 + 8 * fq;
        EPI_LOOP_AM { f32x4 a = acc[ai][0][m][0], c = acc[ai][0][m][1]; const f32x4 ua = acc[ai][1][m][0], uc = acc[ai][1][m][1];
#pragma unroll
            for (int j = 0; j < 4; ++j) { a[j] = a[j] * sigm(a[j]) * ua[j]; c[j] = c[j] * sigm(c[j]) * uc[j]; }
            *(u32x4_t*)(HB + (size_t)(row0 + ai * 128 + m * 16) * 1024 + col0) = pack8(a, c); }
    }
};
struct EpiMoe2 {
    static constexpr bool PERM = true, AFTER_DRAIN = false;
    const float* gate; bf16* YE;
    __device__ __forceinline__ void operator()(const f32x4 (&acc)[2][2][4][2], const Unit& u, int wr, int wc, int fr, int fq) const {
        const int row0 = u.pm * 256 + wr * 64 + fr, col0 = (u.pn & 3) * 256 + wc * 32 + 8 * fq;
        EPI_LOOP_AM { const int row = row0 + ai * 128 + m * 16; const float gt = gate[row];
#pragma unroll
            for (int bj = 0; bj < 2; ++bj) *(u32x4_t*)(YE + (size_t)row * 1024 + col0 + bj * 128) = pack8(acc[ai][bj][m][0] * gt, acc[ai][bj][m][1] * gt); }
    }
};

struct TItem { const float* src; bf16* dst; int N, K; };
__device__ __forceinline__ void titem_load(const TItem& t, f32x4 (&v)[8], int lane) {
    const float* p = t.src + (size_t)(lane >> 3) * t.N + (lane & 7) * 4;
#pragma unroll
    for (int i = 0; i < 8; ++i) v[i] = *(const GAS f32x4*)(p + (size_t)(8 * i) * t.N);
}
__device__ __forceinline__ void titem_store(const TItem& t, const f32x4 (&v)[8], LAS float* scr, int lane) {
#pragma unroll
    for (int i = 0; i < 8; ++i) { LAS float* s = scr + ((lane >> 3) + 8 * i) * 33 + (lane & 7) * 4; s[0] = v[i].x; s[1] = v[i].y; s[2] = v[i].z; s[3] = v[i].w; }
    LDS_WAIT(); asm volatile("" ::: "memory");
    const int c = lane & 7;
#pragma unroll
    for (int j = 0; j < 4; ++j) { const int n = (lane >> 3) + 8 * j; const LAS float* s = scr + (8 * c) * 33 + n;
        v4u o; o.x = pk2(s[0 * 33], s[1 * 33]); o.y = pk2(s[2 * 33], s[3 * 33]); o.z = pk2(s[4 * 33], s[5 * 33]); o.w = pk2(s[6 * 33], s[7 * 33]);
        *(GAS v4u*)(t.dst + (size_t)n * t.K + 8 * c) = o; }
    LDS_WAIT(); asm volatile("" ::: "memory");
}
__device__ __forceinline__ void ssm_par(const Frame& F, int dg, int p, float& lr, float& li, float& cr, float& ci) {
    const float dt = expf(F.in[9][dg]); const float ar = F.in[7][dg * 64 + p], ai = F.in[8][dg * 64 + p];
    lr = ar * dt; li = ai * dt;
    float sn, cs; sincosf(li, &sn, &cs); const float mag = expf(lr);
    const float nr = mag * cs - 1.f, ni = mag * sn, den = ar * ar + ai * ai;
    cr = (nr * ar + ni * ai) / den; ci = (ni * ar - nr * ai) / den;
}
__device__ __forceinline__ void cpow(float lr, float li, float e, float& pr, float& pi) { float sn, cs; sincosf(li * e, &sn, &cs); const float mg = expf(lr * e); pr = mg * cs; pi = mg * sn; }

__device__ __forceinline__ void mext_item(Frame& F, int it) {
    const int tid = F.tid; unsigned char* ws = F.ws;
    LAS float* POW = (LAS float*)(F.lds + RING_OFF);
    LAS float* BB = POW + 2 * 33 * 64 * 2;
    LAS float* CC = BB + 2 * 64 * 16 * 2;
    LAS float* KT = CC + 2 * 4 * 64 * 2;
    LAS float* PAR = KT + 2 * 4 * 32 * 16;
    bf16* MEXT = (bf16*)(ws + WS_MEXT);
    const int g = it >> 2, hq = it & 3;
    __syncthreads();
    if (tid < 128) { float lr, li, cr, ci; ssm_par(F, (tid >> 6) * 32 + g, tid & 63, lr, li, cr, ci); PAR[tid * 4] = lr; PAR[tid * 4 + 1] = li; PAR[tid * 4 + 2] = cr; PAR[tid * 4 + 3] = ci; }
    __syncthreads();
    if (tid < 128) { const int dir = tid >> 6, p = tid & 63; float a1r, a1i; cpow(PAR[tid * 4], PAR[tid * 4 + 1], 1.f, a1r, a1i); float pr = 1.f, pi = 0.f;
        for (int j = 0; j <= 32; ++j) { POW[((dir * 33 + j) * 64 + p) * 2] = pr; POW[((dir * 33 + j) * 64 + p) * 2 + 1] = pi; const float nr = pr * a1r - pi * a1i, ni = pr * a1i + pi * a1r; pr = nr; pi = ni; } }
    for (int i = tid; i < 2 * 64 * 16; i += NWAVES * 64) { const int dir = i / 1024, p = (i >> 4) & 63, h = i & 15; const float cr = PAR[(dir * 64 + p) * 4 + 2], ci = PAR[(dir * 64 + p) * 4 + 3];
        const size_t o = ((size_t)(dir * 32 + g) * 64 + p) * 16 + h; const float br = F.in[10][o], bi = F.in[11][o]; BB[i * 2] = cr * br - ci * bi; BB[i * 2 + 1] = cr * bi + ci * br; }
    for (int i = tid; i < 2 * 4 * 64; i += NWAVES * 64) { const int dir = i / 256, hl = (i >> 6) & 3, p = i & 63; const size_t o = ((size_t)(dir * 32 + g) * 16 + hq * 4 + hl) * 64 + p; CC[i * 2] = F.in[12][o]; CC[i * 2 + 1] = F.in[13][o]; }
    __syncthreads();
    { const int wv = F.wave, dir = wv >> 2, hl = wv & 3, jg = F.lane >> 4, hi = F.lane & 15;
      float acc[8];
#pragma unroll
      for (int jj = 0; jj < 8; ++jj) acc[jj] = 0.f;
#pragma unroll 1
      for (int ph = 0; ph < 2; ++ph) {
          float gr[32], gi[32];
#pragma unroll
          for (int q = 0; q < 32; ++q) { const int p = ph * 32 + q; const f32x2_t2 c = *(const LAS f32x2_t2*)(CC + ((dir * 4 + hl) * 64 + p) * 2), bq = *(const LAS f32x2_t2*)(BB + ((dir * 64 + p) * 16 + hi) * 2);
              gr[q] = c.x * bq.x - c.y * bq.y; gi[q] = c.x * bq.y + c.y * bq.x; }
#pragma unroll
          for (int jj = 0; jj < 8; ++jj) { const LAS f32x4* pw = (const LAS f32x4*)(POW + ((dir * 33 + jg * 8 + jj) * 64 + ph * 32) * 2); float s = acc[jj];
#pragma unroll
              for (int q = 0; q < 16; ++q) { const f32x4 w = pw[q]; s += w.x * gr[2 * q] - w.y * gi[2 * q]; s += w.z * gr[2 * q + 1] - w.w * gi[2 * q + 1]; }
              acc[jj] = s; }
      }
#pragma unroll
      for (int jj = 0; jj < 8; ++jj) KT[((dir * 4 + hl) * 32 + jg * 8 + jj) * 16 + hi] = acc[jj]; }
    __syncthreads();
    LAS float* KC = PAR + 2 * 64 * 4;
    for (int i = tid; i < 4 * 63 * 16; i += NWAVES * 64) { const int hl = i / (63 * 16), r = i % (63 * 16), d = (r >> 4) - 31, hi = r & 15; float x = 0.f;
        if (d >= 0) x += KT[((0 * 4 + hl) * 32 + d) * 16 + hi]; if (d <= 0) x += KT[((1 * 4 + hl) * 32 - d) * 16 + hi];
        if (d == 0 && hi == hq * 4 + hl) x += F.in[14][g * 16 + hi];
        KC[(hl * 64 + d + 31) * 16 + hi] = x; }
    __syncthreads();
    for (int ch = tid; ch < 128 * 96; ch += NWAVES * 64) { const int rl = ch / 96, cc = ch % 96, t = rl >> 2, hl = rl & 3, ho = hq * 4 + hl; float v[8];
        if (cc < 64) { const int s = cc >> 1, hi0 = (cc & 1) * 8; const LAS f32x4* kp = (const LAS f32x4*)(KC + (hl * 64 + t - s + 31) * 16 + hi0); const f32x4 a = kp[0], c = kp[1];
            v[0] = a.x; v[1] = a.y; v[2] = a.z; v[3] = a.w; v[4] = c.x; v[5] = c.y; v[6] = c.z; v[7] = c.w;
        } else { const int kk = (cc - 64) * 8, dir = kk >> 7, reim = (kk >> 6) & 1, p0 = kk & 63, e = dir == 0 ? t + 1 : 32 - t;
#pragma unroll
            for (int j = 0; j < 8; ++j) { const int p = p0 + j; const float cr = CC[((dir * 4 + hl) * 64 + p) * 2], ci = CC[((dir * 4 + hl) * 64 + p) * 2 + 1], pr = POW[((dir * 33 + e) * 64 + p) * 2], pi = POW[((dir * 33 + e) * 64 + p) * 2 + 1];
                v[j] = reim == 0 ? (cr * pr - ci * pi) : -(cr * pi + ci * pr); } }
        v4u o; o.x = pk2(v[0], v[1]); o.y = pk2(v[2], v[3]); o.z = pk2(v[4], v[5]); o.w = pk2(v[6], v[7]);
        *(GAS v4u*)(MEXT + ((size_t)g * 512 + t * 16 + ho) * UGP + cc * 8) = o; }
    __syncthreads();
}
__device__ __forceinline__ TItem titem_decode(int it, const float* w_in, const float* w_glu, const float* w_ab, const float* w_sb, const float* w_o, const float* w_g, const float* w_u, const float* w_d, unsigned char* ws) {
    constexpr int I_IN = 16 * 104, I_GLU = 8 * 16, I_BR = 8 * 32, I_O = 16 * 32, I_E = 16 * 32;
    TItem t; int r = it;
          if (r < I_IN) { const int kb = r / 104, nb = r % 104; t.src = w_in + (size_t)(64 * kb) * INW + 32 * nb; t.N = INW; t.K = 1024; t.dst = (bf16*)(ws + WS_WIN) + (size_t)(32 * nb) * 1024 + 64 * kb; return t; } r -= I_IN;
          if (r < I_GLU) { const int kb = r / 16, nb = r % 16; t.src = w_glu + (size_t)(64 * kb) * 512 + 32 * nb; t.N = 512; t.K = 512; t.dst = (bf16*)(ws + WS_WGLU) + (size_t)(32 * nb) * 512 + 64 * kb; return t; } r -= I_GLU;
          if (r < I_BR) { const int kb = r / 32, nb = r % 32; t.src = w_ab + (size_t)(64 * kb) * 1024 + 32 * nb; t.N = 1024; t.K = 512; t.dst = (bf16*)(ws + WS_WAB) + (size_t)(32 * nb) * 512 + 64 * kb; return t; } r -= I_BR;
          if (r < I_BR) { const int kb = r / 32, nb = r % 32; t.src = w_sb + (size_t)(64 * kb) * 1024 + 32 * nb; t.N = 1024; t.K = 512; t.dst = (bf16*)(ws + WS_WSB) + (size_t)(32 * nb) * 512 + 64 * kb; return t; } r -= I_BR;
          if (r < I_O) { const int kb = r / 32, nb = r % 32; t.src = w_o + (size_t)(64 * kb) * 1024 + 32 * nb; t.N = 1024; t.K = 1024; t.dst = (bf16*)(ws + WS_WO) + (size_t)(32 * nb) * 1024 + 64 * kb; return t; } r -= I_O;
          const int e = r / (3 * I_E), which = (r / I_E) % 3, q = r % I_E, kb = q / 32, nb = q % 32, n0 = 32 * nb;
          const float* W = (which == 0 ? w_g : which == 1 ? w_u : w_d) + (size_t)e * 1024 * 1024;
          t.src = W + (size_t)(64 * kb) * 1024 + n0; t.N = 1024; t.K = 1024;
          const int drow0 = which < 2 ? e * 2048 + (n0 >> 7) * 256 + which * 128 + (n0 & 127) : e * 1024 + n0;
          t.dst = (bf16*)(ws + (which < 2 ? WS_WGU : WS_WD)) + (size_t)drow0 * 1024 + 64 * kb; return t; }
__device__ __forceinline__ void bg_convert(Frame& F, int done_word, unsigned n_main) {
    LAS float* scr = (LAS float*)(F.lds + RING_OFF + F.wave * 16384);
    volatile LAS unsigned* bc = F.MISC + 16;
    for (;;) {
        __syncthreads();
        if (F.tid == 0) { unsigned base = 0xffffffffu;
            const bool stop = n_main != 0u && __hip_atomic_load(F.ctl + done_word, RLX_AGENT) >= n_main;
            if (!stop) base = __hip_atomic_fetch_add(F.ctl + CW_Q, 8u, RLX_AGENT);
            bc[0] = base; }
        __syncthreads();
        const unsigned base = bc[0];
        if (base >= (unsigned)N_EXP_ITEMS) break;
        const TItem t = titem_decode(N_DENSE_ITEMS + (int)base + F.wave, F.in[4], F.in[15], F.in[17], F.in[18], F.in[19], F.in[23], F.in[24], F.in[25], F.ws);
        f32x4 v[8]; titem_load(t, v, F.lane); titem_store(t, v, scr, F.lane);
    }
}
__device__ __forceinline__ void bg_work(Frame& F, int done_word, unsigned n_main) {
    volatile LAS unsigned* bc = F.MISC + 17;
    for (;;) {
        __syncthreads();
        if (F.tid == 0) bc[0] = __hip_atomic_fetch_add(F.ctl + CW_QM, 1u, RLX_AGENT);
        __syncthreads();
        const unsigned it = bc[0];
        if (it >= 128u) break;
        mext_item(F, (int)it);
    }
    bg_convert(F, done_word, n_main);
}
__device__ __forceinline__ void main_done(Frame& F, int done_word) { __syncthreads(); if (F.tid == 0) __hip_atomic_fetch_add(F.ctl + done_word, 1u, RLX_AGENT); }
__device__ __forceinline__ void p0_prologue(Frame& F) {
    const int gw = F.vcu * NWAVES + F.wave, NGW = F.G * NWAVES, lane = F.lane, tid = F.tid;
    unsigned char* ws = F.ws;
    LAS float* scr = (LAS float*)(F.lds + RING_OFF + F.wave * 16384);
    { bf16* WST = (bf16*)(ws + WS_WST);
      for (int it = gw; it < NG * 256; it += NGW) { const int g = it >> 8, n = it & 255, dir = n >> 7, reim = (n >> 6) & 1, p = n & 63; float lr, li, cr, ci; ssm_par(F, dir * 32 + g, p, lr, li, cr, ci);
          const int t = lane >> 1, h0 = (lane & 1) * 8; float pr, pi; cpow(lr, li, (float)(dir == 0 ? 31 - t : t), pr, pi);
          const float er = pr * cr - pi * ci, ei = pr * ci + pi * cr; const size_t o = ((size_t)(dir * 32 + g) * 64 + p) * 16 + h0; float v[8];
#pragma unroll
          for (int j = 0; j < 8; ++j) { const float br = F.in[10][o + j], bi = F.in[11][o + j]; v[j] = reim == 0 ? (er * br - ei * bi) : (er * bi + ei * br); }
          v4u w; w.x = pk2(v[0], v[1]); w.y = pk2(v[2], v[3]); w.z = pk2(v[4], v[5]); w.w = pk2(v[6], v[7]);
          *(GAS v4u*)(WST + ((size_t)g * 256 + n) * 512 + lane * 8) = w; } }
    { constexpr int NIT = N_DENSE_ITEMS;
      f32x4 va[8], vb[8]; TItem ta, tb;
      int it = gw;
      if (it < NIT) { ta = titem_decode(it, F.in[4], F.in[15], F.in[17], F.in[18], F.in[19], F.in[23], F.in[24], F.in[25], ws); titem_load(ta, va, lane); }
      while (it < NIT) {
          const int i1 = it + NGW; if (i1 < NIT) { tb = titem_decode(i1, F.in[4], F.in[15], F.in[17], F.in[18], F.in[19], F.in[23], F.in[24], F.in[25], ws); titem_load(tb, vb, lane); }
          titem_store(ta, va, scr, lane);
          if (i1 >= NIT) break;
          const int i2 = i1 + NGW; if (i2 < NIT) { ta = titem_decode(i2, F.in[4], F.in[15], F.in[17], F.in[18], F.in[19], F.in[23], F.in[24], F.in[25], ws); titem_load(ta, va, lane); }
          titem_store(tb, vb, scr, lane);
          it = i2;
      } }
    { bf16* XN = (bf16*)(ws + WS_XN); f32x2_t2* ST = (f32x2_t2*)(ws + WS_STATS0);
      for (int r = gw; r < M + NMETA; r += NGW) { const float* src = r < M ? F.in[0] + (size_t)r * DM : F.in[1] + (size_t)(r - M) * DM;
          const GAS f32x4* xr = (const GAS f32x4*)src + lane; f32x4 v[4]; float s = 0.f;
#pragma unroll
          for (int j = 0; j < 4; ++j) { v[j] = xr[64 * j]; s += (v[j].x + v[j].y) + (v[j].z + v[j].w); }
          const float mean = wave_sum(s) * (1.f / DM); float s2 = 0.f;
#pragma unroll
          for (int j = 0; j < 4; ++j) { v[j] = v[j] - mean; s2 += (v[j].x * v[j].x + v[j].y * v[j].y) + (v[j].z * v[j].z + v[j].w * v[j].w); }
          const float rstd = 1.f / sqrtf(wave_sum(s2) * (1.f / DM) + LN_EPS);
          if (r < M && lane == 0) ST[r] = (f32x2_t2){mean, rstd};
          GAS unsigned long long* o8 = (GAS unsigned long long*)(XN + (size_t)r * DM) + lane;
#pragma unroll
          for (int j = 0; j < 4; ++j) { const f32x4 gg = ((const GAS f32x4*)F.in[2])[lane + 64 * j], bb = ((const GAS f32x4*)F.in[3])[lane + 64 * j]; const f32x4 o = v[j] * rstd * gg + bb;
              o8[64 * j] = (unsigned long long)pk2(o.x, o.y) | ((unsigned long long)pk2(o.z, o.w) << 32); } } }
    { const int gt = F.vcu * (NWAVES * 64) + tid, NT_ = F.G * NWAVES * 64;
      for (int i = gt; i < 2 * 2 * 112 * 16; i += NT_) { const int arr = i / (2 * 112 * 16), b = (i / (112 * 16)) & 1, q = i % (112 * 16);
          *(GAS v4u*)((bf16*)(ws + (arr ? WS_V : WS_K)) + ((size_t)b * KVROWS + KVALID) * 128 + q * 8) = (v4u){0u, 0u, 0u, 0u}; }
      float* RP = (float*)(ws + WS_ROPE);
      for (int i = gt; i < 3072; i += NT_) { const bool isr = i < 2048; const int q = isr ? i : i - 2048, pos = q >> 4, j = q & 15; const float ang = (float)pos * powf(10000.f, -(float)j / 16.f);
          float sn, cs; sincosf(ang, &sn, &cs); if (isr) { RP[q] = cs; RP[2048 + q] = sn; } else { RP[4096 + q] = cs; RP[5120 + q] = sn; } }
      for (int i = gt; i < 128; i += NT_) RP[6144 + i] = i < 64 ? F.in[5][i] : F.in[6][i - 64]; }
}

__device__ __forceinline__ void qk_prep(Frame& F) {
    const int gw = F.vcu * NWAVES + F.wave, NGW = F.G * NWAVES, lane = F.lane;
    bf16* Q = (bf16*)(F.ws + WS_Q); bf16* K = (bf16*)(F.ws + WS_K); const float* RP = (const float*)(F.ws + WS_ROPE);
    constexpr int NQ = M * 8, NK = 2 * KVALID * 2;
    for (int it = gw; it < NQ + NK; it += NGW) {
        bf16* p; int pos; float gsc, osc;
        if (it < NQ) { const int row = it >> 3, h = it & 7; p = Q + (size_t)row * 512 + h * 64; pos = row & 8191; gsc = F.in[5][lane]; osc = C2Q; }
        else { const int r = it - NQ, b = r / (KVALID * 2), q = r % (KVALID * 2), l = q >> 1, kvh = q & 1; p = K + ((size_t)b * KVROWS + l) * 128 + kvh * 64; pos = l - NMETA; gsc = F.in[6][lane]; osc = 1.f; }
        const float x = bf2f(p[lane]);
        const float ss = wave_sum(x * x) * (1.f / 64.f);
        const float y = x * rsqrtf(ss + QK_EPS) * gsc, yo = __shfl_xor(y, 1);
        float cs = 1.f, sn = 0.f;
        if (pos >= 0) { const int j = lane >> 1; if (j < 16) { cs = RP[(pos >> 6) * 16 + j]; sn = RP[2048 + (pos >> 6) * 16 + j]; } else { cs = RP[4096 + (pos & 63) * 16 + j - 16]; sn = RP[5120 + (pos & 63) * 16 + j - 16]; } }
        const float o = ((lane & 1) ? (yo * sn + y * cs) : (y * cs - yo * sn)) * osc;
        p[lane] = (bf16)f2bf(o);
    }
}

__device__ __forceinline__ void ssm_scan(Frame& F) {
    if (F.wave != 0 || blockIdx.x >= 128) return;
    const int it = blockIdx.x, b = it >> 6, g = (it >> 1) & 31, dir = it & 1, p = F.lane;
    float lr, li, cr, ci; ssm_par(F, dir * 32 + g, p, lr, li, cr, ci);
    float a32r, a32i; cpow(lr, li, 32.f, a32r, a32i);
    const float* S = (const float*)(F.ws + WS_S) + (size_t)(g * 2 + b) * 256 * 256 + dir * 128 + p;
    bf16* U = (bf16*)(F.ws + WS_UG2) + (size_t)(g * 2 + b) * 256 * UGP + 512 + dir * 128 + p;
    float sr = 0.f, si = 0.f;
    if (dir == 0) {
        float a1r, a1i; cpow(lr, li, 1.f, a1r, a1i);
        const bf16* um = (const bf16*)(F.ws + WS_UMETA) + (size_t)g * 256; const size_t o = ((size_t)g * 64 + p) * 16;
        float bbr[16], bbi[16];
#pragma unroll
        for (int h = 0; h < 16; ++h) { const float br = F.in[10][o + h], bi = F.in[11][o + h]; bbr[h] = cr * br - ci * bi; bbi[h] = cr * bi + ci * br; }
        for (int t = 0; t < 16; ++t) { float bur = 0.f, bui = 0.f;
#pragma unroll
            for (int h = 0; h < 16; ++h) { const float uv = bf2f(um[t * 16 + h]); bur = fmaf(bbr[h], uv, bur); bui = fmaf(bbi[h], uv, bui); }
            const float nr = a1r * sr - a1i * si + bur, ni = a1r * si + a1i * sr + bui; sr = nr; si = ni; }
    }
    for (int c0 = 0; c0 < 256; c0 += 32) {
        float vr[32], vi[32];
#pragma unroll
        for (int k = 0; k < 32; ++k) { const int c = dir == 0 ? c0 + k : 255 - (c0 + k); vr[k] = S[(size_t)c * 256]; vi[k] = S[(size_t)c * 256 + 64]; }
#pragma unroll
        for (int k = 0; k < 32; ++k) { const int c = dir == 0 ? c0 + k : 255 - (c0 + k);
            U[(size_t)c * UGP] = (bf16)f2bf(sr); U[(size_t)c * UGP + 64] = (bf16)f2bf(si);
            const float nr = a32r * sr - a32i * si + vr[k], ni = a32r * si + a32i * sr + vi[k]; sr = nr; si = ni; }
    }
}

__device__ __forceinline__ float treduce16(const float (&v)[16], int lane) {
    float r8[8], r4[4], r2[2], r1;
    { const bool up = lane & 32;
#pragma unroll
      for (int i = 0; i < 8; ++i) { const float keep = up ? v[i + 8] : v[i], send = up ? v[i] : v[i + 8]; r8[i] = keep + __shfl_xor(send, 32); } }
    { const bool up = lane & 16;
#pragma unroll
      for (int i = 0; i < 4; ++i) { const float keep = up ? r8[i + 4] : r8[i], send = up ? r8[i] : r8[i + 4]; r4[i] = keep + __shfl_xor(send, 16); } }
    { const bool up = lane & 8;
#pragma unroll
      for (int i = 0; i < 2; ++i) { const float keep = up ? r4[i + 2] : r4[i], send = up ? r4[i] : r4[i + 2]; r2[i] = keep + __shfl_xor(send, 8); } }
    { const bool up = lane & 4; const float keep = up ? r2[1] : r2[0], send = up ? r2[0] : r2[1]; r1 = keep + __shfl_xor(send, 4); }
    r1 += __shfl_xor(r1, 2); r1 += __shfl_xor(r1, 1);
    return r1;
}
__device__ __forceinline__ void ln1_router(Frame& F) {
    const int gw = F.vcu * NWAVES + F.wave, NGW = F.G * NWAVES, lane = F.lane;
    LAS float* WRT = (LAS float*)(F.lds + RING_OFF);
    for (int i = F.tid; i < 16 * 1024; i += NWAVES * 64) { const int d = i >> 4, e = i & 15; WRT[e * 1024 + d] = F.in[22][i]; }
    __syncthreads();
    const float* PRE = F.out; bf16* H1 = (bf16*)(F.ws + WS_H1); f32x2_t2* ST = (f32x2_t2*)(F.ws + WS_STATS1); float* AFF = (float*)(F.ws + WS_AFF);
    f32x4 nx[4];
    if (gw < M) { const GAS f32x4* xr0 = (const GAS f32x4*)(PRE + (size_t)gw * DM) + lane;
#pragma unroll
        for (int j = 0; j < 4; ++j) nx[j] = xr0[64 * j]; }
    for (int r = gw; r < M; r += NGW) {
        f32x4 v[4]; float s = 0.f;
#pragma unroll
        for (int j = 0; j < 4; ++j) { v[j] = nx[j]; s += (v[j].x + v[j].y) + (v[j].z + v[j].w); }
        if (r + NGW < M) { const GAS f32x4* xr1 = (const GAS f32x4*)(PRE + (size_t)(r + NGW) * DM) + lane;
#pragma unroll
            for (int j = 0; j < 4; ++j) nx[j] = xr1[64 * j]; }
        const float mean = wave_sum(s) * (1.f / DM); float s2 = 0.f;
#pragma unroll
        for (int j = 0; j < 4; ++j) { v[j] = v[j] - mean; s2 += (v[j].x * v[j].x + v[j].y * v[j].y) + (v[j].z * v[j].z + v[j].w * v[j].w); }
        const float rstd = 1.f / sqrtf(wave_sum(s2) * (1.f / DM) + LN_EPS);
        if (lane == 0) ST[r] = (f32x2_t2){mean, rstd};
        GAS unsigned long long* o8 = (GAS unsigned long long*)(H1 + (size_t)r * DM) + lane;
#pragma unroll
        for (int j = 0; j < 4; ++j) { const f32x4 gg = ((const GAS f32x4*)F.in[20])[lane + 64 * j], bb = ((const GAS f32x4*)F.in[21])[lane + 64 * j]; v[j] = v[j] * rstd * gg + bb;
            o8[64 * j] = (unsigned long long)pk2(v[j].x, v[j].y) | ((unsigned long long)pk2(v[j].z, v[j].w) << 32); }
        float acc[16];
        asm volatile("" ::: "memory");
#pragma unroll
        for (int e = 0; e < 16; ++e) { float a = 0.f;
#pragma unroll
            for (int j = 0; j < 4; ++j) { const f32x4 w = *(const LAS f32x4*)(WRT + e * 1024 + (lane + 64 * j) * 4); a += (v[j].x * w.x + v[j].y * w.y) + (v[j].z * w.z + v[j].w * w.w); }
            acc[e] = a; }
        const float lg = treduce16(acc, lane);
        float mx = lg;
#pragma unroll
        for (int o = 4; o < 64; o <<= 1) mx = fmaxf(mx, __shfl_xor(mx, o));
        const float ex = expf(lg - mx); float sm = ex;
#pragma unroll
        for (int o = 4; o < 64; o <<= 1) sm += __shfl_xor(sm, o);
        if ((lane & 3) == 0) AFF[((size_t)(r >> 13) * NE + (lane >> 2)) * SEQ + (r & 8191)] = ex / sm;
    }
}

__device__ __forceinline__ void topk_phase(Frame& F) {
    if (blockIdx.x >= BATCH * NE) return;
    const int be = blockIdx.x, b = be >> 4, e = be & 15, t = F.tid, lane = F.lane, w = F.wave;
    LAS int* red = (LAS int*)(F.lds + RING_OFF); LAS int* sc_gt = red + 64; LAS int* sc_eq = sc_gt + 16;
    const float* a = (const float*)(F.ws + WS_AFF) + (size_t)be * SEQ;
    unsigned v[16];
#pragma unroll
    for (int i = 0; i < 16; ++i) v[i] = __float_as_uint(a[t * 16 + i]);
    unsigned thr = 0u;
    for (int step = 0; step < 16; ++step) {
        const int shift = step == 0 ? 30 : 30 - 2 * step; const int nk = step == 0 ? 1 : 3;
        int c1 = 0, c2 = 0, c3 = 0;
        const unsigned t1 = thr | (1u << shift), t2 = thr | (2u << shift), t3 = thr | (3u << shift);
#pragma unroll
        for (int i = 0; i < 16; ++i) { c1 += (v[i] >= t1) ? 1 : 0; if (nk == 3) { c2 += (v[i] >= t2) ? 1 : 0; c3 += (v[i] >= t3) ? 1 : 0; } }
#pragma unroll
        for (int o = 32; o > 0; o >>= 1) { c1 += __shfl_xor(c1, o); c2 += __shfl_xor(c2, o); c3 += __shfl_xor(c3, o); }
        LAS int* rb = red + (step & 1) * 32;
        if (lane == 0) { rb[w * 4] = c1; rb[w * 4 + 1] = c2; rb[w * 4 + 2] = c3; }
        __syncthreads();
        int s1 = 0, s2 = 0, s3 = 0;
#pragma unroll
        for (int k = 0; k < 8; ++k) { s1 += rb[k * 4]; s2 += rb[k * 4 + 1]; s3 += rb[k * 4 + 2]; }
        if (nk == 3 && s3 >= CAP) thr = t3; else if (nk == 3 && s2 >= CAP) thr = t2; else if (s1 >= CAP) thr = t1;
    }
    int ngt = 0, neq = 0;
#pragma unroll
    for (int i = 0; i < 16; ++i) { ngt += (v[i] > thr) ? 1 : 0; neq += (v[i] == thr) ? 1 : 0; }
    int ig = ngt, ie = neq;
#pragma unroll
    for (int o = 1; o < 64; o <<= 1) { const int pg = __shfl_up(ig, o), pe = __shfl_up(ie, o); if (lane >= o) { ig += pg; ie += pe; } }
    __syncthreads();
    if (lane == 63) { sc_gt[w] = ig; sc_eq[w] = ie; }
    __syncthreads();
    int wg_off = 0, we_off = 0, tot_gt = 0;
#pragma unroll
    for (int k = 0; k < 8; ++k) { const int a = sc_gt[k], c2 = sc_eq[k]; if (k < w) { wg_off += a; we_off += c2; } tot_gt += a; }
    const int quota = CAP - tot_gt; int gpre = wg_off + ig - ngt, epre = we_off + ie - neq;
    int* IDX2 = (int*)(F.ws + WS_IDX2); float* GATE2 = (float*)(F.ws + WS_GATE2); int* SLOTOF = (int*)(F.ws + WS_SLOTOF);
#pragma unroll
    for (int i = 0; i < 16; ++i) {
        const bool gt = v[i] > thr, eq = v[i] == thr, sel = gt || (eq && epre < quota);
        const int tok = t * 16 + i; int so = -1;
        if (sel) { const int slot = gpre + (epre < quota ? epre : quota); so = e * 2048 + b * 1024 + slot; IDX2[so] = b * SEQ + tok; GATE2[so] = __uint_as_float(v[i]); }
        SLOTOF[((size_t)b * SEQ + tok) * NE + e] = so;
        gpre += gt ? 1 : 0; epre += eq ? 1 : 0;
    }
    __syncthreads();
}

__device__ __forceinline__ void gather_phase(Frame& F) {
    const int gw = F.vcu * NWAVES + F.wave, NGW = F.G * NWAVES, lane = F.lane;
    const int* IDX2 = (const int*)(F.ws + WS_IDX2); const bf16* H1 = (const bf16*)(F.ws + WS_H1); bf16* XE = (bf16*)(F.ws + WS_XE);
    for (int r = gw; r < NE * 2048; r += NGW) { const int src = IDX2[r];
        const GAS v4u* s = (const GAS v4u*)(H1 + (size_t)src * DM) + lane; GAS v4u* d = (GAS v4u*)(XE + (size_t)r * DM) + lane;
        const v4u a = s[0], c = s[64]; d[0] = a; d[64] = c; }
}

__device__ __forceinline__ void final_phase(Frame& F) {
    const int gw = F.vcu * NWAVES + F.wave, NGW = F.G * NWAVES, lane = F.lane;
    float* OUT = F.out; const f32x2_t2* ST = (const f32x2_t2*)(F.ws + WS_STATS1); const int* SLOTOF = (const int*)(F.ws + WS_SLOTOF); const bf16* YE = (const bf16*)(F.ws + WS_XE);
    f32x4 nx[4]; int nslot = -1; f32x2_t2 nst = (f32x2_t2){0.f, 0.f};
    if (gw < M) { const GAS f32x4* xr0 = (const GAS f32x4*)(OUT + (size_t)gw * DM) + lane;
#pragma unroll
        for (int j = 0; j < 4; ++j) nx[j] = xr0[64 * j];
        nslot = SLOTOF[(size_t)gw * NE + (lane & 15)]; nst = ST[gw]; }
    for (int r = gw; r < M; r += NGW) {
        GAS f32x4* xr = (GAS f32x4*)(OUT + (size_t)r * DM) + lane; f32x4 v[4]; const f32x2_t2 st = nst; const int myslot = nslot;
#pragma unroll
        for (int j = 0; j < 4; ++j) v[j] = nx[j];
        if (r + NGW < M) { const GAS f32x4* xr1 = (const GAS f32x4*)(OUT + (size_t)(r + NGW) * DM) + lane;
#pragma unroll
            for (int j = 0; j < 4; ++j) nx[j] = xr1[64 * j];
            nslot = SLOTOF[(size_t)(r + NGW) * NE + (lane & 15)]; nst = ST[r + NGW]; }
#pragma unroll
        for (int j = 0; j < 4; ++j) { const f32x4 gg = ((const GAS f32x4*)F.in[20])[lane + 64 * j], bb = ((const GAS f32x4*)F.in[21])[lane + 64 * j]; v[j] = ((v[j] - st.x) * st.y * gg + bb) * ALPHA; }
        unsigned long long msk = __ballot(myslot >= 0) & 0xffffull;
        while (msk) {
            const int e0 = __builtin_ctzll(msk); msk &= msk - 1; const int sl0 = __shfl(myslot, e0);
            int sl1 = -1; if (msk) { const int e1 = __builtin_ctzll(msk); msk &= msk - 1; sl1 = __shfl(myslot, e1); }
            const GAS u32x2_t* y0 = (const GAS u32x2_t*)(YE + (size_t)sl0 * DM) + lane; const GAS u32x2_t* y1 = (const GAS u32x2_t*)(YE + (size_t)(sl1 >= 0 ? sl1 : sl0) * DM) + lane;
            u32x2_t a[4], c[4];
#pragma unroll
            for (int j = 0; j < 4; ++j) { a[j] = y0[64 * j]; c[j] = y1[64 * j]; }
            const float w1 = sl1 >= 0 ? 1.f : 0.f;
#pragma unroll
            for (int j = 0; j < 4; ++j) { v[j].x += bflo(a[j].x) + w1 * bflo(c[j].x); v[j].y += bfhi(a[j].x) + w1 * bfhi(c[j].x); v[j].z += bflo(a[j].y) + w1 * bflo(c[j].y); v[j].w += bfhi(a[j].y) + w1 * bfhi(c[j].y); }
        }
        float s = 0.f;
#pragma unroll
        for (int j = 0; j < 4; ++j) s += (v[j].x + v[j].y) + (v[j].z + v[j].w);
        const float mean = wave_sum(s) * (1.f / DM); float s2 = 0.f;
#pragma unroll
        for (int j = 0; j < 4; ++j) { v[j] = v[j] - mean; s2 += (v[j].x * v[j].x + v[j].y * v[j].y) + (v[j].z * v[j].z + v[j].w * v[j].w); }
        const float rstd = 1.f / sqrtf(wave_sum(s2) * (1.f / DM) + LN_EPS);
#pragma unroll
        for (int j = 0; j < 4; ++j) { const f32x4 gg = ((const GAS f32x4*)F.in[26])[lane + 64 * j], bb = ((const GAS f32x4*)F.in[27])[lane + 64 * j]; xr[64 * j] = v[j] * rstd * gg + bb; }
    }
}

#ifndef MK_PER_PHASE
#define MK_PER_PHASE 0
#endif
constexpr int N_PHASES = 16;
struct Args { const float* in[28]; float* out; unsigned char* ws; int ph_lo, ph_hi; };
__global__ void __launch_bounds__(NWAVES * 64, 2) mk_fwd(Args args) {
    extern __shared__ __attribute__((aligned(16))) unsigned char lds[];
    Frame F;
    F.lds = (LAS unsigned char*)lds; F.MISC = (volatile LAS unsigned*)(F.lds + MISC_OFF);
    F.tid = threadIdx.x; F.lane = F.tid & 63; F.wave = __builtin_amdgcn_readfirstlane(F.tid >> 6);
    F.G = gridDim.x; { const int bx = blockIdx.x; F.vcu = (F.G % 8 == 0) ? (bx % 8) * (F.G / 8) + bx / 8 : bx; }
    F.ws = args.ws; F.ctl = (gu32*)(args.ws + WS_CTL); F.out = args.out;
#pragma unroll
    for (int i = 0; i < 28; ++i) F.in[i] = args.in[i];
    for (int u = F.tid; u < (LDS_BYTES - LDSCTL_OFF) / 4; u += NWAVES * 64) ((LAS unsigned*)(F.lds + LDSCTL_OFF))[u] = 0u;
    __syncthreads();
    XcdBarrier bar; bar.bar = (unsigned*)(F.ctl + CW_BAR); bar.x = 0; bar.st = nullptr;
    if (!MK_PER_PHASE) bar = xcd_barrier_post((unsigned*)(F.ctl + CW_BAR), F.MISC + 8);
    const int lo = args.ph_lo, hi = args.ph_hi;
    unsigned char* ws = args.ws;
#ifndef PROBE_LO
#define PROBE_LO -1
#define PROBE_HI -1
#endif
    unsigned long long pr_t0 = 0ull, pr_t1 = 0ull;
#define IN(k) (lo <= (k) && (k) < hi)
#define SEAM(k) do { if (IN(k) && IN((k) + 1)) xcd_barrier(bar); if (PROBE_LO >= 0 && (k) + 1 == PROBE_LO) pr_t0 = rt(); if (PROBE_LO >= 0 && (k) + 1 == PROBE_HI) pr_t1 = rt(); } while (0)
    if (PROBE_LO == 0) pr_t0 = rt();
    using pg8::Gemm; using pg8::gemm_phase;
    if (IN(0)) { p0_prologue(F); } SEAM(0);
    if (IN(1)) { Gemm g{(const bf16*)(ws + WS_XN), (const bf16*)(ws + WS_WIN), 1024, 1024, 1024}; InProjOrder S; S.so.init(M, INW, F.G, (int)blockIdx.x);
        EpiInProj E{(bf16*)(ws + WS_Q), (bf16*)(ws + WS_K), (bf16*)(ws + WS_V), (bf16*)(ws + WS_UG2), (bf16*)args.out, (bf16*)(ws + WS_UMETA), (LAS float*)(F.lds + XCH_OFF), (const float*)(ws + WS_ROPE) + 6144, (const float*)(ws + WS_ROPE)};
        gemm_phase<EpiInProj, InProjOrder, true, true>(F.lds + RING_OFF, g, S, E);
        if ((long)3 * F.G + (long)blockIdx.x < 835) main_done(F, CW_DONE + 64 * 1); else bg_work(F, CW_DONE + 64 * 1, (unsigned)(835 - 3 * F.G)); } SEAM(1);
    if (IN(2)) {
        Gemm g{(const bf16*)(ws + WS_UG2), (const bf16*)(ws + WS_WST), UGP, 512, 512}; SsmStateOrder S{F.G, (int)blockIdx.x}; EpiSsmState E{(float*)(ws + WS_S)};
        gemm_phase<EpiSsmState, SsmStateOrder, true, true>(F.lds + RING_OFF, g, S, E);
        if (blockIdx.x < 64) main_done(F, CW_DONE + 64 * 2); else bg_work(F, CW_DONE + 64 * 2, 64u); } SEAM(2);
    if (IN(3)) { ssm_scan(F); __syncthreads();
        const attn_body::AttnTensors AT{(const attn_body::bf16*)(ws + WS_Q), (const attn_body::bf16*)(ws + WS_K), (const attn_body::bf16*)(ws + WS_V), (attn_body::bf16*)(ws + WS_Q)};
        const attn_body::StaticOrder S((int)F.G, (int)blockIdx.x);
        attn_body::attn_phase<attn_body::StaticOrder>((char*)lds + RING_OFF, AT, S); } SEAM(3);
    if (IN(4)) { Gemm g{(const bf16*)(ws + WS_UG2), (const bf16*)(ws + WS_MEXT), UGP, UGP, UGP}; SsmYOrder S{F.G, (int)blockIdx.x}; EpiSsmY E{(bf16*)(ws + WS_YG)};
        gemm_phase<EpiSsmY, SsmYOrder, true, true>(F.lds + RING_OFF, g, S, E);
        if (blockIdx.x < 128) main_done(F, CW_DONE + 64 * 4); else bg_convert(F, CW_DONE + 64 * 4, 128u); } SEAM(4);
    if (IN(5)) { Gemm g{(const bf16*)(ws + WS_YG), (const bf16*)(ws + WS_WGLU), 512, 512, 512}; pg8::StaticOrder S; S.init(M, 512, F.G, (int)blockIdx.x); EpiGlu E{(const bf16*)(ws + WS_YG), F.in[16], (bf16*)(ws + WS_Z)};
        gemm_phase<EpiGlu, pg8::StaticOrder, true, true>(F.lds + RING_OFF, g, S, E);
        if (blockIdx.x < 128) main_done(F, CW_DONE + 64 * 5); else bg_convert(F, CW_DONE + 64 * 5, 128u); } SEAM(5);
    if (IN(6)) { Gemm g{(const bf16*)(ws + WS_Q), (const bf16*)(ws + WS_WAB), 512, 512, 512}; pg8::StaticOrder S; S.init(M, 1024, F.G, (int)blockIdx.x); EpiBranch<0> E{(const bf16*)args.out, nullptr, (bf16*)(ws + WS_T1)};
        gemm_phase<EpiBranch<0>, pg8::StaticOrder, true, true>(F.lds + RING_OFF, g, S, E); } SEAM(6);
    if (IN(7)) { Gemm g{(const bf16*)(ws + WS_Z), (const bf16*)(ws + WS_WSB), 512, 512, 512}; pg8::StaticOrder S; S.init(M, 1024, F.G, (int)blockIdx.x); EpiBranch<1> E{(const bf16*)args.out, (const bf16*)(ws + WS_T1), (bf16*)(ws + WS_MERGED)};
        gemm_phase<EpiBranch<1>, pg8::StaticOrder, true, true>(F.lds + RING_OFF, g, S, E); } SEAM(7);
    if (IN(8)) { Gemm g{(const bf16*)(ws + WS_MERGED), (const bf16*)(ws + WS_WO), 1024, 1024, 1024}; pg8::StaticOrder S; S.init(M, 1024, F.G, (int)blockIdx.x);
        EpiPre1 E{F.in[0], F.in[2], F.in[3], (const f32x2_t2*)(ws + WS_STATS0), args.out};
        gemm_phase<EpiPre1, pg8::StaticOrder, true, true>(F.lds + RING_OFF, g, S, E); } SEAM(8);
    if (IN(9)) { ln1_router(F); } SEAM(9);
    if (IN(10)) { topk_phase(F); if (blockIdx.x < BATCH * NE) main_done(F, CW_DONE + 64 * 10); else bg_convert(F, CW_DONE + 64 * 10, (unsigned)(BATCH * NE)); } SEAM(10);
    if (IN(11)) { gather_phase(F); bg_convert(F, 0, 0u); } SEAM(11);
    if (IN(12)) { Gemm g{(const bf16*)(ws + WS_XE), (const bf16*)(ws + WS_WGU), 1024, 1024, 1024}; MoeOrder S{F.G, (int)blockIdx.x, 8, 8}; EpiMoe1 E{(bf16*)(ws + WS_HB)};
        gemm_phase<EpiMoe1, MoeOrder, true, true>(F.lds + RING_OFF, g, S, E); } SEAM(12);
    if (IN(13)) { Gemm g{(const bf16*)(ws + WS_HB), (const bf16*)(ws + WS_WD), 1024, 1024, 1024}; MoeOrder S{F.G, (int)blockIdx.x, 8, 4}; EpiMoe2 E{(const float*)(ws + WS_GATE2), (bf16*)(ws + WS_XE)};
        gemm_phase<EpiMoe2, MoeOrder, true, true>(F.lds + RING_OFF, g, S, E); } SEAM(13);
    if (IN(14)) { final_phase(F); }
    if (PROBE_LO >= 0) { if (PROBE_HI == 15) pr_t1 = rt(); if (blockIdx.x == 0) { const unsigned long long span = (pr_t1 - pr_t0) * 8ull, ts = rt(); while (rt() - ts < span) __builtin_amdgcn_s_sleep(8); } }
#undef IN
#undef SEAM
}

extern "C" void kernel_launch(void* const* d_in, const int* in_sizes, int n_in, void* d_out, int out_size, void* d_ws, size_t ws_size, hipStream_t stream) {
    static int grid = 0;
    if (grid == 0) {
        int dev = 0, cus = 0;
        if (hipGetDevice(&dev) != hipSuccess || hipDeviceGetAttribute(&cus, hipDeviceAttributeMultiprocessorCount, dev) != hipSuccess) { fprintf(stderr, "kernel_launch: device query failed\n"); grid = -1; return; }
        if (hipFuncSetAttribute((const void*)mk_fwd, hipFuncAttributeMaxDynamicSharedMemorySize, LDS_BYTES) != hipSuccess) { fprintf(stderr, "kernel_launch: hipFuncSetAttribute failed\n"); grid = -1; return; }
        (void)hipGetLastError();
        grid = cus;
        if (grid != 256 || n_in != 28 || ws_size < WS_END) fprintf(stderr, "kernel_launch: unexpected geometry: %d CUs, %d inputs, %zu bytes of workspace\n", cus, n_in, ws_size);
    }
    if (grid < 0) return;
    (void)hipMemsetAsync((char*)d_ws + WS_CTL, 0, CTL_ZERO_BYTES, stream);
    Args a; memset(&a, 0, sizeof(a));
    for (int i = 0; i < 28; ++i) a.in[i] = (const float*)d_in[i];
    a.out = (float*)d_out; a.ws = (unsigned char*)d_ws;
#if MK_PER_PHASE
    for (int p = 0; p < N_PHASES - 1; ++p) { a.ph_lo = p; a.ph_hi = p + 1; hipLaunchKernelGGL(mk_fwd, dim3(grid), dim3(NWAVES * 64), LDS_BYTES, stream, a); }
#else
    a.ph_lo = 0; a.ph_hi = N_PHASES; hipLaunchKernelGGL(mk_fwd, dim3(grid), dim3(NWAVES * 64), LDS_BYTES, stream, a);
#endif
}
```

```cpp
#include <hip/hip_runtime.h>
#include <cstdio>
#include <cstdint>
#include <cstring>
namespace pg8 {
#define PG8_LAS __attribute__((address_space(3)))
typedef unsigned short bf16_t;
typedef short bf16x8 __attribute__((ext_vector_type(8)));
typedef float f32x4 __attribute__((ext_vector_type(4)));
typedef unsigned u32x4 __attribute__((ext_vector_type(4)));
constexpr int BM = 256, BK = 64, HALF = 128, HTB = HALF * BK * 2  , STAGE_BYTES = 8 * HTB, NXCD = 8, WGM = 8;

__host__ __device__ __forceinline__ int lds_byte(int r, int c) { const int st = (r >> 4) * 2 + (c >> 5), rr = r & 15, cc = c & 31, ob = rr * 64 + cc * 2; return st * 1024 + (ob ^ (((ob >> 9) & 1) << 5)); }
__host__ __device__ __forceinline__ void stage_rc(int b, int& R, int& C) { const int st = b / 1024, sb = b % 1024, swz = sb ^ (((sb >> 9) & 1) << 5); R = (st >> 1) * 16 + swz / 64; C = (st & 1) * 32 + (swz % 64) / 2; }
__host__ __device__ __forceinline__ int perm32(int rho) { const int n = rho >> 4, i = rho & 15; return 8 * (i >> 2) + 4 * n + (i & 3); }

struct Unit { int pm, pn; };
struct Gemm { const bf16_t* A; const bf16_t* Bt; int lda, ldb, K; };

struct StaticOrder {
    int nM, nN, nwg, G, c;
    __host__ __device__ void init(int M, int N, int G_, int c_) { nM = M / BM; nN = N / BM; nwg = nM * nN; G = G_; c = c_; }
    __host__ __device__ bool next(int i, Unit& u) const {
        const long L = (long)i * G + c; if (L >= nwg) return false;
        int wgid = (int)L; { const int q = nwg / NXCD, r = nwg % NXCD, xcd = wgid % NXCD, off = wgid / NXCD; wgid = (xcd < r ? xcd * (q + 1) : r * (q + 1) + (xcd - r) * q) + off; }
        const int nig = WGM * nN, gid = wgid / nig, fm = gid * WGM, gsz = (nM - fm) < WGM ? (nM - fm) : WGM;
        u.pm = fm + ((wgid % nig) % gsz); u.pn = (wgid % nig) / gsz; return true;
    }
    __device__ __forceinline__ void a_ready(const Unit&) const {}
    __device__ __forceinline__ void done(const Unit&) const {}
};

__device__ __forceinline__ unsigned cvt_pk_bf16(float lo, float hi) { unsigned r; asm volatile("v_cvt_pk_bf16_f32 %0, %1, %2" : "=v"(r) : "v"(lo), "v"(hi)); return r; }
typedef float f32x2 __attribute__((ext_vector_type(2)));
template <class Epi, class Sched, bool ALIGN_EPI = false, bool SP2 = false>
__device__ __forceinline__ void gemm_phase(PG8_LAS unsigned char* lds, const Gemm g, const Sched& S, const Epi& E) {
    const int tid = threadIdx.x, wid = __builtin_amdgcn_readfirstlane(tid >> 6), lane = tid & 63, wr = wid >> 2, wc = wid & 3, fr = lane & 15, fq = lane >> 4;
    const int K = g.K, nt = K / BK;
    unsigned voffA[2], voffB[2];
#pragma unroll
    for (int i = 0; i < 2; ++i) { int R, C; stage_rc(tid * 16 + i * 8192, R, C); const int Rb = Epi::PERM ? ((R & ~31) + perm32(R & 31)) : R;
        voffA[i] = (unsigned)(R * g.lda + C) * 2u; voffB[i] = (unsigned)(Rb * g.ldb + C) * 2u; }
    const size_t kstep = (size_t)(BK * 2);
    const size_t hstepA = (size_t)HALF * g.lda * 2, hstepB = (size_t)HALF * g.ldb * 2;
    const size_t tstepA = 2 * hstepA, tstepB = 2 * hstepB;
    const unsigned ldsw = (unsigned)wid * 1024u;
    const int aoff = lds_byte(wr * 64 + fr, fq * 8), boff = lds_byte(wc * 32 + fr, fq * 8);
#define PG8_SA(b, h) (((b) * 2 + (h)) * HTB)
#define PG8_SB(b, h) ((4 + (b) * 2 + (h)) * HTB)
#define PG8_STAGE(bufoff, gbase, voff) do { _Pragma("unroll") for (int _i = 0; _i < 2; ++_i) \
        __builtin_amdgcn_global_load_lds((const unsigned*)((const char*)(gbase) + (voff)[_i]), (PG8_LAS unsigned*)(lds + (bufoff) + ldsw + _i * 8192), 16, 0, 0); } while (0)
#define PG8_LDA(dst, b, h) do { _Pragma("unroll") for (int m = 0; m < 4; ++m) _Pragma("unroll") for (int k = 0; k < 2; ++k) dst[m][k] = *(const PG8_LAS bf16x8*)(lds + PG8_SA(b, h) + aoff + m * 2048 + k * 1024); } while (0)
#define PG8_LDB(dst, b, h) do { _Pragma("unroll") for (int n = 0; n < 2; ++n) _Pragma("unroll") for (int k = 0; k < 2; ++k) dst[n][k] = *(const PG8_LAS bf16x8*)(lds + PG8_SB(b, h) + boff + n * 2048 + k * 1024); } while (0)
#define PG8_MMA(ai, bj, At, Bt) do { __builtin_amdgcn_s_setprio(1); _Pragma("unroll") for (int m = 0; m < 4; ++m) _Pragma("unroll") for (int n = 0; n < 2; ++n) _Pragma("unroll") for (int k = 0; k < 2; ++k) \
        acc[ai][bj][m][n] = __builtin_amdgcn_mfma_f32_16x16x32_bf16(Bt[n][k], At[m][k], acc[ai][bj][m][n], 0, 0, 0); __builtin_amdgcn_s_setprio(0); } while (0)
#define PG8_WAIT_V(n) asm volatile("s_waitcnt vmcnt(" #n ")" ::: "memory")
#define PG8_WAIT_L(n) asm volatile("s_waitcnt lgkmcnt(" #n ")" ::: "memory")
#define PG8_BAR __builtin_amdgcn_s_barrier()
#define PG8_SCHED __builtin_amdgcn_sched_barrier(0)
    Unit cur, nxt; int ui = 0;
    if (!S.next(0, cur)) return;
    f32x4 acc[2][2][4][2];
#pragma unroll
    for (int a = 0; a < 2; ++a)
#pragma unroll
        for (int b = 0; b < 2; ++b)
#pragma unroll
            for (int m = 0; m < 4; ++m)
#pragma unroll
                for (int n = 0; n < 2; ++n) acc[a][b][m][n] = (f32x4){0.f, 0.f, 0.f, 0.f};
    bf16x8 At[4][2], B0[2][2], B1[2][2];
    const char* cA = (const char*)g.A + (size_t)cur.pm * tstepA; const char* cB = (const char*)g.Bt + (size_t)cur.pn * tstepB;
    S.a_ready(cur);
    if constexpr (SP2) {
        PG8_STAGE(PG8_SB(0, 0), cB, voffB); PG8_STAGE(PG8_SB(0, 1), cB + hstepB, voffB); PG8_STAGE(PG8_SA(0, 0), cA, voffA); PG8_STAGE(PG8_SA(0, 1), cA + hstepA, voffA);
        if (wr == 1) PG8_BAR;
        PG8_WAIT_V(2); PG8_BAR;
        PG8_STAGE(PG8_SB(1, 0), cB + kstep, voffB); PG8_STAGE(PG8_SA(1, 0), cA + kstep, voffA); PG8_STAGE(PG8_SB(1, 1), cB + hstepB + kstep, voffB);
        PG8_WAIT_V(6); PG8_BAR;
    } else {
        PG8_STAGE(PG8_SB(0, 0), cB, voffB); PG8_STAGE(PG8_SA(0, 0), cA, voffA); PG8_STAGE(PG8_SB(0, 1), cB + hstepB, voffB); PG8_STAGE(PG8_SA(0, 1), cA + hstepA, voffA);
        if (wr == 1) PG8_BAR;
        PG8_WAIT_V(4); PG8_BAR;
        PG8_STAGE(PG8_SB(1, 0), cB + kstep, voffB); PG8_STAGE(PG8_SA(1, 0), cA + kstep, voffA); PG8_STAGE(PG8_SB(1, 1), cB + hstepB + kstep, voffB);
        PG8_WAIT_V(6); PG8_BAR;
    }
    for (;;) {
        const bool has_next = S.next(ui + 1, nxt);
        const char* nA = has_next ? (const char*)g.A + (size_t)nxt.pm * tstepA : cA; const char* nB = has_next ? (const char*)g.Bt + (size_t)nxt.pn * tstepB : cB;
        for (int t = 0; t < nt; t += 2) {
            const bool last = (t == nt - 2);
            const char* a1 = cA + (size_t)(t + 1) * kstep;
            const char* a2 = last ? nA : cA + (size_t)(t + 2) * kstep; const char* b2 = last ? nB : cB + (size_t)(t + 2) * kstep;
            const char* a3 = a2 + kstep; const char* b3 = b2 + kstep;
            if (last && has_next) S.a_ready(nxt);
            if constexpr (SP2) {
            PG8_LDB(B0, 0, 0); PG8_LDB(B1, 0, 1); PG8_SCHED; PG8_LDA(At, 0, 0); PG8_STAGE(PG8_SA(1, 1), a1 + hstepA, voffA);
            PG8_WAIT_V(8); PG8_WAIT_L(0); PG8_BAR; PG8_MMA(0, 0, At, B0); PG8_MMA(0, 1, At, B1); PG8_BAR; PG8_SCHED;
            PG8_LDA(At, 0, 1); PG8_STAGE(PG8_SB(0, 0), b2, voffB); PG8_STAGE(PG8_SB(0, 1), b2 + hstepB, voffB); PG8_STAGE(PG8_SA(0, 0), a2, voffA);
            PG8_WAIT_V(8); PG8_WAIT_L(0); PG8_BAR; PG8_MMA(1, 0, At, B0); PG8_MMA(1, 1, At, B1); PG8_BAR; PG8_SCHED;
            PG8_LDB(B0, 1, 0); PG8_LDB(B1, 1, 1); PG8_SCHED; PG8_LDA(At, 1, 0); PG8_STAGE(PG8_SA(0, 1), a2 + hstepA, voffA);
            PG8_WAIT_V(8); PG8_WAIT_L(0); PG8_BAR; PG8_MMA(0, 0, At, B0); PG8_MMA(0, 1, At, B1); PG8_BAR; PG8_SCHED;
            PG8_LDA(At, 1, 1); PG8_STAGE(PG8_SB(1, 0), b3, voffB); PG8_STAGE(PG8_SB(1, 1), b3 + hstepB, voffB); PG8_STAGE(PG8_SA(1, 0), a3, voffA);
            PG8_WAIT_V(8); PG8_WAIT_L(0); PG8_BAR; PG8_MMA(1, 0, At, B0); PG8_MMA(1, 1, At, B1); PG8_BAR; PG8_SCHED;
            } else {
            PG8_LDB(B0, 0, 0); PG8_SCHED; PG8_LDA(At, 0, 0); PG8_STAGE(PG8_SA(1, 1), a1 + hstepA, voffA);
            PG8_WAIT_L(8); PG8_BAR; PG8_WAIT_L(0); PG8_MMA(0, 0, At, B0); PG8_BAR; PG8_SCHED;
            PG8_LDB(B1, 0, 1); PG8_STAGE(PG8_SB(0, 0), b2, voffB);
            PG8_BAR; PG8_WAIT_L(0); PG8_MMA(0, 1, At, B1); PG8_BAR;
            PG8_LDA(At, 0, 1); PG8_STAGE(PG8_SA(0, 0), a2, voffA);
            PG8_BAR; PG8_WAIT_L(0); PG8_MMA(1, 0, At, B0); PG8_BAR; PG8_SCHED;
            PG8_STAGE(PG8_SB(0, 1), b2 + hstepB, voffB);
            PG8_WAIT_V(6); PG8_BAR; PG8_MMA(1, 1, At, B1); PG8_BAR;
            PG8_LDB(B0, 1, 0); PG8_SCHED; PG8_LDA(At, 1, 0); PG8_STAGE(PG8_SA(0, 1), a2 + hstepA, voffA);
            PG8_WAIT_L(8); PG8_BAR; PG8_WAIT_L(0); PG8_MMA(0, 0, At, B0); PG8_BAR; PG8_SCHED;
            PG8_LDB(B1, 1, 1); PG8_STAGE(PG8_SB(1, 0), b3, voffB);
            PG8_BAR; PG8_WAIT_L(0); PG8_MMA(0, 1, At, B1); PG8_BAR;
            PG8_LDA(At, 1, 1); PG8_STAGE(PG8_SA(1, 0), a3, voffA);
            PG8_BAR; PG8_WAIT_L(0); PG8_MMA(1, 0, At, B0); PG8_BAR; PG8_SCHED;
            PG8_STAGE(PG8_SB(1, 1), b3 + hstepB, voffB);
            PG8_WAIT_V(6); PG8_BAR; PG8_MMA(1, 1, At, B1); PG8_BAR;
            }
        }
        if constexpr (ALIGN_EPI) { if (wr == 0) PG8_BAR; }
        if constexpr (!Epi::AFTER_DRAIN) { E(acc, cur, wr, wc, fr, fq); S.done(cur); }
        if (!has_next) break;
#pragma unroll
        for (int a = 0; a < 2; ++a)
#pragma unroll
            for (int b = 0; b < 2; ++b)
#pragma unroll
                for (int m = 0; m < 4; ++m)
#pragma unroll
                    for (int n = 0; n < 2; ++n) acc[a][b][m][n] = (f32x4){0.f, 0.f, 0.f, 0.f};
        cur = nxt; cA = nA; cB = nB; ++ui;
        if constexpr (ALIGN_EPI) { if (wr == 1) PG8_BAR; }
    }
    PG8_WAIT_V(0);
    if constexpr (!ALIGN_EPI) { if (wr == 0) PG8_BAR; }
    PG8_BAR;
    if constexpr (Epi::AFTER_DRAIN) { E.fused(acc, cur, wr, wc, fr, fq, lds, wid, lane); S.done(cur); }
#undef PG8_SA
#undef PG8_SB
#undef PG8_STAGE
#undef PG8_LDA
#undef PG8_LDB
#undef PG8_MMA
#undef PG8_WAIT_V
#undef PG8_WAIT_L
#undef PG8_BAR
#undef PG8_SCHED
}
}
#define PG8_SP2 true
#define PG8_ALIGN true
#include <hip/hip_bf16.h>
#include <cmath>
namespace attn_body {
using bf16=__hip_bfloat16;
using bf16x8=__attribute__((ext_vector_type(8)))short;
using s16x4=__attribute__((ext_vector_type(4)))short;
using f32x16=__attribute__((ext_vector_type(16)))float;
using u32x4=__attribute__((ext_vector_type(4)))unsigned;
constexpr int BATCH=2,NHEAD=8,SEQ=8192,D=64,DMQ=NHEAD*D,DMK=128,KVROWS=8320,KVALID=8208;
constexpr int NW=8,QBLK=32,QB=QBLK*NW,KVBLK=64,NQB=SEQ/QB;
constexpr int ATTN_PITCH=DMQ, ATTN_UNIT_ROWS=QB;
__device__ __forceinline__ int crow(int r,int hi){return (r&3)+8*(r>>2)+4*hi;}
#define SBAR() __builtin_amdgcn_sched_barrier(0)
__device__ __forceinline__ void cmask(f32x16&p0,f32x16&p1,int t,int hi){
  const float NEG=-INFINITY; int kb=64*t+4*hi;
  #pragma unroll
  for(int r=0;r<16;++r){int kv=kb+(r&3)+8*(r>>2); if(kv>=KVALID)p0[r]=NEG; if(kv+32>=KVALID)p1[r]=NEG;}
}

constexpr int NSLOT=3, SLOTB=8192;
constexpr int LDS_K=0, LDS_V=NSLOT*SLOTB, LDS_WS=2*NSLOT*SLOTB, LDS_OST=LDS_WS+NW*64*4, LDS_BYTES=LDS_OST+NW*4096;
constexpr float C2=0.125f*1.4426950408889634f;
__device__ __forceinline__ void glds16(const void*gsrc,unsigned lds_dst){unsigned keep;
  asm volatile("s_mov_b32 %0, m0\n\ts_mov_b32 m0, %2\n\ts_nop 0\n\tglobal_load_lds_dwordx4 %1, off\n\ts_mov_b32 m0, %0":"=&s"(keep):"v"(gsrc),"s"(lds_dst):"memory");}
__device__ __forceinline__ float max3f(float a,float b,float c){float r;asm("v_max3_f32 %0, %1, %2, %3":"=v"(r):"v"(a),"v"(b),"v"(c));return r;}
__device__ __forceinline__ float max2f(float a,float b){float r;asm("v_max_f32_e32 %0, %1, %2":"=v"(r):"v"(a),"v"(b));return r;}
__device__ __forceinline__ float fadd_s(float a,float b){float r;asm("v_add_f32_e32 %0, %1, %2":"=v"(r):"v"(a),"v"(b));return r;}
__device__ __forceinline__ float fsub_s(float a,float b){float r;asm("v_sub_f32_e32 %0, %1, %2":"=v"(r):"v"(a),"v"(b));return r;}
typedef float f32x2_t __attribute__((ext_vector_type(2))); typedef __bf16 bf16x2_t __attribute__((ext_vector_type(2)));
__device__ __forceinline__ unsigned cvtpk_s(float lo,float hi){f32x2_t v={lo,hi};bf16x2_t b=__builtin_convertvector(v,bf16x2_t);return __builtin_bit_cast(unsigned,b);}
#define WAIT_BAR(N) asm volatile("s_waitcnt vmcnt(" #N ") lgkmcnt(0)\n\ts_barrier":::"memory")

__device__ __forceinline__ void qkt(f32x16&p0,f32x16&p1,const char*Kslot,const bf16x8*qr,const f32x16&negm,int r32,int hi){
  const char*kb=Kslot+hi*1024+r32*16;
  #pragma unroll
  for(int d0=0;d0<4;++d0){
    const bf16x8 b0=*reinterpret_cast<const bf16x8*>(kb+d0*2048);
    const bf16x8 b1=*reinterpret_cast<const bf16x8*>(kb+d0*2048+512);
    if(d0==0){p0=__builtin_amdgcn_mfma_f32_32x32x16_bf16(b0,qr[0],negm,0,0,0);p1=__builtin_amdgcn_mfma_f32_32x32x16_bf16(b1,qr[0],negm,0,0,0);}
    else{p0=__builtin_amdgcn_mfma_f32_32x32x16_bf16(b0,qr[d0],p0,0,0,0);p1=__builtin_amdgcn_mfma_f32_32x32x16_bf16(b1,qr[d0],p1,0,0,0);}}
}
typedef __attribute__((address_space(3))) const char* lds_cptr;
typedef short v4i16_t __attribute__((ext_vector_type(4)));
__device__ __forceinline__ void kload8(bf16x8*kf,lds_cptr kp){
  kf[0]=*(const __attribute__((address_space(3))) bf16x8*)(kp);      kf[1]=*(const __attribute__((address_space(3))) bf16x8*)(kp+512);
  kf[2]=*(const __attribute__((address_space(3))) bf16x8*)(kp+2048); kf[3]=*(const __attribute__((address_space(3))) bf16x8*)(kp+2560);
  kf[4]=*(const __attribute__((address_space(3))) bf16x8*)(kp+4096); kf[5]=*(const __attribute__((address_space(3))) bf16x8*)(kp+4608);
  kf[6]=*(const __attribute__((address_space(3))) bf16x8*)(kp+6144); kf[7]=*(const __attribute__((address_space(3))) bf16x8*)(kp+6656);
}
__device__ __forceinline__ void kload2(bf16x8*kf,lds_cptr kp,int j){ kf[2*j]=*(const __attribute__((address_space(3))) bf16x8*)(kp+j*2048); kf[2*j+1]=*(const __attribute__((address_space(3))) bf16x8*)(kp+j*2048+512); }
__device__ __forceinline__ s16x4 vtr(lds_cptr p){ return __builtin_bit_cast(s16x4,__builtin_amdgcn_ds_read_tr16_b64_v4i16((__attribute__((address_space(3))) v4i16_t*)p)); }
__device__ __forceinline__ float rowmax(const f32x16&p0,const f32x16&p1){
  float a=max3f(p0[0],p0[1],p1[0]),b=max3f(p0[2],p0[3],p1[1]);a=max3f(a,p1[2],p1[3]);
  #pragma unroll
  for(int r=4;r<16;r+=4){a=max3f(a,p0[r],p0[r+1]);b=max3f(b,p0[r+2],p0[r+3]);a=max3f(a,p1[r],p1[r+1]);b=max3f(b,p1[r+2],p1[r+3]);}
  const float m=max2f(a,b);
  auto rr=__builtin_amdgcn_permlane32_swap(__float_as_uint(m),__float_as_uint(m),false,false);
  return max2f(__uint_as_float(rr[0]),__uint_as_float(rr[1]));
}
__device__ __forceinline__ void pv(f32x16*o,int vb,bf16x8 pa0,bf16x8 pa1,bf16x8 pa2,bf16x8 pa3){
  #pragma unroll
  for(int d0=0;d0<2;++d0){s16x4 lo[4],hi[4];
    #pragma unroll
    for(int ks=0;ks<4;++ks){
      asm volatile("ds_read_b64_tr_b16 %0,%1 offset:%c2":"=&v"(lo[ks]):"v"(vb),"i"(d0*4096+ks*1024):"memory");
      asm volatile("ds_read_b64_tr_b16 %0,%1 offset:%c2":"=&v"(hi[ks]):"v"(vb),"i"(d0*4096+ks*1024+512):"memory");}
    asm volatile("s_waitcnt lgkmcnt(0)":::"memory");SBAR();
    #define PK(k) (bf16x8){lo[k][0],lo[k][1],lo[k][2],lo[k][3],hi[k][0],hi[k][1],hi[k][2],hi[k][3]}
    o[d0]=__builtin_amdgcn_mfma_f32_32x32x16_bf16(pa0,PK(0),o[d0],0,0,0);
    o[d0]=__builtin_amdgcn_mfma_f32_32x32x16_bf16(pa1,PK(1),o[d0],0,0,0);
    o[d0]=__builtin_amdgcn_mfma_f32_32x32x16_bf16(pa2,PK(2),o[d0],0,0,0);
    o[d0]=__builtin_amdgcn_mfma_f32_32x32x16_bf16(pa3,PK(3),o[d0],0,0,0);
    #undef PK
  }
}

#ifndef ATTN_STORE16
#define ATTN_STORE16(p,v) (*(u32x4*)(p)=(v))
#endif
template<int THRL> __device__ __forceinline__ void attn_unit(int b,int h,int qb,const bf16*Q,const bf16*__restrict__ K,const bf16*__restrict__ V,bf16*O,char*shm){
  const int tid=threadIdx.x,lane=tid&63,r32=lane&31,hi=lane>>5; const int wid=__builtin_amdgcn_readfirstlane(tid>>6);
  const long rowbase=(long)b*SEQ, kvbase=(long)b*KVROWS; const int q0=qb*QB;
  const bf16*Qw=Q+(rowbase+q0+wid*QBLK)*DMQ+h*D;
  const bf16*Kh=K+kvbase*DMK+(h>>2)*D,*Vh=V+kvbase*DMK+(h>>2)*D;
  const unsigned lds0=(unsigned)(uintptr_t)shm;
  float*wsf=(float*)(shm+LDS_WS)+wid*64;
  const bf16*ksrc=Kh+(long)lane*DMK+wid*8;
  const bf16*vsrc=Vh+(long)(16*(wid&3)+(lane>>2))*DMK+(wid>>2)*32+(lane&3)*8;
  const unsigned kdst=lds0+LDS_K+wid*1024, vdst=lds0+LDS_V+wid*1024;
  #define DMA_K(t,slot) glds16(ksrc+(long)(t)*KVBLK*DMK,(unsigned)__builtin_amdgcn_readfirstlane(kdst+(slot)))
  #define DMA_V(t,slot) glds16(vsrc+(long)(t)*KVBLK*DMK,(unsigned)__builtin_amdgcn_readfirstlane(vdst+(slot)))
  const int vb0=(int)(lds0+LDS_V)+((lane>>4)&1)*32+(lane&3)*8+(4*hi+((lane&15)>>2))*64;
  const char*Kbase=shm+LDS_K; bf16x8 kf[8];
  const lds_cptr shm3=(lds_cptr)shm; const lds_cptr kp0=shm3+LDS_K+hi*1024+r32*16; const lds_cptr vp0=shm3+LDS_V+((lane>>4)&1)*32+(lane&3)*8+(4*hi+((lane&15)>>2))*64;
  constexpr int NT=KVROWS/KVBLK;
  DMA_K(0,0);DMA_V(0,0);DMA_K(1,SLOTB);
  bf16x8 qr[4];
  #pragma unroll
  for(int d0=0;d0<4;++d0)qr[d0]=*reinterpret_cast<const bf16x8*>(&Qw[(long)r32*DMQ+d0*16+hi*8]);
  float mhat=0.f,l_reg=0.f;f32x16 o[2];o[0]=f32x16{};o[1]=f32x16{};f32x16 negm=f32x16{};asm volatile("":"+v"(negm));
    #define CMASK(P0,P1,t) do{ if((t)>=NT-4)cmask(P0,P1,(t),hi); }while(0)
  bool resc=false;
  #define START(P0,P1) do{ const float rm=rowmax(P0,P1); resc=false; \
    { const float dl=rm; mhat=fadd_s(mhat,dl); \
      _Pragma("unroll") for(int r=0;r<16;++r){P0[r]=fsub_s(P0[r],dl);P1[r]=fsub_s(P1[r],dl);} \
      _Pragma("unroll") for(int r=0;r<16;++r)negm[r]=-mhat; asm volatile("":"+v"(negm)); } \
    _Pragma("unroll") for(int r=0;r<16;++r)P0[r]=__builtin_amdgcn_exp2f(P0[r]); }while(0)
  #define RESC() do{ if(resc){ asm volatile("s_waitcnt lgkmcnt(0)":::"memory"); \
      _Pragma("unroll") for(int d_=0;d_<2;++d_) _Pragma("unroll") for(int r=0;r<16;++r)o[d_][r]*=wsf[crow(r,hi)]; } }while(0)
  f32x16 pA0,pA1,pB0,pB1;
  int sl_prev=0,sl_cur=0,sl_next=SLOTB;
  #define ROT() do{sl_prev=sl_cur;sl_cur=sl_next;sl_next=(sl_next==(NSLOT-1)*SLOTB)?0:sl_next+SLOTB;}while(0)
  DMA_K(2,2*SLOTB);
  WAIT_BAR(3);
  qkt(pA0,pA1,Kbase,qr,negm,r32,hi);asm volatile("s_nop 15\n\ts_nop 7":"+v"(pA0),"+v"(pA1));CMASK(pA0,pA1,0);
  START(pA0,pA1);
  _Pragma("unroll") for(int r=0;r<16;++r)pA1[r]=__builtin_amdgcn_exp2f(pA1[r]);
  WAIT_BAR(0);
  DMA_K(3,0);DMA_V(1,SLOTB);
  ROT();
  kload8(kf,kp0+sl_cur);
  WAIT_BAR(2);
  s16x4 vlo[8],vhi[8]; u32x4 pw0,pw1,pw2,pw3;
  #define PKW(P,B) cvtpk_s(P[B],P[B+1])
  #define PAF(k) __builtin_bit_cast(bf16x8,pw##k)
  #define VFR(i) (bf16x8){vlo[i][0],vlo[i][1],vlo[i][2],vlo[i][3],vhi[i][0],vhi[i][1],vhi[i][2],vhi[i][3]}
  #define PIN(x) asm volatile("":"+v"(x))
  #define MX3(a,b,c) __builtin_fmaxf(__builtin_fmaxf((a),(b)),(c))
  #define GAPA(MF,A0,A1,A2,A3,W0,W1,PW) do{ MF; sacc+=A0; sacc+=A1; sacc+=A2; sacc+=A3; PIN(sacc); W0; W1; PIN(PW); SBAR(); }while(0)
  #define EX(v) __builtin_amdgcn_exp2f(v)
  #define GAPB(MF,X,B) do{ MF; X[B]=EX(X[B]); X[B+1]=EX(X[B+1]); X[B+2]=EX(X[B+2]); X[B+3]=EX(X[B+3]); PIN(X); SBAR(); }while(0)
  #define VRD(i) do{ vlo[i]=vtr(vp_+(((i)>>2)*4096+((i)&3)*1024)); vhi[i]=vtr(vp_+(((i)>>2)*4096+((i)&3)*1024+512)); }while(0)
  #define KRD(G,j) do{ if(G){ kload2(kf,kp0+sl_next,j); SBAR(); } }while(0)
  #define STEP(C0,C1,P0,P1,t,GK,GV,GL) do{ SBAR(); \
    const lds_cptr vp_=vp0+sl_prev; \
    VRD(0); SBAR(); float sacc=(P0[0]+P0[1]); \
    GAPA(C0=__builtin_amdgcn_mfma_f32_32x32x16_bf16(kf[0],qr[0],negm,0,0,0), P0[2],P0[3],P0[4],P0[5],     pw0[0]=PKW(P0,0), pw0[1]=PKW(P0,2), pw0); \
    VRD(4); SBAR(); GAPA(C1=__builtin_amdgcn_mfma_f32_32x32x16_bf16(kf[1],qr[0],negm,0,0,0), P0[6],P0[7],P0[8],P0[9],     pw0[2]=PKW(P0,4), pw0[3]=PKW(P0,6), pw0); \
    VRD(1); SBAR(); GAPA(C0=__builtin_amdgcn_mfma_f32_32x32x16_bf16(kf[2],qr[1],C0,0,0,0),   P0[10],P0[11],P0[12],P0[13], pw1[0]=PKW(P0,8), pw1[1]=PKW(P0,10), pw1); \
    VRD(5); SBAR(); GAPA(C1=__builtin_amdgcn_mfma_f32_32x32x16_bf16(kf[3],qr[1],C1,0,0,0),   P0[14],P0[15],P1[0],P1[1],   pw1[2]=PKW(P0,12),pw1[3]=PKW(P0,14), pw1); \
    VRD(2); SBAR(); GAPA(C0=__builtin_amdgcn_mfma_f32_32x32x16_bf16(kf[4],qr[2],C0,0,0,0),   P1[2],P1[3],P1[4],P1[5],     pw2[0]=PKW(P1,0), pw2[1]=PKW(P1,2), pw2); \
    VRD(6); SBAR(); GAPA(C1=__builtin_amdgcn_mfma_f32_32x32x16_bf16(kf[5],qr[2],C1,0,0,0),   P1[6],P1[7],P1[8],P1[9],     pw2[2]=PKW(P1,4), pw2[3]=PKW(P1,6), pw2); \
    VRD(3); SBAR(); GAPA(C0=__builtin_amdgcn_mfma_f32_32x32x16_bf16(kf[6],qr[3],C0,0,0,0),   P1[10],P1[11],P1[12],P1[13], pw3[0]=PKW(P1,8), pw3[1]=PKW(P1,10), pw3); \
    VRD(7); SBAR(); GAPA(C1=__builtin_amdgcn_mfma_f32_32x32x16_bf16(kf[7],qr[3],C1,0,0,0),   P1[14],P1[15],0.f,0.f,       pw3[2]=PKW(P1,12),pw3[3]=PKW(P1,14), pw3); \
    l_reg+=sacc; \
    if(GK){DMA_K((t)+3,sl_cur);} if(GV){DMA_V((t)+1,sl_next);} \
    CMASK(C0,C1,t); \
    { float a=MX3(C0[0],C0[1],C1[0]),b=MX3(C0[2],C0[3],C1[1]); a=MX3(a,C1[2],C1[3]); \
      _Pragma("unroll") for(int r=4;r<16;r+=4){a=MX3(a,C0[r],C0[r+1]);b=MX3(b,C0[r+2],C0[r+3]);a=MX3(a,C1[r],C1[r+1]);b=MX3(b,C1[r+2],C1[r+3]);} \
      float rm=__builtin_fmaxf(a,b); { auto rr=__builtin_amdgcn_permlane32_swap(__float_as_uint(rm),__float_as_uint(rm),false,false); rm=__builtin_fmaxf(__uint_as_float(rr[0]),__uint_as_float(rr[1])); } \
      resc=false; \
      if(__builtin_expect(__any(rm>(float)THRL),0)){ const float dl=__builtin_fmaxf(rm,0.f); mhat+=dl; \
        _Pragma("unroll") for(int r=0;r<16;++r){C0[r]-=dl;C1[r]-=dl;} \
        _Pragma("unroll") for(int r=0;r<16;++r)negm[r]=-mhat; asm volatile("":"+v"(negm)); \
        const float f=__builtin_amdgcn_exp2f(-dl); l_reg*=f; if(hi==0)wsf[r32]=f; resc=true; } } \
    SBAR(); \
    GAPB(o[0]=__builtin_amdgcn_mfma_f32_32x32x16_bf16(PAF(0),VFR(0),o[0],0,0,0), C0,0); \
    GAPB(o[1]=__builtin_amdgcn_mfma_f32_32x32x16_bf16(PAF(0),VFR(4),o[1],0,0,0), C0,4); \
    KRD(GL,0); GAPB(o[0]=__builtin_amdgcn_mfma_f32_32x32x16_bf16(PAF(1),VFR(1),o[0],0,0,0), C0,8); \
    KRD(GL,1); GAPB(o[1]=__builtin_amdgcn_mfma_f32_32x32x16_bf16(PAF(1),VFR(5),o[1],0,0,0), C0,12); \
    KRD(GL,2); GAPB(o[0]=__builtin_amdgcn_mfma_f32_32x32x16_bf16(PAF(2),VFR(2),o[0],0,0,0), C1,0); \
    KRD(GL,3); GAPB(o[1]=__builtin_amdgcn_mfma_f32_32x32x16_bf16(PAF(2),VFR(6),o[1],0,0,0), C1,4); \
    GAPB(o[0]=__builtin_amdgcn_mfma_f32_32x32x16_bf16(PAF(3),VFR(3),o[0],0,0,0), C1,8); \
    GAPB(o[1]=__builtin_amdgcn_mfma_f32_32x32x16_bf16(PAF(3),VFR(7),o[1],0,0,0), C1,12); \
    }while(0)
  int t=1;
  #undef CMASK
  #define CMASK(P0,P1,t) do{}while(0)
  for(;t+5<NT;t+=2){
    STEP(pB0,pB1,pA0,pA1,t,true,true,true);     WAIT_BAR(2); RESC(); ROT();
    STEP(pA0,pA1,pB0,pB1,t+1,true,true,true);   WAIT_BAR(2); RESC(); ROT();
  }
  #undef CMASK
  #define CMASK(P0,P1,t) do{ if((t)>=NT-4)cmask(P0,P1,(t),hi); }while(0)
  #define ENDW(tt) do{ if((tt)+3<NT){WAIT_BAR(2);} else if((tt)+2<NT){WAIT_BAR(1);} else {WAIT_BAR(0);} }while(0)
  for(;t+1<NT;t+=2){
    STEP(pB0,pB1,pA0,pA1,t,(t+3<NT),(t+1<NT),(t+1<NT));       ENDW(t);   RESC(); ROT();
    STEP(pA0,pA1,pB0,pB1,t+1,(t+4<NT),(t+2<NT),(t+2<NT));     ENDW(t+1); RESC(); ROT();
  }
  STEP(pB0,pB1,pA0,pA1,NT-1,false,false,false); RESC();
  { float sacc=pB0[0]+pB0[1]; _Pragma("unroll") for(int r=2;r<16;++r)sacc+=pB0[r]; _Pragma("unroll") for(int r=0;r<16;++r)sacc+=pB1[r]; l_reg+=sacc;
    pw0=(u32x4){PKW(pB0,0),PKW(pB0,2),PKW(pB0,4),PKW(pB0,6)};pw1=(u32x4){PKW(pB0,8),PKW(pB0,10),PKW(pB0,12),PKW(pB0,14)};pw2=(u32x4){PKW(pB1,0),PKW(pB1,2),PKW(pB1,4),PKW(pB1,6)};pw3=(u32x4){PKW(pB1,8),PKW(pB1,10),PKW(pB1,12),PKW(pB1,14)};
    SBAR(); pv(o,vb0+sl_cur,PAF(0),PAF(1),PAF(2),PAF(3)); }
  #undef PKW
  #undef PAF
  #undef VFR
  #undef PIN
  #undef MX3
  #undef GAPA
  #undef GAPB
  #undef EX
  #undef VRD
  #undef KRD
  #undef STEP
  #undef ENDW
  {auto rr=__builtin_amdgcn_permlane32_swap(__float_as_uint(l_reg),__float_as_uint(l_reg),false,false);l_reg=__uint_as_float(rr[0])+__uint_as_float(rr[1]);}
  if(hi==0)wsf[32+r32]=l_reg;asm volatile("s_waitcnt lgkmcnt(0)":::"memory");
  float rli[16];
  #pragma unroll
  for(int r=0;r<16;++r)rli[r]=__builtin_amdgcn_rcpf(wsf[32+crow(r,hi)]);
  bf16*Ow=O+(rowbase+q0+wid*QBLK)*DMQ+h*D;
  { bf16*stg=(bf16*)(shm+LDS_OST)+wid*2048;
    #pragma unroll
    for(int r=0;r<16;++r){const int orow=crow(r,hi);
      #pragma unroll
      for(int d0=0;d0<2;++d0)stg[orow*64+d0*32+r32]=__float2bfloat16(o[d0][r]*rli[r]);}
    asm volatile("s_waitcnt lgkmcnt(0)":::"memory");
    #pragma unroll
    for(int i=0;i<4;++i){const int row=i*8+(lane>>3),ch=lane&7; const u32x4 v=*(const u32x4*)(stg+row*64+ch*8); ATTN_STORE16(Ow+(long)row*DMQ+ch*8,v);} }
  asm volatile("s_waitcnt lgkmcnt(0)\n\ts_barrier":::"memory");
  #undef DMA_K
  #undef DMA_V
  #undef CMASK
  #undef START
  #undef RESC
  #undef ROT
}
constexpr int ATTN_LDS_BYTES=LDS_BYTES;
struct AttnTensors { const bf16* Q; const bf16* K; const bf16* V; bf16* O; };
struct AttnUnit { int bh; int qb; };
struct StaticOrder {
  int vcu;
  __device__ __forceinline__ explicit StaticOrder(int grid,int block):vcu((block%8)*(grid/8)+block/8){}
  __device__ __forceinline__ bool next(int i,AttnUnit&u)const{ if(i>=2)return false; const int pr=vcu>>6,uu=2*(vcu&63)+i; u.bh=(pr>>1)*NHEAD+(pr&1)*4+(uu>>5); u.qb=uu&31; return true; }
  __device__ __forceinline__ void a_ready(const AttnUnit&)const{}
  __device__ __forceinline__ void done(const AttnUnit&)const{}
};
template<class Sched,int THRL=8> __device__ __forceinline__ void attn_phase(char*lds,const AttnTensors&T,const Sched&S){
  AttnUnit u;
  for(int i=0;S.next(i,u);++i){ S.a_ready(u); attn_unit<THRL>(u.bh/NHEAD,u.bh%NHEAD,u.qb,T.Q,T.K,T.V,T.O,lds); S.done(u); }
}
#undef SBAR
#undef WAIT_BAR
}
#define GAS __attribute__((address_space(1)))
#define LAS __attribute__((address_space(3)))
typedef unsigned short bf16;
typedef unsigned v4u __attribute__((ext_vector_type(4)));
typedef float f32x4 __attribute__((ext_vector_type(4)));
typedef short bf16x8 __attribute__((ext_vector_type(8)));
typedef GAS unsigned gu32;
typedef GAS unsigned long long gu64;
#define RLX_AGENT __ATOMIC_RELAXED, __HIP_MEMORY_SCOPE_AGENT
#define LDS_WAIT() asm volatile("s_waitcnt lgkmcnt(0)" ::: "memory")
#define VM_WAIT() asm volatile("s_waitcnt vmcnt(0)" ::: "memory")
__device__ __forceinline__ unsigned long long rt() { return __builtin_amdgcn_s_memrealtime(); }
__device__ __forceinline__ unsigned f2bf(float f) { unsigned u = __builtin_bit_cast(unsigned, f); return (u + 0x7fffu + ((u >> 16) & 1u)) >> 16; }
__device__ __forceinline__ unsigned pk2(float lo, float hi) { return f2bf(lo) | (f2bf(hi) << 16); }

#define XB_TMO      128
#define XB_XCNT(j)  (256  + 64 * (j))
#define XB_XSUB(j)  (1280 + 64 * (j))
#define XB_XGEN(j)  (2304 + 64 * (j))
#define XB_TOP      3328
#define XB_TOPGEN   3392
#define XCD_BAR_WORDS 3456
#define XB_SPIN_CAP (1u << 18)

__device__ __forceinline__ unsigned xb_ld(unsigned* p)              { return __hip_atomic_load(p, __ATOMIC_RELAXED, __HIP_MEMORY_SCOPE_AGENT); }
__device__ __forceinline__ unsigned xb_add(unsigned* p, unsigned v) { return __hip_atomic_fetch_add(p, v, __ATOMIC_RELAXED, __HIP_MEMORY_SCOPE_AGENT); }
__device__ __forceinline__ unsigned xb_xcc_id() { return (unsigned)__builtin_amdgcn_s_getreg((3 << 11) | 20) & 0xFu; }
#define XB_SPIN(cond, bar) do { unsigned _sp = 0; while (cond) { __builtin_amdgcn_s_sleep(1); \
    if ((++_sp & 255u) == 0u) { if (xb_ld(&(bar)[XB_TMO])) break; if (_sp > XB_SPIN_CAP) { atomicAdd(&(bar)[XB_TMO], 1u); break; } } } } while (0)

struct XcdBarrier {
    unsigned* bar; unsigned x;
    volatile LAS unsigned* st;
};

__device__ __forceinline__ XcdBarrier xcd_barrier_post(unsigned* bar, volatile LAS unsigned* st) {
    XcdBarrier b; b.bar = bar; b.x = xb_xcc_id(); b.st = st;
    if (threadIdx.x == 0) (void)xb_add(&bar[XB_XCNT(b.x)], 1u);
    return b;
}
__device__ __forceinline__ void xcd_barrier_complete(unsigned* bar, unsigned x, unsigned& nloc, unsigned& nx) {
    const unsigned G = gridDim.x * gridDim.y * gridDim.z;
    unsigned sum, cnt, mine, sp = 0u;
    for (;;) {
        sum = 0u; cnt = 0u; mine = 0u;
#pragma unroll
        for (unsigned j = 0; j < 16; ++j) { const unsigned c = xb_ld(&bar[XB_XCNT(j)]); sum += c; cnt += (c > 0u) ? 1u : 0u; mine = (j == x) ? c : mine; }
        if (sum == G) break;
        __builtin_amdgcn_s_sleep(1);
        if ((++sp & 255u) == 0u) { if (xb_ld(&bar[XB_TMO])) break; if (sp > XB_SPIN_CAP) { atomicAdd(&bar[XB_TMO], 1u); break; } }
    }
    nloc = mine > 0u ? mine : 1u; nx = cnt > 0u ? cnt : 1u;
}

__device__ __forceinline__ void xcd_barrier(const XcdBarrier& b) {
    asm volatile("s_waitcnt vmcnt(0)" ::: "memory");
    __syncthreads();
    if (threadIdx.x == 0) {
        unsigned* bar = b.bar;
        __builtin_amdgcn_s_waitcnt(0);
        unsigned nloc = b.st[0], nx = b.st[1];
        if (nloc == 0u) { xcd_barrier_complete(bar, b.x, nloc, nx); b.st[0] = nloc; b.st[1] = nx; }
        const unsigned old = xb_add(&bar[XB_XSUB(b.x)], 1u);
        const unsigned gen = old / nloc;
        if (old + 1u == (gen + 1u) * nloc) {
            __builtin_amdgcn_fence(__ATOMIC_RELEASE, "agent");
            asm volatile("s_waitcnt vmcnt(0)" ::: "memory");
            const unsigned og = xb_add(&bar[XB_TOP], 1u);
            const unsigned tg = og / nx;
            if (og + 1u == (tg + 1u) * nx) xb_add(&bar[XB_TOPGEN], 1u);
            else XB_SPIN(xb_ld(&bar[XB_TOPGEN]) == tg, bar);
            __builtin_amdgcn_fence(__ATOMIC_ACQUIRE, "agent");
            xb_add(&bar[XB_XGEN(b.x)], 1u);
            asm volatile("s_waitcnt vmcnt(0)" ::: "memory");
        } else {
            XB_SPIN(xb_ld(&bar[XB_XGEN(b.x)]) == gen, bar);
            __builtin_amdgcn_fence(__ATOMIC_ACQUIRE, "agent");
            asm volatile("s_waitcnt vmcnt(0)" ::: "memory");
        }
    }
    __syncthreads();
}

constexpr int NWAVES = 8;
constexpr int BATCH = 2, SEQ = 8192, DM = 1024, NMETA = 16;
constexpr int M = BATCH * SEQ;
constexpr int INW = 3328;
constexpr int KVROWS = 8320, KVALID = 8208;
constexpr int NG = 32, NE = 16, CAP = 1024;
constexpr int UGP = 768;
constexpr float LN_EPS = 1e-5f, QK_EPS = 1e-6f, ALPHA = 1.189207115002721f;
constexpr float C2Q = 0.125f * 1.4426950408889634f;

constexpr size_t MiB = 1u << 20;
constexpr size_t WS_CTL = 0, CTL_ZERO_BYTES = 1 * MiB;
constexpr size_t WS_STATS0 = 1 * MiB, WS_STATS1 = WS_STATS0 + 131072, WS_ROPE = WS_STATS1 + 131072, WS_UMETA = WS_ROPE + 32768, WS_GATE2 = WS_UMETA + 32768, WS_IDX2 = WS_GATE2 + 131072;
constexpr size_t WS_SLOTOF = 2 * MiB, WS_AFF = 3 * MiB;
constexpr size_t WS_WGU = 8 * MiB, WS_WD = 72 * MiB;
constexpr size_t WS_WIN = 104 * MiB, WS_WGLU = 111 * MiB, WS_WAB = 112 * MiB, WS_WSB = 113 * MiB, WS_WO = 114 * MiB;
constexpr size_t WS_WST = 116 * MiB, WS_MEXT = 124 * MiB;
constexpr size_t WS_XN = 148 * MiB;
constexpr size_t WS_Q = 181 * MiB, WS_K = 197 * MiB, WS_V = 202 * MiB;
constexpr size_t WS_UG2 = 207 * MiB, WS_S = 231 * MiB;
constexpr size_t WS_END = 247 * MiB;
constexpr size_t WS_YG = WS_XN, WS_Z = WS_XN + 16 * MiB;
constexpr size_t WS_T1 = WS_WST;
constexpr size_t WS_MERGED = WS_UG2;
constexpr size_t WS_H1 = WS_XN;
constexpr size_t WS_XE = WS_Q;
constexpr size_t WS_HB = WS_WIN;
static_assert(WS_XE + 64 * MiB <= WS_END && WS_HB + 64 * MiB <= WS_XE && WS_MERGED + 32 * MiB <= WS_END && WS_T1 + 32 * MiB <= WS_XN, "d_ws overlays");
constexpr int CW_TMO = 0, CW_BAR = 4096;
constexpr int CW_Q = 8192, CW_QM = 8192 + 4096, CW_DONE = 8256;
constexpr int N_DENSE_ITEMS = 16 * 104 + 8 * 16 + 2 * 8 * 32 + 16 * 32, N_EXP_ITEMS = NE * 3 * 16 * 32;

constexpr int RING_OFF = 0, RING_BYTES = 131072;
constexpr int LDSCTL_OFF = RING_BYTES, MISC_OFF = LDSCTL_OFF + 320;
constexpr int LDS_BYTES = 147456;

typedef unsigned u32x4_t __attribute__((ext_vector_type(4)));
typedef unsigned u32x2_t __attribute__((ext_vector_type(2)));
typedef float f32x2_t2 __attribute__((ext_vector_type(2)));
using pg8::Unit;

struct Frame {
    LAS unsigned char* lds; volatile LAS unsigned* MISC; gu32* ctl;
    int tid, lane, wave, vcu, G;
    unsigned char* ws;
    const float* in[28]; float* out;
};
template <int CTRL> __device__ __forceinline__ float dppf(float v) { return __builtin_bit_cast(float, __builtin_amdgcn_update_dpp(0, __builtin_bit_cast(int, v), CTRL, 0xF, 0xF, true)); }
__device__ __forceinline__ float xor16f(float v, int lane) { auto r = __builtin_amdgcn_permlane16_swap(__float_as_uint(v), __float_as_uint(v), false, false); return __uint_as_float((lane & 16) ? r[0] : r[1]); }
__device__ __forceinline__ float xor32f(float v, int lane) { auto r = __builtin_amdgcn_permlane32_swap(__float_as_uint(v), __float_as_uint(v), false, false); return __uint_as_float((lane & 32) ? r[0] : r[1]); }
__device__ __forceinline__ float wave_sum(float v) {
    v += dppf<0xB1>(v); v += dppf<0x4E>(v); v += dppf<0x141>(v); v += dppf<0x140>(v);
    { auto r = __builtin_amdgcn_permlane16_swap(__float_as_uint(v), __float_as_uint(v), false, false); v = __uint_as_float(r[0]) + __uint_as_float(r[1]); }
    { auto r = __builtin_amdgcn_permlane32_swap(__float_as_uint(v), __float_as_uint(v), false, false); v = __uint_as_float(r[0]) + __uint_as_float(r[1]); }
    return v;
}
__device__ __forceinline__ float sigm(float x) { return 1.f / (1.f + __expf(-x)); }
__device__ __forceinline__ float bf2f(unsigned short h) { return __uint_as_float((unsigned)h << 16); }
__device__ __forceinline__ float bflo(unsigned w) { return __uint_as_float(w << 16); }
__device__ __forceinline__ float bfhi(unsigned w) { return __uint_as_float(w & 0xffff0000u); }
__device__ __forceinline__ u32x4_t pack8(const f32x4& a, const f32x4& b) { u32x4_t w; w.x = pg8::cvt_pk_bf16(a[0], a[1]); w.y = pg8::cvt_pk_bf16(a[2], a[3]); w.z = pg8::cvt_pk_bf16(b[0], b[1]); w.w = pg8::cvt_pk_bf16(b[2], b[3]); return w; }
__device__ __forceinline__ float gelu_tanh(float y) { const float in = 0.7978845608028654f * (y + 0.044715f * y * y * y); const float e = __expf(2.f * in); return y * (1.f - 1.f / (e + 1.f)); }

struct InProjOrder {
    pg8::StaticOrder so;
    __device__ bool next(int i, Unit& u) const { if (so.next(i, u)) return true; const long L = (long)i * so.G + so.c; if (L >= so.nwg && L < so.nwg + 3) { u.pm = 64; u.pn = 2 + (int)(L - so.nwg); return true; } return false; }
    __device__ __forceinline__ void a_ready(const Unit&) const {}
    __device__ __forceinline__ void done(const Unit&) const {}
};
struct SsmStateOrder {
    int G, c;
    __device__ bool next(int i, Unit& u) const { const int L = i * G + c; if (L >= 64) return false; u.pm = L; u.pn = L >> 1; return true; }
    __device__ __forceinline__ void a_ready(const Unit&) const {}
    __device__ __forceinline__ void done(const Unit&) const {}
};
struct SsmYOrder {
    int G, c;
    __device__ bool next(int i, Unit& u) const { const int L = i * G + c; if (L >= 128) return false; const int g = L >> 2; u.pm = g * 2 + ((L >> 1) & 1); u.pn = g * 2 + (L & 1); return true; }
    __device__ __forceinline__ void a_ready(const Unit&) const {}
    __device__ __forceinline__ void done(const Unit&) const {}
};
struct MoeOrder {
    int G, c, nmi, nnj;
    __device__ bool next(int i, Unit& u) const { const int per = nmi * nnj, nwg = NE * per; const int L = i * G + c; if (L >= nwg) return false;
        const int wgid = (L % 8) * (nwg / 8) + L / 8; const int e = wgid / per, w = wgid % per; u.pm = e * nmi + (w % nmi); u.pn = e * nnj + (w / nmi); return true; }
    __device__ __forceinline__ void a_ready(const Unit&) const {}
    __device__ __forceinline__ void done(const Unit&) const {}
};

typedef float f32x4 __attribute__((ext_vector_type(4)));
#define EPI_LOOP_AM _Pragma("unroll") for (int ai = 0; ai < 2; ++ai) _Pragma("unroll") for (int m = 0; m < 4; ++m)
constexpr int XCH_OFF = 132096;
struct EpiInProj {
    static constexpr bool PERM = true, AFTER_DRAIN = false;
    bf16* Q; bf16* Kb; bf16* Vb; bf16* UG2; bf16* GATES; bf16* UMETA; LAS float* XCH; const float* ngt; const float* RP;
    __device__ __forceinline__ u32x4_t normrope(const f32x4& a0, const f32x4& a1, float rinv, const f32x4& g0, const f32x4& g1, const f32x4& cs, const f32x4& sn, float osc) const {
        const float y0 = a0[0] * rinv * g0[0], y1 = a0[1] * rinv * g0[1], y2 = a0[2] * rinv * g0[2], y3 = a0[3] * rinv * g0[3];
        const float y4 = a1[0] * rinv * g1[0], y5 = a1[1] * rinv * g1[1], y6 = a1[2] * rinv * g1[2], y7 = a1[3] * rinv * g1[3];
        u32x4_t w;
        w.x = pg8::cvt_pk_bf16((y0 * cs[0] - y1 * sn[0]) * osc, (y0 * sn[0] + y1 * cs[0]) * osc);
        w.y = pg8::cvt_pk_bf16((y2 * cs[1] - y3 * sn[1]) * osc, (y2 * sn[1] + y3 * cs[1]) * osc);
        w.z = pg8::cvt_pk_bf16((y4 * cs[2] - y5 * sn[2]) * osc, (y4 * sn[2] + y5 * cs[2]) * osc);
        w.w = pg8::cvt_pk_bf16((y6 * cs[3] - y7 * sn[3]) * osc, (y6 * sn[3] + y7 * cs[3]) * osc);
        return w;
    }
    __device__ __forceinline__ void operator()(const f32x4 (&acc)[2][2][4][2], const Unit& u, int wr, int wc, int fr_, int fq_) const {
        int fr = fr_, fq = fq_; asm volatile("" : "+v"(fr), "+v"(fq));
        const int pn = u.pn, cl0 = wc * 32 + 8 * fq;
        if (pn <= 2) {
            const int nb = pn == 2 ? 1 : 2;
            EPI_LOOP_AM {
#pragma unroll
                for (int bj = 0; bj < 2; ++bj) {
                    if (bj < nb) { const f32x4 a = acc[ai][bj][m][0], c = acc[ai][bj][m][1]; float s = (a[0] * a[0] + a[1] * a[1]) + (a[2] * a[2] + a[3] * a[3]) + (c[0] * c[0] + c[1] * c[1]) + (c[2] * c[2] + c[3] * c[3]);
                        s += __shfl_xor(s, 16); s += __shfl_xor(s, 32);
                        if (fq == 0) XCH[(ai * 128 + wr * 64 + m * 16 + fr) * 8 + bj * 4 + wc] = s; } } }
            asm volatile("s_waitcnt lgkmcnt(0)" ::: "memory"); __builtin_amdgcn_s_barrier(); asm volatile("" ::: "memory");
            const float* gsrc = ngt + (pn == 2 ? 64 : 0) + (wc & 1) * 32 + 8 * fq;
            const f32x4 g0 = *(const f32x4*)gsrc, g1 = *(const f32x4*)(gsrc + 4);
            const float osc = pn == 2 ? 1.f : C2Q;
            const int codd = wc & 1;
            EPI_LOOP_AM {
                if (u.pm == 64 && (wr != 0 || ai != 0 || m != 0)) continue;
                const int rl = ai * 128 + wr * 64 + m * 16 + fr; const int row = u.pm * 256 + rl;
                f32x4 cs = (f32x4){1.f, 1.f, 1.f, 1.f}, sn = (f32x4){0.f, 0.f, 0.f, 0.f};
                if (u.pm != 64) { const int s = row & 8191; const float* tp = codd ? RP + 4096 + (s & 63) * 16 + 4 * fq : RP + (s >> 6) * 16 + 4 * fq; cs = *(const f32x4*)tp; sn = *(const f32x4*)(tp + (codd ? 1024 : 2048)); }
#pragma unroll
                for (int bj = 0; bj < 2; ++bj) {
                    if (bj < nb) {
                        const f32x2_t2 pr = *(const LAS f32x2_t2*)(XCH + rl * 8 + bj * 4 + (wc & 2)); const float tot = pr.x + pr.y;
                        const float rinv = rsqrtf(tot * (1.f / 64.f) + QK_EPS);
                        const u32x4_t w = normrope(acc[ai][bj][m][0], acc[ai][bj][m][1], rinv, g0, g1, cs, sn, osc);
                        if (pn < 2) *(u32x4_t*)(Q + (size_t)row * 512 + pn * 256 + bj * 128 + cl0) = w;
                        else if (u.pm != 64) *(u32x4_t*)(Kb + ((size_t)(row >> 13) * KVROWS + NMETA + (row & 8191)) * 128 + cl0) = w;
                        else { *(u32x4_t*)(Kb + (size_t)fr * 128 + cl0) = w; *(u32x4_t*)(Kb + ((size_t)KVROWS + fr) * 128 + cl0) = w; }
                    } else {
                        const u32x4_t w = pack8(acc[ai][1][m][0], acc[ai][1][m][1]);
                        if (u.pm != 64) *(u32x4_t*)(Vb + ((size_t)(row >> 13) * KVROWS + NMETA + (row & 8191)) * 128 + cl0) = w;
                        else { *(u32x4_t*)(Vb + (size_t)fr * 128 + cl0) = w; *(u32x4_t*)(Vb + ((size_t)KVROWS + fr) * 128 + cl0) = w; }
                    }
                }
            }
            return;
        }
        if (u.pm == 64) {
            if (wr != 0) return;
#pragma unroll
            for (int bj = 0; bj < 2; ++bj) { const int cu = (pn - 3) * 256 + bj * 128 + cl0; *(u32x4_t*)(UMETA + ((size_t)(cu >> 4) * 16 + fr) * 16 + (cu & 15)) = pack8(acc[0][bj][0][0], acc[0][bj][0][1]); }
            return;
        }
        const int row0 = u.pm * 256 + wr * 64 + fr;
        if (pn < 5) {
            EPI_LOOP_AM { const int row = row0 + ai * 128 + m * 16, b = row >> 13, s = row & 8191;
#pragma unroll
                for (int bj = 0; bj < 2; ++bj) { const int cu = (pn - 3) * 256 + bj * 128 + cl0, g = cu >> 4;
                    *(u32x4_t*)(UG2 + ((size_t)(g * 2 + b) * 256 + (s >> 5)) * UGP + (s & 31) * 16 + (cu & 15)) = pack8(acc[ai][bj][m][0], acc[ai][bj][m][1]); } }
        } else {
            EPI_LOOP_AM { const size_t o = (size_t)(row0 + ai * 128 + m * 16) * 2048 + (pn - 5) * 256 + cl0;
#pragma unroll
                for (int bj = 0; bj < 2; ++bj) { f32x4 a = acc[ai][bj][m][0], c = acc[ai][bj][m][1];
#pragma unroll
                    for (int j = 0; j < 4; ++j) { a[j] = sigm(a[j]); c[j] = sigm(c[j]); }
                    *(u32x4_t*)(GATES + o + bj * 128) = pack8(a, c); } }
        }
    }
};
struct EpiSsmState {
    static constexpr bool PERM = false, AFTER_DRAIN = false;
    float* S;
    __device__ __forceinline__ void operator()(const f32x4 (&acc)[2][2][4][2], const Unit& u, int wr, int wc, int fr, int fq) const {
        EPI_LOOP_AM { float* rp = S + ((size_t)u.pm * 256 + ai * 128 + wr * 64 + m * 16 + fr) * 256 + wc * 32 + 4 * fq;
#pragma unroll
            for (int bj = 0; bj < 2; ++bj)
#pragma unroll
                for (int n = 0; n < 2; ++n) *(f32x4*)(rp + bj * 128 + n * 16) = acc[ai][bj][m][n]; }
    }
};
struct EpiSsmY {
    static constexpr bool PERM = true, AFTER_DRAIN = false;
    bf16* YG;
    __device__ __forceinline__ void operator()(const f32x4 (&acc)[2][2][4][2], const Unit& u, int wr, int wc, int fr, int fq) const {
        const int g = u.pm >> 1, b = u.pm & 1, nh = u.pn & 1;
        EPI_LOOP_AM { const int cp = ai * 128 + wr * 64 + m * 16 + fr;
#pragma unroll
            for (int bj = 0; bj < 2; ++bj) { const int nl = nh * 256 + bj * 128 + wc * 32 + 8 * fq, t = nl >> 4, h0 = nl & 15;
                f32x4 a = acc[ai][bj][m][0], c = acc[ai][bj][m][1];
#pragma unroll
                for (int j = 0; j < 4; ++j) { a[j] = gelu_tanh(a[j]); c[j] = gelu_tanh(c[j]); }
                *(u32x4_t*)(YG + ((size_t)b * SEQ + cp * 32 + t) * 512 + g * 16 + h0) = pack8(a, c); } }
    }
};
struct EpiGlu {
    static constexpr bool PERM = true, AFTER_DRAIN = false;
    const bf16* YG; const float* bias; bf16* Z;
    __device__ __forceinline__ void operator()(const f32x4 (&acc)[2][2][4][2], const Unit& u, int wr, int wc, int fr, int fq) const {
        const int row0 = u.pm * 256 + wr * 64 + fr, col0 = u.pn * 256 + wc * 32 + 8 * fq;
        EPI_LOOP_AM { const size_t o = (size_t)(row0 + ai * 128 + m * 16) * 512 + col0;
#pragma unroll
            for (int bj = 0; bj < 2; ++bj) { const u32x4_t y = *(const u32x4_t*)(YG + o + bj * 128);
                const f32x4 b0 = *(const f32x4*)(bias + col0 + bj * 128), b1 = *(const f32x4*)(bias + col0 + bj * 128 + 4);
                f32x4 a = acc[ai][bj][m][0] + b0, c = acc[ai][bj][m][1] + b1;
                a[0] = bflo(y.x) * sigm(a[0]); a[1] = bfhi(y.x) * sigm(a[1]); a[2] = bflo(y.y) * sigm(a[2]); a[3] = bfhi(y.y) * sigm(a[3]);
                c[0] = bflo(y.z) * sigm(c[0]); c[1] = bfhi(y.z) * sigm(c[1]); c[2] = bflo(y.w) * sigm(c[2]); c[3] = bfhi(y.w) * sigm(c[3]);
                *(u32x4_t*)(Z + o + bj * 128) = pack8(a, c); } }
    }
};
template <int SECOND> struct EpiBranch {
    static constexpr bool PERM = true, AFTER_DRAIN = false;
    const bf16* GATES; const bf16* T1; bf16* O;
    __device__ __forceinline__ void operator()(const f32x4 (&acc)[2][2][4][2], const Unit& u, int wr, int wc, int fr, int fq) const {
        const int row0 = u.pm * 256 + wr * 64 + fr, col0 = u.pn * 256 + wc * 32 + 8 * fq;
        EPI_LOOP_AM { const size_t r = (size_t)(row0 + ai * 128 + m * 16);
#pragma unroll
            for (int bj = 0; bj < 2; ++bj) { const u32x4_t gt = *(const u32x4_t*)(GATES + r * 2048 + SECOND * 1024 + col0 + bj * 128);
                f32x4 a = acc[ai][bj][m][0], c = acc[ai][bj][m][1];
                a[0] *= bflo(gt.x); a[1] *= bfhi(gt.x); a[2] *= bflo(gt.y); a[3] *= bfhi(gt.y); c[0] *= bflo(gt.z); c[1] *= bfhi(gt.z); c[2] *= bflo(gt.w); c[3] *= bfhi(gt.w);
                if (SECOND) { const u32x4_t t1 = *(const u32x4_t*)(T1 + r * 1024 + col0 + bj * 128);
                    a[0] += bflo(t1.x); a[1] += bfhi(t1.x); a[2] += bflo(t1.y); a[3] += bfhi(t1.y); c[0] += bflo(t1.z); c[1] += bfhi(t1.z); c[2] += bflo(t1.w); c[3] += bfhi(t1.w); }
                *(u32x4_t*)(O + r * 1024 + col0 + bj * 128) = pack8(a, c); } }
    }
};
struct EpiPre1 {
    static constexpr bool PERM = false, AFTER_DRAIN = false;
    const float* x; const float* g; const float* bb; const f32x2_t2* st; float* out;
    __device__ __forceinline__ void operator()(const f32x4 (&acc)[2][2][4][2], const Unit& u, int wr, int wc, int fr, int fq) const {
        const int row0 = u.pm * 256 + wr * 64 + fr, col0 = u.pn * 256 + wc * 32 + 4 * fq;
        EPI_LOOP_AM { const int row = row0 + ai * 128 + m * 16; const f32x2_t2 s = st[row]; const size_t o = (size_t)row * 1024 + col0;
#pragma unroll
            for (int bj = 0; bj < 2; ++bj)
#pragma unroll
                for (int n = 0; n < 2; ++n) { const int c = bj * 128 + n * 16; const f32x4 xv = *(const f32x4*)(x + o + c), gv = *(const f32x4*)(g + col0 + c), bv = *(const f32x4*)(bb + col0 + c);
                    *(f32x4*)(out + o + c) = ((xv - s.x) * s.y * gv + bv) * ALPHA + acc[ai][bj][m][n]; } }
    }
};
struct EpiMoe1 {
    static constexpr bool PERM = true, AFTER_DRAIN = false;
    bf16* HB;
    __device__ __forceinline__ void operator()(const f32x4 (&acc)[2][2][4][2], const Unit& u, int wr, int wc, int fr, int fq) const {
        const int row0 = u.pm * 256 + wr * 64 + fr, col0 = (u.pn & 7) * 128 + wc * 32 + 8 * fq;
        EPI_LOOP_AM { f32x4 a = acc[ai][0][m][0], c = acc[ai][0][m][1]; const f32x4 ua = acc[ai][1][m][0], uc = acc[ai][1][m][1];
#pragma unroll
            for (int j = 0; j < 4; ++j) { a[j] = a[j] * sigm(a[j]) * ua[j]; c[j] = c[j] * sigm(c[j]) * uc[j]; }
            *(u32x4_t*)(HB + (size_t)(row0 + ai * 128 + m * 16) * 1024 + col0) = pack8(a, c); }
    }
};
struct EpiMoe2 {
    static constexpr bool PERM = true, AFTER_DRAIN = false;
    const float* gate; bf16* YE;
    __device__ __forceinline__ void operator()(const f32x4 (&acc)[2][2][4][2], const Unit& u, int wr, int wc, int fr, int fq) const {
        const int row0 = u.pm * 256 + wr * 64 + fr, col0 = (u.pn & 3) * 256 + wc * 32 + 8 * fq;
        EPI_LOOP_AM { const int row = row0 + ai * 128 + m * 16; const float gt = gate[row];
#pragma unroll
            for (int bj = 0; bj < 2; ++bj) *(u32x4_t*)(YE + (size_t)row * 1024 + col0 + bj * 128) = pack8(acc[ai][bj][m][0] * gt, acc[ai][bj][m][1] * gt); }
    }
};

struct TItem { const float* src; bf16* dst; int N, K; };
__device__ __forceinline__ void titem_load(const TItem& t, f32x4 (&v)[8], int lane) {
    const float* p = t.src + (size_t)(lane >> 3) * t.N + (lane & 7) * 4;
#pragma unroll
    for (int i = 0; i < 8; ++i) v[i] = *(const GAS f32x4*)(p + (size_t)(8 * i) * t.N);
}
__device__ __forceinline__ void titem_store(const TItem& t, const f32x4 (&v)[8], LAS float* scr, int lane) {
#pragma unroll
    for (int i = 0; i < 8; ++i) { LAS float* s = scr + ((lane >> 3) + 8 * i) * 33 + (lane & 7) * 4; s[0] = v[i].x; s[1] = v[i].y; s[2] = v[i].z; s[3] = v[i].w; }
    LDS_WAIT(); asm volatile("" ::: "memory");
    const int c = lane & 7;
#pragma unroll
    for (int j = 0; j < 4; ++j) { const int n = (lane >> 3) + 8 * j; const LAS float* s = scr + (8 * c) * 33 + n;
        v4u o; o.x = pk2(s[0 * 33], s[1 * 33]); o.y = pk2(s[2 * 33], s[3 * 33]); o.z = pk2(s[4 * 33], s[5 * 33]); o.w = pk2(s[6 * 33], s[7 * 33]);
        *(GAS v4u*)(t.dst + (size_t)n * t.K + 8 * c) = o; }
    LDS_WAIT(); asm volatile("" ::: "memory");
}
__device__ __forceinline__ void ssm_par(const Frame& F, int dg, int p, float& lr, float& li, float& cr, float& ci) {
    const float dt = expf(F.in[9][dg]); const float ar = F.in[7][dg * 64 + p], ai = F.in[8][dg * 64 + p];
    lr = ar * dt; li = ai * dt;
    float sn, cs; sincosf(li, &sn, &cs); const float mag = expf(lr);
    const float nr = mag * cs - 1.f, ni = mag * sn, den = ar * ar + ai * ai;
    cr = (nr * ar + ni * ai) / den; ci = (ni * ar - nr * ai) / den;
}
__device__ __forceinline__ void cpow(float lr, float li, float e, float& pr, float& pi) { float sn, cs; sincosf(li * e, &sn, &cs); const float mg = expf(lr * e); pr = mg * cs; pi = mg * sn; }

__device__ __forceinline__ void mext_item(Frame& F, int it) {
    const int tid = F.tid; unsigned char* ws = F.ws;
    LAS float* POW = (LAS float*)(F.lds + RING_OFF);
    LAS float* BB = POW + 2 * 33 * 64 * 2;
    LAS float* CC = BB + 2 * 64 * 16 * 2;
    LAS float* KT = CC + 2 * 4 * 64 * 2;
    LAS float* PAR = KT + 2 * 4 * 32 * 16;
    bf16* MEXT = (bf16*)(ws + WS_MEXT);
    const int g = it >> 2, hq = it & 3;
    __syncthreads();
    if (tid < 128) { float lr, li, cr, ci; ssm_par(F, (tid >> 6) * 32 + g, tid & 63, lr, li, cr, ci); PAR[tid * 4] = lr; PAR[tid * 4 + 1] = li; PAR[tid * 4 + 2] = cr; PAR[tid * 4 + 3] = ci; }
    __syncthreads();
    if (tid < 128) { const int dir = tid >> 6, p = tid & 63; float a1r, a1i; cpow(PAR[tid * 4], PAR[tid * 4 + 1], 1.f, a1r, a1i); float pr = 1.f, pi = 0.f;
        for (int j = 0; j <= 32; ++j) { POW[((dir * 33 + j) * 64 + p) * 2] = pr; POW[((dir * 33 + j) * 64 + p) * 2 + 1] = pi; const float nr = pr * a1r - pi * a1i, ni = pr * a1i + pi * a1r; pr = nr; pi = ni; } }
    for (int i = tid; i < 2 * 64 * 16; i += NWAVES * 64) { const int dir = i / 1024, p = (i >> 4) & 63, h = i & 15; const float cr = PAR[(dir * 64 + p) * 4 + 2], ci = PAR[(dir * 64 + p) * 4 + 3];
        const size_t o = ((size_t)(dir * 32 + g) * 64 + p) * 16 + h; const float br = F.in[10][o], bi = F.in[11][o]; BB[i * 2] = cr * br - ci * bi; BB[i * 2 + 1] = cr * bi + ci * br; }
    for (int i = tid; i < 2 * 4 * 64; i += NWAVES * 64) { const int dir = i / 256, hl = (i >> 6) & 3, p = i & 63; const size_t o = ((size_t)(dir * 32 + g) * 16 + hq * 4 + hl) * 64 + p; CC[i * 2] = F.in[12][o]; CC[i * 2 + 1] = F.in[13][o]; }
    __syncthreads();
    { const int wv = F.wave, dir = wv >> 2, hl = wv & 3, jg = F.lane >> 4, hi = F.lane & 15;
      float acc[8];
#pragma unroll
      for (int jj = 0; jj < 8; ++jj) acc[jj] = 0.f;
#pragma unroll 1
      for (int ph = 0; ph < 2; ++ph) {
          float gr[32], gi[32];
#pragma unroll
          for (int q = 0; q < 32; ++q) { const int p = ph * 32 + q; const f32x2_t2 c = *(const LAS f32x2_t2*)(CC + ((dir * 4 + hl) * 64 + p) * 2), bq = *(const LAS f32x2_t2*)(BB + ((dir * 64 + p) * 16 + hi) * 2);
              gr[q] = c.x * bq.x - c.y * bq.y; gi[q] = c.x * bq.y + c.y * bq.x; }
#pragma unroll
          for (int jj = 0; jj < 8; ++jj) { const LAS f32x4* pw = (const LAS f32x4*)(POW + ((dir * 33 + jg * 8 + jj) * 64 + ph * 32) * 2); float s = acc[jj];
#pragma unroll
              for (int q = 0; q < 16; ++q) { const f32x4 w = pw[q]; s += w.x * gr[2 * q] - w.y * gi[2 * q]; s += w.z * gr[2 * q + 1] - w.w * gi[2 * q + 1]; }
              acc[jj] = s; }
      }
#pragma unroll
      for (int jj = 0; jj < 8; ++jj) KT[((dir * 4 + hl) * 32 + jg * 8 + jj) * 16 + hi] = acc[jj]; }
    __syncthreads();
    LAS float* KC = PAR + 2 * 64 * 4;
    for (int i = tid; i < 4 * 63 * 16; i += NWAVES * 64) { const int hl = i / (63 * 16), r = i % (63 * 16), d = (r >> 4) - 31, hi = r & 15; float x = 0.f;
        if (d >= 0) x += KT[((0 * 4 + hl) * 32 + d) * 16 + hi]; if (d <= 0) x += KT[((1 * 4 + hl) * 32 - d) * 16 + hi];
        if (d == 0 && hi == hq * 4 + hl) x += F.in[14][g * 16 + hi];
        KC[(hl * 64 + d + 31) * 16 + hi] = x; }
    __syncthreads();
    for (int ch = tid; ch < 128 * 96; ch += NWAVES * 64) { const int rl = ch / 96, cc = ch % 96, t = rl >> 2, hl = rl & 3, ho = hq * 4 + hl; float v[8];
        if (cc < 64) { const int s = cc >> 1, hi0 = (cc & 1) * 8; const LAS f32x4* kp = (const LAS f32x4*)(KC + (hl * 64 + t - s + 31) * 16 + hi0); const f32x4 a = kp[0], c = kp[1];
            v[0] = a.x; v[1] = a.y; v[2] = a.z; v[3] = a.w; v[4] = c.x; v[5] = c.y; v[6] = c.z; v[7] = c.w;
        } else { const int kk = (cc - 64) * 8, dir = kk >> 7, reim = (kk >> 6) & 1, p0 = kk & 63, e = dir == 0 ? t + 1 : 32 - t;
#pragma unroll
            for (int j = 0; j < 8; ++j) { const int p = p0 + j; const float cr = CC[((dir * 4 + hl) * 64 + p) * 2], ci = CC[((dir * 4 + hl) * 64 + p) * 2 + 1], pr = POW[((dir * 33 + e) * 64 + p) * 2], pi = POW[((dir * 33 + e) * 64 + p) * 2 + 1];
                v[j] = reim == 0 ? (cr * pr - ci * pi) : -(cr * pi + ci * pr); } }
        v4u o; o.x = pk2(v[0], v[1]); o.y = pk2(v[2], v[3]); o.z = pk2(v[4], v[5]); o.w = pk2(v[6], v[7]);
        *(GAS v4u*)(MEXT + ((size_t)g * 512 + t * 16 + ho) * UGP + cc * 8) = o; }
    __syncthreads();
}
__device__ __forceinline__ TItem titem_decode(int it, const float* w_in, const float* w_glu, const float* w_ab, const float* w_sb, const float* w_o, const float* w_g, const float* w_u, const float* w_d, unsigned char* ws) {
    constexpr int I_IN = 16 * 104, I_GLU = 8 * 16, I_BR = 8 * 32, I_O = 16 * 32, I_E = 16 * 32;
    TItem t; int r = it;
          if (r < I_IN) { const int kb = r / 104, nb = r % 104; t.src = w_in + (size_t)(64 * kb) * INW + 32 * nb; t.N = INW; t.K = 1024; t.dst = (bf16*)(ws + WS_WIN) + (size_t)(32 * nb) * 1024 + 64 * kb; return t; } r -= I_IN;
          if (r < I_GLU) { const int kb = r / 16, nb = r % 16; t.src = w_glu + (size_t)(64 * kb) * 512 + 32 * nb; t.N = 512; t.K = 512; t.dst = (bf16*)(ws + WS_WGLU) + (size_t)(32 * nb) * 512 + 64 * kb; return t; } r -= I_GLU;
          if (r < I_BR) { const int kb = r / 32, nb = r % 32; t.src = w_ab + (size_t)(64 * kb) * 1024 + 32 * nb; t.N = 1024; t.K = 512; t.dst = (bf16*)(ws + WS_WAB) + (size_t)(32 * nb) * 512 + 64 * kb; return t; } r -= I_BR;
          if (r < I_BR) { const int kb = r / 32, nb = r % 32; t.src = w_sb + (size_t)(64 * kb) * 1024 + 32 * nb; t.N = 1024; t.K = 512; t.dst = (bf16*)(ws + WS_WSB) + (size_t)(32 * nb) * 512 + 64 * kb; return t; } r -= I_BR;
          if (r < I_O) { const int kb = r / 32, nb = r % 32; t.src = w_o + (size_t)(64 * kb) * 1024 + 32 * nb; t.N = 1024; t.K = 1024; t.dst = (bf16*)(ws + WS_WO) + (size_t)(32 * nb) * 1024 + 64 * kb; return t; } r -= I_O;
          const int e = r / (3 * I_E), which = (r / I_E) % 3, q = r % I_E, kb = q / 32, nb = q % 32, n0 = 32 * nb;
          const float* W = (which == 0 ? w_g : which == 1 ? w_u : w_d) + (size_t)e * 1024 * 1024;
          t.src = W + (size_t)(64 * kb) * 1024 + n0; t.N = 1024; t.K = 1024;
          const int drow0 = which < 2 ? e * 2048 + (n0 >> 7) * 256 + which * 128 + (n0 & 127) : e * 1024 + n0;
          t.dst = (bf16*)(ws + (which < 2 ? WS_WGU : WS_WD)) + (size_t)drow0 * 1024 + 64 * kb; return t; }
__device__ __forceinline__ void bg_convert(Frame& F, int done_word, unsigned n_main) {
    LAS float* scr = (LAS float*)(F.lds + RING_OFF + F.wave * 16384);
    volatile LAS unsigned* bc = F.MISC + 16;
    for (;;) {
        __syncthreads();
        if (F.tid == 0) { unsigned base = 0xffffffffu;
            const bool stop = n_main != 0u && __hip_atomic_load(F.ctl + done_word, RLX_AGENT) >= n_main;
            if (!stop) base = __hip_atomic_fetch_add(F.ctl + CW_Q, 8u, RLX_AGENT);
            bc[0] = base; }
        __syncthreads();
        const unsigned base = bc[0];
        if (base >= (unsigned)N_EXP_ITEMS) break;
        const TItem t = titem_decode(N_DENSE_ITEMS + (int)base + F.wave, F.in[4], F.in[15], F.in[17], F.in[18], F.in[19], F.in[23], F.in[24], F.in[25], F.ws);
        f32x4 v[8]; titem_load(t, v, F.lane); titem_store(t, v, scr, F.lane);
    }
}
__device__ __forceinline__ void bg_work(Frame& F, int done_word, unsigned n_main) {
    volatile LAS unsigned* bc = F.MISC + 17;
    for (;;) {
        __syncthreads();
        if (F.tid == 0) bc[0] = __hip_atomic_fetch_add(F.ctl + CW_QM, 1u, RLX_AGENT);
        __syncthreads();
        const unsigned it = bc[0];
        if (it >= 128u) break;
        mext_item(F, (int)it);
    }
    bg_convert(F, done_word, n_main);
}
__device__ __forceinline__ void main_done(Frame& F, int done_word) { __syncthreads(); if (F.tid == 0) __hip_atomic_fetch_add(F.ctl + done_word, 1u, RLX_AGENT); }
__device__ __forceinline__ void p0_prologue(Frame& F) {
    const int gw = F.vcu * NWAVES + F.wave, NGW = F.G * NWAVES, lane = F.lane, tid = F.tid;
    unsigned char* ws = F.ws;
    LAS float* scr = (LAS float*)(F.lds + RING_OFF + F.wave * 16384);
    { bf16* WST = (bf16*)(ws + WS_WST);
      for (int it = gw; it < NG * 256; it += NGW) { const int g = it >> 8, n = it & 255, dir = n >> 7, reim = (n >> 6) & 1, p = n & 63; float lr, li, cr, ci; ssm_par(F, dir * 32 + g, p, lr, li, cr, ci);
          const int t = lane >> 1, h0 = (lane & 1) * 8; float pr, pi; cpow(lr, li, (float)(dir == 0 ? 31 - t : t), pr, pi);
          const float er = pr * cr - pi * ci, ei = pr * ci + pi * cr; const size_t o = ((size_t)(dir * 32 + g) * 64 + p) * 16 + h0; float v[8];
#pragma unroll
          for (int j = 0; j < 8; ++j) { const float br = F.in[10][o + j], bi = F.in[11][o + j]; v[j] = reim == 0 ? (er * br - ei * bi) : (er * bi + ei * br); }
          v4u w; w.x = pk2(v[0], v[1]); w.y = pk2(v[2], v[3]); w.z = pk2(v[4], v[5]); w.w = pk2(v[6], v[7]);
          *(GAS v4u*)(WST + ((size_t)g * 256 + n) * 512 + lane * 8) = w; } }
    { constexpr int NIT = N_DENSE_ITEMS;
      f32x4 va[8], vb[8]; TItem ta, tb;
      int it = gw;
      if (it < NIT) { ta = titem_decode(it, F.in[4], F.in[15], F.in[17], F.in[18], F.in[19], F.in[23], F.in[24], F.in[25], ws); titem_load(ta, va, lane); }
      while (it < NIT) {
          const int i1 = it + NGW; if (i1 < NIT) { tb = titem_decode(i1, F.in[4], F.in[15], F.in[17], F.in[18], F.in[19], F.in[23], F.in[24], F.in[25], ws); titem_load(tb, vb, lane); }
          titem_store(ta, va, scr, lane);
          if (i1 >= NIT) break;
          const int i2 = i1 + NGW; if (i2 < NIT) { ta = titem_decode(i2, F.in[4], F.in[15], F.in[17], F.in[18], F.in[19], F.in[23], F.in[24], F.in[25], ws); titem_load(ta, va, lane); }
          titem_store(tb, vb, scr, lane);
          it = i2;
      } }
    { bf16* XN = (bf16*)(ws + WS_XN); f32x2_t2* ST = (f32x2_t2*)(ws + WS_STATS0);
      for (int r = gw; r < M + NMETA; r += NGW) { const float* src = r < M ? F.in[0] + (size_t)r * DM : F.in[1] + (size_t)(r - M) * DM;
          const GAS f32x4* xr = (const GAS f32x4*)src + lane; f32x4 v[4]; float s = 0.f;
#pragma unroll
          for (int j = 0; j < 4; ++j) { v[j] = xr[64 * j]; s += (v[j].x + v[j].y) + (v[j].z + v[j].w); }
          const float mean = wave_sum(s) * (1.f / DM); float s2 = 0.f;
#pragma unroll
          for (int j = 0; j < 4; ++j) { v[j] = v[j] - mean; s2 += (v[j].x * v[j].x + v[j].y * v[j].y) + (v[j].z * v[j].z + v[j].w * v[j].w); }
          const float rstd = 1.f / sqrtf(wave_sum(s2) * (1.f / DM) + LN_EPS);
          if (r < M && lane == 0) ST[r] = (f32x2_t2){mean, rstd};
          GAS unsigned long long* o8 = (GAS unsigned long long*)(XN + (size_t)r * DM) + lane;
#pragma unroll
          for (int j = 0; j < 4; ++j) { const f32x4 gg = ((const GAS f32x4*)F.in[2])[lane + 64 * j], bb = ((const GAS f32x4*)F.in[3])[lane + 64 * j]; const f32x4 o = v[j] * rstd * gg + bb;
              o8[64 * j] = (unsigned long long)pk2(o.x, o.y) | ((unsigned long long)pk2(o.z, o.w) << 32); } } }
    { const int gt = F.vcu * (NWAVES * 64) + tid, NT_ = F.G * NWAVES * 64;
      for (int i = gt; i < 2 * 2 * 112 * 16; i += NT_) { const int arr = i / (2 * 112 * 16), b = (i / (112 * 16)) & 1, q = i % (112 * 16);
          *(GAS v4u*)((bf16*)(ws + (arr ? WS_V : WS_K)) + ((size_t)b * KVROWS + KVALID) * 128 + q * 8) = (v4u){0u, 0u, 0u, 0u}; }
      float* RP = (float*)(ws + WS_ROPE);
      for (int i = gt; i < 3072; i += NT_) { const bool isr = i < 2048; const int q = isr ? i : i - 2048, pos = q >> 4, j = q & 15; const float ang = (float)pos * powf(10000.f, -(float)j / 16.f);
          float sn, cs; sincosf(ang, &sn, &cs); if (isr) { RP[q] = cs; RP[2048 + q] = sn; } else { RP[4096 + q] = cs; RP[5120 + q] = sn; } }
      for (int i = gt; i < 128; i += NT_) RP[6144 + i] = i < 64 ? F.in[5][i] : F.in[6][i - 64]; }
}

__device__ __forceinline__ void qk_prep(Frame& F) {
    const int gw = F.vcu * NWAVES + F.wave, NGW = F.G * NWAVES, lane = F.lane;
    bf16* Q = (bf16*)(F.ws + WS_Q); bf16* K = (bf16*)(F.ws + WS_K); const float* RP = (const float*)(F.ws + WS_ROPE);
    constexpr int NQ = M * 8, NK = 2 * KVALID * 2;
    for (int it = gw; it < NQ + NK; it += NGW) {
        bf16* p; int pos; float gsc, osc;
        if (it < NQ) { const int row = it >> 3, h = it & 7; p = Q + (size_t)row * 512 + h * 64; pos = row & 8191; gsc = F.in[5][lane]; osc = C2Q; }
        else { const int r = it - NQ, b = r / (KVALID * 2), q = r % (KVALID * 2), l = q >> 1, kvh = q & 1; p = K + ((size_t)b * KVROWS + l) * 128 + kvh * 64; pos = l - NMETA; gsc = F.in[6][lane]; osc = 1.f; }
        const float x = bf2f(p[lane]);
        const float ss = wave_sum(x * x) * (1.f / 64.f);
        const float y = x * rsqrtf(ss + QK_EPS) * gsc, yo = __shfl_xor(y, 1);
        float cs = 1.f, sn = 0.f;
        if (pos >= 0) { const int j = lane >> 1; if (j < 16) { cs = RP[(pos >> 6) * 16 + j]; sn = RP[2048 + (pos >> 6) * 16 + j]; } else { cs = RP[4096 + (pos & 63) * 16 + j - 16]; sn = RP[5120 + (pos & 63) * 16 + j - 16]; } }
        const float o = ((lane & 1) ? (yo * sn + y * cs) : (y * cs - yo * sn)) * osc;
        p[lane] = (bf16)f2bf(o);
    }
}

__device__ __forceinline__ void ssm_scan(Frame& F) {
    if (F.wave != 0 || blockIdx.x >= 128) return;
    const int it = blockIdx.x, b = it >> 6, g = (it >> 1) & 31, dir = it & 1, p = F.lane;
    float lr, li, cr, ci; ssm_par(F, dir * 32 + g, p, lr, li, cr, ci);
    float a32r, a32i; cpow(lr, li, 32.f, a32r, a32i);
    const float* S = (const float*)(F.ws + WS_S) + (size_t)(g * 2 + b) * 256 * 256 + dir * 128 + p;
    bf16* U = (bf16*)(F.ws + WS_UG2) + (size_t)(g * 2 + b) * 256 * UGP + 512 + dir * 128 + p;
    float sr = 0.f, si = 0.f;
    if (dir == 0) {
        float a1r, a1i; cpow(lr, li, 1.f, a1r, a1i);
        const bf16* um = (const bf16*)(F.ws + WS_UMETA) + (size_t)g * 256; const size_t o = ((size_t)g * 64 + p) * 16;
        float bbr[16], bbi[16];
#pragma unroll
        for (int h = 0; h < 16; ++h) { const float br = F.in[10][o + h], bi = F.in[11][o + h]; bbr[h] = cr * br - ci * bi; bbi[h] = cr * bi + ci * br; }
        for (int t = 0; t < 16; ++t) { float bur = 0.f, bui = 0.f;
#pragma unroll
            for (int h = 0; h < 16; ++h) { const float uv = bf2f(um[t * 16 + h]); bur = fmaf(bbr[h], uv, bur); bui = fmaf(bbi[h], uv, bui); }
            const float nr = a1r * sr - a1i * si + bur, ni = a1r * si + a1i * sr + bui; sr = nr; si = ni; }
    }
    for (int c0 = 0; c0 < 256; c0 += 32) {
        float vr[32], vi[32];
#pragma unroll
        for (int k = 0; k < 32; ++k) { const int c = dir == 0 ? c0 + k : 255 - (c0 + k); vr[k] = S[(size_t)c * 256]; vi[k] = S[(size_t)c * 256 + 64]; }
#pragma unroll
        for (int k = 0; k < 32; ++k) { const int c = dir == 0 ? c0 + k : 255 - (c0 + k);
            U[(size_t)c * UGP] = (bf16)f2bf(sr); U[(size_t)c * UGP + 64] = (bf16)f2bf(si);
            const float nr = a32r * sr - a32i * si + vr[k], ni = a32r * si + a32i * sr + vi[k]; sr = nr; si = ni; }
    }
}

__device__ __forceinline__ float treduce16(const float (&v)[16], int lane) {
    float r8[8], r4[4], r2[2], r1;
    { const bool up = lane & 32;
#pragma unroll
      for (int i = 0; i < 8; ++i) { const float keep = up ? v[i + 8] : v[i], send = up ? v[i] : v[i + 8]; r8[i] = keep + xor32f(send, lane); } }
    { const bool up = lane & 16;
#pragma unroll
      for (int i = 0; i < 4; ++i) { const float keep = up ? r8[i + 4] : r8[i], send = up ? r8[i] : r8[i + 4]; r4[i] = keep + xor16f(send, lane); } }
    { const bool up = lane & 8;
#pragma unroll
      for (int i = 0; i < 2; ++i) { const float keep = up ? r4[i + 2] : r4[i], send = up ? r4[i] : r4[i + 2]; r2[i] = keep + dppf<0x140>(send); } }
    { const bool up = lane & 4; const float keep = up ? r2[1] : r2[0], send = up ? r2[0] : r2[1]; r1 = keep + dppf<0x141>(send); }
    r1 += dppf<0x4E>(r1); r1 += dppf<0xB1>(r1);
    return r1;
}
__device__ __forceinline__ void ln1_router(Frame& F) {
    const int gw = F.vcu * NWAVES + F.wave, NGW = F.G * NWAVES, lane = F.lane;
    LAS float* WRT = (LAS float*)(F.lds + RING_OFF);
    for (int i = F.tid; i < 16 * 1024; i += NWAVES * 64) { const int d = i >> 4, e = i & 15; WRT[e * 1024 + d] = F.in[22][i]; }
    __syncthreads();
    const float* PRE = F.out; bf16* H1 = (bf16*)(F.ws + WS_H1); f32x2_t2* ST = (f32x2_t2*)(F.ws + WS_STATS1); float* AFF = (float*)(F.ws + WS_AFF);
    f32x4 nx[4];
    if (gw < M) { const GAS f32x4* xr0 = (const GAS f32x4*)(PRE + (size_t)gw * DM) + lane;
#pragma unroll
        for (int j = 0; j < 4; ++j) nx[j] = xr0[64 * j]; }
    for (int r = gw; r < M; r += NGW) {
        f32x4 v[4]; float s = 0.f;
#pragma unroll
        for (int j = 0; j < 4; ++j) { v[j] = nx[j]; s += (v[j].x + v[j].y) + (v[j].z + v[j].w); }
        if (r + NGW < M) { const GAS f32x4* xr1 = (const GAS f32x4*)(PRE + (size_t)(r + NGW) * DM) + lane;
#pragma unroll
            for (int j = 0; j < 4; ++j) nx[j] = xr1[64 * j]; }
        const float mean = wave_sum(s) * (1.f / DM); float s2 = 0.f;
#pragma unroll
        for (int j = 0; j < 4; ++j) { v[j] = v[j] - mean; s2 += (v[j].x * v[j].x + v[j].y * v[j].y) + (v[j].z * v[j].z + v[j].w * v[j].w); }
        const float rstd = 1.f / sqrtf(wave_sum(s2) * (1.f / DM) + LN_EPS);
        if (lane == 0) ST[r] = (f32x2_t2){mean, rstd};
        GAS unsigned long long* o8 = (GAS unsigned long long*)(H1 + (size_t)r * DM) + lane;
#pragma unroll
        for (int j = 0; j < 4; ++j) { const f32x4 gg = ((const GAS f32x4*)F.in[20])[lane + 64 * j], bb = ((const GAS f32x4*)F.in[21])[lane + 64 * j]; v[j] = v[j] * rstd * gg + bb;
            o8[64 * j] = (unsigned long long)pk2(v[j].x, v[j].y) | ((unsigned long long)pk2(v[j].z, v[j].w) << 32); }
        float acc[16];
        asm volatile("" ::: "memory");
#pragma unroll
        for (int e = 0; e < 16; ++e) { float a = 0.f;
#pragma unroll
            for (int j = 0; j < 4; ++j) { const f32x4 w = *(const LAS f32x4*)(WRT + e * 1024 + (lane + 64 * j) * 4); a += (v[j].x * w.x + v[j].y * w.y) + (v[j].z * w.z + v[j].w * w.w); }
            acc[e] = a; }
        const float lg = treduce16(acc, lane);
        float mx = lg; mx = fmaxf(mx, dppf<0x141>(mx)); mx = fmaxf(mx, dppf<0x140>(mx)); mx = fmaxf(mx, xor16f(mx, lane)); mx = fmaxf(mx, xor32f(mx, lane));
        const float ex = expf(lg - mx); float sm = ex; sm += dppf<0x141>(sm); sm += dppf<0x140>(sm); sm += xor16f(sm, lane); sm += xor32f(sm, lane);
        if ((lane & 3) == 0) AFF[((size_t)(r >> 13) * NE + (lane >> 2)) * SEQ + (r & 8191)] = ex / sm;
    }
}

__device__ __forceinline__ void topk_phase(Frame& F) {
    if (blockIdx.x >= BATCH * NE) return;
    const int be = blockIdx.x, b = be >> 4, e = be & 15, t = F.tid, lane = F.lane, w = F.wave;
    LAS int* red = (LAS int*)(F.lds + RING_OFF); LAS int* sc_gt = red + 64; LAS int* sc_eq = sc_gt + 16;
    const float* a = (const float*)(F.ws + WS_AFF) + (size_t)be * SEQ;
    unsigned v[16];
#pragma unroll
    for (int i = 0; i < 16; ++i) v[i] = __float_as_uint(a[t * 16 + i]);
    unsigned thr = 0u;
    for (int step = 0; step < 16; ++step) {
        const int shift = step == 0 ? 30 : 30 - 2 * step; const int nk = step == 0 ? 1 : 3;
        int c1 = 0, c2 = 0, c3 = 0;
        const unsigned t1 = thr | (1u << shift), t2 = thr | (2u << shift), t3 = thr | (3u << shift);
#pragma unroll
        for (int i = 0; i < 16; ++i) { c1 += (v[i] >= t1) ? 1 : 0; if (nk == 3) { c2 += (v[i] >= t2) ? 1 : 0; c3 += (v[i] >= t3) ? 1 : 0; } }
#pragma unroll
        for (int o = 32; o > 0; o >>= 1) { c1 += __shfl_xor(c1, o); c2 += __shfl_xor(c2, o); c3 += __shfl_xor(c3, o); }
        LAS int* rb = red + (step & 1) * 32;
        if (lane == 0) { rb[w * 4] = c1; rb[w * 4 + 1] = c2; rb[w * 4 + 2] = c3; }
        __syncthreads();
        int s1 = 0, s2 = 0, s3 = 0;
#pragma unroll
        for (int k = 0; k < 8; ++k) { s1 += rb[k * 4]; s2 += rb[k * 4 + 1]; s3 += rb[k * 4 + 2]; }
        if (nk == 3 && s3 >= CAP) thr = t3; else if (nk == 3 && s2 >= CAP) thr = t2; else if (s1 >= CAP) thr = t1;
    }
    int ngt = 0, neq = 0;
#pragma unroll
    for (int i = 0; i < 16; ++i) { ngt += (v[i] > thr) ? 1 : 0; neq += (v[i] == thr) ? 1 : 0; }
    int ig = ngt, ie = neq;
#pragma unroll
    for (int o = 1; o < 64; o <<= 1) { const int pg = __shfl_up(ig, o), pe = __shfl_up(ie, o); if (lane >= o) { ig += pg; ie += pe; } }
    __syncthreads();
    if (lane == 63) { sc_gt[w] = ig; sc_eq[w] = ie; }
    __syncthreads();
    int wg_off = 0, we_off = 0, tot_gt = 0;
#pragma unroll
    for (int k = 0; k < 8; ++k) { const int a = sc_gt[k], c2 = sc_eq[k]; if (k < w) { wg_off += a; we_off += c2; } tot_gt += a; }
    const int quota = CAP - tot_gt; int gpre = wg_off + ig - ngt, epre = we_off + ie - neq;
    int* IDX2 = (int*)(F.ws + WS_IDX2); float* GATE2 = (float*)(F.ws + WS_GATE2); int* SLOTOF = (int*)(F.ws + WS_SLOTOF);
#pragma unroll
    for (int i = 0; i < 16; ++i) {
        const bool gt = v[i] > thr, eq = v[i] == thr, sel = gt || (eq && epre < quota);
        const int tok = t * 16 + i; int so = -1;
        if (sel) { const int slot = gpre + (epre < quota ? epre : quota); so = e * 2048 + b * 1024 + slot; IDX2[so] = b * SEQ + tok; GATE2[so] = __uint_as_float(v[i]); }
        SLOTOF[((size_t)b * SEQ + tok) * NE + e] = so;
        gpre += gt ? 1 : 0; epre += eq ? 1 : 0;
    }
    __syncthreads();
}

__device__ __forceinline__ void gather_phase(Frame& F) {
    const int gw = F.vcu * NWAVES + F.wave, NGW = F.G * NWAVES, lane = F.lane;
    const int* IDX2 = (const int*)(F.ws + WS_IDX2); const bf16* H1 = (const bf16*)(F.ws + WS_H1); bf16* XE = (bf16*)(F.ws + WS_XE);
    for (int r = gw; r < NE * 2048; r += NGW) { const int src = IDX2[r];
        const GAS v4u* s = (const GAS v4u*)(H1 + (size_t)src * DM) + lane; GAS v4u* d = (GAS v4u*)(XE + (size_t)r * DM) + lane;
        const v4u a = s[0], c = s[64]; d[0] = a; d[64] = c; }
}

__device__ __forceinline__ void final_phase(Frame& F) {
    const int gw = F.vcu * NWAVES + F.wave, NGW = F.G * NWAVES, lane = F.lane;
    float* OUT = F.out; const f32x2_t2* ST = (const f32x2_t2*)(F.ws + WS_STATS1); const int* SLOTOF = (const int*)(F.ws + WS_SLOTOF); const bf16* YE = (const bf16*)(F.ws + WS_XE);
    f32x4 nx[4]; int nslot = -1; f32x2_t2 nst = (f32x2_t2){0.f, 0.f};
    if (gw < M) { const GAS f32x4* xr0 = (const GAS f32x4*)(OUT + (size_t)gw * DM) + lane;
#pragma unroll
        for (int j = 0; j < 4; ++j) nx[j] = xr0[64 * j];
        nslot = SLOTOF[(size_t)gw * NE + (lane & 15)]; nst = ST[gw]; }
    for (int r = gw; r < M; r += NGW) {
        GAS f32x4* xr = (GAS f32x4*)(OUT + (size_t)r * DM) + lane; f32x4 v[4]; const f32x2_t2 st = nst; const int myslot = nslot;
#pragma unroll
        for (int j = 0; j < 4; ++j) v[j] = nx[j];
        if (r + NGW < M) { const GAS f32x4* xr1 = (const GAS f32x4*)(OUT + (size_t)(r + NGW) * DM) + lane;
#pragma unroll
            for (int j = 0; j < 4; ++j) nx[j] = xr1[64 * j];
            nslot = SLOTOF[(size_t)(r + NGW) * NE + (lane & 15)]; nst = ST[r + NGW]; }
#pragma unroll
        for (int j = 0; j < 4; ++j) { const f32x4 gg = ((const GAS f32x4*)F.in[20])[lane + 64 * j], bb = ((const GAS f32x4*)F.in[21])[lane + 64 * j]; v[j] = ((v[j] - st.x) * st.y * gg + bb) * ALPHA; }
        unsigned long long msk = __ballot(myslot >= 0) & 0xffffull;
        while (msk) {
            const int e0 = __builtin_ctzll(msk); msk &= msk - 1; const int sl0 = __shfl(myslot, e0);
            int sl1 = -1; if (msk) { const int e1 = __builtin_ctzll(msk); msk &= msk - 1; sl1 = __shfl(myslot, e1); }
            const GAS u32x2_t* y0 = (const GAS u32x2_t*)(YE + (size_t)sl0 * DM) + lane; const GAS u32x2_t* y1 = (const GAS u32x2_t*)(YE + (size_t)(sl1 >= 0 ? sl1 : sl0) * DM) + lane;
            u32x2_t a[4], c[4];
#pragma unroll
            for (int j = 0; j < 4; ++j) { a[j] = y0[64 * j]; c[j] = y1[64 * j]; }
            const float w1 = sl1 >= 0 ? 1.f : 0.f;
#pragma unroll
            for (int j = 0; j < 4; ++j) { v[j].x += bflo(a[j].x) + w1 * bflo(c[j].x); v[j].y += bfhi(a[j].x) + w1 * bfhi(c[j].x); v[j].z += bflo(a[j].y) + w1 * bflo(c[j].y); v[j].w += bfhi(a[j].y) + w1 * bfhi(c[j].y); }
        }
        float s = 0.f;
#pragma unroll
        for (int j = 0; j < 4; ++j) s += (v[j].x + v[j].y) + (v[j].z + v[j].w);
        const float mean = wave_sum(s) * (1.f / DM); float s2 = 0.f;
#pragma unroll
        for (int j = 0; j < 4; ++j) { v[j] = v[j] - mean; s2 += (v[j].x * v[j].x + v[j].y * v[j].y) + (v[j].z * v[j].z + v[j].w * v[j].w); }
        const float rstd = 1.f / sqrtf(wave_sum(s2) * (1.f / DM) + LN_EPS);
#pragma unroll
        for (int j = 0; j < 4; ++j) { const f32x4 gg = ((const GAS f32x4*)F.in[26])[lane + 64 * j], bb = ((const GAS f32x4*)F.in[27])[lane + 64 * j]; xr[64 * j] = v[j] * rstd * gg + bb; }
    }
}

#ifndef MK_PER_PHASE
#define MK_PER_PHASE 0
#endif
constexpr int N_PHASES = 16;
struct Args { const float* in[28]; float* out; unsigned char* ws; int ph_lo, ph_hi; };
__global__ void __launch_bounds__(NWAVES * 64, 2) mk_fwd(Args args) {
    extern __shared__ __attribute__((aligned(16))) unsigned char lds[];
    Frame F;
    F.lds = (LAS unsigned char*)lds; F.MISC = (volatile LAS unsigned*)(F.lds + MISC_OFF);
    F.tid = threadIdx.x; F.lane = F.tid & 63; F.wave = __builtin_amdgcn_readfirstlane(F.tid >> 6);
    F.G = gridDim.x; { const int bx = blockIdx.x; F.vcu = (F.G % 8 == 0) ? (bx % 8) * (F.G / 8) + bx / 8 : bx; }
    F.ws = args.ws; F.ctl = (gu32*)(args.ws + WS_CTL); F.out = args.out;
#pragma unroll
    for (int i = 0; i < 28; ++i) F.in[i] = args.in[i];
    for (int u = F.tid; u < (LDS_BYTES - LDSCTL_OFF) / 4; u += NWAVES * 64) ((LAS unsigned*)(F.lds + LDSCTL_OFF))[u] = 0u;
    __syncthreads();
    XcdBarrier bar; bar.bar = (unsigned*)(F.ctl + CW_BAR); bar.x = 0; bar.st = nullptr;
    if (!MK_PER_PHASE) bar = xcd_barrier_post((unsigned*)(F.ctl + CW_BAR), F.MISC + 8);
    const int lo = args.ph_lo, hi = args.ph_hi;
    unsigned char* ws = args.ws;
#ifndef PROBE_LO
#define PROBE_LO -1
#define PROBE_HI -1
#endif
    unsigned long long pr_t0 = 0ull, pr_t1 = 0ull;
#define IN(k) (lo <= (k) && (k) < hi)
#define SEAM(k) do { if (IN(k) && IN((k) + 1)) xcd_barrier(bar); if (PROBE_LO >= 0 && (k) + 1 == PROBE_LO) pr_t0 = rt(); if (PROBE_LO >= 0 && (k) + 1 == PROBE_HI) pr_t1 = rt(); } while (0)
    if (PROBE_LO == 0) pr_t0 = rt();
    using pg8::Gemm; using pg8::gemm_phase;
    if (IN(0)) { p0_prologue(F); } SEAM(0);
    if (IN(1)) { Gemm g{(const bf16*)(ws + WS_XN), (const bf16*)(ws + WS_WIN), 1024, 1024, 1024}; InProjOrder S; S.so.init(M, INW, F.G, (int)blockIdx.x);
        EpiInProj E{(bf16*)(ws + WS_Q), (bf16*)(ws + WS_K), (bf16*)(ws + WS_V), (bf16*)(ws + WS_UG2), (bf16*)args.out, (bf16*)(ws + WS_UMETA), (LAS float*)(F.lds + XCH_OFF), (const float*)(ws + WS_ROPE) + 6144, (const float*)(ws + WS_ROPE)};
        gemm_phase<EpiInProj, InProjOrder, true, true>(F.lds + RING_OFF, g, S, E);
        if ((long)3 * F.G + (long)blockIdx.x < 835) main_done(F, CW_DONE + 64 * 1); else bg_work(F, CW_DONE + 64 * 1, (unsigned)(835 - 3 * F.G)); } SEAM(1);
    if (IN(2)) {
        Gemm g{(const bf16*)(ws + WS_UG2), (const bf16*)(ws + WS_WST), UGP, 512, 512}; SsmStateOrder S{F.G, (int)blockIdx.x}; EpiSsmState E{(float*)(ws + WS_S)};
        gemm_phase<EpiSsmState, SsmStateOrder, true, true>(F.lds + RING_OFF, g, S, E);
        if (blockIdx.x < 64) main_done(F, CW_DONE + 64 * 2); else bg_work(F, CW_DONE + 64 * 2, 64u); } SEAM(2);
    if (IN(3)) { ssm_scan(F); __syncthreads();
        const attn_body::AttnTensors AT{(const attn_body::bf16*)(ws + WS_Q), (const attn_body::bf16*)(ws + WS_K), (const attn_body::bf16*)(ws + WS_V), (attn_body::bf16*)(ws + WS_Q)};
        const attn_body::StaticOrder S((int)F.G, (int)blockIdx.x);
        attn_body::attn_phase<attn_body::StaticOrder>((char*)lds + RING_OFF, AT, S); } SEAM(3);
    if (IN(4)) { Gemm g{(const bf16*)(ws + WS_UG2), (const bf16*)(ws + WS_MEXT), UGP, UGP, UGP}; SsmYOrder S{F.G, (int)blockIdx.x}; EpiSsmY E{(bf16*)(ws + WS_YG)};
        gemm_phase<EpiSsmY, SsmYOrder, true, true>(F.lds + RING_OFF, g, S, E);
        if (blockIdx.x < 128) main_done(F, CW_DONE + 64 * 4); else bg_convert(F, CW_DONE + 64 * 4, 128u); } SEAM(4);
    if (IN(5)) { Gemm g{(const bf16*)(ws + WS_YG), (const bf16*)(ws + WS_WGLU), 512, 512, 512}; pg8::StaticOrder S; S.init(M, 512, F.G, (int)blockIdx.x); EpiGlu E{(const bf16*)(ws + WS_YG), F.in[16], (bf16*)(ws + WS_Z)};
        gemm_phase<EpiGlu, pg8::StaticOrder, true, true>(F.lds + RING_OFF, g, S, E);
        if (blockIdx.x < 128) main_done(F, CW_DONE + 64 * 5); else bg_convert(F, CW_DONE + 64 * 5, 128u); } SEAM(5);
    if (IN(6)) { Gemm g{(const bf16*)(ws + WS_Q), (const bf16*)(ws + WS_WAB), 512, 512, 512}; pg8::StaticOrder S; S.init(M, 1024, F.G, (int)blockIdx.x); EpiBranch<0> E{(const bf16*)args.out, nullptr, (bf16*)(ws + WS_T1)};
        gemm_phase<EpiBranch<0>, pg8::StaticOrder, true, true>(F.lds + RING_OFF, g, S, E); } SEAM(6);
    if (IN(7)) { Gemm g{(const bf16*)(ws + WS_Z), (const bf16*)(ws + WS_WSB), 512, 512, 512}; pg8::StaticOrder S; S.init(M, 1024, F.G, (int)blockIdx.x); EpiBranch<1> E{(const bf16*)args.out, (const bf16*)(ws + WS_T1), (bf16*)(ws + WS_MERGED)};
        gemm_phase<EpiBranch<1>, pg8::StaticOrder, true, true>(F.lds + RING_OFF, g, S, E); } SEAM(7);
    if (IN(8)) { Gemm g{(const bf16*)(ws + WS_MERGED), (const bf16*)(ws + WS_WO), 1024, 1024, 1024}; pg8::StaticOrder S; S.init(M, 1024, F.G, (int)blockIdx.x);
        EpiPre1 E{F.in[0], F.in[2], F.in[3], (const f32x2_t2*)(ws + WS_STATS0), args.out};
        gemm_phase<EpiPre1, pg8::StaticOrder, true, true>(F.lds + RING_OFF, g, S, E); } SEAM(8);
    if (IN(9)) { ln1_router(F); } SEAM(9);
    if (IN(10)) { topk_phase(F); if (blockIdx.x < BATCH * NE) main_done(F, CW_DONE + 64 * 10); else bg_convert(F, CW_DONE + 64 * 10, (unsigned)(BATCH * NE)); } SEAM(10);
    if (IN(11)) { gather_phase(F); bg_convert(F, 0, 0u); } SEAM(11);
    if (IN(12)) { Gemm g{(const bf16*)(ws + WS_XE), (const bf16*)(ws + WS_WGU), 1024, 1024, 1024}; MoeOrder S{F.G, (int)blockIdx.x, 8, 8}; EpiMoe1 E{(bf16*)(ws + WS_HB)};
        gemm_phase<EpiMoe1, MoeOrder, true, true>(F.lds + RING_OFF, g, S, E); } SEAM(12);
    if (IN(13)) { Gemm g{(const bf16*)(ws + WS_HB), (const bf16*)(ws + WS_WD), 1024, 1024, 1024}; MoeOrder S{F.G, (int)blockIdx.x, 8, 4}; EpiMoe2 E{(const float*)(ws + WS_GATE2), (bf16*)(ws + WS_XE)};
        gemm_phase<EpiMoe2, MoeOrder, true, true>(F.lds + RING_OFF, g, S, E); } SEAM(13);
    if (IN(14)) { final_phase(F); }
    if (PROBE_LO >= 0) { if (PROBE_HI == 15) pr_t1 = rt(); if (blockIdx.x == 0) { const unsigned long long span = (pr_t1 - pr_t0) * 8ull, ts = rt(); while (rt() - ts < span) __builtin_amdgcn_s_sleep(8); } }
#undef IN
#undef SEAM
}

extern "C" void kernel_launch(void* const* d_in, const int* in_sizes, int n_in, void* d_out, int out_size, void* d_ws, size_t ws_size, hipStream_t stream) {
    static int grid = 0;
    if (grid == 0) {
        int dev = 0, cus = 0;
        if (hipGetDevice(&dev) != hipSuccess || hipDeviceGetAttribute(&cus, hipDeviceAttributeMultiprocessorCount, dev) != hipSuccess) { fprintf(stderr, "kernel_launch: device query failed\n"); grid = -1; return; }
        if (hipFuncSetAttribute((const void*)mk_fwd, hipFuncAttributeMaxDynamicSharedMemorySize, LDS_BYTES) != hipSuccess) { fprintf(stderr, "kernel_launch: hipFuncSetAttribute failed\n"); grid = -1; return; }
        (void)hipGetLastError();
        grid = cus;
        if (grid != 256 || n_in != 28 || ws_size < WS_END) fprintf(stderr, "kernel_launch: unexpected geometry: %d CUs, %d inputs, %zu bytes of workspace\n", cus, n_in, ws_size);
    }
    if (grid < 0) return;
    (void)hipMemsetAsync((char*)d_ws + WS_CTL, 0, CTL_ZERO_BYTES, stream);
    Args a; memset(&a, 0, sizeof(a));
    for (int i = 0; i < 28; ++i) a.in[i] = (const float*)d_in[i];
    a.out = (float*)d_out; a.ws = (unsigned char*)d_ws;
#if MK_PER_PHASE
    for (int p = 0; p < N_PHASES - 1; ++p) { a.ph_lo = p; a.ph_hi = p + 1; hipLaunchKernelGGL(mk_fwd, dim3(grid), dim3(NWAVES * 64), LDS_BYTES, stream, a); }
#else
    a.ph_lo = 0; a.ph_hi = N_PHASES; hipLaunchKernelGGL(mk_fwd, dim3(grid), dim3(NWAVES * 64), LDS_BYTES, stream, a);
#endif
}
```
